# Optimizing an MI355X kernel written in HIP

```python
import math
import jax, jax.numpy as jnp
from jax import lax
import numpy as np

D_MODEL = 1024
BATCH = 2
SEQ = 16384
DEPTH = 2

CHUNK = 64
RMS_EPS = 1e-6
POOL_WINDOWS = (2, 4, 8, 16)
N_POOL_GROUPS = len(POOL_WINDOWS)
POOL_WIDTH = D_MODEL // 2
POOL_GROUP = POOL_WIDTH // N_POOL_GROUPS
CONV_CH = D_MODEL // 2
CONV_K = 3
MIX_IN0 = POOL_WIDTH + 3 * CONV_CH
HEAD_DIM = 64
N_Q_HEADS = D_MODEL // HEAD_DIM
N_KV_HEADS = 2
Q_PER_KV = N_Q_HEADS // N_KV_HEADS
WINDOW = 128
WINDOW_CHUNKS = -(-WINDOW // CHUNK)
KV_SPAN = (WINDOW_CHUNKS + 1) * CHUNK
QKV_WIDTH = (N_Q_HEADS + 2 * N_KV_HEADS) * HEAD_DIM
N_BUCKETS = 32
MAX_DISTANCE = 128
D_FF = 2816
N_EXPERTS = 8
TOP_K = 2
D_FF_EXPERT = 3584
N_EVEN = (DEPTH + 1) // 2
N_ODD = DEPTH // 2
NEG_INF = -1e30

kernel_name = 'hybrid_pool_conv_swa_moe_encoder'


def rmsnorm(x, g):
    xf = x.astype(jnp.float32)
    y = xf * lax.rsqrt(jnp.mean(xf * xf, axis=-1, keepdims=True) + RMS_EPS)
    return (y * g.astype(jnp.float32)).astype(x.dtype)


def swiglu(h, w_gate, w_up, w_down):
    return (jax.nn.silu(h @ w_gate) * (h @ w_up)) @ w_down


def multiscale_pool(u, pool_w, pool_scale):
    s = u.shape[1]
    uf = u.astype(jnp.float32)
    cs = jnp.pad(jnp.cumsum(uf, axis=1), ((0, 0), (1, 0), (0, 0)))
    t = jnp.arange(s)
    groups = []
    for g, w in enumerate(POOL_WINDOWS):
        c = cs[:, :, g * POOL_GROUP:(g + 1) * POOL_GROUP]
        hi = c[:, 1:]
        lo = jnp.pad(c[:, :s + 1 - w], ((0, 0), (w - 1, 0), (0, 0)))
        count = jnp.minimum(t + 1, w).astype(jnp.float32)[None, :, None]
        groups.append((hi - lo) / count - uf[:, :, g * POOL_GROUP:(g + 1) * POOL_GROUP])
    pooled = jnp.stack(groups, axis=2).astype(u.dtype)
    mixed = jnp.einsum('bsgc,gcd->bsgd', pooled, pool_w)
    return mixed.reshape(u.shape) * pool_scale


def causal_depthwise_conv(z, conv_w):
    c = z.shape[-1]
    return lax.conv_general_dilated(
        z, conv_w[:, None, :].astype(z.dtype), window_strides=(1,),
        padding=[(CONV_K - 1, 0)], dimension_numbers=('NWC', 'WIO', 'NWC'),
        feature_group_count=c)


def pool_conv_mixer(h, w_in, pool_w, pool_scale, conv_w, w_out):
    proj = h @ w_in
    u, gate_post, gate_pre, v = jnp.split(
        proj, [POOL_WIDTH, POOL_WIDTH + CONV_CH, POOL_WIDTH + 2 * CONV_CH], axis=-1)
    y_a = multiscale_pool(u, pool_w, pool_scale)
    y_b = gate_post * causal_depthwise_conv(gate_pre * v, conv_w)
    return jnp.concatenate([y_a, y_b], axis=-1) @ w_out


def t5_bucket(rel):
    nb = N_BUCKETS // 2
    max_exact = nb // 2
    ret = jnp.where(rel > 0, nb, 0)
    n = jnp.abs(rel)
    nf = jnp.maximum(n, 1).astype(jnp.float32)
    large = max_exact + (jnp.log(nf / max_exact) / math.log(MAX_DISTANCE / max_exact)
                         * (nb - max_exact)).astype(jnp.int32)
    large = jnp.minimum(large, nb - 1)
    return ret + jnp.where(n < max_exact, n, large)


def sliding_window_attention(h, w_qkv, b_qkv, sinks, w_o, b_o, rel_bias):
    b, s, _ = h.shape
    nc = s // CHUNK
    pad = WINDOW_CHUNKS * CHUNK
    qkv = h @ w_qkv + b_qkv
    q, k, v = jnp.split(qkv, [N_Q_HEADS * HEAD_DIM, (N_Q_HEADS + N_KV_HEADS) * HEAD_DIM], axis=-1)
    q = q.reshape(b, nc, CHUNK, N_KV_HEADS, Q_PER_KV, HEAD_DIM)

    def band(t):
        tp = jnp.pad(t.reshape(b, s, N_KV_HEADS, HEAD_DIM), ((0, 0), (pad, 0), (0, 0), (0, 0)))
        tp = tp.reshape(b, nc + WINDOW_CHUNKS, CHUNK, N_KV_HEADS, HEAD_DIM)
        return jnp.concatenate([tp[:, i:i + nc] for i in range(WINDOW_CHUNKS + 1)], axis=2)

    kb, vb = band(k), band(v)
    scores = jnp.einsum('bnqkgd,bnskd->bnkgqs', q, kb,
                        preferred_element_type=jnp.float32) * (HEAD_DIM ** -0.5)
    rel = (jnp.arange(KV_SPAN) - pad)[None, :] - jnp.arange(CHUNK)[:, None]
    bias = jnp.transpose(rel_bias[t5_bucket(rel)].astype(jnp.float32), (2, 0, 1))
    scores = scores + bias.reshape(N_KV_HEADS, Q_PER_KV, CHUNK, KV_SPAN)
    key_pos = jnp.arange(nc)[:, None] * CHUNK - pad + jnp.arange(KV_SPAN)[None, :]
    valid = (key_pos >= 0)[None, :, None, None, None, :]
    scores = jnp.where(valid, scores, NEG_INF)
    sink = sinks.astype(jnp.float32).reshape(N_KV_HEADS, Q_PER_KV)[None, None, :, :, None, None]
    m = jnp.maximum(jnp.max(scores, axis=-1, keepdims=True), sink)
    p = jnp.exp(scores - m)
    p = p / (jnp.sum(p, axis=-1, keepdims=True) + jnp.exp(sink - m))
    out = jnp.einsum('bnkgqs,bnskd->bnqkgd', p.astype(vb.dtype), vb)
    return out.reshape(b, s, N_Q_HEADS * HEAD_DIM) @ w_o + b_o


def moe_swiglu(h, w_router, w_gate, w_up, w_down):
    logits = (h @ w_router).astype(jnp.float32)
    top_vals, top_idx = lax.top_k(logits, TOP_K)
    top_w = jax.nn.softmax(top_vals, axis=-1)
    combine = jnp.einsum('bsk,bske->bse', top_w,
                         jax.nn.one_hot(top_idx, N_EXPERTS, dtype=jnp.float32)).astype(h.dtype)
    out = jnp.zeros_like(h)
    for e in range(N_EXPERTS):
        out = out + combine[..., e:e + 1] * swiglu(h, w_gate[e], w_up[e], w_down[e])
    return out


def setup_inputs(seed: int = 0) -> dict:
    key = jax.random.key(seed)
    ks = jax.random.split(key, 32)
    f32 = jnp.float32

    def nrm(k, shape, scale):
        return jax.random.normal(k, shape, f32) * scale

    d = D_MODEL
    return {
        'x': nrm(ks[0], (BATCH, SEQ, d), 1.0),
        'rel_bias': nrm(ks[1], (N_BUCKETS, N_Q_HEADS), 0.5),
        'ev_norm_mix': 1.0 + nrm(ks[2], (N_EVEN, d), 0.02),
        'ev_w_in': nrm(ks[3], (N_EVEN, d, MIX_IN0), d ** -0.5),
        'ev_pool_w': nrm(ks[4], (N_EVEN, N_POOL_GROUPS, POOL_GROUP, POOL_GROUP), POOL_GROUP ** -0.5),
        'ev_pool_scale': 1.0 + nrm(ks[5], (N_EVEN, POOL_WIDTH), 0.1),
        'ev_conv_w': nrm(ks[6], (N_EVEN, CONV_K, CONV_CH), CONV_K ** -0.5),
        'ev_w_out': nrm(ks[7], (N_EVEN, d, d), d ** -0.5),
        'ev_norm_ffn': 1.0 + nrm(ks[8], (N_EVEN, d), 0.02),
        'ev_ffn_gate': nrm(ks[9], (N_EVEN, d, D_FF), d ** -0.5),
        'ev_ffn_up': nrm(ks[10], (N_EVEN, d, D_FF), d ** -0.5),
        'ev_ffn_down': nrm(ks[11], (N_EVEN, D_FF, d), D_FF ** -0.5),
        'od_norm_mix': 1.0 + nrm(ks[12], (N_ODD, d), 0.02),
        'od_w_qkv': nrm(ks[13], (N_ODD, d, QKV_WIDTH), d ** -0.5),
        'od_b_qkv': nrm(ks[14], (N_ODD, QKV_WIDTH), 0.02),
        'od_sinks': nrm(ks[15], (N_ODD, N_Q_HEADS), 0.5),
        'od_w_o': nrm(ks[16], (N_ODD, N_Q_HEADS * HEAD_DIM, d), (N_Q_HEADS * HEAD_DIM) ** -0.5),
        'od_b_o': nrm(ks[17], (N_ODD, d), 0.02),
        'od_norm_ffn': 1.0 + nrm(ks[18], (N_ODD, d), 0.02),
        'od_router': nrm(ks[19], (N_ODD, d, N_EXPERTS), d ** -0.5),
        'od_exp_gate': nrm(ks[20], (N_ODD, N_EXPERTS, d, D_FF_EXPERT), d ** -0.5),
        'od_exp_up': nrm(ks[21], (N_ODD, N_EXPERTS, d, D_FF_EXPERT), d ** -0.5),
        'od_exp_down': nrm(ks[22], (N_ODD, N_EXPERTS, D_FF_EXPERT, d), D_FF_EXPERT ** -0.5),
        'final_norm': 1.0 + nrm(ks[23], (d,), 0.02),
    }


def reference(x, rel_bias, ev_norm_mix, ev_w_in, ev_pool_w, ev_pool_scale, ev_conv_w, ev_w_out,
              ev_norm_ffn, ev_ffn_gate, ev_ffn_up, ev_ffn_down, od_norm_mix, od_w_qkv, od_b_qkv,
              od_sinks, od_w_o, od_b_o, od_norm_ffn, od_router, od_exp_gate, od_exp_up,
              od_exp_down, final_norm):
    for layer in range(DEPTH):
        i = layer // 2
        if layer % 2 == 0:
            h = rmsnorm(x, ev_norm_mix[i])
            x = x + pool_conv_mixer(h, ev_w_in[i], ev_pool_w[i], ev_pool_scale[i],
                                    ev_conv_w[i], ev_w_out[i])
            h = rmsnorm(x, ev_norm_ffn[i])
            x = x + swiglu(h, ev_ffn_gate[i], ev_ffn_up[i], ev_ffn_down[i])
        else:
            h = rmsnorm(x, od_norm_mix[i])
            x = x + sliding_window_attention(h, od_w_qkv[i], od_b_qkv[i], od_sinks[i],
                                             od_w_o[i], od_b_o[i], rel_bias)
            h = rmsnorm(x, od_norm_ffn[i])
            x = x + moe_swiglu(h, od_router[i], od_exp_gate[i], od_exp_up[i], od_exp_down[i])
    return rmsnorm(x, final_norm)
```

```cpp
#include <hip/hip_runtime.h>
#include <cstdio>
#include <cstdint>

#ifndef MK_N_LAUNCHES
#define MK_N_LAUNCHES 22
#endif

#define LAS __attribute__((address_space(3)))
#define GAS __attribute__((address_space(1)))
typedef unsigned short bf16_t;
typedef short bf16x8 __attribute__((ext_vector_type(8)));
typedef short s16x4 __attribute__((ext_vector_type(4)));
typedef float f32x2 __attribute__((ext_vector_type(2)));
typedef float f32x4 __attribute__((ext_vector_type(4)));
typedef float f32x16 __attribute__((ext_vector_type(16)));
typedef unsigned u32x2 __attribute__((ext_vector_type(2)));
typedef unsigned u32x4 __attribute__((ext_vector_type(4)));
typedef __bf16 hbf16x2 __attribute__((ext_vector_type(2)));

constexpr int D = 1024, BATCH = 2, SEQ = 16384, M = BATCH * SEQ;
constexpr int MIXN = 2048;
constexpr int DFF = 2816, NFF_T = DFF / 128;
constexpr int QKVN = 1280, NQH = 16, NKVH = 2, HD = 64, CHUNK = 64, KVSPAN = 192;
constexpr int NEXP = 8, DFE = 3584, NFE_T = DFE / 128;
constexpr int DFE_H = DFE / 2;
constexpr float RMS_EPS = 1e-6f;
constexpr int MAXSLOT = 69120;
constexpr int MAXTILES = MAXSLOT / 256;
constexpr int NWAVES = 8, NTHR = 512;

constexpr size_t MiB = 1u << 20;
constexpr size_t WS_CTL = 0, CTL_ZERO_BYTES = 1 * MiB;
constexpr size_t WS_BIAS = 1 * MiB;
constexpr size_t WS_WGCNT = WS_BIAS + 16 * 256 * 4;
constexpr size_t WS_TILE = WS_WGCNT + 1024 * 16 * 4;
constexpr size_t WS_TOKE = WS_TILE + 4096;
constexpr size_t WS_TOKW = WS_TOKE + 2 * (size_t)M * 4;
constexpr size_t WS_TOKR = WS_TOKW + 2 * (size_t)M * 4;
constexpr size_t WS_SLOTT = WS_TOKR + 2 * (size_t)M * 4;
constexpr size_t WS_SLOTW = WS_SLOTT + (size_t)MAXSLOT * 4;
static_assert(WS_SLOTW + (size_t)MAXSLOT * 4 <= 4 * MiB, "route region");
constexpr size_t WS_WIN = 4 * MiB;
constexpr size_t WS_WOUT = WS_WIN + (size_t)MIXN * D * 2;
constexpr size_t WS_WGU = WS_WOUT + (size_t)D * D * 2;
constexpr size_t WS_WD = WS_WGU + (size_t)2 * DFF * D * 2;
constexpr size_t WS_WQKV = WS_WD + (size_t)D * DFF * 2;
constexpr size_t WS_WO = WS_WQKV + (size_t)QKVN * D * 2;
static_assert(WS_WO + (size_t)D * D * 2 <= 31 * MiB, "dense weights");
constexpr size_t WS_WEGU = 31 * MiB;
constexpr size_t WS_WED = WS_WEGU + (size_t)NEXP * 2 * DFE * D * 2;
static_assert(WS_WED + (size_t)NEXP * D * DFE * 2 == 199 * MiB, "expert weights");
constexpr size_t WS_XN = 199 * MiB;
constexpr size_t WS_R = 263 * MiB;
constexpr size_t WS_PROJ = WS_R, WS_MIXED = WS_R + (size_t)M * MIXN * 2;
constexpr size_t WS_H = WS_R;
constexpr size_t WS_QKV = WS_R, WS_AO = WS_R + (size_t)M * QKVN * 2;
constexpr size_t WS_HS = WS_R, WS_H2 = WS_R + (size_t)MAXSLOT * D * 2;
constexpr size_t WS_END = WS_H2 + (size_t)(MAXSLOT / 2) * DFE_H * 2;
static_assert(WS_END <= 543497280ull, "workspace");
static_assert(WS_MIXED + (size_t)M * D * 2 <= 543497280ull && WS_H + (size_t)M * DFF * 2 <= 543497280ull, "workspace");

constexpr int CW_BAR = 4096;

constexpr int RING_BYTES = 131072;
constexpr int LDS_TILE_OFF = RING_BYTES;
constexpr int LDS_MISC_OFF = RING_BYTES + 2048;
constexpr int LDS_BYTES = 147456;

__device__ __forceinline__ unsigned pk2(float lo, float hi) { f32x2 v = {lo, hi}; hbf16x2 b = __builtin_convertvector(v, hbf16x2); return __builtin_bit_cast(unsigned, b); }
__device__ __forceinline__ float bf_lo(unsigned w) { return __uint_as_float(w << 16); }
__device__ __forceinline__ float bf_hi(unsigned w) { return __uint_as_float(w & 0xffff0000u); }
__device__ __forceinline__ void unpack8(const u32x4 w, float (&f)[8]) { f[0] = bf_lo(w.x); f[1] = bf_hi(w.x); f[2] = bf_lo(w.y); f[3] = bf_hi(w.y); f[4] = bf_lo(w.z); f[5] = bf_hi(w.z); f[6] = bf_lo(w.w); f[7] = bf_hi(w.w); }
__device__ __forceinline__ u32x4 pack8(const float (&f)[8]) { u32x4 w; w.x = pk2(f[0], f[1]); w.y = pk2(f[2], f[3]); w.z = pk2(f[4], f[5]); w.w = pk2(f[6], f[7]); return w; }
__device__ __forceinline__ float wave_sum(float v) {
#pragma unroll
    for (int o = 1; o < 64; o <<= 1) v += __shfl_xor(v, o);
    return v;
}
#define LDS_WAIT() asm volatile("s_waitcnt lgkmcnt(0)" ::: "memory")
#define VM_WAIT() asm volatile("s_waitcnt vmcnt(0)" ::: "memory")

namespace pg8 {
constexpr int BM = 256, BK = 64, HALF = 128, HTB = HALF * BK * 2, STAGE_BYTES = 8 * HTB, NXCD = 8, WGM = 8;
__host__ __device__ __forceinline__ int lds_byte(int r, int c) { const int st = (r >> 4) * 2 + (c >> 5), rr = r & 15, cc = c & 31, ob = rr * 64 + cc * 2; return st * 1024 + (ob ^ (((ob >> 9) & 1) << 5)); }
__host__ __device__ __forceinline__ void stage_rc(int b, int& R, int& C) { const int st = b / 1024, sb = b % 1024, swz = sb ^ (((sb >> 9) & 1) << 5); R = (st >> 1) * 16 + swz / 64; C = (st & 1) * 32 + (swz % 64) / 2; }
__host__ __device__ __forceinline__ int perm32(int rho) { const int n = rho >> 4, i = rho & 15; return 8 * (i >> 2) + 4 * n + (i & 3); }

struct Unit { int pm, pn, rm, cn; };
struct Gemm { const bf16_t* A; const bf16_t* Bt; int lda, ldb, K; };

struct TileOrder {
    int nM, nN, nwg, G, c;
    __device__ __forceinline__ void init(int nM_, int nN_, int G_, int c_) { nM = nM_; nN = nN_; nwg = nM * nN; G = G_; c = c_; }
    __device__ __forceinline__ bool next(int i, int& m, int& n) const {
        const long L = (long)i * G + c; if (L >= nwg) return false;
        int wgid = (int)L; { const int q = nwg / NXCD, r = nwg % NXCD, xcd = wgid % NXCD, off = wgid / NXCD; wgid = (xcd < r ? xcd * (q + 1) : r * (q + 1) + (xcd - r) * q) + off; }
        const int nig = WGM * nN, gid = wgid / nig, fm = gid * WGM, gsz = (nM - fm) < WGM ? (nM - fm) : WGM;
        m = fm + ((wgid % nig) % gsz); n = (wgid % nig) / gsz; return true;
    }
};
struct DenseOrder {
    TileOrder T;
    __device__ __forceinline__ void init(int Mr, int N, int G, int c) { T.init(Mr / BM, N / BM, G, c); }
    __device__ __forceinline__ bool next(int i, Unit& u) const { int m, n; if (!T.next(i, m, n)) return false; u.pm = m; u.pn = n; u.rm = m; u.cn = n; return true; }
    __device__ __forceinline__ void a_ready(const Unit&) const {}
    __device__ __forceinline__ void done(const Unit&) const {}
};
struct MoeOrder {
    TileOrder T; int rt_lo, tpe, ct0, a_abs; const LAS int* tile_e;
    __device__ __forceinline__ bool next(int i, Unit& u) const { int m, n; if (!T.next(i, m, n)) return false;
        const int e = __builtin_amdgcn_readfirstlane(tile_e[rt_lo + m]);
        u.pm = a_abs ? rt_lo + m : m; u.pn = e * tpe + ct0 + n; u.rm = a_abs ? m : rt_lo + m; u.cn = n; return true; }
    __device__ __forceinline__ void a_ready(const Unit&) const {}
    __device__ __forceinline__ void done(const Unit&) const {}
};

struct EpiBf16 {
    static constexpr bool PERM = true;
    bf16_t* O; int ldc; const float* bias;
    __device__ __forceinline__ void operator()(const f32x4 (&acc)[2][2][4][2], const Unit& u, int wr, int wc, int fr, int fq) const {
        const int row0 = u.rm * BM + wr * 64 + fr, col0 = u.cn * BM + wc * 32 + 8 * fq;
        f32x4 bv[2][2];
#pragma unroll
        for (int bj = 0; bj < 2; ++bj)
#pragma unroll
            for (int n = 0; n < 2; ++n) bv[bj][n] = bias ? *(const f32x4*)(bias + col0 + bj * HALF + 4 * n) : (f32x4){0.f, 0.f, 0.f, 0.f};
#pragma unroll
        for (int ai = 0; ai < 2; ++ai)
#pragma unroll
            for (int m = 0; m < 4; ++m) { bf16_t* rowp = O + (size_t)(row0 + ai * HALF + m * 16) * ldc + col0;
#pragma unroll
                for (int bj = 0; bj < 2; ++bj) { const f32x4 v0 = acc[ai][bj][m][0] + bv[bj][0], v1 = acc[ai][bj][m][1] + bv[bj][1];
                    u32x4 w; w.x = pk2(v0[0], v0[1]); w.y = pk2(v0[2], v0[3]); w.z = pk2(v1[0], v1[1]); w.w = pk2(v1[2], v1[3]);
                    *(u32x4*)(rowp + bj * HALF) = w; } }
    }
};
__device__ __forceinline__ float silu_mul(float g, float u) { return g * u * __builtin_amdgcn_rcpf(1.0f + __builtin_amdgcn_exp2f(-1.44269504089f * g)); }
struct EpiSwiGLU {
    static constexpr bool PERM = true;
    bf16_t* O; int ldc;
    __device__ __forceinline__ void operator()(const f32x4 (&acc)[2][2][4][2], const Unit& u, int wr, int wc, int fr, int fq) const {
        const int row0 = u.rm * BM + wr * 64 + fr, col0 = u.cn * HALF + wc * 32 + 8 * fq;
#pragma unroll
        for (int ai = 0; ai < 2; ++ai)
#pragma unroll
            for (int m = 0; m < 4; ++m) { bf16_t* rowp = O + (size_t)(row0 + ai * HALF + m * 16) * ldc + col0;
                const f32x4 g0 = acc[ai][0][m][0], g1 = acc[ai][0][m][1], u0 = acc[ai][1][m][0], u1 = acc[ai][1][m][1];
                u32x4 w; w.x = pk2(silu_mul(g0[0], u0[0]), silu_mul(g0[1], u0[1])); w.y = pk2(silu_mul(g0[2], u0[2]), silu_mul(g0[3], u0[3]));
                w.z = pk2(silu_mul(g1[0], u1[0]), silu_mul(g1[1], u1[1])); w.w = pk2(silu_mul(g1[2], u1[2]), silu_mul(g1[3], u1[3]));
                *(u32x4*)rowp = w; }
    }
};
struct EpiResid {
    static constexpr bool PERM = false;
    const float* base; float* out; const float* bias;
    __device__ __forceinline__ void operator()(const f32x4 (&acc)[2][2][4][2], const Unit& u, int wr, int wc, int fr, int fq) const {
        const int row0 = u.rm * BM + wr * 64 + fr, col0 = u.cn * BM + wc * 32 + 4 * fq;
        f32x4 bv[2][2];
#pragma unroll
        for (int bj = 0; bj < 2; ++bj)
#pragma unroll
            for (int n = 0; n < 2; ++n) bv[bj][n] = bias ? *(const f32x4*)(bias + col0 + bj * HALF + n * 16) : (f32x4){0.f, 0.f, 0.f, 0.f};
#pragma unroll
        for (int ai = 0; ai < 2; ++ai)
#pragma unroll
            for (int m = 0; m < 4; ++m) { const size_t off = (size_t)(row0 + ai * HALF + m * 16) * D + col0;
                f32x4 bs[2][2];
#pragma unroll
                for (int bj = 0; bj < 2; ++bj)
#pragma unroll
                    for (int n = 0; n < 2; ++n) bs[bj][n] = *(const f32x4*)(base + off + bj * HALF + n * 16);
#pragma unroll
                for (int bj = 0; bj < 2; ++bj)
#pragma unroll
                    for (int n = 0; n < 2; ++n) *(f32x4*)(out + off + bj * HALF + n * 16) = bs[bj][n] + acc[ai][bj][m][n] + bv[bj][n];
                asm volatile("" ::: "memory"); }
    }
};
struct EpiMoeDown {
    static constexpr bool PERM = false;
    float* out; const int* slot_tok; const float* slot_w;
    __device__ __forceinline__ void operator()(const f32x4 (&acc)[2][2][4][2], const Unit& u, int wr, int wc, int fr, int fq) const {
        const int row0 = u.rm * BM + wr * 64 + fr, col0 = u.cn * BM + wc * 32 + 4 * fq;
#pragma unroll
        for (int ai = 0; ai < 2; ++ai)
#pragma unroll
            for (int m = 0; m < 4; ++m) { const int slot = row0 + ai * HALF + m * 16; const int tok = slot_tok[slot]; const float w = slot_w[slot];
                if (tok >= 0) { float* rowp = out + (size_t)tok * D + col0;
                    f32x4 bs[2][2];
#pragma unroll
                    for (int bj = 0; bj < 2; ++bj)
#pragma unroll
                        for (int n = 0; n < 2; ++n) bs[bj][n] = *(const f32x4*)(rowp + bj * HALF + n * 16);
#pragma unroll
                    for (int bj = 0; bj < 2; ++bj)
#pragma unroll
                        for (int n = 0; n < 2; ++n) *(f32x4*)(rowp + bj * HALF + n * 16) = bs[bj][n] + acc[ai][bj][m][n] * w; }
                asm volatile("" ::: "memory"); }
    }
};

template <class Epi, class Sched, bool ALIGN_EPI = true, bool SP2 = true>
__device__ __forceinline__ void gemm_phase(LAS unsigned char* lds, const Gemm g, const Sched& S, const Epi& E) {
    const int tid = threadIdx.x, wid = __builtin_amdgcn_readfirstlane(tid >> 6), lane = tid & 63, wr = wid >> 2, wc = wid & 3, fr = lane & 15, fq = lane >> 4;
    const int nt = g.K / BK;
    unsigned voffA[2], voffB[2];
#pragma unroll
    for (int i = 0; i < 2; ++i) { int R, C; stage_rc(tid * 16 + i * 8192, R, C); const int Rb = Epi::PERM ? ((R & ~31) + perm32(R & 31)) : R;
        voffA[i] = (unsigned)(R * g.lda + C) * 2u; voffB[i] = (unsigned)(Rb * g.ldb + C) * 2u; }
    const size_t kstep = (size_t)(BK * 2);
    const size_t hstepA = (size_t)HALF * g.lda * 2, hstepB = (size_t)HALF * g.ldb * 2;
    const size_t tstepA = 2 * hstepA, tstepB = 2 * hstepB;
    const unsigned ldsw = (unsigned)wid * 1024u;
    const int aoff = lds_byte(wr * 64 + fr, fq * 8), boff = lds_byte(wc * 32 + fr, fq * 8);
#define PG8_SA(b, h) (((b) * 2 + (h)) * HTB)
#define PG8_SB(b, h) ((4 + (b) * 2 + (h)) * HTB)
#define PG8_STAGE(bufoff, gbase, voff) do { _Pragma("unroll") for (int _i = 0; _i < 2; ++_i) \
        __builtin_amdgcn_global_load_lds((const unsigned*)((const char*)(gbase) + (voff)[_i]), (LAS unsigned*)(lds + (bufoff) + ldsw + _i * 8192), 16, 0, 0); } while (0)
#define PG8_LDA(dst, b, h) do { _Pragma("unroll") for (int m = 0; m < 4; ++m) _Pragma("unroll") for (int k = 0; k < 2; ++k) dst[m][k] = *(const LAS bf16x8*)(lds + PG8_SA(b, h) + aoff + m * 2048 + k * 1024); } while (0)
#define PG8_LDB(dst, b, h) do { _Pragma("unroll") for (int n = 0; n < 2; ++n) _Pragma("unroll") for (int k = 0; k < 2; ++k) dst[n][k] = *(const LAS bf16x8*)(lds + PG8_SB(b, h) + boff + n * 2048 + k * 1024); } while (0)
#define PG8_MMA(ai, bj, At, Bt) do { __builtin_amdgcn_s_setprio(1); _Pragma("unroll") for (int m = 0; m < 4; ++m) _Pragma("unroll") for (int n = 0; n < 2; ++n) _Pragma("unroll") for (int k = 0; k < 2; ++k) \
        acc[ai][bj][m][n] = __builtin_amdgcn_mfma_f32_16x16x32_bf16(Bt[n][k], At[m][k], acc[ai][bj][m][n], 0, 0, 0); __builtin_amdgcn_s_setprio(0); } while (0)
#define PG8_WAIT_V(n) asm volatile("s_waitcnt vmcnt(" #n ")" ::: "memory")
#define PG8_WAIT_L(n) asm volatile("s_waitcnt lgkmcnt(" #n ")" ::: "memory")
#define PG8_BAR __builtin_amdgcn_s_barrier()
#define PG8_SCHED __builtin_amdgcn_sched_barrier(0)
    Unit cur, nxt; int ui = 0;
    if (!S.next(0, cur)) return;
    f32x4 acc[2][2][4][2];
#pragma unroll
    for (int a = 0; a < 2; ++a)
#pragma unroll
        for (int b = 0; b < 2; ++b)
#pragma unroll
            for (int m = 0; m < 4; ++m)
#pragma unroll
                for (int n = 0; n < 2; ++n) acc[a][b][m][n] = (f32x4){0.f, 0.f, 0.f, 0.f};
    bf16x8 At[4][2], B0[2][2], B1[2][2];
    const char* cA = (const char*)g.A + (size_t)cur.pm * tstepA; const char* cB = (const char*)g.Bt + (size_t)cur.pn * tstepB;
    S.a_ready(cur);
    if constexpr (SP2) {
        PG8_STAGE(PG8_SB(0, 0), cB, voffB); PG8_STAGE(PG8_SB(0, 1), cB + hstepB, voffB); PG8_STAGE(PG8_SA(0, 0), cA, voffA); PG8_STAGE(PG8_SA(0, 1), cA + hstepA, voffA);
        if (wr == 1) PG8_BAR;
        PG8_WAIT_V(2); PG8_BAR;
        PG8_STAGE(PG8_SB(1, 0), cB + kstep, voffB); PG8_STAGE(PG8_SA(1, 0), cA + kstep, voffA); PG8_STAGE(PG8_SB(1, 1), cB + hstepB + kstep, voffB);
        PG8_WAIT_V(6); PG8_BAR;
    } else {
        PG8_STAGE(PG8_SB(0, 0), cB, voffB); PG8_STAGE(PG8_SA(0, 0), cA, voffA); PG8_STAGE(PG8_SB(0, 1), cB + hstepB, voffB); PG8_STAGE(PG8_SA(0, 1), cA + hstepA, voffA);
        if (wr == 1) PG8_BAR;
        PG8_WAIT_V(4); PG8_BAR;
        PG8_STAGE(PG8_SB(1, 0), cB + kstep, voffB); PG8_STAGE(PG8_SA(1, 0), cA + kstep, voffA); PG8_STAGE(PG8_SB(1, 1), cB + hstepB + kstep, voffB);
        PG8_WAIT_V(6); PG8_BAR;
    }
    for (;;) {
        const bool has_next = S.next(ui + 1, nxt);
        const char* nA = has_next ? (const char*)g.A + (size_t)nxt.pm * tstepA : cA; const char* nB = has_next ? (const char*)g.Bt + (size_t)nxt.pn * tstepB : cB;
        for (int t = 0; t < nt; t += 2) {
            const bool last = (t == nt - 2);
            const char* a1 = cA + (size_t)(t + 1) * kstep;
            const char* a2 = last ? nA : cA + (size_t)(t + 2) * kstep; const char* b2 = last ? nB : cB + (size_t)(t + 2) * kstep;
            const char* a3 = a2 + kstep; const char* b3 = b2 + kstep;
            if (last && has_next) S.a_ready(nxt);
            if constexpr (SP2) {
            PG8_LDB(B0, 0, 0); PG8_LDB(B1, 0, 1); PG8_SCHED; PG8_LDA(At, 0, 0); PG8_STAGE(PG8_SA(1, 1), a1 + hstepA, voffA);
            PG8_WAIT_V(8); PG8_WAIT_L(0); PG8_BAR; PG8_MMA(0, 0, At, B0); PG8_MMA(0, 1, At, B1); PG8_BAR; PG8_SCHED;
            PG8_LDA(At, 0, 1); PG8_STAGE(PG8_SB(0, 0), b2, voffB); PG8_STAGE(PG8_SB(0, 1), b2 + hstepB, voffB); PG8_STAGE(PG8_SA(0, 0), a2, voffA);
            PG8_WAIT_V(8); PG8_WAIT_L(0); PG8_BAR; PG8_MMA(1, 0, At, B0); PG8_MMA(1, 1, At, B1); PG8_BAR; PG8_SCHED;
            PG8_LDB(B0, 1, 0); PG8_LDB(B1, 1, 1); PG8_SCHED; PG8_LDA(At, 1, 0); PG8_STAGE(PG8_SA(0, 1), a2 + hstepA, voffA);
            PG8_WAIT_V(8); PG8_WAIT_L(0); PG8_BAR; PG8_MMA(0, 0, At, B0); PG8_MMA(0, 1, At, B1); PG8_BAR; PG8_SCHED;
            PG8_LDA(At, 1, 1); PG8_STAGE(PG8_SB(1, 0), b3, voffB); PG8_STAGE(PG8_SB(1, 1), b3 + hstepB, voffB); PG8_STAGE(PG8_SA(1, 0), a3, voffA);
            PG8_WAIT_V(8); PG8_WAIT_L(0); PG8_BAR; PG8_MMA(1, 0, At, B0); PG8_MMA(1, 1, At, B1); PG8_BAR; PG8_SCHED;
            } else {
            PG8_LDB(B0, 0, 0); PG8_SCHED; PG8_LDA(At, 0, 0); PG8_STAGE(PG8_SA(1, 1), a1 + hstepA, voffA);
            PG8_WAIT_L(8); PG8_BAR; PG8_WAIT_L(0); PG8_MMA(0, 0, At, B0); PG8_BAR; PG8_SCHED;
            PG8_LDB(B1, 0, 1); PG8_STAGE(PG8_SB(0, 0), b2, voffB);
            PG8_BAR; PG8_WAIT_L(0); PG8_MMA(0, 1, At, B1); PG8_BAR;
            PG8_LDA(At, 0, 1); PG8_STAGE(PG8_SA(0, 0), a2, voffA);
            PG8_BAR; PG8_WAIT_L(0); PG8_MMA(1, 0, At, B0); PG8_BAR; PG8_SCHED;
            PG8_STAGE(PG8_SB(0, 1), b2 + hstepB, voffB);
            PG8_WAIT_V(6); PG8_BAR; PG8_MMA(1, 1, At, B1); PG8_BAR;
            PG8_LDB(B0, 1, 0); PG8_SCHED; PG8_LDA(At, 1, 0); PG8_STAGE(PG8_SA(0, 1), a2 + hstepA, voffA);
            PG8_WAIT_L(8); PG8_BAR; PG8_WAIT_L(0); PG8_MMA(0, 0, At, B0); PG8_BAR; PG8_SCHED;
            PG8_LDB(B1, 1, 1); PG8_STAGE(PG8_SB(1, 0), b3, voffB);
            PG8_BAR; PG8_WAIT_L(0); PG8_MMA(0, 1, At, B1); PG8_BAR;
            PG8_LDA(At, 1, 1); PG8_STAGE(PG8_SA(1, 0), a3, voffA);
            PG8_BAR; PG8_WAIT_L(0); PG8_MMA(1, 0, At, B0); PG8_BAR; PG8_SCHED;
            PG8_STAGE(PG8_SB(1, 1), b3 + hstepB, voffB);
            PG8_WAIT_V(6); PG8_BAR; PG8_MMA(1, 1, At, B1); PG8_BAR;
            }
        }
        if constexpr (ALIGN_EPI) { if (wr == 0) PG8_BAR; }
        E(acc, cur, wr, wc, fr, fq); S.done(cur);
        if (!has_next) break;
#pragma unroll
        for (int a = 0; a < 2; ++a)
#pragma unroll
            for (int b = 0; b < 2; ++b)
#pragma unroll
                for (int m = 0; m < 4; ++m)
#pragma unroll
                    for (int n = 0; n < 2; ++n) acc[a][b][m][n] = (f32x4){0.f, 0.f, 0.f, 0.f};
        cur = nxt; cA = nA; cB = nB; ++ui;
        if constexpr (ALIGN_EPI) { if (wr == 1) PG8_BAR; }
    }
    PG8_WAIT_V(0);
    if constexpr (!ALIGN_EPI) { if (wr == 0) PG8_BAR; }
    PG8_BAR;
#undef PG8_SA
#undef PG8_SB
#undef PG8_STAGE
#undef PG8_LDA
#undef PG8_LDB
#undef PG8_MMA
#undef PG8_WAIT_V
#undef PG8_WAIT_L
#undef PG8_BAR
#undef PG8_SCHED
}
}

#define XB_TMO      128
#define XB_XCNT(j)  (256  + 64 * (j))
#define XB_XSUB(j)  (1280 + 64 * (j))
#define XB_XGEN(j)  (2304 + 64 * (j))
#define XB_TOP      3328
#define XB_TOPGEN   3392
#define XCD_BAR_WORDS 3456
#define XB_SPIN_CAP (1u << 18)
__device__ __forceinline__ unsigned xb_ld(unsigned* p)              { return __hip_atomic_load(p, __ATOMIC_RELAXED, __HIP_MEMORY_SCOPE_AGENT); }
__device__ __forceinline__ unsigned xb_add(unsigned* p, unsigned v) { return __hip_atomic_fetch_add(p, v, __ATOMIC_RELAXED, __HIP_MEMORY_SCOPE_AGENT); }
__device__ __forceinline__ unsigned xb_xcc_id() { return (unsigned)__builtin_amdgcn_s_getreg((3 << 11) | 20) & 0xFu; }
#define XB_SPIN(cond, bar) do { unsigned _sp = 0; while (cond) { __builtin_amdgcn_s_sleep(1); \
    if ((++_sp & 255u) == 0u) { if (xb_ld(&(bar)[XB_TMO])) break; if (_sp > XB_SPIN_CAP) { atomicAdd(&(bar)[XB_TMO], 1u); break; } } } } while (0)
struct XcdBarrier { unsigned* bar; unsigned x; volatile LAS unsigned* st; };
__device__ __forceinline__ XcdBarrier xcd_barrier_post(unsigned* bar, volatile LAS unsigned* st) {
    XcdBarrier b; b.bar = bar; b.x = xb_xcc_id(); b.st = st;
    if (threadIdx.x == 0) (void)xb_add(&bar[XB_XCNT(b.x)], 1u);
    return b;
}
__device__ __forceinline__ void xcd_barrier_complete(unsigned* bar, unsigned x, unsigned& nloc, unsigned& nx) {
    const unsigned G = gridDim.x * gridDim.y * gridDim.z;
    unsigned sum, cnt, mine, sp = 0u;
    for (;;) {
        sum = 0u; cnt = 0u; mine = 0u;
#pragma unroll
        for (unsigned j = 0; j < 16; ++j) { const unsigned c = xb_ld(&bar[XB_XCNT(j)]); sum += c; cnt += (c > 0u) ? 1u : 0u; mine = (j == x) ? c : mine; }
        if (sum == G) break;
        __builtin_amdgcn_s_sleep(1);
        if ((++sp & 255u) == 0u) { if (xb_ld(&bar[XB_TMO])) break; if (sp > XB_SPIN_CAP) { atomicAdd(&bar[XB_TMO], 1u); break; } }
    }
    nloc = mine > 0u ? mine : 1u; nx = cnt > 0u ? cnt : 1u;
}
__device__ __forceinline__ void xcd_barrier(const XcdBarrier& b) {
    asm volatile("s_waitcnt vmcnt(0)" ::: "memory");
    __syncthreads();
    if (threadIdx.x == 0) {
        unsigned* bar = b.bar;
        __builtin_amdgcn_s_waitcnt(0);
        unsigned nloc = b.st[0], nx = b.st[1];
        if (nloc == 0u) { xcd_barrier_complete(bar, b.x, nloc, nx); b.st[0] = nloc; b.st[1] = nx; }
        const unsigned old = xb_add(&bar[XB_XSUB(b.x)], 1u);
        const unsigned gen = old / nloc;
        if (old + 1u == (gen + 1u) * nloc) {
            __builtin_amdgcn_fence(__ATOMIC_RELEASE, "agent");
            asm volatile("s_waitcnt vmcnt(0)" ::: "memory");
            const unsigned og = xb_add(&bar[XB_TOP], 1u);
            const unsigned tg = og / nx;
            if (og + 1u == (tg + 1u) * nx) xb_add(&bar[XB_TOPGEN], 1u);
            else XB_SPIN(xb_ld(&bar[XB_TOPGEN]) == tg, bar);
            __builtin_amdgcn_fence(__ATOMIC_ACQUIRE, "agent");
            xb_add(&bar[XB_XGEN(b.x)], 1u);
            asm volatile("s_waitcnt vmcnt(0)" ::: "memory");
        } else {
            XB_SPIN(xb_ld(&bar[XB_XGEN(b.x)]) == gen, bar);
            __builtin_amdgcn_fence(__ATOMIC_ACQUIRE, "agent");
            asm volatile("s_waitcnt vmcnt(0)" ::: "memory");
        }
    }
    __syncthreads();
}

struct Params { const float* in[24]; float* out; unsigned char* ws; int ph_lo, ph_hi; };
enum { I_X = 0, I_RELB, I_EVNM, I_WIN, I_POOLW, I_POOLS, I_CONVW, I_WOUT, I_EVNF, I_FG, I_FU, I_FD, I_ODNM, I_WQKV, I_BQKV, I_SINK, I_WO, I_BO, I_ODNF, I_ROUTER, I_EG, I_EU, I_ED, I_FINAL };

__device__ __forceinline__ void p0_tile(const float* __restrict__ src, int N, int k0, int n0, bf16_t* __restrict__ dst, int ldd, LAS unsigned char* scr, int lane) {
    const int n4 = (lane & 15) * 4, kp = lane >> 4;
    f32x4 a[8], b[8];
#pragma unroll
    for (int i = 0; i < 8; ++i) { const float* p = src + (size_t)(k0 + 8 * i + 2 * kp) * N + n0 + n4; a[i] = *(const f32x4*)p; b[i] = *(const f32x4*)(p + N); }
#pragma unroll
    for (int i = 0; i < 8; ++i) { const int k = 8 * i + 2 * kp;
#pragma unroll
        for (int q = 0; q < 4; ++q) *(LAS unsigned*)(scr + (n4 + q) * 136 + k * 2) = pk2(a[i][q], b[i][q]); }
    LDS_WAIT();
    const int c = lane & 7, nr = lane >> 3;
#pragma unroll
    for (int j = 0; j < 8; ++j) { const int n = 8 * j + nr; const u32x2 lo = *(const LAS u32x2*)(scr + n * 136 + 16 * c), hi = *(const LAS u32x2*)(scr + n * 136 + 16 * c + 8);
        u32x4 o; o.x = lo.x; o.y = lo.y; o.z = hi.x; o.w = hi.y; *(u32x4*)(dst + (size_t)n * ldd + 8 * c) = o; }
    LDS_WAIT();
}
__device__ __forceinline__ void norm_row_bf16(const float* __restrict__ xrow, const float* __restrict__ gain, bf16_t* __restrict__ orow, int lane, float (&y)[16]) {
    f32x4 v[4];
#pragma unroll
    for (int j = 0; j < 2; ++j) { v[2 * j] = *(const f32x4*)(xrow + 512 * j + 8 * lane); v[2 * j + 1] = *(const f32x4*)(xrow + 512 * j + 8 * lane + 4); }
    float s = 0.f;
#pragma unroll
    for (int j = 0; j < 4; ++j) s += (v[j][0] * v[j][0] + v[j][1] * v[j][1]) + (v[j][2] * v[j][2] + v[j][3] * v[j][3]);
    const float r = 1.0f / sqrtf(wave_sum(s) * (1.0f / D) + RMS_EPS);
#pragma unroll
    for (int j = 0; j < 2; ++j) { const f32x4 g0 = *(const f32x4*)(gain + 512 * j + 8 * lane), g1 = *(const f32x4*)(gain + 512 * j + 8 * lane + 4);
#pragma unroll
        for (int q = 0; q < 4; ++q) { y[8 * j + q] = v[2 * j][q] * r * g0[q]; y[8 * j + 4 + q] = v[2 * j + 1][q] * r * g1[q]; }
        u32x4 w; w.x = pk2(y[8 * j], y[8 * j + 1]); w.y = pk2(y[8 * j + 2], y[8 * j + 3]); w.z = pk2(y[8 * j + 4], y[8 * j + 5]); w.w = pk2(y[8 * j + 6], y[8 * j + 7]);
        *(u32x4*)(orow + 512 * j + 8 * lane) = w; }
}

__device__ __forceinline__ int t5_bucket(int rel) {
    const int n = rel < 0 ? -rel : rel; const int ret = rel > 0 ? 16 : 0;
    int v;
    if (n < 8) v = n; else if (n < 12) v = 8; else if (n < 16) v = 9; else if (n < 23) v = 10; else if (n < 32) v = 11; else if (n < 46) v = 12; else if (n < 64) v = 13; else if (n < 91) v = 14; else v = 15;
    return ret + v;
}

__global__ void __launch_bounds__(NTHR, 2) fwd_kernel(Params p) {
    extern __shared__ __attribute__((aligned(16))) unsigned char lds_raw[];
    LAS unsigned char* lds = (LAS unsigned char*)lds_raw;
    volatile LAS unsigned* MISC = (volatile LAS unsigned*)(lds + LDS_MISC_OFF);
    const int tid = threadIdx.x, lane = tid & 63, wave = __builtin_amdgcn_readfirstlane(tid >> 6);
    const int G = gridDim.x, bx = blockIdx.x;
    const int vcu = (G % 8 == 0) ? (bx % 8) * (G / 8) + bx / 8 : bx;
    const int gw = vcu * NWAVES + wave, NGW = G * NWAVES;
    unsigned char* ws = p.ws;
    unsigned* ctl = (unsigned*)(ws + WS_CTL);
    if (tid < 64) MISC[tid] = 0u;
    __syncthreads();
    XcdBarrier bar; bar.bar = ctl + CW_BAR; bar.x = 0; bar.st = nullptr;
    if (MK_N_LAUNCHES == 1) bar = xcd_barrier_post(ctl + CW_BAR, MISC + 8);
    const int lo = p.ph_lo, hi = p.ph_hi;
#define IN(k) (lo <= (k) && (k) < hi)
#define SEAM(k) do { if (MK_N_LAUNCHES == 1 && IN((k) + 1)) xcd_barrier(bar); } while (0)

    bf16_t* Win_t = (bf16_t*)(ws + WS_WIN); bf16_t* Wout_t = (bf16_t*)(ws + WS_WOUT); bf16_t* Wgu_t = (bf16_t*)(ws + WS_WGU); bf16_t* Wd_t = (bf16_t*)(ws + WS_WD);
    bf16_t* Wqkv_t = (bf16_t*)(ws + WS_WQKV); bf16_t* Wo_t = (bf16_t*)(ws + WS_WO); bf16_t* Wegu_t = (bf16_t*)(ws + WS_WEGU); bf16_t* Wed_t = (bf16_t*)(ws + WS_WED);
    bf16_t* XN = (bf16_t*)(ws + WS_XN); bf16_t* PROJ = (bf16_t*)(ws + WS_PROJ); bf16_t* MIXED = (bf16_t*)(ws + WS_MIXED); bf16_t* Hb = (bf16_t*)(ws + WS_H);
    bf16_t* QKV = (bf16_t*)(ws + WS_QKV); bf16_t* AO = (bf16_t*)(ws + WS_AO); bf16_t* HS = (bf16_t*)(ws + WS_HS); bf16_t* H2 = (bf16_t*)(ws + WS_H2);
    float* bias_tab = (float*)(ws + WS_BIAS); int* wgcnt = (int*)(ws + WS_WGCNT); int* tilemeta = (int*)(ws + WS_TILE);
    int* tok_e = (int*)(ws + WS_TOKE); float* tok_w = (float*)(ws + WS_TOKW); int* tok_r = (int*)(ws + WS_TOKR); int* slot_tok = (int*)(ws + WS_SLOTT); float* slot_w = (float*)(ws + WS_SLOTW);
    float* X = p.out;

    if (IN(0)) {
        LAS unsigned char* scr = lds + wave * 8704;
        constexpr int T_WIN = 16 * 32, T_WOUT = 8 * 16, T_FG = 16 * 44, T_FD = 44 * 16, T_QKV = 16 * 20, T_WO = 16 * 16, T_EG = 16 * 56, T_ED = 56 * 16;
        constexpr int NT = T_WIN + T_WOUT + 2 * T_FG + T_FD + T_QKV + T_WO + NEXP * (2 * T_EG + T_ED);
        for (int it = gw; it < NT; it += NGW) {
            int r = it;
            if (r < T_WIN) { const int kb = r / 32, nb = r % 32; p0_tile(p.in[I_WIN], MIXN, 64 * kb, 64 * nb, Win_t + (size_t)(64 * nb) * D + 64 * kb, D, scr, lane); continue; } r -= T_WIN;
            if (r < T_WOUT) { const int kb = 8 + r / 16, nb = r % 16; p0_tile(p.in[I_WOUT], D, 64 * kb, 64 * nb, Wout_t + (size_t)(64 * nb) * D + 64 * kb, D, scr, lane); continue; } r -= T_WOUT;
            if (r < 2 * T_FG) { const int up = r >= T_FG; const int q = up ? r - T_FG : r; const int kb = q / 44, nb = q % 44, n0 = 64 * nb;
                p0_tile(p.in[up ? I_FU : I_FG], DFF, 64 * kb, n0, Wgu_t + (size_t)((n0 / 128) * 256 + (n0 % 128) + (up ? 128 : 0)) * D + 64 * kb, D, scr, lane); continue; } r -= 2 * T_FG;
            if (r < T_FD) { const int kb = r / 16, nb = r % 16; p0_tile(p.in[I_FD], D, 64 * kb, 64 * nb, Wd_t + (size_t)(64 * nb) * DFF + 64 * kb, DFF, scr, lane); continue; } r -= T_FD;
            if (r < T_QKV) { const int kb = r / 20, nb = r % 20; p0_tile(p.in[I_WQKV], QKVN, 64 * kb, 64 * nb, Wqkv_t + (size_t)(64 * nb) * D + 64 * kb, D, scr, lane); continue; } r -= T_QKV;
            if (r < T_WO) { const int kb = r / 16, nb = r % 16; p0_tile(p.in[I_WO], D, 64 * kb, 64 * nb, Wo_t + (size_t)(64 * nb) * D + 64 * kb, D, scr, lane); continue; } r -= T_WO;
            { const int per_e = 2 * T_EG + T_ED; const int e = r / per_e; int q = r % per_e;
              if (q < 2 * T_EG) { const int up = q >= T_EG; if (up) q -= T_EG; const int kb = q / 56, nb = q % 56, n0 = 64 * nb;
                  p0_tile(p.in[up ? I_EU : I_EG] + (size_t)e * D * DFE, DFE, 64 * kb, n0, Wegu_t + ((size_t)e * 2 * DFE + (n0 / 128) * 256 + (n0 % 128) + (up ? 128 : 0)) * D + 64 * kb, D, scr, lane); }
              else { q -= 2 * T_EG; const int kb = q / 16, nb = q % 16;
                  p0_tile(p.in[I_ED] + (size_t)e * DFE * D, D, 64 * kb, 64 * nb, Wed_t + ((size_t)e * D + 64 * nb) * DFE + 64 * kb, DFE, scr, lane); } }
        }
        for (int it = gw; it < 4 * 16 * 16; it += NGW) {
            const int g = it >> 8, cb = (it >> 4) & 15, nb = it & 15; const int n = 64 * nb + lane, c0 = 8 * cb;
            const float* wo = p.in[I_WOUT] + (size_t)(g * 128) * D + n; const float* ps = p.in[I_POOLS] + g * 128; const float* pw = p.in[I_POOLW] + (size_t)(g * 128 + c0) * 128;
            float acc[8];
#pragma unroll
            for (int cc = 0; cc < 8; ++cc) acc[cc] = 0.f;
            for (int d = 0; d < 128; ++d) { const float w = wo[(size_t)d * D] * ps[d];
#pragma unroll
                for (int cc = 0; cc < 8; ++cc) acc[cc] += pw[cc * 128 + d] * w; }
            *(u32x4*)(Wout_t + (size_t)n * D + g * 128 + c0) = pack8(acc);
        }
        for (int m = gw; m < M; m += NGW) { float y[16]; norm_row_bf16(p.in[I_X] + (size_t)m * D, p.in[I_EVNM], XN + (size_t)m * D, lane, y); }
        for (int i = bx * NTHR + tid; i < NQH * 256; i += G * NTHR) { const int h = i >> 8, idx = i & 255; bias_tab[i] = idx < 255 ? p.in[I_RELB][t5_bucket(idx - 191) * NQH + h] : 0.f; }
    }
    SEAM(0);

    if (IN(1)) { pg8::Gemm g{XN, Win_t, D, D, D}; pg8::DenseOrder S; S.init(M, MIXN, G, bx); pg8::EpiBf16 E{PROJ, MIXN, nullptr};
        pg8::gemm_phase<pg8::EpiBf16, pg8::DenseOrder>(lds, g, S, E); }
    SEAM(1);

    if (IN(2)) {
        for (int unit = gw; unit < (M / 32) * 2; unit += NGW) {
            const int rb = unit >> 1, half = unit & 1, r0 = rb * 32, bs = r0 & ~(SEQ - 1);
            if (half == 0) {
                const int w = 2 << (lane >> 4); const bf16_t* P = PROJ + 8 * lane;
                float s[8];
#pragma unroll
                for (int q = 0; q < 8; ++q) s[q] = 0.f;
                for (int j = 1; j <= 16; ++j) if (j <= w && r0 - j >= bs) { float f[8]; unpack8(*(const u32x4*)(P + (size_t)(r0 - j) * MIXN), f);
#pragma unroll
                    for (int q = 0; q < 8; ++q) s[q] += f[q]; }
#pragma unroll 4
                for (int r = r0; r < r0 + 32; ++r) {
                    float cur[8], old[8]; unpack8(*(const u32x4*)(P + (size_t)r * MIXN), cur);
                    const bool has_old = (r - w >= bs);
                    if (has_old) unpack8(*(const u32x4*)(P + (size_t)(r - w) * MIXN), old);
                    const int pos = r - bs + 1; const float inv = 1.0f / (float)(pos < w ? pos : w);
                    float o[8];
#pragma unroll
                    for (int q = 0; q < 8; ++q) { s[q] += cur[q]; if (has_old) s[q] -= old[q]; o[q] = s[q] * inv - cur[q]; }
                    *(u32x4*)(MIXED + (size_t)r * D + 8 * lane) = pack8(o);
                }
            } else {
                const bf16_t* P = PROJ + 8 * lane;
                float w0[8], w1[8], w2[8], z1[8], z2[8];
                { const float* cw = p.in[I_CONVW] + 8 * lane;
#pragma unroll
                  for (int q = 0; q < 8; ++q) { w0[q] = cw[q]; w1[q] = cw[512 + q]; w2[q] = cw[1024 + q]; z1[q] = 0.f; z2[q] = 0.f; } }
                if (r0 - 1 >= bs) { float a[8], b[8]; unpack8(*(const u32x4*)(P + (size_t)(r0 - 1) * MIXN + 1024), a); unpack8(*(const u32x4*)(P + (size_t)(r0 - 1) * MIXN + 1536), b);
#pragma unroll
                    for (int q = 0; q < 8; ++q) z1[q] = a[q] * b[q]; }
                if (r0 - 2 >= bs) { float a[8], b[8]; unpack8(*(const u32x4*)(P + (size_t)(r0 - 2) * MIXN + 1024), a); unpack8(*(const u32x4*)(P + (size_t)(r0 - 2) * MIXN + 1536), b);
#pragma unroll
                    for (int q = 0; q < 8; ++q) z2[q] = a[q] * b[q]; }
#pragma unroll 4
                for (int r = r0; r < r0 + 32; ++r) {
                    float gp[8], a[8], b[8], o[8];
                    unpack8(*(const u32x4*)(P + (size_t)r * MIXN + 512), gp); unpack8(*(const u32x4*)(P + (size_t)r * MIXN + 1024), a); unpack8(*(const u32x4*)(P + (size_t)r * MIXN + 1536), b);
#pragma unroll
                    for (int q = 0; q < 8; ++q) { const float zc = a[q] * b[q]; o[q] = gp[q] * (w0[q] * z2[q] + w1[q] * z1[q] + w2[q] * zc); z2[q] = z1[q]; z1[q] = zc; }
                    *(u32x4*)(MIXED + (size_t)r * D + 512 + 8 * lane) = pack8(o);
                }
            }
        }
    }
    SEAM(2);

    if (IN(3)) { pg8::Gemm g{MIXED, Wout_t, D, D, D}; pg8::DenseOrder S; S.init(M, D, G, bx); pg8::EpiResid E{p.in[I_X], X, nullptr};
        pg8::gemm_phase<pg8::EpiResid, pg8::DenseOrder>(lds, g, S, E); }
    SEAM(3);

    if (IN(4)) { for (int m = gw; m < M; m += NGW) { float y[16]; norm_row_bf16(X + (size_t)m * D, p.in[I_EVNF], XN + (size_t)m * D, lane, y); } }
    SEAM(4);

    if (IN(5)) { pg8::Gemm g{XN, Wgu_t, D, D, D}; pg8::DenseOrder S; S.init(M, 2 * DFF, G, bx); pg8::EpiSwiGLU E{Hb, DFF};
        pg8::gemm_phase<pg8::EpiSwiGLU, pg8::DenseOrder>(lds, g, S, E); }
    SEAM(5);

    if (IN(6)) { pg8::Gemm g{Hb, Wd_t, DFF, DFF, DFF}; pg8::DenseOrder S; S.init(M, D, G, bx); pg8::EpiResid E{X, X, nullptr};
        pg8::gemm_phase<pg8::EpiResid, pg8::DenseOrder>(lds, g, S, E); }
    SEAM(6);

    if (IN(7)) { for (int m = gw; m < M; m += NGW) { float y[16]; norm_row_bf16(X + (size_t)m * D, p.in[I_ODNM], XN + (size_t)m * D, lane, y); } }
    SEAM(7);

    if (IN(8)) { pg8::Gemm g{XN, Wqkv_t, D, D, D}; pg8::DenseOrder S; S.init(M, QKVN, G, bx); pg8::EpiBf16 E{QKV, QKVN, p.in[I_BQKV]};
        pg8::gemm_phase<pg8::EpiBf16, pg8::DenseOrder>(lds, g, S, E); }
    SEAM(8);

    if (IN(9)) {
        constexpr int KS_STR = 144, VT_STR = 392;
        constexpr int L_K = 0, L_VT = 192 * KS_STR, L_BT = L_VT + 64 * VT_STR, L_OST = L_BT + NQH * 256 * 4;
        static_assert(L_OST + NWAVES * 32 * 144 <= RING_BYTES, "attention LDS");
        for (int i = tid; i < NQH * 256; i += NTHR) *(LAS float*)(lds + L_BT + 4 * i) = bias_tab[i];
        const int r32 = lane & 31, hh = lane >> 5;
        for (int unit = vcu; unit < BATCH * (SEQ / CHUNK) * NKVH; unit += G) {
            const int kvh = unit & 1, n = (unit >> 1) & 255, b = unit >> 9;
            const int t0 = b * SEQ + n * CHUNK;
            __syncthreads();
#pragma unroll
            for (int i = 0; i < 3; ++i) { const int pc = tid + i * NTHR, j = pc >> 3, c = pc & 7; const bool valid = (n * CHUNK - 128 + j) >= 0;
                u32x4 kv = {0u, 0u, 0u, 0u}, vv = {0u, 0u, 0u, 0u};
                if (valid) { const bf16_t* src = QKV + (size_t)(t0 - 128 + j) * QKVN + 1024 + kvh * HD + 8 * c; kv = *(const u32x4*)src; vv = *(const u32x4*)(src + 128); }
                *(LAS u32x4*)(lds + L_K + j * KS_STR + 16 * c) = kv;
                const unsigned vw[4] = {vv.x, vv.y, vv.z, vv.w};
#pragma unroll
                for (int q = 0; q < 4; ++q) { *(LAS unsigned short*)(lds + L_VT + (8 * c + 2 * q) * VT_STR + 2 * j) = (unsigned short)(vw[q] & 0xffffu);
                                              *(LAS unsigned short*)(lds + L_VT + (8 * c + 2 * q + 1) * VT_STR + 2 * j) = (unsigned short)(vw[q] >> 16); } }
            __syncthreads();
            const int head = kvh * 8 + wave;
            const float sink = p.in[I_SINK][head];
            const LAS float* bt = (const LAS float*)(lds + L_BT + head * 1024);
            const int kb_min = n == 0 ? 4 : (n == 1 ? 2 : 0);
#pragma unroll 1
            for (int qb = 0; qb < 2; ++qb) {
                bf16x8 qf[4];
                { const bf16_t* qp = QKV + (size_t)(t0 + qb * 32 + r32) * QKVN + head * HD + 8 * hh;
#pragma unroll
                  for (int ks = 0; ks < 4; ++ks) qf[ks] = *(const bf16x8*)(qp + 16 * ks); }
                f32x16 st[6];
#pragma unroll
                for (int kb = 0; kb < 6; ++kb) {
#pragma unroll
                    for (int e = 0; e < 16; ++e) st[kb][e] = 0.f;
#pragma unroll
                    for (int ks = 0; ks < 4; ++ks) { const bf16x8 kf = *(const LAS bf16x8*)(lds + L_K + (kb * 32 + r32) * KS_STR + 32 * ks + 16 * hh);
                        st[kb] = __builtin_amdgcn_mfma_f32_32x32x16_bf16(kf, qf[ks], st[kb], 0, 0, 0); } }
                float mx = sink;
#pragma unroll
                for (int kb = 0; kb < 6; ++kb)
#pragma unroll
                    for (int e = 0; e < 16; ++e) { const int j = kb * 32 + (e & 3) + 8 * (e >> 2) + 4 * hh; const int idx = j - (qb * 32 + r32) + 63;
                        float sc = st[kb][e] * 0.125f + bt[idx]; sc = (kb < kb_min) ? -1e30f : sc; st[kb][e] = sc; mx = fmaxf(mx, sc); }
                mx = fmaxf(mx, __shfl_xor(mx, 32));
                float sum = 0.f;
#pragma unroll
                for (int kb = 0; kb < 6; ++kb)
#pragma unroll
                    for (int e = 0; e < 16; ++e) { const float pe = __builtin_amdgcn_exp2f((st[kb][e] - mx) * 1.44269504089f); st[kb][e] = pe; sum += pe; }
                sum += __shfl_xor(sum, 32);
                const float inv = 1.0f / (sum + __builtin_amdgcn_exp2f((sink - mx) * 1.44269504089f));
                f32x16 ot[2];
#pragma unroll
                for (int db = 0; db < 2; ++db)
#pragma unroll
                    for (int e = 0; e < 16; ++e) ot[db][e] = 0.f;
#pragma unroll
                for (int kb = 0; kb < 6; ++kb)
#pragma unroll
                    for (int s = 0; s < 2; ++s) {
                        u32x4 pw; pw.x = pk2(st[kb][8 * s], st[kb][8 * s + 1]); pw.y = pk2(st[kb][8 * s + 2], st[kb][8 * s + 3]); pw.z = pk2(st[kb][8 * s + 4], st[kb][8 * s + 5]); pw.w = pk2(st[kb][8 * s + 6], st[kb][8 * s + 7]);
                        const bf16x8 pf = __builtin_bit_cast(bf16x8, pw);
#pragma unroll
                        for (int db = 0; db < 2; ++db) { const LAS unsigned char* vp = lds + L_VT + (db * 32 + r32) * VT_STR + 2 * (kb * 32 + 16 * s + 4 * hh);
                            const u32x2 v0 = *(const LAS u32x2*)vp, v1 = *(const LAS u32x2*)(vp + 16);
                            u32x4 vw; vw.x = v0.x; vw.y = v0.y; vw.z = v1.x; vw.w = v1.y;
                            ot[db] = __builtin_amdgcn_mfma_f32_32x32x16_bf16(__builtin_bit_cast(bf16x8, vw), pf, ot[db], 0, 0, 0); } }
                LAS unsigned char* ost = lds + L_OST + wave * (32 * 144);
#pragma unroll
                for (int db = 0; db < 2; ++db)
#pragma unroll
                    for (int g4 = 0; g4 < 4; ++g4) { u32x2 w; w.x = pk2(ot[db][4 * g4] * inv, ot[db][4 * g4 + 1] * inv); w.y = pk2(ot[db][4 * g4 + 2] * inv, ot[db][4 * g4 + 3] * inv);
                        *(LAS u32x2*)(ost + r32 * 144 + 2 * (db * 32 + 8 * g4 + 4 * hh)) = w; }
                LDS_WAIT();
#pragma unroll
                for (int i = 0; i < 4; ++i) { const int q = 8 * i + (lane >> 3), c = lane & 7; const u32x4 w = *(const LAS u32x4*)(ost + q * 144 + 16 * c);
                    *(u32x4*)(AO + (size_t)(t0 + qb * 32 + q) * D + head * HD + 8 * c) = w; }
                LDS_WAIT();
            }
        }
        __syncthreads();
    }
    SEAM(9);

    if (IN(10)) { pg8::Gemm g{AO, Wo_t, D, D, D}; pg8::DenseOrder S; S.init(M, D, G, bx); pg8::EpiResid E{X, X, p.in[I_BO]};
        pg8::gemm_phase<pg8::EpiResid, pg8::DenseOrder>(lds, g, S, E); }
    SEAM(10);

    const int RPW = (M + G - 1) / G;
    constexpr int L_RW = 0, L_RE = 32768, L_RWT = L_RE + 2 * 512 * 4, L_CNT = L_RWT + 2 * 512 * 4;
    if (IN(11)) {
        for (int i = tid; i < D * NEXP / 4; i += NTHR) *(LAS f32x4*)(lds + L_RW + 16 * i) = *(const f32x4*)(p.in[I_ROUTER] + 4 * i);
        if (tid < 16) *(LAS int*)(lds + L_CNT + 4 * tid) = 0;
        __syncthreads();
        const int rbase = bx * RPW;
        for (int rl = wave; rl < RPW && rbase + rl < M; rl += NWAVES) {
            const int m = rbase + rl; float y[16];
            norm_row_bf16(X + (size_t)m * D, p.in[I_ODNF], XN + (size_t)m * D, lane, y);
            float lg[8];
#pragma unroll
            for (int e = 0; e < 8; ++e) lg[e] = 0.f;
#pragma unroll
            for (int j = 0; j < 2; ++j)
#pragma unroll
                for (int q = 0; q < 8; ++q) { const int c = 512 * j + 8 * lane + q; const f32x4 wa = *(const LAS f32x4*)(lds + L_RW + 32 * c), wb = *(const LAS f32x4*)(lds + L_RW + 32 * c + 16); const float yv = y[8 * j + q];
                    lg[0] += yv * wa[0]; lg[1] += yv * wa[1]; lg[2] += yv * wa[2]; lg[3] += yv * wa[3]; lg[4] += yv * wb[0]; lg[5] += yv * wb[1]; lg[6] += yv * wb[2]; lg[7] += yv * wb[3]; }
#pragma unroll
            for (int e = 0; e < 8; ++e) lg[e] = wave_sum(lg[e]);
            int e0 = 0; float v0 = lg[0];
#pragma unroll
            for (int e = 1; e < 8; ++e) if (lg[e] > v0) { v0 = lg[e]; e0 = e; }
            int e1 = -1; float v1 = -3.0e38f;
#pragma unroll
            for (int e = 0; e < 8; ++e) if (e != e0 && lg[e] > v1) { v1 = lg[e]; e1 = e; }
            const float wt0 = 1.0f / (1.0f + __expf(v1 - v0));
            if (lane == 0) { *(LAS int*)(lds + L_RE + 4 * rl) = e0; *(LAS int*)(lds + L_RE + 2048 + 4 * rl) = e1; *(LAS float*)(lds + L_RWT + 4 * rl) = wt0; *(LAS float*)(lds + L_RWT + 2048 + 4 * rl) = 1.0f - wt0; }
        }
        __syncthreads();
        for (int rl = tid; rl < RPW && rbase + rl < M; rl += NTHR) {
            const int m = rbase + rl; const int e0 = *(LAS int*)(lds + L_RE + 4 * rl), e1 = *(LAS int*)(lds + L_RE + 2048 + 4 * rl);
            int r0 = 0, r1 = 0;
            for (int j = 0; j < rl; ++j) { r0 += (*(LAS int*)(lds + L_RE + 4 * j) == e0); r1 += (*(LAS int*)(lds + L_RE + 2048 + 4 * j) == e1); }
            tok_e[m] = e0; tok_e[M + m] = e1; tok_w[m] = *(LAS float*)(lds + L_RWT + 4 * rl); tok_w[M + m] = *(LAS float*)(lds + L_RWT + 2048 + 4 * rl); tok_r[m] = r0; tok_r[M + m] = r1;
            __hip_atomic_fetch_add((LAS int*)(lds + L_CNT + 4 * e0), 1, __ATOMIC_RELAXED, __HIP_MEMORY_SCOPE_WORKGROUP); __hip_atomic_fetch_add((LAS int*)(lds + L_CNT + 4 * (8 + e1)), 1, __ATOMIC_RELAXED, __HIP_MEMORY_SCOPE_WORKGROUP);
        }
        __syncthreads();
        if (tid < 16) wgcnt[bx * 16 + tid] = *(LAS int*)(lds + L_CNT + 4 * tid);
        __syncthreads();
    }
    SEAM(11);

    if (IN(12)) {
        LAS int* sb = (LAS int*)(lds + 0);
        if (tid < 16) { int tot = 0, pre = 0; for (int w = 0; w < G; ++w) { const int c = wgcnt[w * 16 + tid]; tot += c; if (w < bx) pre += c; } sb[32 + tid] = tot; sb[16 + tid] = pre; }
        __syncthreads();
        if (tid == 0) { int base = 0; for (int s = 0; s < 16; ++s) { sb[s] = base; base += (sb[32 + s] + 255) & ~255; } sb[48] = base; }
        __syncthreads();
        const int rbase = bx * RPW;
        for (int pr = wave; pr < 2 * RPW; pr += NWAVES) { const int k = pr & 1, rl = pr >> 1, m = rbase + rl; if (m >= M) continue;
            const int s = k * 8 + tok_e[k * M + m]; const int slot = sb[s] + sb[16 + s] + tok_r[k * M + m];
            const u32x4* src = (const u32x4*)(XN + (size_t)m * D); u32x4* dst = (u32x4*)(HS + (size_t)slot * D);
            const u32x4 a = src[lane], b2 = src[64 + lane]; dst[lane] = a; dst[64 + lane] = b2;
            if (lane == 0) { slot_tok[slot] = m; slot_w[slot] = tok_w[k * M + m]; } }
        if (bx == 0) {
            for (int s = 0; s < 16; ++s) { const int b0 = sb[s] + sb[32 + s], b1 = sb[s] + ((sb[32 + s] + 255) & ~255); for (int i = b0 + tid; i < b1; i += NTHR) { slot_tok[i] = -1; slot_w[i] = 0.f; } }
            const int nt_all = sb[48] >> 8;
            for (int j = tid; j < nt_all; j += NTHR) { int s = 0; for (int q = 1; q < 16; ++q) if ((j << 8) >= sb[q]) s = q; tilemeta[8 + j] = s & 7; }
            if (tid == 0) { tilemeta[0] = sb[8] >> 8; tilemeta[1] = nt_all; }
        }
        __syncthreads();
    }
    SEAM(12);

#pragma unroll 1
    for (int kh = 0; kh < 4; ++kh) {
        const int k = kh >> 1, h = kh & 1;
        if (IN(13 + 2 * kh) || IN(14 + 2 * kh)) {
            for (int j = tid; j < 288; j += NTHR) *(LAS int*)(lds + LDS_TILE_OFF + 4 * j) = (j < MAXTILES + 8) ? tilemeta[j] : 0;
            __syncthreads();
        }
        const LAS int* tmeta = (const LAS int*)(lds + LDS_TILE_OFF);
        if (IN(13 + 2 * kh)) {
            const int nk0 = __builtin_amdgcn_readfirstlane(tmeta[0]), nall = __builtin_amdgcn_readfirstlane(tmeta[1]);
            const int rt_lo = k ? nk0 : 0, nM = k ? nall - nk0 : nk0;
            pg8::Gemm g{HS, Wegu_t, D, D, D}; pg8::MoeOrder S; S.T.init(nM, NFE_T / 2, G, bx); S.rt_lo = rt_lo; S.tpe = NFE_T; S.ct0 = h * (NFE_T / 2); S.a_abs = 1; S.tile_e = tmeta + 8;
            pg8::EpiSwiGLU E{H2, DFE_H};
            pg8::gemm_phase<pg8::EpiSwiGLU, pg8::MoeOrder>(lds, g, S, E);
        }
        SEAM(13 + 2 * kh);
        if (IN(14 + 2 * kh)) {
            const int nk0 = __builtin_amdgcn_readfirstlane(tmeta[0]), nall = __builtin_amdgcn_readfirstlane(tmeta[1]);
            const int rt_lo = k ? nk0 : 0, nM = k ? nall - nk0 : nk0;
            pg8::Gemm g{H2, Wed_t + (size_t)h * DFE_H, DFE_H, DFE, DFE_H}; pg8::MoeOrder S; S.T.init(nM, D / 256, G, bx); S.rt_lo = rt_lo; S.tpe = D / 256; S.ct0 = 0; S.a_abs = 0; S.tile_e = tmeta + 8;
            pg8::EpiMoeDown E{X, slot_tok, slot_w};
            pg8::gemm_phase<pg8::EpiMoeDown, pg8::MoeOrder>(lds, g, S, E);
        }
        SEAM(14 + 2 * kh);
    }

    if (IN(21)) {
        for (int m = gw; m < M; m += NGW) {
            float* xrow = X + (size_t)m * D; f32x4 v[4];
#pragma unroll
            for (int j = 0; j < 4; ++j) v[j] = *(const f32x4*)(xrow + 256 * j + 4 * lane);
            float s = 0.f;
#pragma unroll
            for (int j = 0; j < 4; ++j) s += (v[j][0] * v[j][0] + v[j][1] * v[j][1]) + (v[j][2] * v[j][2] + v[j][3] * v[j][3]);
            const float r = 1.0f / sqrtf(wave_sum(s) * (1.0f / D) + RMS_EPS);
#pragma unroll
            for (int j = 0; j < 4; ++j) { const f32x4 g4 = *(const f32x4*)(p.in[I_FINAL] + 256 * j + 4 * lane); *(f32x4*)(xrow + 256 * j + 4 * lane) = v[j] * r * g4; }
        }
    }
#undef IN
#undef SEAM
}

extern "C" void kernel_launch(void* const* d_in, const int* in_sizes, int n_in, void* d_out, int out_size, void* d_ws, size_t ws_size, hipStream_t stream) {
    static int grid = 0;
    if (grid == 0) {
        if (n_in != 24 || in_sizes[0] != M * D || out_size != M * D || ws_size < WS_END) { fprintf(stderr, "kernel_launch: unexpected shapes (n_in %d, in0 %d, out %d, ws %zu < %zu)\n", n_in, n_in > 0 ? in_sizes[0] : -1, out_size, ws_size, (size_t)WS_END); grid = -1; return; }
        int dev = 0, cus = 0, per_cu = 0;
        if (hipGetDevice(&dev) != hipSuccess || hipDeviceGetAttribute(&cus, hipDeviceAttributeMultiprocessorCount, dev) != hipSuccess) { grid = -1; return; }
        if (hipFuncSetAttribute((const void*)fwd_kernel, hipFuncAttributeMaxDynamicSharedMemorySize, LDS_BYTES) != hipSuccess) { fprintf(stderr, "kernel_launch: hipFuncSetAttribute failed\n"); grid = -1; return; }
        if (hipOccupancyMaxActiveBlocksPerMultiprocessor(&per_cu, (const void*)fwd_kernel, NTHR, LDS_BYTES) != hipSuccess || per_cu < 1) fprintf(stderr, "kernel_launch: occupancy query reports %d\n", per_cu);
        (void)hipGetLastError();
        grid = cus < 256 ? cus : 256;
    }
    if (grid < 0) return;
    (void)hipMemsetAsync((char*)d_ws + WS_CTL, 0, CTL_ZERO_BYTES, stream);
    Params a{};
    for (int i = 0; i < 24; ++i) a.in[i] = (const float*)d_in[i];
    a.out = (float*)d_out; a.ws = (unsigned char*)d_ws;
    constexpr int NPH = 22;
    if (MK_N_LAUNCHES == 1) { a.ph_lo = 0; a.ph_hi = NPH; hipLaunchKernelGGL(fwd_kernel, dim3(grid), dim3(NTHR), LDS_BYTES, stream, a); }
    else for (int li = 0; li < NPH; ++li) { a.ph_lo = li; a.ph_hi = li + 1; hipLaunchKernelGGL(fwd_kernel, dim3(grid), dim3(NTHR), LDS_BYTES, stream, a); }
}
```

```cpp
#include <hip/hip_runtime.h>
#include <cstdio>
#include <cstdint>

#ifndef MK_N_LAUNCHES
#define MK_N_LAUNCHES 1
#endif

#define LAS __attribute__((address_space(3)))
#define GAS __attribute__((address_space(1)))
typedef unsigned short bf16_t;
typedef short bf16x8 __attribute__((ext_vector_type(8)));
typedef short s16x4 __attribute__((ext_vector_type(4)));
typedef float f32x2 __attribute__((ext_vector_type(2)));
typedef float f32x4 __attribute__((ext_vector_type(4)));
typedef float f32x16 __attribute__((ext_vector_type(16)));
typedef unsigned u32x2 __attribute__((ext_vector_type(2)));
typedef unsigned u32x4 __attribute__((ext_vector_type(4)));
typedef __bf16 hbf16x2 __attribute__((ext_vector_type(2)));

constexpr int D = 1024, BATCH = 2, SEQ = 16384, M = BATCH * SEQ;
constexpr int MIXN = 2048;
constexpr int DFF = 2816, NFF_T = DFF / 128;
constexpr int QKVN = 1280, NQH = 16, NKVH = 2, HD = 64, CHUNK = 64, KVSPAN = 192;
constexpr int NEXP = 8, DFE = 3584, NFE_T = DFE / 128;
constexpr int DFE_H = DFE / 2;
constexpr float RMS_EPS = 1e-6f;
constexpr int MAXSLOT = 69120;
constexpr int MAXTILES = MAXSLOT / 256;
constexpr int NWAVES = 8, NTHR = 512;

constexpr size_t MiB = 1u << 20;
constexpr size_t WS_CTL = 0, CTL_ZERO_BYTES = 1 * MiB;
constexpr size_t WS_BIAS = 1 * MiB;
constexpr size_t WS_WGCNT = WS_BIAS + 16 * 256 * 4;
constexpr size_t WS_TILE = WS_WGCNT + 1024 * 16 * 4;
constexpr size_t WS_TOKE = WS_TILE + 4096;
constexpr size_t WS_TOKW = WS_TOKE + 2 * (size_t)M * 4;
constexpr size_t WS_TOKR = WS_TOKW + 2 * (size_t)M * 4;
constexpr size_t WS_SLOTT = WS_TOKR + 2 * (size_t)M * 4;
constexpr size_t WS_SLOTW = WS_SLOTT + (size_t)MAXSLOT * 4;
static_assert(WS_SLOTW + (size_t)MAXSLOT * 4 <= 4 * MiB, "route region");
constexpr size_t WS_WIN = 4 * MiB;
constexpr size_t WS_WOUT = WS_WIN + (size_t)MIXN * D * 2;
constexpr size_t WS_WGU = WS_WOUT + (size_t)D * D * 2;
constexpr size_t WS_WD = WS_WGU + (size_t)2 * DFF * D * 2;
constexpr size_t WS_WQKV = WS_WD + (size_t)D * DFF * 2;
constexpr size_t WS_WO = WS_WQKV + (size_t)QKVN * D * 2;
static_assert(WS_WO + (size_t)D * D * 2 <= 31 * MiB, "dense weights");
constexpr size_t WS_WEGU = 31 * MiB;
constexpr size_t WS_WED = WS_WEGU + (size_t)NEXP * 2 * DFE * D * 2;
static_assert(WS_WED + (size_t)NEXP * D * DFE * 2 == 199 * MiB, "expert weights");
constexpr size_t WS_XN = 199 * MiB;
constexpr size_t WS_R = 263 * MiB;
constexpr size_t WS_PROJ = WS_R, WS_MIXED = WS_R + (size_t)M * MIXN * 2;
constexpr size_t WS_H = WS_R;
constexpr size_t WS_QKV = WS_R, WS_AO = WS_R + (size_t)M * QKVN * 2;
constexpr size_t WS_HS = WS_R, WS_H2 = WS_R + (size_t)MAXSLOT * D * 2;
constexpr size_t WS_END = WS_H2 + (size_t)(MAXSLOT / 2) * DFE_H * 2;
static_assert(WS_END <= 543497280ull, "workspace");
static_assert(WS_MIXED + (size_t)M * D * 2 <= 543497280ull && WS_H + (size_t)M * DFF * 2 <= 543497280ull, "workspace");

constexpr int CW_BAR = 4096;

constexpr int RING_BYTES = 131072;
constexpr int LDS_TILE_OFF = RING_BYTES;
constexpr int LDS_MISC_OFF = RING_BYTES + 2048;
constexpr int LDS_BYTES = 147456;

__device__ __forceinline__ unsigned pk2(float lo, float hi) { f32x2 v = {lo, hi}; hbf16x2 b = __builtin_convertvector(v, hbf16x2); return __builtin_bit_cast(unsigned, b); }
__device__ __forceinline__ float bf_lo(unsigned w) { return __uint_as_float(w << 16); }
__device__ __forceinline__ float bf_hi(unsigned w) { return __uint_as_float(w & 0xffff0000u); }
__device__ __forceinline__ void unpack8(const u32x4 w, float (&f)[8]) { f[0] = bf_lo(w.x); f[1] = bf_hi(w.x); f[2] = bf_lo(w.y); f[3] = bf_hi(w.y); f[4] = bf_lo(w.z); f[5] = bf_hi(w.z); f[6] = bf_lo(w.w); f[7] = bf_hi(w.w); }
__device__ __forceinline__ u32x4 pack8(const float (&f)[8]) { u32x4 w; w.x = pk2(f[0], f[1]); w.y = pk2(f[2], f[3]); w.z = pk2(f[4], f[5]); w.w = pk2(f[6], f[7]); return w; }
__device__ __forceinline__ float wave_sum(float v) {
#pragma unroll
    for (int o = 1; o < 64; o <<= 1) v += __shfl_xor(v, o);
    return v;
}
#define LDS_WAIT() asm volatile("s_waitcnt lgkmcnt(0)" ::: "memory")
#define VM_WAIT() asm volatile("s_waitcnt vmcnt(0)" ::: "memory")

namespace pg8 {
constexpr int BM = 256, BK = 64, HALF = 128, HTB = HALF * BK * 2, STAGE_BYTES = 8 * HTB, NXCD = 8, WGM = 8;
__host__ __device__ __forceinline__ int lds_byte(int r, int c) { const int st = (r >> 4) * 2 + (c >> 5), rr = r & 15, cc = c & 31, ob = rr * 64 + cc * 2; return st * 1024 + (ob ^ (((ob >> 9) & 1) << 5)); }
__host__ __device__ __forceinline__ void stage_rc(int b, int& R, int& C) { const int st = b / 1024, sb = b % 1024, swz = sb ^ (((sb >> 9) & 1) << 5); R = (st >> 1) * 16 + swz / 64; C = (st & 1) * 32 + (swz % 64) / 2; }
__host__ __device__ __forceinline__ int perm32(int rho) { const int n = rho >> 4, i = rho & 15; return 8 * (i >> 2) + 4 * n + (i & 3); }

struct Unit { int pm, pn, rm, cn; };
struct Gemm { const bf16_t* A; const bf16_t* Bt; int lda, ldb, K; };

struct TileOrder {
    int nM, nN, nwg, G, c;
    __device__ __forceinline__ void init(int nM_, int nN_, int G_, int c_) { nM = nM_; nN = nN_; nwg = nM * nN; G = G_; c = c_; }
    __device__ __forceinline__ bool next(int i, int& m, int& n) const {
        const long L = (long)i * G + c; if (L >= nwg) return false;
        int wgid = (int)L; { const int q = nwg / NXCD, r = nwg % NXCD, xcd = wgid % NXCD, off = wgid / NXCD; wgid = (xcd < r ? xcd * (q + 1) : r * (q + 1) + (xcd - r) * q) + off; }
        const int nig = WGM * nN, gid = wgid / nig, fm = gid * WGM, gsz = (nM - fm) < WGM ? (nM - fm) : WGM;
        m = fm + ((wgid % nig) % gsz); n = (wgid % nig) / gsz; return true;
    }
};
struct DenseOrder {
    TileOrder T;
    __device__ __forceinline__ void init(int Mr, int N, int G, int c) { T.init(Mr / BM, N / BM, G, c); }
    __device__ __forceinline__ bool next(int i, Unit& u) const { int m, n; if (!T.next(i, m, n)) return false; u.pm = m; u.pn = n; u.rm = m; u.cn = n; return true; }
    __device__ __forceinline__ void a_ready(const Unit&) const {}
    __device__ __forceinline__ void done(const Unit&) const {}
};
struct MoeOrder {
    TileOrder T; int rt_lo, tpe, ct0, a_abs; const LAS int* tile_e;
    __device__ __forceinline__ bool next(int i, Unit& u) const { int m, n; if (!T.next(i, m, n)) return false;
        const int e = __builtin_amdgcn_readfirstlane(tile_e[rt_lo + m]);
        u.pm = a_abs ? rt_lo + m : m; u.pn = e * tpe + ct0 + n; u.rm = a_abs ? m : rt_lo + m; u.cn = n; return true; }
    __device__ __forceinline__ void a_ready(const Unit&) const {}
    __device__ __forceinline__ void done(const Unit&) const {}
};

struct EpiBf16 {
    static constexpr bool PERM = true;
    bf16_t* O; int ldc; const float* bias;
    __device__ __forceinline__ void operator()(const f32x4 (&acc)[2][2][4][2], const Unit& u, int wr, int wc, int fr, int fq) const {
        const int row0 = u.rm * BM + wr * 64 + fr, col0 = u.cn * BM + wc * 32 + 8 * fq;
        f32x4 bv[2][2];
#pragma unroll
        for (int bj = 0; bj < 2; ++bj)
#pragma unroll
            for (int n = 0; n < 2; ++n) bv[bj][n] = bias ? *(const f32x4*)(bias + col0 + bj * HALF + 4 * n) : (f32x4){0.f, 0.f, 0.f, 0.f};
#pragma unroll
        for (int ai = 0; ai < 2; ++ai)
#pragma unroll
            for (int m = 0; m < 4; ++m) { bf16_t* rowp = O + (size_t)(row0 + ai * HALF + m * 16) * ldc + col0;
#pragma unroll
                for (int bj = 0; bj < 2; ++bj) { const f32x4 v0 = acc[ai][bj][m][0] + bv[bj][0], v1 = acc[ai][bj][m][1] + bv[bj][1];
                    u32x4 w; w.x = pk2(v0[0], v0[1]); w.y = pk2(v0[2], v0[3]); w.z = pk2(v1[0], v1[1]); w.w = pk2(v1[2], v1[3]);
                    *(u32x4*)(rowp + bj * HALF) = w; } }
    }
};
__device__ __forceinline__ float silu_mul(float g, float u) { return g * u * __builtin_amdgcn_rcpf(1.0f + __builtin_amdgcn_exp2f(-1.44269504089f * g)); }
struct EpiSwiGLU {
    static constexpr bool PERM = true;
    bf16_t* O; int ldc;
    __device__ __forceinline__ void operator()(const f32x4 (&acc)[2][2][4][2], const Unit& u, int wr, int wc, int fr, int fq) const {
        const int row0 = u.rm * BM + wr * 64 + fr, col0 = u.cn * HALF + wc * 32 + 8 * fq;
#pragma unroll
        for (int ai = 0; ai < 2; ++ai)
#pragma unroll
            for (int m = 0; m < 4; ++m) { bf16_t* rowp = O + (size_t)(row0 + ai * HALF + m * 16) * ldc + col0;
                const f32x4 g0 = acc[ai][0][m][0], g1 = acc[ai][0][m][1], u0 = acc[ai][1][m][0], u1 = acc[ai][1][m][1];
                u32x4 w; w.x = pk2(silu_mul(g0[0], u0[0]), silu_mul(g0[1], u0[1])); w.y = pk2(silu_mul(g0[2], u0[2]), silu_mul(g0[3], u0[3]));
                w.z = pk2(silu_mul(g1[0], u1[0]), silu_mul(g1[1], u1[1])); w.w = pk2(silu_mul(g1[2], u1[2]), silu_mul(g1[3], u1[3]));
                *(u32x4*)rowp = w; }
    }
};
struct EpiResid {
    static constexpr bool PERM = false;
    const float* base; float* out; const float* bias;
    __device__ __forceinline__ void operator()(const f32x4 (&acc)[2][2][4][2], const Unit& u, int wr, int wc, int fr, int fq) const {
        const int row0 = u.rm * BM + wr * 64 + fr, col0 = u.cn * BM + wc * 32 + 4 * fq;
        f32x4 bv[2][2];
#pragma unroll
        for (int bj = 0; bj < 2; ++bj)
#pragma unroll
            for (int n = 0; n < 2; ++n) bv[bj][n] = bias ? *(const f32x4*)(bias + col0 + bj * HALF + n * 16) : (f32x4){0.f, 0.f, 0.f, 0.f};
#pragma unroll
        for (int ai = 0; ai < 2; ++ai)
#pragma unroll
            for (int m = 0; m < 4; ++m) { const size_t off = (size_t)(row0 + ai * HALF + m * 16) * D + col0;
                f32x4 bs[2][2];
#pragma unroll
                for (int bj = 0; bj < 2; ++bj)
#pragma unroll
                    for (int n = 0; n < 2; ++n) bs[bj][n] = *(const f32x4*)(base + off + bj * HALF + n * 16);
#pragma unroll
                for (int bj = 0; bj < 2; ++bj)
#pragma unroll
                    for (int n = 0; n < 2; ++n) *(f32x4*)(out + off + bj * HALF + n * 16) = bs[bj][n] + acc[ai][bj][m][n] + bv[bj][n];
                asm volatile("" ::: "memory"); }
    }
};
struct EpiMoeDown {
    static constexpr bool PERM = false;
    float* out; const int* slot_tok; const float* slot_w;
    __device__ __forceinline__ void operator()(const f32x4 (&acc)[2][2][4][2], const Unit& u, int wr, int wc, int fr, int fq) const {
        const int row0 = u.rm * BM + wr * 64 + fr, col0 = u.cn * BM + wc * 32 + 4 * fq;
#pragma unroll
        for (int ai = 0; ai < 2; ++ai)
#pragma unroll
            for (int m = 0; m < 4; ++m) { const int slot = row0 + ai * HALF + m * 16; const int tok = slot_tok[slot]; const float w = slot_w[slot];
                if (tok >= 0) { float* rowp = out + (size_t)tok * D + col0;
                    f32x4 bs[2][2];
#pragma unroll
                    for (int bj = 0; bj < 2; ++bj)
#pragma unroll
                        for (int n = 0; n < 2; ++n) bs[bj][n] = *(const f32x4*)(rowp + bj * HALF + n * 16);
#pragma unroll
                    for (int bj = 0; bj < 2; ++bj)
#pragma unroll
                        for (int n = 0; n < 2; ++n) *(f32x4*)(rowp + bj * HALF + n * 16) = bs[bj][n] + acc[ai][bj][m][n] * w; }
                asm volatile("" ::: "memory"); }
    }
};

template <class Epi, class Sched, bool ALIGN_EPI = true, bool SP2 = true>
__device__ __forceinline__ void gemm_phase(LAS unsigned char* lds, const Gemm g, const Sched& S, const Epi& E) {
    const int tid = threadIdx.x, wid = __builtin_amdgcn_readfirstlane(tid >> 6), lane = tid & 63, wr = wid >> 2, wc = wid & 3, fr = lane & 15, fq = lane >> 4;
    const int nt = g.K / BK;
    unsigned voffA[2], voffB[2];
#pragma unroll
    for (int i = 0; i < 2; ++i) { int R, C; stage_rc(tid * 16 + i * 8192, R, C); const int Rb = Epi::PERM ? ((R & ~31) + perm32(R & 31)) : R;
        voffA[i] = (unsigned)(R * g.lda + C) * 2u; voffB[i] = (unsigned)(Rb * g.ldb + C) * 2u; }
    const size_t kstep = (size_t)(BK * 2);
    const size_t hstepA = (size_t)HALF * g.lda * 2, hstepB = (size_t)HALF * g.ldb * 2;
    const size_t tstepA = 2 * hstepA, tstepB = 2 * hstepB;
    const unsigned ldsw = (unsigned)wid * 1024u;
    const int aoff = lds_byte(wr * 64 + fr, fq * 8), boff = lds_byte(wc * 32 + fr, fq * 8);
#define PG8_SA(b, h) (((b) * 2 + (h)) * HTB)
#define PG8_SB(b, h) ((4 + (b) * 2 + (h)) * HTB)
#define PG8_STAGE(bufoff, gbase, voff) do { _Pragma("unroll") for (int _i = 0; _i < 2; ++_i) \
        __builtin_amdgcn_global_load_lds((const unsigned*)((const char*)(gbase) + (voff)[_i]), (LAS unsigned*)(lds + (bufoff) + ldsw + _i * 8192), 16, 0, 0); } while (0)
#define PG8_LDA(dst, b, h) do { _Pragma("unroll") for (int m = 0; m < 4; ++m) _Pragma("unroll") for (int k = 0; k < 2; ++k) dst[m][k] = *(const LAS bf16x8*)(lds + PG8_SA(b, h) + aoff + m * 2048 + k * 1024); } while (0)
#define PG8_LDB(dst, b, h) do { _Pragma("unroll") for (int n = 0; n < 2; ++n) _Pragma("unroll") for (int k = 0; k < 2; ++k) dst[n][k] = *(const LAS bf16x8*)(lds + PG8_SB(b, h) + boff + n * 2048 + k * 1024); } while (0)
#define PG8_MMA(ai, bj, At, Bt) do { __builtin_amdgcn_s_setprio(1); _Pragma("unroll") for (int m = 0; m < 4; ++m) _Pragma("unroll") for (int n = 0; n < 2; ++n) _Pragma("unroll") for (int k = 0; k < 2; ++k) \
        acc[ai][bj][m][n] = __builtin_amdgcn_mfma_f32_16x16x32_bf16(Bt[n][k], At[m][k], acc[ai][bj][m][n], 0, 0, 0); __builtin_amdgcn_s_setprio(0); } while (0)
#define PG8_WAIT_V(n) asm volatile("s_waitcnt vmcnt(" #n ")" ::: "memory")
#define PG8_WAIT_L(n) asm volatile("s_waitcnt lgkmcnt(" #n ")" ::: "memory")
#define PG8_BAR __builtin_amdgcn_s_barrier()
#define PG8_SCHED __builtin_amdgcn_sched_barrier(0)
    Unit cur, nxt; int ui = 0;
    if (!S.next(0, cur)) return;
    f32x4 acc[2][2][4][2];
#pragma unroll
    for (int a = 0; a < 2; ++a)
#pragma unroll
        for (int b = 0; b < 2; ++b)
#pragma unroll
            for (int m = 0; m < 4; ++m)
#pragma unroll
                for (int n = 0; n < 2; ++n) acc[a][b][m][n] = (f32x4){0.f, 0.f, 0.f, 0.f};
    bf16x8 At[4][2], B0[2][2], B1[2][2];
    const char* cA = (const char*)g.A + (size_t)cur.pm * tstepA; const char* cB = (const char*)g.Bt + (size_t)cur.pn * tstepB;
    S.a_ready(cur);
    if constexpr (SP2) {
        PG8_STAGE(PG8_SB(0, 0), cB, voffB); PG8_STAGE(PG8_SB(0, 1), cB + hstepB, voffB); PG8_STAGE(PG8_SA(0, 0), cA, voffA); PG8_STAGE(PG8_SA(0, 1), cA + hstepA, voffA);
        if (wr == 1) PG8_BAR;
        PG8_WAIT_V(2); PG8_BAR;
        PG8_STAGE(PG8_SB(1, 0), cB + kstep, voffB); PG8_STAGE(PG8_SA(1, 0), cA + kstep, voffA); PG8_STAGE(PG8_SB(1, 1), cB + hstepB + kstep, voffB);
        PG8_WAIT_V(6); PG8_BAR;
    } else {
        PG8_STAGE(PG8_SB(0, 0), cB, voffB); PG8_STAGE(PG8_SA(0, 0), cA, voffA); PG8_STAGE(PG8_SB(0, 1), cB + hstepB, voffB); PG8_STAGE(PG8_SA(0, 1), cA + hstepA, voffA);
        if (wr == 1) PG8_BAR;
        PG8_WAIT_V(4); PG8_BAR;
        PG8_STAGE(PG8_SB(1, 0), cB + kstep, voffB); PG8_STAGE(PG8_SA(1, 0), cA + kstep, voffA); PG8_STAGE(PG8_SB(1, 1), cB + hstepB + kstep, voffB);
        PG8_WAIT_V(6); PG8_BAR;
    }
    for (;;) {
        const bool has_next = S.next(ui + 1, nxt);
        const char* nA = has_next ? (const char*)g.A + (size_t)nxt.pm * tstepA : cA; const char* nB = has_next ? (const char*)g.Bt + (size_t)nxt.pn * tstepB : cB;
        for (int t = 0; t < nt; t += 2) {
            const bool last = (t == nt - 2);
            const char* a1 = cA + (size_t)(t + 1) * kstep;
            const char* a2 = last ? nA : cA + (size_t)(t + 2) * kstep; const char* b2 = last ? nB : cB + (size_t)(t + 2) * kstep;
            const char* a3 = a2 + kstep; const char* b3 = b2 + kstep;
            if (last && has_next) S.a_ready(nxt);
            if constexpr (SP2) {
            PG8_LDB(B0, 0, 0); PG8_LDB(B1, 0, 1); PG8_SCHED; PG8_LDA(At, 0, 0); PG8_STAGE(PG8_SA(1, 1), a1 + hstepA, voffA);
            PG8_WAIT_V(8); PG8_WAIT_L(0); PG8_BAR; PG8_MMA(0, 0, At, B0); PG8_MMA(0, 1, At, B1); PG8_BAR; PG8_SCHED;
            PG8_LDA(At, 0, 1); PG8_STAGE(PG8_SB(0, 0), b2, voffB); PG8_STAGE(PG8_SB(0, 1), b2 + hstepB, voffB); PG8_STAGE(PG8_SA(0, 0), a2, voffA);
            PG8_WAIT_V(8); PG8_WAIT_L(0); PG8_BAR; PG8_MMA(1, 0, At, B0); PG8_MMA(1, 1, At, B1); PG8_BAR; PG8_SCHED;
            PG8_LDB(B0, 1, 0); PG8_LDB(B1, 1, 1); PG8_SCHED; PG8_LDA(At, 1, 0); PG8_STAGE(PG8_SA(0, 1), a2 + hstepA, voffA);
            PG8_WAIT_V(8); PG8_WAIT_L(0); PG8_BAR; PG8_MMA(0, 0, At, B0); PG8_MMA(0, 1, At, B1); PG8_BAR; PG8_SCHED;
            PG8_LDA(At, 1, 1); PG8_STAGE(PG8_SB(1, 0), b3, voffB); PG8_STAGE(PG8_SB(1, 1), b3 + hstepB, voffB); PG8_STAGE(PG8_SA(1, 0), a3, voffA);
            PG8_WAIT_V(8); PG8_WAIT_L(0); PG8_BAR; PG8_MMA(1, 0, At, B0); PG8_MMA(1, 1, At, B1); PG8_BAR; PG8_SCHED;
            } else {
            PG8_LDB(B0, 0, 0); PG8_SCHED; PG8_LDA(At, 0, 0); PG8_STAGE(PG8_SA(1, 1), a1 + hstepA, voffA);
            PG8_WAIT_L(8); PG8_BAR; PG8_WAIT_L(0); PG8_MMA(0, 0, At, B0); PG8_BAR; PG8_SCHED;
            PG8_LDB(B1, 0, 1); PG8_STAGE(PG8_SB(0, 0), b2, voffB);
            PG8_BAR; PG8_WAIT_L(0); PG8_MMA(0, 1, At, B1); PG8_BAR;
            PG8_LDA(At, 0, 1); PG8_STAGE(PG8_SA(0, 0), a2, voffA);
            PG8_BAR; PG8_WAIT_L(0); PG8_MMA(1, 0, At, B0); PG8_BAR; PG8_SCHED;
            PG8_STAGE(PG8_SB(0, 1), b2 + hstepB, voffB);
            PG8_WAIT_V(6); PG8_BAR; PG8_MMA(1, 1, At, B1); PG8_BAR;
            PG8_LDB(B0, 1, 0); PG8_SCHED; PG8_LDA(At, 1, 0); PG8_STAGE(PG8_SA(0, 1), a2 + hstepA, voffA);
            PG8_WAIT_L(8); PG8_BAR; PG8_WAIT_L(0); PG8_MMA(0, 0, At, B0); PG8_BAR; PG8_SCHED;
            PG8_LDB(B1, 1, 1); PG8_STAGE(PG8_SB(1, 0), b3, voffB);
            PG8_BAR; PG8_WAIT_L(0); PG8_MMA(0, 1, At, B1); PG8_BAR;
            PG8_LDA(At, 1, 1); PG8_STAGE(PG8_SA(1, 0), a3, voffA);
            PG8_BAR; PG8_WAIT_L(0); PG8_MMA(1, 0, At, B0); PG8_BAR; PG8_SCHED;
            PG8_STAGE(PG8_SB(1, 1), b3 + hstepB, voffB);
            PG8_WAIT_V(6); PG8_BAR; PG8_MMA(1, 1, At, B1); PG8_BAR;
            }
        }
        if constexpr (ALIGN_EPI) { if (wr == 0) PG8_BAR; }
        E(acc, cur, wr, wc, fr, fq); S.done(cur);
        if (!has_next) break;
#pragma unroll
        for (int a = 0; a < 2; ++a)
#pragma unroll
            for (int b = 0; b < 2; ++b)
#pragma unroll
                for (int m = 0; m < 4; ++m)
#pragma unroll
                    for (int n = 0; n < 2; ++n) acc[a][b][m][n] = (f32x4){0.f, 0.f, 0.f, 0.f};
        cur = nxt; cA = nA; cB = nB; ++ui;
        if constexpr (ALIGN_EPI) { if (wr == 1) PG8_BAR; }
    }
    PG8_WAIT_V(0);
    if constexpr (!ALIGN_EPI) { if (wr == 0) PG8_BAR; }
    PG8_BAR;
#undef PG8_SA
#undef PG8_SB
#undef PG8_STAGE
#undef PG8_LDA
#undef PG8_LDB
#undef PG8_MMA
#undef PG8_WAIT_V
#undef PG8_WAIT_L
#undef PG8_BAR
#undef PG8_SCHED
}
}

#define XB_TMO      128
#define XB_XCNT(j)  (256  + 64 * (j))
#define XB_XSUB(j)  (1280 + 64 * (j))
#define XB_XGEN(j)  (2304 + 64 * (j))
#define XB_TOP      3328
#define XB_TOPGEN   3392
#define XCD_BAR_WORDS 3456
#define XB_SPIN_CAP (1u << 18)
__device__ __forceinline__ unsigned xb_ld(unsigned* p)              { return __hip_atomic_load(p, __ATOMIC_RELAXED, __HIP_MEMORY_SCOPE_AGENT); }
__device__ __forceinline__ unsigned xb_add(unsigned* p, unsigned v) { return __hip_atomic_fetch_add(p, v, __ATOMIC_RELAXED, __HIP_MEMORY_SCOPE_AGENT); }
__device__ __forceinline__ unsigned xb_xcc_id() { return (unsigned)__builtin_amdgcn_s_getreg((3 << 11) | 20) & 0xFu; }
#define XB_SPIN(cond, bar) do { unsigned _sp = 0; while (cond) { __builtin_amdgcn_s_sleep(1); \
    if ((++_sp & 255u) == 0u) { if (xb_ld(&(bar)[XB_TMO])) break; if (_sp > XB_SPIN_CAP) { atomicAdd(&(bar)[XB_TMO], 1u); break; } } } } while (0)
struct XcdBarrier { unsigned* bar; unsigned x; volatile LAS unsigned* st; };
__device__ __forceinline__ XcdBarrier xcd_barrier_post(unsigned* bar, volatile LAS unsigned* st) {
    XcdBarrier b; b.bar = bar; b.x = xb_xcc_id(); b.st = st;
    if (threadIdx.x == 0) (void)xb_add(&bar[XB_XCNT(b.x)], 1u);
    return b;
}
__device__ __forceinline__ void xcd_barrier_complete(unsigned* bar, unsigned x, unsigned& nloc, unsigned& nx) {
    const unsigned G = gridDim.x * gridDim.y * gridDim.z;
    unsigned sum, cnt, mine, sp = 0u;
    for (;;) {
        sum = 0u; cnt = 0u; mine = 0u;
#pragma unroll
        for (unsigned j = 0; j < 16; ++j) { const unsigned c = xb_ld(&bar[XB_XCNT(j)]); sum += c; cnt += (c > 0u) ? 1u : 0u; mine = (j == x) ? c : mine; }
        if (sum == G) break;
        __builtin_amdgcn_s_sleep(1);
        if ((++sp & 255u) == 0u) { if (xb_ld(&bar[XB_TMO])) break; if (sp > XB_SPIN_CAP) { atomicAdd(&bar[XB_TMO], 1u); break; } }
    }
    nloc = mine > 0u ? mine : 1u; nx = cnt > 0u ? cnt : 1u;
}
__device__ __forceinline__ void xcd_barrier(const XcdBarrier& b) {
    asm volatile("s_waitcnt vmcnt(0)" ::: "memory");
    __syncthreads();
    if (threadIdx.x == 0) {
        unsigned* bar = b.bar;
        __builtin_amdgcn_s_waitcnt(0);
        unsigned nloc = b.st[0], nx = b.st[1];
        if (nloc == 0u) { xcd_barrier_complete(bar, b.x, nloc, nx); b.st[0] = nloc; b.st[1] = nx; }
        const unsigned old = xb_add(&bar[XB_XSUB(b.x)], 1u);
        const unsigned gen = old / nloc;
        if (old + 1u == (gen + 1u) * nloc) {
            __builtin_amdgcn_fence(__ATOMIC_RELEASE, "agent");
            asm volatile("s_waitcnt vmcnt(0)" ::: "memory");
            const unsigned og = xb_add(&bar[XB_TOP], 1u);
            const unsigned tg = og / nx;
            if (og + 1u == (tg + 1u) * nx) xb_add(&bar[XB_TOPGEN], 1u);
            else XB_SPIN(xb_ld(&bar[XB_TOPGEN]) == tg, bar);
            __builtin_amdgcn_fence(__ATOMIC_ACQUIRE, "agent");
            xb_add(&bar[XB_XGEN(b.x)], 1u);
            asm volatile("s_waitcnt vmcnt(0)" ::: "memory");
        } else {
            XB_SPIN(xb_ld(&bar[XB_XGEN(b.x)]) == gen, bar);
            __builtin_amdgcn_fence(__ATOMIC_ACQUIRE, "agent");
            asm volatile("s_waitcnt vmcnt(0)" ::: "memory");
        }
    }
    __syncthreads();
}

struct Params { const float* in[24]; float* out; unsigned char* ws; int ph_lo, ph_hi; };
enum { I_X = 0, I_RELB, I_EVNM, I_WIN, I_POOLW, I_POOLS, I_CONVW, I_WOUT, I_EVNF, I_FG, I_FU, I_FD, I_ODNM, I_WQKV, I_BQKV, I_SINK, I_WO, I_BO, I_ODNF, I_ROUTER, I_EG, I_EU, I_ED, I_FINAL };

__device__ __forceinline__ void p0_tile(const float* __restrict__ src, int N, int k0, int n0, bf16_t* __restrict__ dst, int ldd, LAS unsigned char* scr, int lane) {
    const int n4 = (lane & 15) * 4, kp = lane >> 4;
    f32x4 a[8], b[8];
#pragma unroll
    for (int i = 0; i < 8; ++i) { const float* p = src + (size_t)(k0 + 8 * i + 2 * kp) * N + n0 + n4; a[i] = *(const f32x4*)p; b[i] = *(const f32x4*)(p + N); }
#pragma unroll
    for (int i = 0; i < 8; ++i) { const int k = 8 * i + 2 * kp;
#pragma unroll
        for (int q = 0; q < 4; ++q) *(LAS unsigned*)(scr + (n4 + q) * 136 + k * 2) = pk2(a[i][q], b[i][q]); }
    LDS_WAIT();
    const int c = lane & 7, nr = lane >> 3;
#pragma unroll
    for (int j = 0; j < 8; ++j) { const int n = 8 * j + nr; const u32x2 lo = *(const LAS u32x2*)(scr + n * 136 + 16 * c), hi = *(const LAS u32x2*)(scr + n * 136 + 16 * c + 8);
        u32x4 o; o.x = lo.x; o.y = lo.y; o.z = hi.x; o.w = hi.y; *(u32x4*)(dst + (size_t)n * ldd + 8 * c) = o; }
    LDS_WAIT();
}
__device__ __forceinline__ void norm_row_bf16(const float* __restrict__ xrow, const float* __restrict__ gain, bf16_t* __restrict__ orow, int lane, float (&y)[16]) {
    f32x4 v[4];
#pragma unroll
    for (int j = 0; j < 2; ++j) { v[2 * j] = *(const f32x4*)(xrow + 512 * j + 8 * lane); v[2 * j + 1] = *(const f32x4*)(xrow + 512 * j + 8 * lane + 4); }
    float s = 0.f;
#pragma unroll
    for (int j = 0; j < 4; ++j) s += (v[j][0] * v[j][0] + v[j][1] * v[j][1]) + (v[j][2] * v[j][2] + v[j][3] * v[j][3]);
    const float r = 1.0f / sqrtf(wave_sum(s) * (1.0f / D) + RMS_EPS);
#pragma unroll
    for (int j = 0; j < 2; ++j) { const f32x4 g0 = *(const f32x4*)(gain + 512 * j + 8 * lane), g1 = *(const f32x4*)(gain + 512 * j + 8 * lane + 4);
#pragma unroll
        for (int q = 0; q < 4; ++q) { y[8 * j + q] = v[2 * j][q] * r * g0[q]; y[8 * j + 4 + q] = v[2 * j + 1][q] * r * g1[q]; }
        u32x4 w; w.x = pk2(y[8 * j], y[8 * j + 1]); w.y = pk2(y[8 * j + 2], y[8 * j + 3]); w.z = pk2(y[8 * j + 4], y[8 * j + 5]); w.w = pk2(y[8 * j + 6], y[8 * j + 7]);
        *(u32x4*)(orow + 512 * j + 8 * lane) = w; }
}

__device__ __forceinline__ int t5_bucket(int rel) {
    const int n = rel < 0 ? -rel : rel; const int ret = rel > 0 ? 16 : 0;
    int v;
    if (n < 8) v = n; else if (n < 12) v = 8; else if (n < 16) v = 9; else if (n < 23) v = 10; else if (n < 32) v = 11; else if (n < 46) v = 12; else if (n < 64) v = 13; else if (n < 91) v = 14; else v = 15;
    return ret + v;
}

__global__ void __launch_bounds__(NTHR, 2) fwd_kernel(Params p) {
    extern __shared__ __attribute__((aligned(16))) unsigned char lds_raw[];
    LAS unsigned char* lds = (LAS unsigned char*)lds_raw;
    volatile LAS unsigned* MISC = (volatile LAS unsigned*)(lds + LDS_MISC_OFF);
    const int tid = threadIdx.x, lane = tid & 63, wave = __builtin_amdgcn_readfirstlane(tid >> 6);
    const int G = gridDim.x, bx = blockIdx.x;
    const int vcu = (G % 8 == 0) ? (bx % 8) * (G / 8) + bx / 8 : bx;
    const int gw = vcu * NWAVES + wave, NGW = G * NWAVES;
    unsigned char* ws = p.ws;
    unsigned* ctl = (unsigned*)(ws + WS_CTL);
    if (tid < 64) MISC[tid] = 0u;
    __syncthreads();
    XcdBarrier bar; bar.bar = ctl + CW_BAR; bar.x = 0; bar.st = nullptr;
    if (MK_N_LAUNCHES == 1) bar = xcd_barrier_post(ctl + CW_BAR, MISC + 8);
    const int lo = p.ph_lo, hi = p.ph_hi;
#define IN(k) (lo <= (k) && (k) < hi)
#define SEAM(k) do { if (MK_N_LAUNCHES == 1 && IN((k) + 1)) xcd_barrier(bar); } while (0)

    bf16_t* Win_t = (bf16_t*)(ws + WS_WIN); bf16_t* Wout_t = (bf16_t*)(ws + WS_WOUT); bf16_t* Wgu_t = (bf16_t*)(ws + WS_WGU); bf16_t* Wd_t = (bf16_t*)(ws + WS_WD);
    bf16_t* Wqkv_t = (bf16_t*)(ws + WS_WQKV); bf16_t* Wo_t = (bf16_t*)(ws + WS_WO); bf16_t* Wegu_t = (bf16_t*)(ws + WS_WEGU); bf16_t* Wed_t = (bf16_t*)(ws + WS_WED);
    bf16_t* XN = (bf16_t*)(ws + WS_XN); bf16_t* PROJ = (bf16_t*)(ws + WS_PROJ); bf16_t* MIXED = (bf16_t*)(ws + WS_MIXED); bf16_t* Hb = (bf16_t*)(ws + WS_H);
    bf16_t* QKV = (bf16_t*)(ws + WS_QKV); bf16_t* AO = (bf16_t*)(ws + WS_AO); bf16_t* HS = (bf16_t*)(ws + WS_HS); bf16_t* H2 = (bf16_t*)(ws + WS_H2);
    float* bias_tab = (float*)(ws + WS_BIAS); int* wgcnt = (int*)(ws + WS_WGCNT); int* tilemeta = (int*)(ws + WS_TILE);
    int* tok_e = (int*)(ws + WS_TOKE); float* tok_w = (float*)(ws + WS_TOKW); int* tok_r = (int*)(ws + WS_TOKR); int* slot_tok = (int*)(ws + WS_SLOTT); float* slot_w = (float*)(ws + WS_SLOTW);
    float* X = p.out;

    if (IN(0)) {
        LAS unsigned char* scr = lds + wave * 8704;
        constexpr int T_WIN = 16 * 32, T_WOUT = 8 * 16, T_FG = 16 * 44, T_FD = 44 * 16, T_QKV = 16 * 20, T_WO = 16 * 16, T_EG = 16 * 56, T_ED = 56 * 16;
        constexpr int NT = T_WIN + T_WOUT + 2 * T_FG + T_FD + T_QKV + T_WO + NEXP * (2 * T_EG + T_ED);
        for (int it = gw; it < NT; it += NGW) {
            int r = it;
            if (r < T_WIN) { const int kb = r / 32, nb = r % 32; p0_tile(p.in[I_WIN], MIXN, 64 * kb, 64 * nb, Win_t + (size_t)(64 * nb) * D + 64 * kb, D, scr, lane); continue; } r -= T_WIN;
            if (r < T_WOUT) { const int kb = 8 + r / 16, nb = r % 16; p0_tile(p.in[I_WOUT], D, 64 * kb, 64 * nb, Wout_t + (size_t)(64 * nb) * D + 64 * kb, D, scr, lane); continue; } r -= T_WOUT;
            if (r < 2 * T_FG) { const int up = r >= T_FG; const int q = up ? r - T_FG : r; const int kb = q / 44, nb = q % 44, n0 = 64 * nb;
                p0_tile(p.in[up ? I_FU : I_FG], DFF, 64 * kb, n0, Wgu_t + (size_t)((n0 / 128) * 256 + (n0 % 128) + (up ? 128 : 0)) * D + 64 * kb, D, scr, lane); continue; } r -= 2 * T_FG;
            if (r < T_FD) { const int kb = r / 16, nb = r % 16; p0_tile(p.in[I_FD], D, 64 * kb, 64 * nb, Wd_t + (size_t)(64 * nb) * DFF + 64 * kb, DFF, scr, lane); continue; } r -= T_FD;
            if (r < T_QKV) { const int kb = r / 20, nb = r % 20; p0_tile(p.in[I_WQKV], QKVN, 64 * kb, 64 * nb, Wqkv_t + (size_t)(64 * nb) * D + 64 * kb, D, scr, lane); continue; } r -= T_QKV;
            if (r < T_WO) { const int kb = r / 16, nb = r % 16; p0_tile(p.in[I_WO], D, 64 * kb, 64 * nb, Wo_t + (size_t)(64 * nb) * D + 64 * kb, D, scr, lane); continue; } r -= T_WO;
            { const int per_e = 2 * T_EG + T_ED; const int e = r / per_e; int q = r % per_e;
              if (q < 2 * T_EG) { const int up = q >= T_EG; if (up) q -= T_EG; const int kb = q / 56, nb = q % 56, n0 = 64 * nb;
                  p0_tile(p.in[up ? I_EU : I_EG] + (size_t)e * D * DFE, DFE, 64 * kb, n0, Wegu_t + ((size_t)e * 2 * DFE + (n0 / 128) * 256 + (n0 % 128) + (up ? 128 : 0)) * D + 64 * kb, D, scr, lane); }
              else { q -= 2 * T_EG; const int kb = q / 16, nb = q % 16;
                  p0_tile(p.in[I_ED] + (size_t)e * DFE * D, D, 64 * kb, 64 * nb, Wed_t + ((size_t)e * D + 64 * nb) * DFE + 64 * kb, DFE, scr, lane); } }
        }
        for (int it = gw; it < 4 * 16 * 16; it += NGW) {
            const int g = it >> 8, cb = (it >> 4) & 15, nb = it & 15; const int n = 64 * nb + lane, c0 = 8 * cb;
            const float* wo = p.in[I_WOUT] + (size_t)(g * 128) * D + n; const float* ps = p.in[I_POOLS] + g * 128; const float* pw = p.in[I_POOLW] + (size_t)(g * 128 + c0) * 128;
            float acc[8];
#pragma unroll
            for (int cc = 0; cc < 8; ++cc) acc[cc] = 0.f;
            for (int d = 0; d < 128; ++d) { const float w = wo[(size_t)d * D] * ps[d];
#pragma unroll
                for (int cc = 0; cc < 8; ++cc) acc[cc] += pw[cc * 128 + d] * w; }
            *(u32x4*)(Wout_t + (size_t)n * D + g * 128 + c0) = pack8(acc);
        }
        for (int m = gw; m < M; m += NGW) { float y[16]; norm_row_bf16(p.in[I_X] + (size_t)m * D, p.in[I_EVNM], XN + (size_t)m * D, lane, y); }
        for (int i = bx * NTHR + tid; i < NQH * 256; i += G * NTHR) { const int h = i >> 8, idx = i & 255; bias_tab[i] = idx < 255 ? p.in[I_RELB][t5_bucket(idx - 191) * NQH + h] : 0.f; }
    }
    SEAM(0);

    if (IN(1)) { pg8::Gemm g{XN, Win_t, D, D, D}; pg8::DenseOrder S; S.init(M, MIXN, G, bx); pg8::EpiBf16 E{PROJ, MIXN, nullptr};
        pg8::gemm_phase<pg8::EpiBf16, pg8::DenseOrder>(lds, g, S, E); }
    SEAM(1);

    if (IN(2)) {
        for (int unit = gw; unit < (M / 32) * 2; unit += NGW) {
            const int rb = unit >> 1, half = unit & 1, r0 = rb * 32, bs = r0 & ~(SEQ - 1);
            if (half == 0) {
                const int w = 2 << (lane >> 4); const bf16_t* P = PROJ + 8 * lane;
                float s[8];
#pragma unroll
                for (int q = 0; q < 8; ++q) s[q] = 0.f;
                for (int j = 1; j <= 16; ++j) if (j <= w && r0 - j >= bs) { float f[8]; unpack8(*(const u32x4*)(P + (size_t)(r0 - j) * MIXN), f);
#pragma unroll
                    for (int q = 0; q < 8; ++q) s[q] += f[q]; }
#pragma unroll 4
                for (int r = r0; r < r0 + 32; ++r) {
                    float cur[8], old[8]; unpack8(*(const u32x4*)(P + (size_t)r * MIXN), cur);
                    const bool has_old = (r - w >= bs);
                    if (has_old) unpack8(*(const u32x4*)(P + (size_t)(r - w) * MIXN), old);
                    const int pos = r - bs + 1; const float inv = 1.0f / (float)(pos < w ? pos : w);
                    float o[8];
#pragma unroll
                    for (int q = 0; q < 8; ++q) { s[q] += cur[q]; if (has_old) s[q] -= old[q]; o[q] = s[q] * inv - cur[q]; }
                    *(u32x4*)(MIXED + (size_t)r * D + 8 * lane) = pack8(o);
                }
            } else {
                const bf16_t* P = PROJ + 8 * lane;
                float w0[8], w1[8], w2[8], z1[8], z2[8];
                { const float* cw = p.in[I_CONVW] + 8 * lane;
#pragma unroll
                  for (int q = 0; q < 8; ++q) { w0[q] = cw[q]; w1[q] = cw[512 + q]; w2[q] = cw[1024 + q]; z1[q] = 0.f; z2[q] = 0.f; } }
                if (r0 - 1 >= bs) { float a[8], b[8]; unpack8(*(const u32x4*)(P + (size_t)(r0 - 1) * MIXN + 1024), a); unpack8(*(const u32x4*)(P + (size_t)(r0 - 1) * MIXN + 1536), b);
#pragma unroll
                    for (int q = 0; q < 8; ++q) z1[q] = a[q] * b[q]; }
                if (r0 - 2 >= bs) { float a[8], b[8]; unpack8(*(const u32x4*)(P + (size_t)(r0 - 2) * MIXN + 1024), a); unpack8(*(const u32x4*)(P + (size_t)(r0 - 2) * MIXN + 1536), b);
#pragma unroll
                    for (int q = 0; q < 8; ++q) z2[q] = a[q] * b[q]; }
#pragma unroll 4
                for (int r = r0; r < r0 + 32; ++r) {
                    float gp[8], a[8], b[8], o[8];
                    unpack8(*(const u32x4*)(P + (size_t)r * MIXN + 512), gp); unpack8(*(const u32x4*)(P + (size_t)r * MIXN + 1024), a); unpack8(*(const u32x4*)(P + (size_t)r * MIXN + 1536), b);
#pragma unroll
                    for (int q = 0; q < 8; ++q) { const float zc = a[q] * b[q]; o[q] = gp[q] * (w0[q] * z2[q] + w1[q] * z1[q] + w2[q] * zc); z2[q] = z1[q]; z1[q] = zc; }
                    *(u32x4*)(MIXED + (size_t)r * D + 512 + 8 * lane) = pack8(o);
                }
            }
        }
    }
    SEAM(2);

    if (IN(3)) { pg8::Gemm g{MIXED, Wout_t, D, D, D}; pg8::DenseOrder S; S.init(M, D, G, bx); pg8::EpiResid E{p.in[I_X], X, nullptr};
        pg8::gemm_phase<pg8::EpiResid, pg8::DenseOrder>(lds, g, S, E); }
    SEAM(3);

    if (IN(4)) { for (int m = gw; m < M; m += NGW) { float y[16]; norm_row_bf16(X + (size_t)m * D, p.in[I_EVNF], XN + (size_t)m * D, lane, y); } }
    SEAM(4);

    if (IN(5)) { pg8::Gemm g{XN, Wgu_t, D, D, D}; pg8::DenseOrder S; S.init(M, 2 * DFF, G, bx); pg8::EpiSwiGLU E{Hb, DFF};
        pg8::gemm_phase<pg8::EpiSwiGLU, pg8::DenseOrder>(lds, g, S, E); }
    SEAM(5);

    if (IN(6)) { pg8::Gemm g{Hb, Wd_t, DFF, DFF, DFF}; pg8::DenseOrder S; S.init(M, D, G, bx); pg8::EpiResid E{X, X, nullptr};
        pg8::gemm_phase<pg8::EpiResid, pg8::DenseOrder>(lds, g, S, E); }
    SEAM(6);

    if (IN(7)) { for (int m = gw; m < M; m += NGW) { float y[16]; norm_row_bf16(X + (size_t)m * D, p.in[I_ODNM], XN + (size_t)m * D, lane, y); } }
    SEAM(7);

    if (IN(8)) { pg8::Gemm g{XN, Wqkv_t, D, D, D}; pg8::DenseOrder S; S.init(M, QKVN, G, bx); pg8::EpiBf16 E{QKV, QKVN, p.in[I_BQKV]};
        pg8::gemm_phase<pg8::EpiBf16, pg8::DenseOrder>(lds, g, S, E); }
    SEAM(8);

    if (IN(9)) {
        constexpr int KS_STR = 144, VT_STR = 392;
        constexpr int L_K = 0, L_VT = 192 * KS_STR, L_BT = L_VT + 64 * VT_STR, L_OST = L_BT + NQH * 256 * 4;
        static_assert(L_OST + NWAVES * 32 * 144 <= RING_BYTES, "attention LDS");
        for (int i = tid; i < NQH * 256; i += NTHR) *(LAS float*)(lds + L_BT + 4 * i) = bias_tab[i];
        const int r32 = lane & 31, hh = lane >> 5;
        for (int unit = vcu; unit < BATCH * (SEQ / CHUNK) * NKVH; unit += G) {
            const int kvh = unit & 1, n = (unit >> 1) & 255, b = unit >> 9;
            const int t0 = b * SEQ + n * CHUNK;
            __syncthreads();
#pragma unroll
            for (int i = 0; i < 3; ++i) { const int pc = tid + i * NTHR, j = pc >> 3, c = pc & 7; const bool valid = (n * CHUNK - 128 + j) >= 0;
                u32x4 kv = {0u, 0u, 0u, 0u}, vv = {0u, 0u, 0u, 0u};
                if (valid) { const bf16_t* src = QKV + (size_t)(t0 - 128 + j) * QKVN + 1024 + kvh * HD + 8 * c; kv = *(const u32x4*)src; vv = *(const u32x4*)(src + 128); }
                *(LAS u32x4*)(lds + L_K + j * KS_STR + 16 * c) = kv;
                const unsigned vw[4] = {vv.x, vv.y, vv.z, vv.w};
#pragma unroll
                for (int q = 0; q < 4; ++q) { *(LAS unsigned short*)(lds + L_VT + (8 * c + 2 * q) * VT_STR + 2 * j) = (unsigned short)(vw[q] & 0xffffu);
                                              *(LAS unsigned short*)(lds + L_VT + (8 * c + 2 * q + 1) * VT_STR + 2 * j) = (unsigned short)(vw[q] >> 16); } }
            __syncthreads();
            const int head = kvh * 8 + wave;
            const float sink = p.in[I_SINK][head];
            const LAS float* bt = (const LAS float*)(lds + L_BT + head * 1024);
            const int kb_min = n == 0 ? 4 : (n == 1 ? 2 : 0);
#pragma unroll 1
            for (int qb = 0; qb < 2; ++qb) {
                bf16x8 qf[4];
                { const bf16_t* qp = QKV + (size_t)(t0 + qb * 32 + r32) * QKVN + head * HD + 8 * hh;
#pragma unroll
                  for (int ks = 0; ks < 4; ++ks) qf[ks] = *(const bf16x8*)(qp + 16 * ks); }
                f32x16 st[6];
#pragma unroll
                for (int kb = 0; kb < 6; ++kb) {
#pragma unroll
                    for (int e = 0; e < 16; ++e) st[kb][e] = 0.f;
#pragma unroll
                    for (int ks = 0; ks < 4; ++ks) { const bf16x8 kf = *(const LAS bf16x8*)(lds + L_K + (kb * 32 + r32) * KS_STR + 32 * ks + 16 * hh);
                        st[kb] = __builtin_amdgcn_mfma_f32_32x32x16_bf16(kf, qf[ks], st[kb], 0, 0, 0); } }
                float mx = sink;
#pragma unroll
                for (int kb = 0; kb < 6; ++kb)
#pragma unroll
                    for (int e = 0; e < 16; ++e) { const int j = kb * 32 + (e & 3) + 8 * (e >> 2) + 4 * hh; const int idx = j - (qb * 32 + r32) + 63;
                        float sc = st[kb][e] * 0.125f + bt[idx]; sc = (kb < kb_min) ? -1e30f : sc; st[kb][e] = sc; mx = fmaxf(mx, sc); }
                mx = fmaxf(mx, __shfl_xor(mx, 32));
                float sum = 0.f;
#pragma unroll
                for (int kb = 0; kb < 6; ++kb)
#pragma unroll
                    for (int e = 0; e < 16; ++e) { const float pe = __builtin_amdgcn_exp2f((st[kb][e] - mx) * 1.44269504089f); st[kb][e] = pe; sum += pe; }
                sum += __shfl_xor(sum, 32);
                const float inv = 1.0f / (sum + __builtin_amdgcn_exp2f((sink - mx) * 1.44269504089f));
                f32x16 ot[2];
#pragma unroll
                for (int db = 0; db < 2; ++db)
#pragma unroll
                    for (int e = 0; e < 16; ++e) ot[db][e] = 0.f;
#pragma unroll
                for (int kb = 0; kb < 6; ++kb)
#pragma unroll
                    for (int s = 0; s < 2; ++s) {
                        u32x4 pw; pw.x = pk2(st[kb][8 * s], st[kb][8 * s + 1]); pw.y = pk2(st[kb][8 * s + 2], st[kb][8 * s + 3]); pw.z = pk2(st[kb][8 * s + 4], st[kb][8 * s + 5]); pw.w = pk2(st[kb][8 * s + 6], st[kb][8 * s + 7]);
                        const bf16x8 pf = __builtin_bit_cast(bf16x8, pw);
#pragma unroll
                        for (int db = 0; db < 2; ++db) { const LAS unsigned char* vp = lds + L_VT + (db * 32 + r32) * VT_STR + 2 * (kb * 32 + 16 * s + 4 * hh);
                            const u32x2 v0 = *(const LAS u32x2*)vp, v1 = *(const LAS u32x2*)(vp + 16);
                            u32x4 vw; vw.x = v0.x; vw.y = v0.y; vw.z = v1.x; vw.w = v1.y;
                            ot[db] = __builtin_amdgcn_mfma_f32_32x32x16_bf16(__builtin_bit_cast(bf16x8, vw), pf, ot[db], 0, 0, 0); } }
                LAS unsigned char* ost = lds + L_OST + wave * (32 * 144);
#pragma unroll
                for (int db = 0; db < 2; ++db)
#pragma unroll
                    for (int g4 = 0; g4 < 4; ++g4) { u32x2 w; w.x = pk2(ot[db][4 * g4] * inv, ot[db][4 * g4 + 1] * inv); w.y = pk2(ot[db][4 * g4 + 2] * inv, ot[db][4 * g4 + 3] * inv);
                        *(LAS u32x2*)(ost + r32 * 144 + 2 * (db * 32 + 8 * g4 + 4 * hh)) = w; }
                LDS_WAIT();
#pragma unroll
                for (int i = 0; i < 4; ++i) { const int q = 8 * i + (lane >> 3), c = lane & 7; const u32x4 w = *(const LAS u32x4*)(ost + q * 144 + 16 * c);
                    *(u32x4*)(AO + (size_t)(t0 + qb * 32 + q) * D + head * HD + 8 * c) = w; }
                LDS_WAIT();
            }
        }
        __syncthreads();
    }
    SEAM(9);

    if (IN(10)) { pg8::Gemm g{AO, Wo_t, D, D, D}; pg8::DenseOrder S; S.init(M, D, G, bx); pg8::EpiResid E{X, X, p.in[I_BO]};
        pg8::gemm_phase<pg8::EpiResid, pg8::DenseOrder>(lds, g, S, E); }
    SEAM(10);

    const int RPW = (M + G - 1) / G;
    constexpr int L_RW = 0, L_RE = 32768, L_RWT = L_RE + 2 * 512 * 4, L_CNT = L_RWT + 2 * 512 * 4;
    if (IN(11)) {
        for (int i = tid; i < D * NEXP / 4; i += NTHR) *(LAS f32x4*)(lds + L_RW + 16 * i) = *(const f32x4*)(p.in[I_ROUTER] + 4 * i);
        if (tid < 16) *(LAS int*)(lds + L_CNT + 4 * tid) = 0;
        __syncthreads();
        const int rbase = bx * RPW;
        for (int rl = wave; rl < RPW && rbase + rl < M; rl += NWAVES) {
            const int m = rbase + rl; float y[16];
            norm_row_bf16(X + (size_t)m * D, p.in[I_ODNF], XN + (size_t)m * D, lane, y);
            float lg[8];
#pragma unroll
            for (int e = 0; e < 8; ++e) lg[e] = 0.f;
#pragma unroll
            for (int j = 0; j < 2; ++j)
#pragma unroll
                for (int q = 0; q < 8; ++q) { const int c = 512 * j + 8 * lane + q; const f32x4 wa = *(const LAS f32x4*)(lds + L_RW + 32 * c), wb = *(const LAS f32x4*)(lds + L_RW + 32 * c + 16); const float yv = y[8 * j + q];
                    lg[0] += yv * wa[0]; lg[1] += yv * wa[1]; lg[2] += yv * wa[2]; lg[3] += yv * wa[3]; lg[4] += yv * wb[0]; lg[5] += yv * wb[1]; lg[6] += yv * wb[2]; lg[7] += yv * wb[3]; }
#pragma unroll
            for (int e = 0; e < 8; ++e) lg[e] = wave_sum(lg[e]);
            int e0 = 0; float v0 = lg[0];
#pragma unroll
            for (int e = 1; e < 8; ++e) if (lg[e] > v0) { v0 = lg[e]; e0 = e; }
            int e1 = -1; float v1 = -3.0e38f;
#pragma unroll
            for (int e = 0; e < 8; ++e) if (e != e0 && lg[e] > v1) { v1 = lg[e]; e1 = e; }
            const float wt0 = 1.0f / (1.0f + __expf(v1 - v0));
            if (lane == 0) { *(LAS int*)(lds + L_RE + 4 * rl) = e0; *(LAS int*)(lds + L_RE + 2048 + 4 * rl) = e1; *(LAS float*)(lds + L_RWT + 4 * rl) = wt0; *(LAS float*)(lds + L_RWT + 2048 + 4 * rl) = 1.0f - wt0; }
        }
        __syncthreads();
        for (int rl = tid; rl < RPW && rbase + rl < M; rl += NTHR) {
            const int m = rbase + rl; const int e0 = *(LAS int*)(lds + L_RE + 4 * rl), e1 = *(LAS int*)(lds + L_RE + 2048 + 4 * rl);
            int r0 = 0, r1 = 0;
            for (int j = 0; j < rl; ++j) { r0 += (*(LAS int*)(lds + L_RE + 4 * j) == e0); r1 += (*(LAS int*)(lds + L_RE + 2048 + 4 * j) == e1); }
            tok_e[m] = e0; tok_e[M + m] = e1; tok_w[m] = *(LAS float*)(lds + L_RWT + 4 * rl); tok_w[M + m] = *(LAS float*)(lds + L_RWT + 2048 + 4 * rl); tok_r[m] = r0; tok_r[M + m] = r1;
            __hip_atomic_fetch_add((LAS int*)(lds + L_CNT + 4 * e0), 1, __ATOMIC_RELAXED, __HIP_MEMORY_SCOPE_WORKGROUP); __hip_atomic_fetch_add((LAS int*)(lds + L_CNT + 4 * (8 + e1)), 1, __ATOMIC_RELAXED, __HIP_MEMORY_SCOPE_WORKGROUP);
        }
        __syncthreads();
        if (tid < 16) wgcnt[bx * 16 + tid] = *(LAS int*)(lds + L_CNT + 4 * tid);
        __syncthreads();
    }
    SEAM(11);

    if (IN(12)) {
        LAS int* sb = (LAS int*)(lds + 0);
        if (tid < 16) { int tot = 0, pre = 0; for (int w = 0; w < G; ++w) { const int c = wgcnt[w * 16 + tid]; tot += c; if (w < bx) pre += c; } sb[32 + tid] = tot; sb[16 + tid] = pre; }
        __syncthreads();
        if (tid == 0) { int base = 0; for (int s = 0; s < 16; ++s) { sb[s] = base; base += (sb[32 + s] + 255) & ~255; } sb[48] = base; }
        __syncthreads();
        const int rbase = bx * RPW;
        for (int pr = wave; pr < 2 * RPW; pr += NWAVES) { const int k = pr & 1, rl = pr >> 1, m = rbase + rl; if (m >= M) continue;
            const int s = k * 8 + tok_e[k * M + m]; const int slot = sb[s] + sb[16 + s] + tok_r[k * M + m];
            const u32x4* src = (const u32x4*)(XN + (size_t)m * D); u32x4* dst = (u32x4*)(HS + (size_t)slot * D);
            const u32x4 a = src[lane], b2 = src[64 + lane]; dst[lane] = a; dst[64 + lane] = b2;
            if (lane == 0) { slot_tok[slot] = m; slot_w[slot] = tok_w[k * M + m]; } }
        if (bx == 0) {
            for (int s = 0; s < 16; ++s) { const int b0 = sb[s] + sb[32 + s], b1 = sb[s] + ((sb[32 + s] + 255) & ~255); for (int i = b0 + tid; i < b1; i += NTHR) { slot_tok[i] = -1; slot_w[i] = 0.f; } }
            const int nt_all = sb[48] >> 8;
            for (int j = tid; j < nt_all; j += NTHR) { int s = 0; for (int q = 1; q < 16; ++q) if ((j << 8) >= sb[q]) s = q; tilemeta[8 + j] = s & 7; }
            if (tid == 0) { tilemeta[0] = sb[8] >> 8; tilemeta[1] = nt_all; }
        }
        __syncthreads();
    }
    SEAM(12);

#pragma unroll 1
    for (int kh = 0; kh < 4; ++kh) {
        const int k = kh >> 1, h = kh & 1;
        if (IN(13 + 2 * kh) || IN(14 + 2 * kh)) {
            for (int j = tid; j < 288; j += NTHR) *(LAS int*)(lds + LDS_TILE_OFF + 4 * j) = (j < MAXTILES + 8) ? tilemeta[j] : 0;
            __syncthreads();
        }
        const LAS int* tmeta = (const LAS int*)(lds + LDS_TILE_OFF);
        if (IN(13 + 2 * kh)) {
            const int nk0 = __builtin_amdgcn_readfirstlane(tmeta[0]), nall = __builtin_amdgcn_readfirstlane(tmeta[1]);
            const int rt_lo = k ? nk0 : 0, nM = k ? nall - nk0 : nk0;
            pg8::Gemm g{HS, Wegu_t, D, D, D}; pg8::MoeOrder S; S.T.init(nM, NFE_T / 2, G, bx); S.rt_lo = rt_lo; S.tpe = NFE_T; S.ct0 = h * (NFE_T / 2); S.a_abs = 1; S.tile_e = tmeta + 8;
            pg8::EpiSwiGLU E{H2, DFE_H};
            pg8::gemm_phase<pg8::EpiSwiGLU, pg8::MoeOrder>(lds, g, S, E);
        }
        SEAM(13 + 2 * kh);
        if (IN(14 + 2 * kh)) {
            const int nk0 = __builtin_amdgcn_readfirstlane(tmeta[0]), nall = __builtin_amdgcn_readfirstlane(tmeta[1]);
            const int rt_lo = k ? nk0 : 0, nM = k ? nall - nk0 : nk0;
            pg8::Gemm g{H2, Wed_t + (size_t)h * DFE_H, DFE_H, DFE, DFE_H}; pg8::MoeOrder S; S.T.init(nM, D / 256, G, bx); S.rt_lo = rt_lo; S.tpe = D / 256; S.ct0 = 0; S.a_abs = 0; S.tile_e = tmeta + 8;
            pg8::EpiMoeDown E{X, slot_tok, slot_w};
            pg8::gemm_phase<pg8::EpiMoeDown, pg8::MoeOrder>(lds, g, S, E);
        }
        SEAM(14 + 2 * kh);
    }

    if (IN(21)) {
        for (int m = gw; m < M; m += NGW) {
            float* xrow = X + (size_t)m * D; f32x4 v[4];
#pragma unroll
            for (int j = 0; j < 4; ++j) v[j] = *(const f32x4*)(xrow + 256 * j + 4 * lane);
            float s = 0.f;
#pragma unroll
            for (int j = 0; j < 4; ++j) s += (v[j][0] * v[j][0] + v[j][1] * v[j][1]) + (v[j][2] * v[j][2] + v[j][3] * v[j][3]);
            const float r = 1.0f / sqrtf(wave_sum(s) * (1.0f / D) + RMS_EPS);
#pragma unroll
            for (int j = 0; j < 4; ++j) { const f32x4 g4 = *(const f32x4*)(p.in[I_FINAL] + 256 * j + 4 * lane); *(f32x4*)(xrow + 256 * j + 4 * lane) = v[j] * r * g4; }
        }
    }
#undef IN
#undef SEAM
}

extern "C" void kernel_launch(void* const* d_in, const int* in_sizes, int n_in, void* d_out, int out_size, void* d_ws, size_t ws_size, hipStream_t stream) {
    static int grid = 0;
    if (grid == 0) {
        if (n_in != 24 || in_sizes[0] != M * D || out_size != M * D || ws_size < WS_END) { fprintf(stderr, "kernel_launch: unexpected shapes (n_in %d, in0 %d, out %d, ws %zu < %zu)\n", n_in, n_in > 0 ? in_sizes[0] : -1, out_size, ws_size, (size_t)WS_END); grid = -1; return; }
        int dev = 0, cus = 0, per_cu = 0;
        if (hipGetDevice(&dev) != hipSuccess || hipDeviceGetAttribute(&cus, hipDeviceAttributeMultiprocessorCount, dev) != hipSuccess) { grid = -1; return; }
        if (hipFuncSetAttribute((const void*)fwd_kernel, hipFuncAttributeMaxDynamicSharedMemorySize, LDS_BYTES) != hipSuccess) { fprintf(stderr, "kernel_launch: hipFuncSetAttribute failed\n"); grid = -1; return; }
        if (hipOccupancyMaxActiveBlocksPerMultiprocessor(&per_cu, (const void*)fwd_kernel, NTHR, LDS_BYTES) != hipSuccess || per_cu < 1) fprintf(stderr, "kernel_launch: occupancy query reports %d\n", per_cu);
        (void)hipGetLastError();
        grid = cus < 256 ? cus : 256;
    }
    if (grid < 0) return;
    (void)hipMemsetAsync((char*)d_ws + WS_CTL, 0, CTL_ZERO_BYTES, stream);
    Params a{};
    for (int i = 0; i < 24; ++i) a.in[i] = (const float*)d_in[i];
    a.out = (float*)d_out; a.ws = (unsigned char*)d_ws;
    constexpr int NPH = 22;
    if (MK_N_LAUNCHES == 1) { a.ph_lo = 0; a.ph_hi = NPH; hipLaunchKernelGGL(fwd_kernel, dim3(grid), dim3(NTHR), LDS_BYTES, stream, a); }
    else for (int li = 0; li < NPH; ++li) { a.ph_lo = li; a.ph_hi = li + 1; hipLaunchKernelGGL(fwd_kernel, dim3(grid), dim3(NTHR), LDS_BYTES, stream, a); }
}
```

```cpp
#include <hip/hip_runtime.h>
#include <cstdio>
#include <cstdint>

#ifndef MK_N_LAUNCHES
#define MK_N_LAUNCHES 1
#endif

#ifndef REPMASK
#define REPMASK 0u
#endif
#define NREP(k) ((((REPMASK) >> (k)) & 1u) ? 2 : 1)
#define LAS __attribute__((address_space(3)))
#define GAS __attribute__((address_space(1)))
typedef unsigned short bf16_t;
typedef short bf16x8 __attribute__((ext_vector_type(8)));
typedef short s16x4 __attribute__((ext_vector_type(4)));
typedef float f32x2 __attribute__((ext_vector_type(2)));
typedef float f32x4 __attribute__((ext_vector_type(4)));
typedef float f32x16 __attribute__((ext_vector_type(16)));
typedef unsigned u32x2 __attribute__((ext_vector_type(2)));
typedef unsigned u32x4 __attribute__((ext_vector_type(4)));
typedef __bf16 hbf16x2 __attribute__((ext_vector_type(2)));
typedef int i32x4 __attribute__((ext_vector_type(4)));
typedef int i32x8 __attribute__((ext_vector_type(8)));

constexpr int D = 1024, BATCH = 2, SEQ = 16384, M = BATCH * SEQ;
constexpr int MIXN = 2048;
constexpr int DFF = 2816, NFF_T = DFF / 128;
constexpr int QKVN = 1280, NQH = 16, NKVH = 2, HD = 64, CHUNK = 64, KVSPAN = 192;
constexpr int NEXP = 8, DFE = 3584, NFE_T = DFE / 128;
constexpr float RMS_EPS = 1e-6f;
constexpr int MAXSLOT = 67328;
constexpr int MAXTILES = MAXSLOT / 256;
constexpr int NWAVES = 8, NTHR = 512;

constexpr size_t MiB = 1u << 20;
constexpr size_t WS_CTL = 0, CTL_ZERO_BYTES = 1 * MiB;
constexpr size_t WS_BIAS = 1 * MiB;
constexpr size_t WS_WGCNT = WS_BIAS + 16 * 256 * 4;
constexpr size_t WS_TILE = WS_WGCNT + 1024 * 16 * 4;
constexpr size_t WS_TOKE = WS_TILE + 4096;
constexpr size_t WS_TOKW = WS_TOKE + 2 * (size_t)M * 4;
constexpr size_t WS_TOKR = WS_TOKW + 2 * (size_t)M * 4;
constexpr size_t WS_SLOTT = WS_TOKR + 2 * (size_t)M * 4;
constexpr size_t WS_SLOTW = WS_SLOTT + (size_t)MAXSLOT * 4;
static_assert(WS_SLOTW + (size_t)MAXSLOT * 4 <= 4 * MiB, "route region");
constexpr size_t WS_WIN = 4 * MiB;
constexpr size_t WS_WOUT = WS_WIN + (size_t)MIXN * D * 2;
constexpr size_t WS_WGU = WS_WOUT + (size_t)D * D * 2;
constexpr size_t WS_WD = WS_WGU + (size_t)2 * DFF * D * 2;
constexpr size_t WS_WQKV = WS_WD + (size_t)D * DFF * 2;
constexpr size_t WS_WO = WS_WQKV + (size_t)QKVN * D * 2;
static_assert(WS_WO + (size_t)D * D * 2 <= 31 * MiB, "dense weights");
constexpr size_t WS_WEGU = 31 * MiB;
constexpr size_t WS_WED = WS_WEGU + (size_t)NEXP * 2 * DFE * D;
static_assert(WS_WED + (size_t)NEXP * D * DFE == 115 * MiB, "expert weights");
constexpr size_t WS_XN = 115 * MiB;
constexpr size_t WS_Y0 = WS_XN;
constexpr size_t WS_R = 179 * MiB;
constexpr size_t WS_PROJ = WS_R, WS_MIXED = WS_R + (size_t)M * MIXN * 2;
constexpr size_t WS_H = WS_R;
constexpr size_t WS_QKV = WS_R, WS_AO = WS_R + (size_t)M * QKVN * 2;
constexpr size_t WS_HS = WS_R, WS_H2 = WS_R + 66 * MiB;
static_assert((size_t)MAXSLOT * D <= 66 * MiB, "HS");
constexpr size_t WS_END = WS_H2 + (size_t)MAXSLOT * DFE;
static_assert(WS_END <= 543497280ull, "workspace");
static_assert(WS_MIXED + (size_t)M * D * 2 <= 543497280ull && WS_H + (size_t)M * DFF * 2 <= 543497280ull, "workspace");

constexpr int CW_BAR = 4096;

constexpr int RING_BYTES = 131072;
constexpr int LDS_TILE_OFF = RING_BYTES;
constexpr int LDS_MISC_OFF = RING_BYTES + 2048;
constexpr int LDS_BYTES = 147456;

__device__ __forceinline__ unsigned pk2(float lo, float hi) { f32x2 v = {lo, hi}; hbf16x2 b = __builtin_convertvector(v, hbf16x2); return __builtin_bit_cast(unsigned, b); }
__device__ __forceinline__ float bf_lo(unsigned w) { return __uint_as_float(w << 16); }
__device__ __forceinline__ float bf_hi(unsigned w) { return __uint_as_float(w & 0xffff0000u); }
__device__ __forceinline__ void unpack8(const u32x4 w, float (&f)[8]) { f[0] = bf_lo(w.x); f[1] = bf_hi(w.x); f[2] = bf_lo(w.y); f[3] = bf_hi(w.y); f[4] = bf_lo(w.z); f[5] = bf_hi(w.z); f[6] = bf_lo(w.w); f[7] = bf_hi(w.w); }
__device__ __forceinline__ u32x4 pack8(const float (&f)[8]) { u32x4 w; w.x = pk2(f[0], f[1]); w.y = pk2(f[2], f[3]); w.z = pk2(f[4], f[5]); w.w = pk2(f[6], f[7]); return w; }
__device__ __forceinline__ float wave_sum(float v) {
#pragma unroll
    for (int o = 1; o < 64; o <<= 1) v += __shfl_xor(v, o);
    return v;
}
__device__ __forceinline__ int fresh_tid() { int t = threadIdx.x; asm volatile("" : "+v"(t)); return t; }
#define LDS_WAIT() asm volatile("s_waitcnt lgkmcnt(0)" ::: "memory")
#define VM_WAIT() asm volatile("s_waitcnt vmcnt(0)" ::: "memory")

namespace pg8 {
constexpr int BM = 256, BK = 64, HALF = 128, HTB = HALF * BK * 2, STAGE_BYTES = 8 * HTB, NXCD = 8, WGM = 8;
__host__ __device__ __forceinline__ int lds_byte(int r, int c) { const int st = (r >> 4) * 2 + (c >> 5), rr = r & 15, cc = c & 31, ob = rr * 64 + cc * 2; return st * 1024 + (ob ^ (((ob >> 9) & 1) << 5)); }
__host__ __device__ __forceinline__ void stage_rc(int b, int& R, int& C) { const int st = b / 1024, sb = b % 1024, swz = sb ^ (((sb >> 9) & 1) << 5); R = (st >> 1) * 16 + swz / 64; C = (st & 1) * 32 + (swz % 64) / 2; }
__host__ __device__ __forceinline__ int perm32(int rho) { const int n = rho >> 4, i = rho & 15; return 8 * (i >> 2) + 4 * n + (i & 3); }

struct Unit { int pm, pn, rm, cn; };
struct Gemm { const void* A; const void* Bt; int lda, ldb, K; };

struct TileOrder {
    int nM, nN, nwg, G, c;
    __device__ __forceinline__ void init(int nM_, int nN_, int G_, int c_) { nM = nM_; nN = nN_; nwg = nM * nN; G = G_; c = c_; }
    __device__ __forceinline__ bool next(int i, int& m, int& n) const {
        const int L = i * G + c; if (L >= nwg) return false;
        int wgid = L; { const int q = nwg / NXCD, r = nwg % NXCD, xcd = wgid % NXCD, off = wgid / NXCD; wgid = (xcd < r ? xcd * (q + 1) : r * (q + 1) + (xcd - r) * q) + off; }
        const int nig = WGM * nN, gid = wgid / nig, fm = gid * WGM, gsz = (nM - fm) < WGM ? (nM - fm) : WGM;
        m = fm + ((wgid % nig) % gsz); n = (wgid % nig) / gsz; return true;
    }
};
struct DenseOrder {
    TileOrder T;
    __device__ __forceinline__ void init(int Mr, int N, int G, int c) { T.init(Mr / BM, N / BM, G, c); }
    __device__ __forceinline__ bool next(int i, Unit& u) const { int m, n; if (!T.next(i, m, n)) return false; u.pm = m; u.pn = n; u.rm = m; u.cn = n; return true; }
    __device__ __forceinline__ void a_ready(const Unit&) const {}
    __device__ __forceinline__ void done(const Unit&) const {}
};
struct MoeOrder {
    TileOrder T; int tpe; const LAS int* tile_e;
    __device__ __forceinline__ bool next(int i, Unit& u) const { int m, n; if (!T.next(i, m, n)) return false;
        const int e = __builtin_amdgcn_readfirstlane(tile_e[m]);
        u.pm = m; u.pn = e * tpe + n; u.rm = m; u.cn = n; return true; }
    __device__ __forceinline__ void a_ready(const Unit&) const {}
    __device__ __forceinline__ void done(const Unit&) const {}
};

struct EpiBf16 {
    static constexpr bool PERM = true;
    bf16_t* O; int ldc; const float* bias;
    __device__ __forceinline__ void operator()(const f32x4 (&acc)[2][2][4][2], const Unit& u, int wr, int wc, int fr, int fq) const {
        const int row0 = u.rm * BM + wr * 64 + fr, col0 = u.cn * BM + wc * 32 + 8 * fq;
        f32x4 bv[2][2];
#pragma unroll
        for (int bj = 0; bj < 2; ++bj)
#pragma unroll
            for (int n = 0; n < 2; ++n) bv[bj][n] = bias ? *(const f32x4*)(bias + col0 + bj * HALF + 4 * n) : (f32x4){0.f, 0.f, 0.f, 0.f};
#pragma unroll
        for (int ai = 0; ai < 2; ++ai)
#pragma unroll
            for (int m = 0; m < 4; ++m) { bf16_t* rowp = O + (size_t)(row0 + ai * HALF + m * 16) * ldc + col0;
#pragma unroll
                for (int bj = 0; bj < 2; ++bj) { const f32x4 v0 = acc[ai][bj][m][0] + bv[bj][0], v1 = acc[ai][bj][m][1] + bv[bj][1];
                    u32x4 w; w.x = pk2(v0[0], v0[1]); w.y = pk2(v0[2], v0[3]); w.z = pk2(v1[0], v1[1]); w.w = pk2(v1[2], v1[3]);
                    *(u32x4*)(rowp + bj * HALF) = w; } }
    }
};
__device__ __forceinline__ float silu_mul(float g, float u) { return g * u * __builtin_amdgcn_rcpf(1.0f + __builtin_amdgcn_exp2f(-1.44269504089f * g)); }
struct EpiSwiGLU {
    static constexpr bool PERM = true;
    bf16_t* O; int ldc;
    __device__ __forceinline__ void operator()(const f32x4 (&acc)[2][2][4][2], const Unit& u, int wr, int wc, int fr, int fq) const {
        const int row0 = u.rm * BM + wr * 64 + fr, col0 = u.cn * HALF + wc * 32 + 8 * fq;
#pragma unroll
        for (int ai = 0; ai < 2; ++ai)
#pragma unroll
            for (int m = 0; m < 4; ++m) { bf16_t* rowp = O + (size_t)(row0 + ai * HALF + m * 16) * ldc + col0;
                const f32x4 g0 = acc[ai][0][m][0], g1 = acc[ai][0][m][1], u0 = acc[ai][1][m][0], u1 = acc[ai][1][m][1];
                u32x4 w; w.x = pk2(silu_mul(g0[0], u0[0]), silu_mul(g0[1], u0[1])); w.y = pk2(silu_mul(g0[2], u0[2]), silu_mul(g0[3], u0[3]));
                w.z = pk2(silu_mul(g1[0], u1[0]), silu_mul(g1[1], u1[1])); w.w = pk2(silu_mul(g1[2], u1[2]), silu_mul(g1[3], u1[3]));
                *(u32x4*)rowp = w; }
    }
};
struct EpiResid {
    static constexpr bool PERM = true;
    const float* base; float* out; const float* bias;
    __device__ __forceinline__ void operator()(const f32x4 (&acc)[2][2][4][2], const Unit& u, int wr, int wc, int fr, int fq) const {
        const int row0 = u.rm * BM + wr * 64 + fr, col0 = u.cn * BM + wc * 32 + 8 * fq;
        f32x4 bv[2][2];
#pragma unroll
        for (int bj = 0; bj < 2; ++bj)
#pragma unroll
            for (int n = 0; n < 2; ++n) bv[bj][n] = bias ? *(const f32x4*)(bias + col0 + bj * HALF + 4 * n) : (f32x4){0.f, 0.f, 0.f, 0.f};
#pragma unroll
        for (int ai = 0; ai < 2; ++ai)
#pragma unroll
            for (int m = 0; m < 4; ++m) { const size_t off = (size_t)(row0 + ai * HALF + m * 16) * D + col0;
                f32x4 bs[2][2];
#pragma unroll
                for (int bj = 0; bj < 2; ++bj)
#pragma unroll
                    for (int n = 0; n < 2; ++n) bs[bj][n] = *(const f32x4*)(base + off + bj * HALF + 4 * n);
#pragma unroll
                for (int bj = 0; bj < 2; ++bj)
#pragma unroll
                    for (int n = 0; n < 2; ++n) *(f32x4*)(out + off + bj * HALF + 4 * n) = bs[bj][n] + acc[ai][bj][m][n] + bv[bj][n];
                asm volatile("" ::: "memory"); }
    }
};
__device__ __forceinline__ unsigned pk4_fp8(float a, float b, float c, float d) {
    int w = __builtin_amdgcn_cvt_pk_fp8_f32(__builtin_amdgcn_fmed3f(a, -448.f, 448.f), __builtin_amdgcn_fmed3f(b, -448.f, 448.f), 0, false);
    w = __builtin_amdgcn_cvt_pk_fp8_f32(__builtin_amdgcn_fmed3f(c, -448.f, 448.f), __builtin_amdgcn_fmed3f(d, -448.f, 448.f), w, true);
    return (unsigned)w;
}
constexpr int E8M0_ONE = 0x7f7f7f7f, E8M0_2M6 = 0x79797979;
struct EpiSwiGLU8 {
    static constexpr bool PERM = true; static constexpr int SCALE_A = E8M0_ONE, SCALE_B = E8M0_2M6;
    unsigned char* O; int ldc;
    __device__ __forceinline__ void operator()(const f32x4 (&acc)[2][2][4][2], const Unit& u, int wr, int wc, int fr, int fq) const {
        const int row0 = u.rm * BM + wr * 64 + fr, col0 = u.cn * HALF + wc * 32 + 8 * fq;
#pragma unroll
        for (int ai = 0; ai < 2; ++ai)
#pragma unroll
            for (int m = 0; m < 4; ++m) { unsigned char* rowp = O + (size_t)(row0 + ai * HALF + m * 16) * ldc + col0;
                const f32x4 g0 = acc[ai][0][m][0], g1 = acc[ai][0][m][1], u0 = acc[ai][1][m][0], u1 = acc[ai][1][m][1];
                u32x2 w; w.x = pk4_fp8(silu_mul(g0[0], u0[0]), silu_mul(g0[1], u0[1]), silu_mul(g0[2], u0[2]), silu_mul(g0[3], u0[3]));
                w.y = pk4_fp8(silu_mul(g1[0], u1[0]), silu_mul(g1[1], u1[1]), silu_mul(g1[2], u1[2]), silu_mul(g1[3], u1[3]));
                *(u32x2*)rowp = w; }
    }
};
struct EpiMoeDown {
    static constexpr bool PERM = true; static constexpr int SCALE_A = E8M0_ONE, SCALE_B = E8M0_2M6;
    float* X; bf16_t* Y0; const int* slot_tok; const float* slot_w;
    __device__ __forceinline__ void operator()(const f32x4 (&acc)[2][2][4][2], const Unit& u, int wr, int wc, int fr, int fq) const {
        const int row0 = u.rm * BM + wr * 64 + fr, col0 = u.cn * BM + wc * 32 + 8 * fq;
#pragma unroll
        for (int ai = 0; ai < 2; ++ai)
#pragma unroll
            for (int m = 0; m < 4; ++m) { const int slot = row0 + ai * HALF + m * 16; const int meta = slot_tok[slot]; const float w = slot_w[slot];
                if (meta >= 0) { const size_t off = (size_t)(meta >> 1) * D + col0;
                    if (meta & 1) {
                        f32x4 bs[2][2];
#pragma unroll
                        for (int bj = 0; bj < 2; ++bj)
#pragma unroll
                            for (int n = 0; n < 2; ++n) bs[bj][n] = *(const f32x4*)(X + off + bj * HALF + 4 * n);
#pragma unroll
                        for (int bj = 0; bj < 2; ++bj)
#pragma unroll
                            for (int n = 0; n < 2; ++n) *(f32x4*)(X + off + bj * HALF + 4 * n) = bs[bj][n] + acc[ai][bj][m][n] * w;
                    } else {
#pragma unroll
                        for (int bj = 0; bj < 2; ++bj) { const f32x4 v0 = acc[ai][bj][m][0] * w, v1 = acc[ai][bj][m][1] * w;
                            u32x4 o; o.x = pk2(v0[0], v0[1]); o.y = pk2(v0[2], v0[3]); o.z = pk2(v1[0], v1[1]); o.w = pk2(v1[2], v1[3]);
                            *(u32x4*)(Y0 + off + bj * HALF) = o; }
                    } }
                asm volatile("" ::: "memory"); }
    }
};

template <int OFF> __device__ __forceinline__ void glds_s(const char* sbase, unsigned voff, unsigned lds_base) {
    unsigned keep;
    asm volatile("s_mov_b32 %0, m0\n\ts_add_u32 m0, %3, %4\n\ts_nop 0\n\tglobal_load_lds_dwordx4 %1, %2\n\ts_mov_b32 m0, %0" : "=&s"(keep) : "v"(voff), "s"(sbase), "s"(lds_base), "i"(OFF) : "memory", "scc");
}
template <class Epi, class Sched, bool FP8 = false, bool ALIGN_EPI = true, bool SP2 = true>
__device__ __forceinline__ void gemm_phase(LAS unsigned char* lds, const Gemm g, const Sched& S, const Epi& E) {
    const int tid = threadIdx.x, wid = __builtin_amdgcn_readfirstlane(tid >> 6), lane = tid & 63, wr = wid >> 2, wc = wid & 3, fr = lane & 15, fq = lane >> 4;
    const int nt = g.K / (BK * 2);
    unsigned voffA[2], voffB[2];
#pragma unroll
    for (int i = 0; i < 2; ++i) { int R, C; stage_rc(tid * 16 + i * 8192, R, C); const int Rb = Epi::PERM ? ((R & ~31) + perm32(R & 31)) : R;
        voffA[i] = (unsigned)(R * g.lda + C * 2); voffB[i] = (unsigned)(Rb * g.ldb + C * 2); }
    const size_t kstep = (size_t)(BK * 2);
    const size_t hstepA = (size_t)HALF * g.lda, hstepB = (size_t)HALF * g.ldb;
    const size_t tstepA = 2 * hstepA, tstepB = 2 * hstepB;
    const unsigned lds_base = (unsigned)(size_t)lds + (unsigned)wid * 1024u;
    const int aoff = lds_byte(wr * 64 + fr, fq * 8), boff = lds_byte(wc * 32 + fr, fq * 8);
#define PG8_SA(b, h) (((b) * 2 + (h)) * HTB)
#define PG8_SB(b, h) ((4 + (b) * 2 + (h)) * HTB)
#define PG8_STAGE(bufoff, gbase, voff) do { glds_s<(bufoff)>((const char*)(gbase), (voff)[0], lds_base); glds_s<(bufoff) + 8192>((const char*)(gbase), (voff)[1], lds_base); } while (0)
#define PG8_LDA(dst, b, h) do { _Pragma("unroll") for (int m = 0; m < 4; ++m) _Pragma("unroll") for (int k = 0; k < 2; ++k) dst[m][k] = *(const LAS bf16x8*)(lds + PG8_SA(b, h) + aoff + m * 2048 + k * 1024); } while (0)
#define PG8_LDB(dst, b, h) do { _Pragma("unroll") for (int n = 0; n < 2; ++n) _Pragma("unroll") for (int k = 0; k < 2; ++k) dst[n][k] = *(const LAS bf16x8*)(lds + PG8_SB(b, h) + boff + n * 2048 + k * 1024); } while (0)
#define PG8_MMA(ai, bj, At, Bt) do { __builtin_amdgcn_s_setprio(1); _Pragma("unroll") for (int m = 0; m < 4; ++m) _Pragma("unroll") for (int n = 0; n < 2; ++n) { \
        if constexpr (FP8) { const i32x4 b_lo = __builtin_bit_cast(i32x4, Bt[n][0]), b_hi = __builtin_bit_cast(i32x4, Bt[n][1]), a_lo = __builtin_bit_cast(i32x4, At[m][0]), a_hi = __builtin_bit_cast(i32x4, At[m][1]); \
            acc[ai][bj][m][n] = __builtin_amdgcn_mfma_scale_f32_16x16x128_f8f6f4(__builtin_shufflevector(b_lo, b_hi, 0, 1, 2, 3, 4, 5, 6, 7), __builtin_shufflevector(a_lo, a_hi, 0, 1, 2, 3, 4, 5, 6, 7), acc[ai][bj][m][n], 0, 0, 0, Epi::SCALE_B, 0, Epi::SCALE_A); } \
        else { _Pragma("unroll") for (int k = 0; k < 2; ++k) acc[ai][bj][m][n] = __builtin_amdgcn_mfma_f32_16x16x32_bf16(Bt[n][k], At[m][k], acc[ai][bj][m][n], 0, 0, 0); } } \
        __builtin_amdgcn_s_setprio(0); } while (0)
#define PG8_WAIT_V(n) asm volatile("s_waitcnt vmcnt(" #n ")" ::: "memory")
#define PG8_WAIT_L(n) asm volatile("s_waitcnt lgkmcnt(" #n ")" ::: "memory")
#define PG8_BAR __builtin_amdgcn_s_barrier()
#define PG8_SCHED __builtin_amdgcn_sched_barrier(0)
    Unit cur, nxt; int ui = 0;
    if (!S.next(0, cur)) return;
    f32x4 acc[2][2][4][2];
#pragma unroll
    for (int a = 0; a < 2; ++a)
#pragma unroll
        for (int b = 0; b < 2; ++b)
#pragma unroll
            for (int m = 0; m < 4; ++m)
#pragma unroll
                for (int n = 0; n < 2; ++n) acc[a][b][m][n] = (f32x4){0.f, 0.f, 0.f, 0.f};
    bf16x8 At[4][2], B0[2][2], B1[2][2];
    const char* cA = (const char*)g.A + (size_t)cur.pm * tstepA; const char* cB = (const char*)g.Bt + (size_t)cur.pn * tstepB;
    S.a_ready(cur);
    if constexpr (SP2) {
        PG8_STAGE(PG8_SB(0, 0), cB, voffB); PG8_STAGE(PG8_SB(0, 1), cB + hstepB, voffB); PG8_STAGE(PG8_SA(0, 0), cA, voffA); PG8_STAGE(PG8_SA(0, 1), cA + hstepA, voffA);
        if (wr == 1) PG8_BAR;
        PG8_WAIT_V(2); PG8_BAR;
        PG8_STAGE(PG8_SB(1, 0), cB + kstep, voffB); PG8_STAGE(PG8_SA(1, 0), cA + kstep, voffA); PG8_STAGE(PG8_SB(1, 1), cB + hstepB + kstep, voffB);
        PG8_WAIT_V(6); PG8_BAR;
    } else {
        PG8_STAGE(PG8_SB(0, 0), cB, voffB); PG8_STAGE(PG8_SA(0, 0), cA, voffA); PG8_STAGE(PG8_SB(0, 1), cB + hstepB, voffB); PG8_STAGE(PG8_SA(0, 1), cA + hstepA, voffA);
        if (wr == 1) PG8_BAR;
        PG8_WAIT_V(4); PG8_BAR;
        PG8_STAGE(PG8_SB(1, 0), cB + kstep, voffB); PG8_STAGE(PG8_SA(1, 0), cA + kstep, voffA); PG8_STAGE(PG8_SB(1, 1), cB + hstepB + kstep, voffB);
        PG8_WAIT_V(6); PG8_BAR;
    }
    for (;;) {
        const bool has_next = S.next(ui + 1, nxt);
        const char* nA = has_next ? (const char*)g.A + (size_t)nxt.pm * tstepA : cA; const char* nB = has_next ? (const char*)g.Bt + (size_t)nxt.pn * tstepB : cB;
#pragma clang loop unroll(disable)
        for (int t = 0; t < nt; t += 2) {
            const bool last = (t == nt - 2);
            const char* a1 = cA + (size_t)(t + 1) * kstep;
            const char* a2 = last ? nA : cA + (size_t)(t + 2) * kstep; const char* b2 = last ? nB : cB + (size_t)(t + 2) * kstep;
            const char* a3 = a2 + kstep; const char* b3 = b2 + kstep;
            if (last && has_next) S.a_ready(nxt);
            if constexpr (SP2) {
            PG8_LDB(B0, 0, 0); PG8_LDB(B1, 0, 1); PG8_SCHED; PG8_LDA(At, 0, 0); PG8_STAGE(PG8_SA(1, 1), a1 + hstepA, voffA);
            PG8_WAIT_V(8); PG8_WAIT_L(0); PG8_BAR; PG8_MMA(0, 0, At, B0); PG8_MMA(0, 1, At, B1); PG8_BAR; PG8_SCHED;
            PG8_LDA(At, 0, 1); PG8_STAGE(PG8_SB(0, 0), b2, voffB); PG8_STAGE(PG8_SB(0, 1), b2 + hstepB, voffB); PG8_STAGE(PG8_SA(0, 0), a2, voffA);
            PG8_WAIT_V(8); PG8_WAIT_L(0); PG8_BAR; PG8_MMA(1, 0, At, B0); PG8_MMA(1, 1, At, B1); PG8_BAR; PG8_SCHED;
            PG8_LDB(B0, 1, 0); PG8_LDB(B1, 1, 1); PG8_SCHED; PG8_LDA(At, 1, 0); PG8_STAGE(PG8_SA(0, 1), a2 + hstepA, voffA);
            PG8_WAIT_V(8); PG8_WAIT_L(0); PG8_BAR; PG8_MMA(0, 0, At, B0); PG8_MMA(0, 1, At, B1); PG8_BAR; PG8_SCHED;
            PG8_LDA(At, 1, 1); PG8_STAGE(PG8_SB(1, 0), b3, voffB); PG8_STAGE(PG8_SB(1, 1), b3 + hstepB, voffB); PG8_STAGE(PG8_SA(1, 0), a3, voffA);
            PG8_WAIT_V(8); PG8_WAIT_L(0); PG8_BAR; PG8_MMA(1, 0, At, B0); PG8_MMA(1, 1, At, B1); PG8_BAR; PG8_SCHED;
            } else {
            PG8_LDB(B0, 0, 0); PG8_SCHED; PG8_LDA(At, 0, 0); PG8_STAGE(PG8_SA(1, 1), a1 + hstepA, voffA);
            PG8_WAIT_L(8); PG8_BAR; PG8_WAIT_L(0); PG8_MMA(0, 0, At, B0); PG8_BAR; PG8_SCHED;
            PG8_LDB(B1, 0, 1); PG8_STAGE(PG8_SB(0, 0), b2, voffB);
            PG8_BAR; PG8_WAIT_L(0); PG8_MMA(0, 1, At, B1); PG8_BAR;
            PG8_LDA(At, 0, 1); PG8_STAGE(PG8_SA(0, 0), a2, voffA);
            PG8_BAR; PG8_WAIT_L(0); PG8_MMA(1, 0, At, B0); PG8_BAR; PG8_SCHED;
            PG8_STAGE(PG8_SB(0, 1), b2 + hstepB, voffB);
            PG8_WAIT_V(6); PG8_BAR; PG8_MMA(1, 1, At, B1); PG8_BAR;
            PG8_LDB(B0, 1, 0); PG8_SCHED; PG8_LDA(At, 1, 0); PG8_STAGE(PG8_SA(0, 1), a2 + hstepA, voffA);
            PG8_WAIT_L(8); PG8_BAR; PG8_WAIT_L(0); PG8_MMA(0, 0, At, B0); PG8_BAR; PG8_SCHED;
            PG8_LDB(B1, 1, 1); PG8_STAGE(PG8_SB(1, 0), b3, voffB);
            PG8_BAR; PG8_WAIT_L(0); PG8_MMA(0, 1, At, B1); PG8_BAR;
            PG8_LDA(At, 1, 1); PG8_STAGE(PG8_SA(1, 0), a3, voffA);
            PG8_BAR; PG8_WAIT_L(0); PG8_MMA(1, 0, At, B0); PG8_BAR; PG8_SCHED;
            PG8_STAGE(PG8_SB(1, 1), b3 + hstepB, voffB);
            PG8_WAIT_V(6); PG8_BAR; PG8_MMA(1, 1, At, B1); PG8_BAR;
            }
        }
        if constexpr (ALIGN_EPI) { if (wr == 0) PG8_BAR; }
        { int l2 = threadIdx.x; asm volatile("" : "+v"(l2)); l2 &= 63; E(acc, cur, wr, wc, l2 & 15, l2 >> 4); }
        S.done(cur);
        if (!has_next) break;
#pragma unroll
        for (int a = 0; a < 2; ++a)
#pragma unroll
            for (int b = 0; b < 2; ++b)
#pragma unroll
                for (int m = 0; m < 4; ++m)
#pragma unroll
                    for (int n = 0; n < 2; ++n) acc[a][b][m][n] = (f32x4){0.f, 0.f, 0.f, 0.f};
        cur = nxt; cA = nA; cB = nB; ++ui;
        if constexpr (ALIGN_EPI) { if (wr == 1) PG8_BAR; }
    }
    PG8_WAIT_V(0);
    if constexpr (!ALIGN_EPI) { if (wr == 0) PG8_BAR; }
    PG8_BAR;
#undef PG8_SA
#undef PG8_SB
#undef PG8_STAGE
#undef PG8_LDA
#undef PG8_LDB
#undef PG8_MMA
#undef PG8_WAIT_V
#undef PG8_WAIT_L
#undef PG8_BAR
#undef PG8_SCHED
}
}

#define XB_TMO      128
#define XB_XCNT(j)  (256  + 64 * (j))
#define XB_XSUB(j)  (1280 + 64 * (j))
#define XB_XGEN(j)  (2304 + 64 * (j))
#define XB_TOP      3328
#define XB_TOPGEN   3392
#define XCD_BAR_WORDS 3456
#define XB_SPIN_CAP (1u << 18)
__device__ __forceinline__ unsigned xb_ld(unsigned* p)              { return __hip_atomic_load(p, __ATOMIC_RELAXED, __HIP_MEMORY_SCOPE_AGENT); }
__device__ __forceinline__ unsigned xb_add(unsigned* p, unsigned v) { return __hip_atomic_fetch_add(p, v, __ATOMIC_RELAXED, __HIP_MEMORY_SCOPE_AGENT); }
__device__ __forceinline__ unsigned xb_xcc_id() { return (unsigned)__builtin_amdgcn_s_getreg((3 << 11) | 20) & 0xFu; }
#define XB_SPIN(cond, bar) do { unsigned _sp = 0; while (cond) { __builtin_amdgcn_s_sleep(1); \
    if ((++_sp & 255u) == 0u) { if (xb_ld(&(bar)[XB_TMO])) break; if (_sp > XB_SPIN_CAP) { atomicAdd(&(bar)[XB_TMO], 1u); break; } } } } while (0)
struct XcdBarrier { unsigned* bar; unsigned x; volatile LAS unsigned* st; };
__device__ __forceinline__ XcdBarrier xcd_barrier_post(unsigned* bar, volatile LAS unsigned* st) {
    XcdBarrier b; b.bar = bar; b.x = xb_xcc_id(); b.st = st;
    if (threadIdx.x == 0) (void)xb_add(&bar[XB_XCNT(b.x)], 1u);
    return b;
}
__device__ __forceinline__ void xcd_barrier_complete(unsigned* bar, unsigned x, unsigned& nloc, unsigned& nx) {
    const unsigned G = gridDim.x * gridDim.y * gridDim.z;
    unsigned sum, cnt, mine, sp = 0u;
    for (;;) {
        sum = 0u; cnt = 0u; mine = 0u;
#pragma unroll
        for (unsigned j = 0; j < 16; ++j) { const unsigned c = xb_ld(&bar[XB_XCNT(j)]); sum += c; cnt += (c > 0u) ? 1u : 0u; mine = (j == x) ? c : mine; }
        if (sum == G) break;
        __builtin_amdgcn_s_sleep(1);
        if ((++sp & 255u) == 0u) { if (xb_ld(&bar[XB_TMO])) break; if (sp > XB_SPIN_CAP) { atomicAdd(&bar[XB_TMO], 1u); break; } }
    }
    nloc = mine > 0u ? mine : 1u; nx = cnt > 0u ? cnt : 1u;
}
__device__ __forceinline__ void xcd_barrier(const XcdBarrier& b) {
    asm volatile("s_waitcnt vmcnt(0)" ::: "memory");
    __syncthreads();
    if (threadIdx.x == 0) {
        unsigned* bar = b.bar;
        __builtin_amdgcn_s_waitcnt(0);
        unsigned nloc = b.st[0], nx = b.st[1];
        if (nloc == 0u) { xcd_barrier_complete(bar, b.x, nloc, nx); b.st[0] = nloc; b.st[1] = nx; }
        const unsigned old = xb_add(&bar[XB_XSUB(b.x)], 1u);
        const unsigned gen = old / nloc;
        if (old + 1u == (gen + 1u) * nloc) {
            __builtin_amdgcn_fence(__ATOMIC_RELEASE, "agent");
            asm volatile("s_waitcnt vmcnt(0)" ::: "memory");
            const unsigned og = xb_add(&bar[XB_TOP], 1u);
            const unsigned tg = og / nx;
            if (og + 1u == (tg + 1u) * nx) xb_add(&bar[XB_TOPGEN], 1u);
            else XB_SPIN(xb_ld(&bar[XB_TOPGEN]) == tg, bar);
            __builtin_amdgcn_fence(__ATOMIC_ACQUIRE, "agent");
            xb_add(&bar[XB_XGEN(b.x)], 1u);
            asm volatile("s_waitcnt vmcnt(0)" ::: "memory");
        } else {
            XB_SPIN(xb_ld(&bar[XB_XGEN(b.x)]) == gen, bar);
            __builtin_amdgcn_fence(__ATOMIC_ACQUIRE, "agent");
            asm volatile("s_waitcnt vmcnt(0)" ::: "memory");
        }
    }
    __syncthreads();
}

struct Params { const float* in[24]; float* out; unsigned char* ws; int ph_lo, ph_hi; };
enum { I_X = 0, I_RELB, I_EVNM, I_WIN, I_POOLW, I_POOLS, I_CONVW, I_WOUT, I_EVNF, I_FG, I_FU, I_FD, I_ODNM, I_WQKV, I_BQKV, I_SINK, I_WO, I_BO, I_ODNF, I_ROUTER, I_EG, I_EU, I_ED, I_FINAL };

__device__ __forceinline__ void p0_tile(const float* __restrict__ src, int N, int k0, int n0, bf16_t* __restrict__ dst, int ldd, LAS unsigned char* scr, int lane) {
    const int n4 = (lane & 15) * 4, kp = lane >> 4;
    f32x4 a[8], b[8];
#pragma unroll
    for (int i = 0; i < 8; ++i) { const float* p = src + (size_t)(k0 + 8 * i + 2 * kp) * N + n0 + n4; a[i] = *(const f32x4*)p; b[i] = *(const f32x4*)(p + N); }
#pragma unroll
    for (int i = 0; i < 8; ++i) { const int k = 8 * i + 2 * kp;
#pragma unroll
        for (int q = 0; q < 4; ++q) *(LAS unsigned*)(scr + (n4 + q) * 136 + k * 2) = pk2(a[i][q], b[i][q]); }
    LDS_WAIT();
    const int c = lane & 7, nr = lane >> 3;
#pragma unroll
    for (int j = 0; j < 8; ++j) { const int n = 8 * j + nr; const u32x2 lo = *(const LAS u32x2*)(scr + n * 136 + 16 * c), hi = *(const LAS u32x2*)(scr + n * 136 + 16 * c + 8);
        u32x4 o; o.x = lo.x; o.y = lo.y; o.z = hi.x; o.w = hi.y; *(u32x4*)(dst + (size_t)n * ldd + 8 * c) = o; }
    LDS_WAIT();
}
__device__ __forceinline__ void p0_tile8(const float* __restrict__ src, int N, int k0, int n0, unsigned char* __restrict__ dst, int ldd, float scale, LAS unsigned char* scr, int lane) {
    const int n4 = (lane & 7) * 4, kq = lane >> 3;
    f32x4 a[4][4];
#pragma unroll
    for (int i = 0; i < 4; ++i)
#pragma unroll
        for (int j = 0; j < 4; ++j) a[i][j] = *(const f32x4*)(src + (size_t)(k0 + 32 * i + 4 * kq + j) * N + n0 + n4);
#pragma unroll
    for (int i = 0; i < 4; ++i)
#pragma unroll
        for (int q = 0; q < 4; ++q) *(LAS unsigned*)(scr + (n4 + q) * 144 + 32 * i + 4 * kq) = pg8::pk4_fp8(a[i][0][q] * scale, a[i][1][q] * scale, a[i][2][q] * scale, a[i][3][q] * scale);
    LDS_WAIT();
    const int c = lane & 7, nr = lane >> 3;
#pragma unroll
    for (int j = 0; j < 4; ++j) { const int n = 8 * j + nr; *(u32x4*)(dst + (size_t)n * ldd + 16 * c) = *(const LAS u32x4*)(scr + n * 144 + 16 * c); }
    LDS_WAIT();
}
__device__ __forceinline__ void norm_row_bf16(const float* __restrict__ xrow, const float* __restrict__ gain, bf16_t* __restrict__ orow, int lane, float (&y)[16]) {
    f32x4 v[4];
#pragma unroll
    for (int j = 0; j < 2; ++j) { v[2 * j] = *(const f32x4*)(xrow + 512 * j + 8 * lane); v[2 * j + 1] = *(const f32x4*)(xrow + 512 * j + 8 * lane + 4); }
    float s = 0.f;
#pragma unroll
    for (int j = 0; j < 4; ++j) s += (v[j][0] * v[j][0] + v[j][1] * v[j][1]) + (v[j][2] * v[j][2] + v[j][3] * v[j][3]);
    const float r = 1.0f / sqrtf(wave_sum(s) * (1.0f / D) + RMS_EPS);
#pragma unroll
    for (int j = 0; j < 2; ++j) { const f32x4 g0 = *(const f32x4*)(gain + 512 * j + 8 * lane), g1 = *(const f32x4*)(gain + 512 * j + 8 * lane + 4);
#pragma unroll
        for (int q = 0; q < 4; ++q) { y[8 * j + q] = v[2 * j][q] * r * g0[q]; y[8 * j + 4 + q] = v[2 * j + 1][q] * r * g1[q]; }
        u32x4 w; w.x = pk2(y[8 * j], y[8 * j + 1]); w.y = pk2(y[8 * j + 2], y[8 * j + 3]); w.z = pk2(y[8 * j + 4], y[8 * j + 5]); w.w = pk2(y[8 * j + 6], y[8 * j + 7]);
        *(u32x4*)(orow + 512 * j + 8 * lane) = w; }
}

__device__ __forceinline__ int t5_bucket(int rel) {
    const int n = rel < 0 ? -rel : rel; const int ret = rel > 0 ? 16 : 0;
    int v;
    if (n < 8) v = n; else if (n < 12) v = 8; else if (n < 16) v = 9; else if (n < 23) v = 10; else if (n < 32) v = 11; else if (n < 46) v = 12; else if (n < 64) v = 13; else if (n < 91) v = 14; else v = 15;
    return ret + v;
}

__global__ void __launch_bounds__(NTHR, 2) fwd_kernel(Params p) {
    extern __shared__ __attribute__((aligned(16))) unsigned char lds_raw[];
    LAS unsigned char* lds = (LAS unsigned char*)lds_raw;
    volatile LAS unsigned* MISC = (volatile LAS unsigned*)(lds + LDS_MISC_OFF);
    const int tid = threadIdx.x, lane = tid & 63, wave = __builtin_amdgcn_readfirstlane(tid >> 6);
    const int G = gridDim.x, bx = blockIdx.x;
    const int vcu = (G % 8 == 0) ? (bx % 8) * (G / 8) + bx / 8 : bx;
    const int gw = vcu * NWAVES + wave, NGW = G * NWAVES;
    unsigned char* ws = p.ws;
    unsigned* ctl = (unsigned*)(ws + WS_CTL);
    if (tid < 64) MISC[tid] = 0u;
    __syncthreads();
    XcdBarrier bar; bar.bar = ctl + CW_BAR; bar.x = 0; bar.st = nullptr;
    if (MK_N_LAUNCHES == 1) bar = xcd_barrier_post(ctl + CW_BAR, MISC + 8);
    const int lo = p.ph_lo, hi = p.ph_hi;
#define IN(k) (lo <= (k) && (k) < hi)
#define SEAM(k) do { if (MK_N_LAUNCHES == 1 && IN((k) + 1)) xcd_barrier(bar); } while (0)

    bf16_t* Win_t = (bf16_t*)(ws + WS_WIN); bf16_t* Wout_t = (bf16_t*)(ws + WS_WOUT); bf16_t* Wgu_t = (bf16_t*)(ws + WS_WGU); bf16_t* Wd_t = (bf16_t*)(ws + WS_WD);
    bf16_t* Wqkv_t = (bf16_t*)(ws + WS_WQKV); bf16_t* Wo_t = (bf16_t*)(ws + WS_WO); bf16_t* Wegu_t = (bf16_t*)(ws + WS_WEGU); bf16_t* Wed_t = (bf16_t*)(ws + WS_WED);
    bf16_t* XN = (bf16_t*)(ws + WS_XN); bf16_t* PROJ = (bf16_t*)(ws + WS_PROJ); bf16_t* MIXED = (bf16_t*)(ws + WS_MIXED); bf16_t* Hb = (bf16_t*)(ws + WS_H);
    bf16_t* QKV = (bf16_t*)(ws + WS_QKV); bf16_t* AO = (bf16_t*)(ws + WS_AO); bf16_t* HS = (bf16_t*)(ws + WS_HS); bf16_t* H2 = (bf16_t*)(ws + WS_H2);
    float* bias_tab = (float*)(ws + WS_BIAS); int* wgcnt = (int*)(ws + WS_WGCNT); int* tilemeta = (int*)(ws + WS_TILE);
    int* tok_e = (int*)(ws + WS_TOKE); float* tok_w = (float*)(ws + WS_TOKW); int* tok_r = (int*)(ws + WS_TOKR); int* slot_tok = (int*)(ws + WS_SLOTT); float* slot_w = (float*)(ws + WS_SLOTW);
    float* X = p.out;

    if (IN(0)) for (int rep_ = 0; rep_ < NREP(0); ++rep_) {
        const int tid = fresh_tid(), lane = tid & 63;
        LAS unsigned char* scr = lds + wave * 8704;
        constexpr int T_WIN = 16 * 32, T_WOUT = 8 * 16, T_FG = 16 * 44, T_FD = 44 * 16, T_QKV = 16 * 20, T_WO = 16 * 16;
        constexpr int T_EG = 8 * 112, T_ED = 28 * 32;
        constexpr int NT8 = NEXP * (2 * T_EG + T_ED);
        constexpr int NT = T_WIN + T_WOUT + 2 * T_FG + T_FD + T_QKV + T_WO;
        unsigned char* Wegu8 = (unsigned char*)Wegu_t; unsigned char* Wed8 = (unsigned char*)Wed_t;
        for (int it = gw; it < NT8; it += NGW) {
            const int per_e = 2 * T_EG + T_ED; const int e = it / per_e; int q = it % per_e;
            if (q < 2 * T_EG) { const int up = q >= T_EG; if (up) q -= T_EG; const int kb = q / 112, nb = q % 112, n0 = 32 * nb;
                p0_tile8(p.in[up ? I_EU : I_EG] + (size_t)e * D * DFE, DFE, 128 * kb, n0, Wegu8 + ((size_t)e * 2 * DFE + (n0 / 128) * 256 + (n0 % 128) + (up ? 128 : 0)) * D + 128 * kb, D, 64.f, scr, lane); }
            else { q -= 2 * T_EG; const int kb = q / 32, nb = q % 32;
                p0_tile8(p.in[I_ED] + (size_t)e * DFE * D, D, 128 * kb, 32 * nb, Wed8 + ((size_t)e * D + 32 * nb) * DFE + 128 * kb, DFE, 64.f, scr, lane); }
        }
        for (int it = gw; it < NT; it += NGW) {
            int r = it;
            if (r < T_WIN) { const int kb = r / 32, nb = r % 32; p0_tile(p.in[I_WIN], MIXN, 64 * kb, 64 * nb, Win_t + (size_t)(64 * nb) * D + 64 * kb, D, scr, lane); continue; } r -= T_WIN;
            if (r < T_WOUT) { const int kb = 8 + r / 16, nb = r % 16; p0_tile(p.in[I_WOUT], D, 64 * kb, 64 * nb, Wout_t + (size_t)(64 * nb) * D + 64 * kb, D, scr, lane); continue; } r -= T_WOUT;
            if (r < 2 * T_FG) { const int up = r >= T_FG; const int q = up ? r - T_FG : r; const int kb = q / 44, nb = q % 44, n0 = 64 * nb;
                p0_tile(p.in[up ? I_FU : I_FG], DFF, 64 * kb, n0, Wgu_t + (size_t)((n0 / 128) * 256 + (n0 % 128) + (up ? 128 : 0)) * D + 64 * kb, D, scr, lane); continue; } r -= 2 * T_FG;
            if (r < T_FD) { const int kb = r / 16, nb = r % 16; p0_tile(p.in[I_FD], D, 64 * kb, 64 * nb, Wd_t + (size_t)(64 * nb) * DFF + 64 * kb, DFF, scr, lane); continue; } r -= T_FD;
            if (r < T_QKV) { const int kb = r / 20, nb = r % 20; p0_tile(p.in[I_WQKV], QKVN, 64 * kb, 64 * nb, Wqkv_t + (size_t)(64 * nb) * D + 64 * kb, D, scr, lane); continue; } r -= T_QKV;
            { const int kb = r / 16, nb = r % 16; p0_tile(p.in[I_WO], D, 64 * kb, 64 * nb, Wo_t + (size_t)(64 * nb) * D + 64 * kb, D, scr, lane); }
        }
        for (int it = gw; it < 4 * 16 * 16; it += NGW) {
            const int g = it >> 8, cb = (it >> 4) & 15, nb = it & 15; const int n = 64 * nb + lane, c0 = 8 * cb;
            const float* wo = p.in[I_WOUT] + (size_t)(g * 128) * D + n; const float* ps = p.in[I_POOLS] + g * 128; const float* pw = p.in[I_POOLW] + (size_t)(g * 128 + c0) * 128;
            float acc[8];
#pragma unroll
            for (int cc = 0; cc < 8; ++cc) acc[cc] = 0.f;
            for (int d = 0; d < 128; ++d) { const float w = wo[(size_t)d * D] * ps[d];
#pragma unroll
                for (int cc = 0; cc < 8; ++cc) acc[cc] += pw[cc * 128 + d] * w; }
            *(u32x4*)(Wout_t + (size_t)n * D + g * 128 + c0) = pack8(acc);
        }
        for (int m = gw; m < M; m += NGW) { float y[16]; norm_row_bf16(p.in[I_X] + (size_t)m * D, p.in[I_EVNM], XN + (size_t)m * D, lane, y); }
        for (int i = bx * NTHR + tid; i < NQH * 256; i += G * NTHR) { const int h = i >> 8, idx = i & 255; bias_tab[i] = idx < 255 ? p.in[I_RELB][t5_bucket(idx - 191) * NQH + h] : 0.f; }
    }
    SEAM(0);

    if (IN(1)) for (int rep_ = 0; rep_ < NREP(1); ++rep_) { pg8::Gemm g{XN, Win_t, 2 * D, 2 * D, 2 * D}; pg8::DenseOrder S; S.init(M, MIXN, G, bx); pg8::EpiBf16 E{PROJ, MIXN, nullptr};
        pg8::gemm_phase<pg8::EpiBf16, pg8::DenseOrder>(lds, g, S, E); }
    SEAM(1);

    if (IN(2)) for (int rep_ = 0; rep_ < NREP(2); ++rep_) {
        const int tid = fresh_tid(), lane = tid & 63;
        for (int unit = gw; unit < (M / 32) * 2; unit += NGW) {
            const int rb = unit >> 1, half = unit & 1, r0 = rb * 32, bs = r0 & ~(SEQ - 1);
            if (half == 0) {
                const int w = 2 << (lane >> 4); const bf16_t* P = PROJ + 8 * lane;
                float s[8];
#pragma unroll
                for (int q = 0; q < 8; ++q) s[q] = 0.f;
                for (int j = 1; j <= 16; ++j) if (j <= w && r0 - j >= bs) { float f[8]; unpack8(*(const u32x4*)(P + (size_t)(r0 - j) * MIXN), f);
#pragma unroll
                    for (int q = 0; q < 8; ++q) s[q] += f[q]; }
#pragma unroll 4
                for (int r = r0; r < r0 + 32; ++r) {
                    float cur[8], old[8]; unpack8(*(const u32x4*)(P + (size_t)r * MIXN), cur);
                    const bool has_old = (r - w >= bs);
                    if (has_old) unpack8(*(const u32x4*)(P + (size_t)(r - w) * MIXN), old);
                    const int pos = r - bs + 1; const float inv = 1.0f / (float)(pos < w ? pos : w);
                    float o[8];
#pragma unroll
                    for (int q = 0; q < 8; ++q) { s[q] += cur[q]; if (has_old) s[q] -= old[q]; o[q] = s[q] * inv - cur[q]; }
                    *(u32x4*)(MIXED + (size_t)r * D + 8 * lane) = pack8(o);
                }
            } else {
                const bf16_t* P = PROJ + 8 * lane;
                float w0[8], w1[8], w2[8], z1[8], z2[8];
                { const float* cw = p.in[I_CONVW] + 8 * lane;
#pragma unroll
                  for (int q = 0; q < 8; ++q) { w0[q] = cw[q]; w1[q] = cw[512 + q]; w2[q] = cw[1024 + q]; z1[q] = 0.f; z2[q] = 0.f; } }
                if (r0 - 1 >= bs) { float a[8], b[8]; unpack8(*(const u32x4*)(P + (size_t)(r0 - 1) * MIXN + 1024), a); unpack8(*(const u32x4*)(P + (size_t)(r0 - 1) * MIXN + 1536), b);
#pragma unroll
                    for (int q = 0; q < 8; ++q) z1[q] = a[q] * b[q]; }
                if (r0 - 2 >= bs) { float a[8], b[8]; unpack8(*(const u32x4*)(P + (size_t)(r0 - 2) * MIXN + 1024), a); unpack8(*(const u32x4*)(P + (size_t)(r0 - 2) * MIXN + 1536), b);
#pragma unroll
                    for (int q = 0; q < 8; ++q) z2[q] = a[q] * b[q]; }
#pragma unroll 4
                for (int r = r0; r < r0 + 32; ++r) {
                    float gp[8], a[8], b[8], o[8];
                    unpack8(*(const u32x4*)(P + (size_t)r * MIXN + 512), gp); unpack8(*(const u32x4*)(P + (size_t)r * MIXN + 1024), a); unpack8(*(const u32x4*)(P + (size_t)r * MIXN + 1536), b);
#pragma unroll
                    for (int q = 0; q < 8; ++q) { const float zc = a[q] * b[q]; o[q] = gp[q] * (w0[q] * z2[q] + w1[q] * z1[q] + w2[q] * zc); z2[q] = z1[q]; z1[q] = zc; }
                    *(u32x4*)(MIXED + (size_t)r * D + 512 + 8 * lane) = pack8(o);
                }
            }
        }
    }
    SEAM(2);

    if (IN(3)) for (int rep_ = 0; rep_ < NREP(3); ++rep_) { pg8::Gemm g{MIXED, Wout_t, 2 * D, 2 * D, 2 * D}; pg8::DenseOrder S; S.init(M, D, G, bx); pg8::EpiResid E{p.in[I_X], X, nullptr};
        pg8::gemm_phase<pg8::EpiResid, pg8::DenseOrder>(lds, g, S, E); }
    SEAM(3);

    if (IN(4)) for (int rep_ = 0; rep_ < NREP(4); ++rep_) { const int lane = fresh_tid() & 63; for (int m = gw; m < M; m += NGW) { float y[16]; norm_row_bf16(X + (size_t)m * D, p.in[I_EVNF], XN + (size_t)m * D, lane, y); } }
    SEAM(4);

    if (IN(5)) for (int rep_ = 0; rep_ < NREP(5); ++rep_) { pg8::Gemm g{XN, Wgu_t, 2 * D, 2 * D, 2 * D}; pg8::DenseOrder S; S.init(M, 2 * DFF, G, bx); pg8::EpiSwiGLU E{Hb, DFF};
        pg8::gemm_phase<pg8::EpiSwiGLU, pg8::DenseOrder>(lds, g, S, E); }
    SEAM(5);

    if (IN(6)) for (int rep_ = 0; rep_ < NREP(6); ++rep_) { pg8::Gemm g{Hb, Wd_t, 2 * DFF, 2 * DFF, 2 * DFF}; pg8::DenseOrder S; S.init(M, D, G, bx); pg8::EpiResid E{X, X, nullptr};
        pg8::gemm_phase<pg8::EpiResid, pg8::DenseOrder>(lds, g, S, E); }
    SEAM(6);

    if (IN(7)) for (int rep_ = 0; rep_ < NREP(7); ++rep_) { const int lane = fresh_tid() & 63; for (int m = gw; m < M; m += NGW) { float y[16]; norm_row_bf16(X + (size_t)m * D, p.in[I_ODNM], XN + (size_t)m * D, lane, y); } }
    SEAM(7);

    if (IN(8)) for (int rep_ = 0; rep_ < NREP(8); ++rep_) { pg8::Gemm g{XN, Wqkv_t, 2 * D, 2 * D, 2 * D}; pg8::DenseOrder S; S.init(M, QKVN, G, bx); pg8::EpiBf16 E{QKV, QKVN, p.in[I_BQKV]};
        pg8::gemm_phase<pg8::EpiBf16, pg8::DenseOrder>(lds, g, S, E); }
    SEAM(8);

    if (IN(9)) for (int rep_ = 0; rep_ < NREP(9); ++rep_) {
        const int tid = fresh_tid(), lane = tid & 63;
        constexpr int KS_STR = 144, VT_STR = 392;
        constexpr int L_K = 0, L_VT = 192 * KS_STR, L_BT = L_VT + 64 * VT_STR, L_OST = L_BT + NQH * 256 * 4;
        static_assert(L_OST + NWAVES * 32 * 144 <= RING_BYTES, "attention LDS");
        for (int i = tid; i < NQH * 256; i += NTHR) *(LAS float*)(lds + L_BT + 4 * i) = bias_tab[i];
        const int r32 = lane & 31, hh = lane >> 5;
        for (int unit = vcu; unit < BATCH * (SEQ / CHUNK) * NKVH; unit += G) {
            const int kvh = unit & 1, n = (unit >> 1) & 255, b = unit >> 9;
            const int t0 = b * SEQ + n * CHUNK;
            __syncthreads();
#pragma unroll
            for (int i = 0; i < 3; ++i) { const int pc = tid + i * NTHR, j = pc >> 3, c = pc & 7; const bool valid = (n * CHUNK - 128 + j) >= 0;
                u32x4 kv = {0u, 0u, 0u, 0u}, vv = {0u, 0u, 0u, 0u};
                if (valid) { const bf16_t* src = QKV + (size_t)(t0 - 128 + j) * QKVN + 1024 + kvh * HD + 8 * c; kv = *(const u32x4*)src; vv = *(const u32x4*)(src + 128); }
                *(LAS u32x4*)(lds + L_K + j * KS_STR + 16 * c) = kv;
                const unsigned vw[4] = {vv.x, vv.y, vv.z, vv.w};
#pragma unroll
                for (int q = 0; q < 4; ++q) { *(LAS unsigned short*)(lds + L_VT + (8 * c + 2 * q) * VT_STR + 2 * j) = (unsigned short)(vw[q] & 0xffffu);
                                              *(LAS unsigned short*)(lds + L_VT + (8 * c + 2 * q + 1) * VT_STR + 2 * j) = (unsigned short)(vw[q] >> 16); } }
            __syncthreads();
            const int head = kvh * 8 + wave;
            const float sink = p.in[I_SINK][head];
            const LAS float* bt = (const LAS float*)(lds + L_BT + head * 1024);
            const int kb_min = n == 0 ? 4 : (n == 1 ? 2 : 0);
#pragma unroll 1
            for (int qb = 0; qb < 2; ++qb) {
                bf16x8 qf[4];
                { const bf16_t* qp = QKV + (size_t)(t0 + qb * 32 + r32) * QKVN + head * HD + 8 * hh;
#pragma unroll
                  for (int ks = 0; ks < 4; ++ks) qf[ks] = *(const bf16x8*)(qp + 16 * ks); }
                f32x16 st[6];
#pragma unroll
                for (int kb = 0; kb < 6; ++kb) {
#pragma unroll
                    for (int e = 0; e < 16; ++e) st[kb][e] = 0.f;
#pragma unroll
                    for (int ks = 0; ks < 4; ++ks) { const bf16x8 kf = *(const LAS bf16x8*)(lds + L_K + (kb * 32 + r32) * KS_STR + 32 * ks + 16 * hh);
                        st[kb] = __builtin_amdgcn_mfma_f32_32x32x16_bf16(kf, qf[ks], st[kb], 0, 0, 0); } }
                float mx = sink;
#pragma unroll
                for (int kb = 0; kb < 6; ++kb)
#pragma unroll
                    for (int e = 0; e < 16; ++e) { const int j = kb * 32 + (e & 3) + 8 * (e >> 2) + 4 * hh; const int idx = j - (qb * 32 + r32) + 63;
                        float sc = st[kb][e] * 0.125f + bt[idx]; sc = (kb < kb_min) ? -1e30f : sc; st[kb][e] = sc; mx = fmaxf(mx, sc); }
                mx = fmaxf(mx, __shfl_xor(mx, 32));
                float sum = 0.f;
#pragma unroll
                for (int kb = 0; kb < 6; ++kb)
#pragma unroll
                    for (int e = 0; e < 16; ++e) { const float pe = __builtin_amdgcn_exp2f((st[kb][e] - mx) * 1.44269504089f); st[kb][e] = pe; sum += pe; }
                sum += __shfl_xor(sum, 32);
                const float inv = 1.0f / (sum + __builtin_amdgcn_exp2f((sink - mx) * 1.44269504089f));
                f32x16 ot[2];
#pragma unroll
                for (int db = 0; db < 2; ++db)
#pragma unroll
                    for (int e = 0; e < 16; ++e) ot[db][e] = 0.f;
#pragma unroll
                for (int kb = 0; kb < 6; ++kb)
#pragma unroll
                    for (int s = 0; s < 2; ++s) {
                        u32x4 pw; pw.x = pk2(st[kb][8 * s], st[kb][8 * s + 1]); pw.y = pk2(st[kb][8 * s + 2], st[kb][8 * s + 3]); pw.z = pk2(st[kb][8 * s + 4], st[kb][8 * s + 5]); pw.w = pk2(st[kb][8 * s + 6], st[kb][8 * s + 7]);
                        const bf16x8 pf = __builtin_bit_cast(bf16x8, pw);
#pragma unroll
                        for (int db = 0; db < 2; ++db) { const LAS unsigned char* vp = lds + L_VT + (db * 32 + r32) * VT_STR + 2 * (kb * 32 + 16 * s + 4 * hh);
                            const u32x2 v0 = *(const LAS u32x2*)vp, v1 = *(const LAS u32x2*)(vp + 16);
                            u32x4 vw; vw.x = v0.x; vw.y = v0.y; vw.z = v1.x; vw.w = v1.y;
                            ot[db] = __builtin_amdgcn_mfma_f32_32x32x16_bf16(__builtin_bit_cast(bf16x8, vw), pf, ot[db], 0, 0, 0); } }
                LAS unsigned char* ost = lds + L_OST + wave * (32 * 144);
#pragma unroll
                for (int db = 0; db < 2; ++db)
#pragma unroll
                    for (int g4 = 0; g4 < 4; ++g4) { u32x2 w; w.x = pk2(ot[db][4 * g4] * inv, ot[db][4 * g4 + 1] * inv); w.y = pk2(ot[db][4 * g4 + 2] * inv, ot[db][4 * g4 + 3] * inv);
                        *(LAS u32x2*)(ost + r32 * 144 + 2 * (db * 32 + 8 * g4 + 4 * hh)) = w; }
                LDS_WAIT();
#pragma unroll
                for (int i = 0; i < 4; ++i) { const int q = 8 * i + (lane >> 3), c = lane & 7; const u32x4 w = *(const LAS u32x4*)(ost + q * 144 + 16 * c);
                    *(u32x4*)(AO + (size_t)(t0 + qb * 32 + q) * D + head * HD + 8 * c) = w; }
                LDS_WAIT();
            }
        }
        __syncthreads();
    }
    SEAM(9);

    if (IN(10)) for (int rep_ = 0; rep_ < NREP(10); ++rep_) { pg8::Gemm g{AO, Wo_t, 2 * D, 2 * D, 2 * D}; pg8::DenseOrder S; S.init(M, D, G, bx); pg8::EpiResid E{X, X, p.in[I_BO]};
        pg8::gemm_phase<pg8::EpiResid, pg8::DenseOrder>(lds, g, S, E); }
    SEAM(10);

    const int RPW = (M + G - 1) / G;
    constexpr int L_RW = 0, L_RE = 32768, L_RWT = L_RE + 1024 * 4, L_CNT = L_RWT + 1024 * 4;
    if (IN(11)) for (int rep_ = 0; rep_ < NREP(11); ++rep_) {
        const int tid = fresh_tid(), lane = tid & 63;
        for (int i = tid; i < D * NEXP / 4; i += NTHR) *(LAS f32x4*)(lds + L_RW + 16 * i) = *(const f32x4*)(p.in[I_ROUTER] + 4 * i);
        if (tid < 8) *(LAS int*)(lds + L_CNT + 4 * tid) = 0;
        __syncthreads();
        const int rbase = bx * RPW;
        for (int rl = wave; rl < RPW && rbase + rl < M; rl += NWAVES) {
            const int m = rbase + rl; float y[16];
            norm_row_bf16(X + (size_t)m * D, p.in[I_ODNF], XN + (size_t)m * D, lane, y);
            float lg[8];
#pragma unroll
            for (int e = 0; e < 8; ++e) lg[e] = 0.f;
#pragma unroll
            for (int j = 0; j < 2; ++j)
#pragma unroll
                for (int q = 0; q < 8; ++q) { const int c = 512 * j + 8 * lane + q; const f32x4 wa = *(const LAS f32x4*)(lds + L_RW + 32 * c), wb = *(const LAS f32x4*)(lds + L_RW + 32 * c + 16); const float yv = y[8 * j + q];
                    lg[0] += yv * wa[0]; lg[1] += yv * wa[1]; lg[2] += yv * wa[2]; lg[3] += yv * wa[3]; lg[4] += yv * wb[0]; lg[5] += yv * wb[1]; lg[6] += yv * wb[2]; lg[7] += yv * wb[3]; }
#pragma unroll
            for (int e = 0; e < 8; ++e) lg[e] = wave_sum(lg[e]);
            int e0 = 0; float v0 = lg[0];
#pragma unroll
            for (int e = 1; e < 8; ++e) if (lg[e] > v0) { v0 = lg[e]; e0 = e; }
            int e1 = -1; float v1 = -3.0e38f;
#pragma unroll
            for (int e = 0; e < 8; ++e) if (e != e0 && lg[e] > v1) { v1 = lg[e]; e1 = e; }
            const float wt0 = 1.0f / (1.0f + __expf(v1 - v0));
            if (lane == 0) { *(LAS int*)(lds + L_RE + 8 * rl) = e0; *(LAS int*)(lds + L_RE + 8 * rl + 4) = e1; *(LAS float*)(lds + L_RWT + 8 * rl) = wt0; *(LAS float*)(lds + L_RWT + 8 * rl + 4) = 1.0f - wt0; }
        }
        __syncthreads();
        const int nrows = (M - rbase) < RPW ? (M - rbase) : RPW;
        for (int en = tid; en < 2 * nrows; en += NTHR) {
            const int e = *(LAS int*)(lds + L_RE + 4 * en); int r = 0;
            for (int j = 0; j < en; ++j) r += (*(LAS int*)(lds + L_RE + 4 * j) == e);
            const int m = rbase + (en >> 1), k = en & 1;
            tok_e[k * M + m] = e; tok_w[k * M + m] = *(LAS float*)(lds + L_RWT + 4 * en); tok_r[k * M + m] = r;
            __hip_atomic_fetch_add((LAS int*)(lds + L_CNT + 4 * e), 1, __ATOMIC_RELAXED, __HIP_MEMORY_SCOPE_WORKGROUP);
        }
        __syncthreads();
        if (tid < 8) wgcnt[bx * 16 + tid] = *(LAS int*)(lds + L_CNT + 4 * tid);
        __syncthreads();
    }
    SEAM(11);

    if (IN(12)) for (int rep_ = 0; rep_ < NREP(12); ++rep_) {
        const int tid = fresh_tid(), lane = tid & 63;
        LAS int* sb = (LAS int*)(lds + 0);
        if (tid < 8) { int tot = 0, pre = 0; for (int w = 0; w < G; ++w) { const int c = wgcnt[w * 16 + tid]; tot += c; if (w < bx) pre += c; } sb[32 + tid] = tot; sb[16 + tid] = pre; }
        __syncthreads();
        if (tid == 0) { int base = 0; for (int e = 0; e < 8; ++e) { sb[e] = base; base += (sb[32 + e] + 255) & ~255; } sb[48] = base; }
        __syncthreads();
        const int rbase = bx * RPW;
        unsigned char* HS8 = (unsigned char*)HS;
        for (int pr = wave; pr < 2 * RPW; pr += NWAVES) { const int k = pr & 1, rl = pr >> 1, m = rbase + rl; if (m >= M) continue;
            const int e = tok_e[k * M + m]; const int slot = sb[e] + sb[16 + e] + tok_r[k * M + m];
            float f[8], g8[8]; unpack8(*(const u32x4*)(XN + (size_t)m * D + 16 * lane), f); unpack8(*(const u32x4*)(XN + (size_t)m * D + 16 * lane + 8), g8);
            u32x4 o; o.x = pg8::pk4_fp8(f[0], f[1], f[2], f[3]); o.y = pg8::pk4_fp8(f[4], f[5], f[6], f[7]); o.z = pg8::pk4_fp8(g8[0], g8[1], g8[2], g8[3]); o.w = pg8::pk4_fp8(g8[4], g8[5], g8[6], g8[7]);
            *(u32x4*)(HS8 + (size_t)slot * D + 16 * lane) = o;
            if (lane == 0) { slot_tok[slot] = 2 * m + k; slot_w[slot] = tok_w[k * M + m]; } }
        if (bx == 0) {
            for (int e = 0; e < 8; ++e) { const int b0 = sb[e] + sb[32 + e], b1 = sb[e] + ((sb[32 + e] + 255) & ~255); for (int i = b0 + tid; i < b1; i += NTHR) { slot_tok[i] = -1; slot_w[i] = 0.f; } }
            const int nt_all = sb[48] >> 8;
            for (int j = tid; j < nt_all; j += NTHR) { int e = 0; for (int q = 1; q < 8; ++q) if ((j << 8) >= sb[q]) e = q; tilemeta[8 + j] = e; }
            if (tid == 0) { tilemeta[0] = nt_all; tilemeta[1] = nt_all; }
        }
        __syncthreads();
    }
    SEAM(12);

    if (IN(13) || IN(14)) {
        const int tid = fresh_tid();
        for (int j = tid; j < 288; j += NTHR) *(LAS int*)(lds + LDS_TILE_OFF + 4 * j) = (j < MAXTILES + 8) ? tilemeta[j] : 0;
        __syncthreads();
    }
    const LAS int* tmeta = (const LAS int*)(lds + LDS_TILE_OFF);
    if (IN(13)) {
        const int nall = __builtin_amdgcn_readfirstlane(tmeta[0]);
        pg8::Gemm g{HS, Wegu_t, D, D, D}; pg8::MoeOrder S; S.T.init(nall, NFE_T, G, bx); S.tpe = NFE_T; S.tile_e = tmeta + 8;
        pg8::EpiSwiGLU8 E{(unsigned char*)H2, DFE};
        pg8::gemm_phase<pg8::EpiSwiGLU8, pg8::MoeOrder, true>(lds, g, S, E);
    }
    SEAM(13);
    if (IN(14)) {
        const int nall = __builtin_amdgcn_readfirstlane(tmeta[0]);
        pg8::Gemm g{H2, Wed_t, DFE, DFE, DFE}; pg8::MoeOrder S; S.T.init(nall, D / 256, G, bx); S.tpe = D / 256; S.tile_e = tmeta + 8;
        pg8::EpiMoeDown E{X, (bf16_t*)(ws + WS_Y0), slot_tok, slot_w};
        pg8::gemm_phase<pg8::EpiMoeDown, pg8::MoeOrder, true>(lds, g, S, E);
    }
    SEAM(14);

    if (IN(15)) {
        const int lane = fresh_tid() & 63;
        const bf16_t* Y0 = (const bf16_t*)(ws + WS_Y0);
        for (int m = gw; m < M; m += NGW) {
            float* xrow = X + (size_t)m * D; f32x4 v[4];
#pragma unroll
            for (int j = 0; j < 2; ++j) { v[2 * j] = *(const f32x4*)(xrow + 512 * j + 8 * lane); v[2 * j + 1] = *(const f32x4*)(xrow + 512 * j + 8 * lane + 4);
                float f[8]; unpack8(*(const u32x4*)(Y0 + (size_t)m * D + 512 * j + 8 * lane), f);
#pragma unroll
                for (int q = 0; q < 4; ++q) { v[2 * j][q] += f[q]; v[2 * j + 1][q] += f[4 + q]; } }
            float s2 = 0.f;
#pragma unroll
            for (int j = 0; j < 4; ++j) s2 += (v[j][0] * v[j][0] + v[j][1] * v[j][1]) + (v[j][2] * v[j][2] + v[j][3] * v[j][3]);
            const float r = 1.0f / sqrtf(wave_sum(s2) * (1.0f / D) + RMS_EPS);
#pragma unroll
            for (int j = 0; j < 2; ++j) { const f32x4 g0 = *(const f32x4*)(p.in[I_FINAL] + 512 * j + 8 * lane), g1 = *(const f32x4*)(p.in[I_FINAL] + 512 * j + 8 * lane + 4);
                *(f32x4*)(xrow + 512 * j + 8 * lane) = v[2 * j] * r * g0; *(f32x4*)(xrow + 512 * j + 8 * lane + 4) = v[2 * j + 1] * r * g1; }
        }
    }
#undef IN
#undef SEAM
}

extern "C" void kernel_launch(void* const* d_in, const int* in_sizes, int n_in, void* d_out, int out_size, void* d_ws, size_t ws_size, hipStream_t stream) {
    static int grid = 0;
    if (grid == 0) {
        if (n_in != 24 || in_sizes[0] != M * D || out_size != M * D || ws_size < WS_END) { fprintf(stderr, "kernel_launch: unexpected shapes (n_in %d, in0 %d, out %d, ws %zu < %zu)\n", n_in, n_in > 0 ? in_sizes[0] : -1, out_size, ws_size, (size_t)WS_END); grid = -1; return; }
        int dev = 0, cus = 0, per_cu = 0;
        if (hipGetDevice(&dev) != hipSuccess || hipDeviceGetAttribute(&cus, hipDeviceAttributeMultiprocessorCount, dev) != hipSuccess) { grid = -1; return; }
        if (hipFuncSetAttribute((const void*)fwd_kernel, hipFuncAttributeMaxDynamicSharedMemorySize, LDS_BYTES) != hipSuccess) { fprintf(stderr, "kernel_launch: hipFuncSetAttribute failed\n"); grid = -1; return; }
        if (hipOccupancyMaxActiveBlocksPerMultiprocessor(&per_cu, (const void*)fwd_kernel, NTHR, LDS_BYTES) != hipSuccess || per_cu < 1) fprintf(stderr, "kernel_launch: occupancy query reports %d\n", per_cu);
        (void)hipGetLastError();
        grid = cus < 256 ? cus : 256;
    }
    if (grid < 0) return;
    (void)hipMemsetAsync((char*)d_ws + WS_CTL, 0, CTL_ZERO_BYTES, stream);
    Params a{};
    for (int i = 0; i < 24; ++i) a.in[i] = (const float*)d_in[i];
    a.out = (float*)d_out; a.ws = (unsigned char*)d_ws;
    constexpr int NPH = 16;
    if (MK_N_LAUNCHES == 1) { a.ph_lo = 0; a.ph_hi = NPH; hipLaunchKernelGGL(fwd_kernel, dim3(grid), dim3(NTHR), LDS_BYTES, stream, a); }
    else for (int li = 0; li < NPH; ++li) { a.ph_lo = li; a.ph_hi = li + 1; hipLaunchKernelGGL(fwd_kernel, dim3(grid), dim3(NTHR), LDS_BYTES, stream, a); }
}
```

```cpp
#include <hip/hip_runtime.h>
#include <cstdio>
#include <cstdint>

#ifndef MK_N_LAUNCHES
#define MK_N_LAUNCHES 1
#endif

#ifndef REPMASK
#define REPMASK 0u
#endif
#define NREP(k) ((((REPMASK) >> (k)) & 1u) ? 2 : 1)
#define LAS __attribute__((address_space(3)))
#define GAS __attribute__((address_space(1)))
typedef unsigned short bf16_t;
typedef short bf16x8 __attribute__((ext_vector_type(8)));
typedef short s16x4 __attribute__((ext_vector_type(4)));
typedef float f32x2 __attribute__((ext_vector_type(2)));
typedef float f32x4 __attribute__((ext_vector_type(4)));
typedef float f32x16 __attribute__((ext_vector_type(16)));
typedef unsigned u32x2 __attribute__((ext_vector_type(2)));
typedef unsigned u32x4 __attribute__((ext_vector_type(4)));
typedef __bf16 hbf16x2 __attribute__((ext_vector_type(2)));
typedef int i32x4 __attribute__((ext_vector_type(4)));
typedef int i32x8 __attribute__((ext_vector_type(8)));

constexpr int D = 1024, BATCH = 2, SEQ = 16384, M = BATCH * SEQ;
constexpr int MIXN = 2048;
constexpr int DFF = 2816, NFF_T = DFF / 128;
constexpr int QKVN = 1280, NQH = 16, NKVH = 2, HD = 64, CHUNK = 64, KVSPAN = 192;
constexpr int NEXP = 8, DFE = 3584, NFE_T = DFE / 128;
constexpr float RMS_EPS = 1e-6f;
constexpr int MAXSLOT = 67328;
constexpr int MAXTILES = MAXSLOT / 256;
constexpr int NWAVES = 8, NTHR = 512;

constexpr size_t MiB = 1u << 20;
constexpr size_t WS_CTL = 0, CTL_ZERO_BYTES = 1 * MiB;
constexpr size_t WS_BIAS = 1 * MiB;
constexpr size_t WS_WGCNT = WS_BIAS + 16 * 256 * 4;
constexpr size_t WS_TILE = WS_WGCNT + 1024 * 16 * 4;
constexpr size_t WS_TOKE = WS_TILE + 4096;
constexpr size_t WS_TOKW = WS_TOKE + 2 * (size_t)M * 4;
constexpr size_t WS_TOKR = WS_TOKW + 2 * (size_t)M * 4;
constexpr size_t WS_SLOTT = WS_TOKR + 2 * (size_t)M * 4;
constexpr size_t WS_SLOTW = WS_SLOTT + (size_t)MAXSLOT * 4;
static_assert(WS_SLOTW + (size_t)MAXSLOT * 4 <= 4 * MiB, "route region");
constexpr size_t WS_WIN = 4 * MiB;
constexpr size_t WS_WOUT = WS_WIN + (size_t)MIXN * D * 2;
constexpr size_t WS_WGU = WS_WOUT + (size_t)D * D * 2;
constexpr size_t WS_WD = WS_WGU + (size_t)2 * DFF * D * 2;
constexpr size_t WS_WQKV = WS_WD + (size_t)D * DFF * 2;
constexpr size_t WS_WO = WS_WQKV + (size_t)QKVN * D * 2;
static_assert(WS_WO + (size_t)D * D * 2 <= 31 * MiB, "dense weights");
constexpr size_t WS_WEGU = 31 * MiB;
constexpr size_t WS_WED = WS_WEGU + (size_t)NEXP * 2 * DFE * D;
static_assert(WS_WED + (size_t)NEXP * D * DFE == 115 * MiB, "expert weights");
constexpr size_t WS_XN = 115 * MiB;
constexpr size_t WS_Y0 = WS_XN;
constexpr size_t WS_R = 179 * MiB;
constexpr size_t WS_PROJ = WS_R, WS_MIXED = WS_R + (size_t)M * MIXN * 2;
constexpr size_t WS_H = WS_R;
constexpr size_t WS_QKV = WS_R, WS_AO = WS_R + (size_t)M * QKVN * 2;
constexpr size_t WS_HS = WS_R, WS_H2 = WS_R + 66 * MiB;
static_assert((size_t)MAXSLOT * D <= 66 * MiB, "HS");
constexpr size_t WS_END = WS_H2 + (size_t)MAXSLOT * DFE;
static_assert(WS_END <= 543497280ull, "workspace");
static_assert(WS_MIXED + (size_t)M * D * 2 <= 543497280ull && WS_H + (size_t)M * DFF * 2 <= 543497280ull, "workspace");

constexpr int CW_BAR = 4096;

constexpr int RING_BYTES = 131072;
constexpr int LDS_TILE_OFF = RING_BYTES;
constexpr int LDS_MISC_OFF = RING_BYTES + 2048;
constexpr int LDS_BYTES = 147456;

__device__ __forceinline__ unsigned pk2(float lo, float hi) { f32x2 v = {lo, hi}; hbf16x2 b = __builtin_convertvector(v, hbf16x2); return __builtin_bit_cast(unsigned, b); }
__device__ __forceinline__ float bf_lo(unsigned w) { return __uint_as_float(w << 16); }
__device__ __forceinline__ float bf_hi(unsigned w) { return __uint_as_float(w & 0xffff0000u); }
__device__ __forceinline__ void unpack8(const u32x4 w, float (&f)[8]) { f[0] = bf_lo(w.x); f[1] = bf_hi(w.x); f[2] = bf_lo(w.y); f[3] = bf_hi(w.y); f[4] = bf_lo(w.z); f[5] = bf_hi(w.z); f[6] = bf_lo(w.w); f[7] = bf_hi(w.w); }
__device__ __forceinline__ u32x4 pack8(const float (&f)[8]) { u32x4 w; w.x = pk2(f[0], f[1]); w.y = pk2(f[2], f[3]); w.z = pk2(f[4], f[5]); w.w = pk2(f[6], f[7]); return w; }
__device__ __forceinline__ float wave_sum(float v) {
#pragma unroll
    for (int o = 1; o < 64; o <<= 1) v += __shfl_xor(v, o);
    return v;
}
__device__ __forceinline__ int fresh_tid() { int t = threadIdx.x; asm volatile("" : "+v"(t)); return t; }
#define LDS_WAIT() asm volatile("s_waitcnt lgkmcnt(0)" ::: "memory")
#define VM_WAIT() asm volatile("s_waitcnt vmcnt(0)" ::: "memory")

namespace pg8 {
constexpr int BM = 256, BK = 64, HALF = 128, HTB = HALF * BK * 2, STAGE_BYTES = 8 * HTB, NXCD = 8, WGM = 8;
__host__ __device__ __forceinline__ int lds_byte(int r, int c) { const int st = (r >> 4) * 2 + (c >> 5), rr = r & 15, cc = c & 31, ob = rr * 64 + cc * 2; return st * 1024 + (ob ^ (((ob >> 9) & 1) << 5)); }
__host__ __device__ __forceinline__ void stage_rc(int b, int& R, int& C) { const int st = b / 1024, sb = b % 1024, swz = sb ^ (((sb >> 9) & 1) << 5); R = (st >> 1) * 16 + swz / 64; C = (st & 1) * 32 + (swz % 64) / 2; }
__host__ __device__ __forceinline__ int perm32(int rho) { const int n = rho >> 4, i = rho & 15; return 8 * (i >> 2) + 4 * n + (i & 3); }

struct Unit { int pm, pn, rm, cn; };
struct Gemm { const void* A; const void* Bt; int lda, ldb, K; };

struct TileOrder {
    int nM, nN, nwg, G, c;
    __device__ __forceinline__ void init(int nM_, int nN_, int G_, int c_) { nM = nM_; nN = nN_; nwg = nM * nN; G = G_; c = c_; }
    __device__ __forceinline__ bool next(int i, int& m, int& n) const {
        const int L = i * G + c; if (L >= nwg) return false;
        int wgid = L; { const int q = nwg / NXCD, r = nwg % NXCD, xcd = wgid % NXCD, off = wgid / NXCD; wgid = (xcd < r ? xcd * (q + 1) : r * (q + 1) + (xcd - r) * q) + off; }
        const int nig = WGM * nN, gid = wgid / nig, fm = gid * WGM, gsz = (nM - fm) < WGM ? (nM - fm) : WGM;
        m = fm + ((wgid % nig) % gsz); n = (wgid % nig) / gsz; return true;
    }
};
struct DenseOrder {
    TileOrder T;
    __device__ __forceinline__ void init(int Mr, int N, int G, int c) { T.init(Mr / BM, N / BM, G, c); }
    __device__ __forceinline__ bool next(int i, Unit& u) const { int m, n; if (!T.next(i, m, n)) return false; u.pm = m; u.pn = n; u.rm = m; u.cn = n; return true; }
    __device__ __forceinline__ void a_ready(const Unit&) const {}
    __device__ __forceinline__ void done(const Unit&) const {}
};
struct MoeOrder {
    TileOrder T; int tpe; const LAS int* tile_e;
    __device__ __forceinline__ bool next(int i, Unit& u) const { int m, n; if (!T.next(i, m, n)) return false;
        const int e = __builtin_amdgcn_readfirstlane(tile_e[m]);
        u.pm = m; u.pn = e * tpe + n; u.rm = m; u.cn = n; return true; }
    __device__ __forceinline__ void a_ready(const Unit&) const {}
    __device__ __forceinline__ void done(const Unit&) const {}
};

struct EpiBf16 {
    static constexpr bool PERM = true;
    bf16_t* O; int ldc; const float* bias;
    __device__ __forceinline__ void operator()(const f32x4 (&acc)[2][2][4][2], const Unit& u, int wr, int wc, int fr, int fq) const {
        const int row0 = u.rm * BM + wr * 64 + fr, col0 = u.cn * BM + wc * 32 + 8 * fq;
        f32x4 bv[2][2];
#pragma unroll
        for (int bj = 0; bj < 2; ++bj)
#pragma unroll
            for (int n = 0; n < 2; ++n) bv[bj][n] = bias ? *(const f32x4*)(bias + col0 + bj * HALF + 4 * n) : (f32x4){0.f, 0.f, 0.f, 0.f};
#pragma unroll
        for (int ai = 0; ai < 2; ++ai)
#pragma unroll
            for (int m = 0; m < 4; ++m) { bf16_t* rowp = O + (size_t)(row0 + ai * HALF + m * 16) * ldc + col0;
#pragma unroll
                for (int bj = 0; bj < 2; ++bj) { const f32x4 v0 = acc[ai][bj][m][0] + bv[bj][0], v1 = acc[ai][bj][m][1] + bv[bj][1];
                    u32x4 w; w.x = pk2(v0[0], v0[1]); w.y = pk2(v0[2], v0[3]); w.z = pk2(v1[0], v1[1]); w.w = pk2(v1[2], v1[3]);
                    *(u32x4*)(rowp + bj * HALF) = w; } }
    }
};
__device__ __forceinline__ float silu_mul(float g, float u) { return g * u * __builtin_amdgcn_rcpf(1.0f + __builtin_amdgcn_exp2f(-1.44269504089f * g)); }
struct EpiSwiGLU {
    static constexpr bool PERM = true;
    bf16_t* O; int ldc;
    __device__ __forceinline__ void operator()(const f32x4 (&acc)[2][2][4][2], const Unit& u, int wr, int wc, int fr, int fq) const {
        const int row0 = u.rm * BM + wr * 64 + fr, col0 = u.cn * HALF + wc * 32 + 8 * fq;
#pragma unroll
        for (int ai = 0; ai < 2; ++ai)
#pragma unroll
            for (int m = 0; m < 4; ++m) { bf16_t* rowp = O + (size_t)(row0 + ai * HALF + m * 16) * ldc + col0;
                const f32x4 g0 = acc[ai][0][m][0], g1 = acc[ai][0][m][1], u0 = acc[ai][1][m][0], u1 = acc[ai][1][m][1];
                u32x4 w; w.x = pk2(silu_mul(g0[0], u0[0]), silu_mul(g0[1], u0[1])); w.y = pk2(silu_mul(g0[2], u0[2]), silu_mul(g0[3], u0[3]));
                w.z = pk2(silu_mul(g1[0], u1[0]), silu_mul(g1[1], u1[1])); w.w = pk2(silu_mul(g1[2], u1[2]), silu_mul(g1[3], u1[3]));
                *(u32x4*)rowp = w; }
    }
};
struct EpiResid {
    static constexpr bool PERM = true;
    const float* base; float* out; const float* bias;
    __device__ __forceinline__ void operator()(const f32x4 (&acc)[2][2][4][2], const Unit& u, int wr, int wc, int fr, int fq) const {
        const int row0 = u.rm * BM + wr * 64 + fr, col0 = u.cn * BM + wc * 32 + 8 * fq;
        f32x4 bv[2][2];
#pragma unroll
        for (int bj = 0; bj < 2; ++bj)
#pragma unroll
            for (int n = 0; n < 2; ++n) bv[bj][n] = bias ? *(const f32x4*)(bias + col0 + bj * HALF + 4 * n) : (f32x4){0.f, 0.f, 0.f, 0.f};
#pragma unroll
        for (int ai = 0; ai < 2; ++ai)
#pragma unroll
            for (int m = 0; m < 4; ++m) { const size_t off = (size_t)(row0 + ai * HALF + m * 16) * D + col0;
                f32x4 bs[2][2];
#pragma unroll
                for (int bj = 0; bj < 2; ++bj)
#pragma unroll
                    for (int n = 0; n < 2; ++n) bs[bj][n] = *(const f32x4*)(base + off + bj * HALF + 4 * n);
#pragma unroll
                for (int bj = 0; bj < 2; ++bj)
#pragma unroll
                    for (int n = 0; n < 2; ++n) *(f32x4*)(out + off + bj * HALF + 4 * n) = bs[bj][n] + acc[ai][bj][m][n] + bv[bj][n];
                asm volatile("" ::: "memory"); }
    }
};
__device__ __forceinline__ unsigned pk4_fp8(float a, float b, float c, float d) {
    int w = __builtin_amdgcn_cvt_pk_fp8_f32(__builtin_amdgcn_fmed3f(a, -448.f, 448.f), __builtin_amdgcn_fmed3f(b, -448.f, 448.f), 0, false);
    w = __builtin_amdgcn_cvt_pk_fp8_f32(__builtin_amdgcn_fmed3f(c, -448.f, 448.f), __builtin_amdgcn_fmed3f(d, -448.f, 448.f), w, true);
    return (unsigned)w;
}
constexpr int E8M0_ONE = 0x7f7f7f7f, E8M0_2M6 = 0x79797979;
struct EpiSwiGLU8 {
    static constexpr bool PERM = true; static constexpr int SCALE_A = E8M0_ONE, SCALE_B = E8M0_2M6;
    unsigned char* O; int ldc;
    __device__ __forceinline__ void operator()(const f32x4 (&acc)[2][2][4][2], const Unit& u, int wr, int wc, int fr, int fq) const {
        const int row0 = u.rm * BM + wr * 64 + fr, col0 = u.cn * HALF + wc * 32 + 8 * fq;
#pragma unroll
        for (int ai = 0; ai < 2; ++ai)
#pragma unroll
            for (int m = 0; m < 4; ++m) { unsigned char* rowp = O + (size_t)(row0 + ai * HALF + m * 16) * ldc + col0;
                const f32x4 g0 = acc[ai][0][m][0], g1 = acc[ai][0][m][1], u0 = acc[ai][1][m][0], u1 = acc[ai][1][m][1];
                u32x2 w; w.x = pk4_fp8(silu_mul(g0[0], u0[0]), silu_mul(g0[1], u0[1]), silu_mul(g0[2], u0[2]), silu_mul(g0[3], u0[3]));
                w.y = pk4_fp8(silu_mul(g1[0], u1[0]), silu_mul(g1[1], u1[1]), silu_mul(g1[2], u1[2]), silu_mul(g1[3], u1[3]));
                *(u32x2*)rowp = w; }
    }
};
struct EpiMoeDown {
    static constexpr bool PERM = true; static constexpr int SCALE_A = E8M0_ONE, SCALE_B = E8M0_2M6;
    float* X; bf16_t* Y0; const int* slot_tok; const float* slot_w;
    __device__ __forceinline__ void operator()(const f32x4 (&acc)[2][2][4][2], const Unit& u, int wr, int wc, int fr, int fq) const {
        const int row0 = u.rm * BM + wr * 64 + fr, col0 = u.cn * BM + wc * 32 + 8 * fq;
#pragma unroll
        for (int ai = 0; ai < 2; ++ai)
#pragma unroll
            for (int m = 0; m < 4; ++m) { const int slot = row0 + ai * HALF + m * 16; const int meta = slot_tok[slot]; const float w = slot_w[slot];
                if (meta >= 0) { const size_t off = (size_t)(meta >> 1) * D + col0;
                    if (meta & 1) {
                        f32x4 bs[2][2];
#pragma unroll
                        for (int bj = 0; bj < 2; ++bj)
#pragma unroll
                            for (int n = 0; n < 2; ++n) bs[bj][n] = *(const f32x4*)(X + off + bj * HALF + 4 * n);
#pragma unroll
                        for (int bj = 0; bj < 2; ++bj)
#pragma unroll
                            for (int n = 0; n < 2; ++n) *(f32x4*)(X + off + bj * HALF + 4 * n) = bs[bj][n] + acc[ai][bj][m][n] * w;
                    } else {
#pragma unroll
                        for (int bj = 0; bj < 2; ++bj) { const f32x4 v0 = acc[ai][bj][m][0] * w, v1 = acc[ai][bj][m][1] * w;
                            u32x4 o; o.x = pk2(v0[0], v0[1]); o.y = pk2(v0[2], v0[3]); o.z = pk2(v1[0], v1[1]); o.w = pk2(v1[2], v1[3]);
                            *(u32x4*)(Y0 + off + bj * HALF) = o; }
                    } }
                asm volatile("" ::: "memory"); }
    }
};

template <int OFF> __device__ __forceinline__ void glds_s(const char* sbase, unsigned voff, unsigned lds_base) {
    unsigned keep;
    asm volatile("s_mov_b32 %0, m0\n\ts_add_u32 m0, %3, %4\n\ts_nop 0\n\tglobal_load_lds_dwordx4 %1, %2\n\ts_mov_b32 m0, %0" : "=&s"(keep) : "v"(voff), "s"(sbase), "s"(lds_base), "i"(OFF) : "memory", "scc");
}
template <class Epi, class Sched, bool FP8 = false, bool ALIGN_EPI = true, bool SP2 = true>
__device__ __forceinline__ void gemm_phase(LAS unsigned char* lds, const Gemm g, const Sched& S, const Epi& E) {
    const int tid = threadIdx.x, wid = __builtin_amdgcn_readfirstlane(tid >> 6), lane = tid & 63, wr = wid >> 2, wc = wid & 3, fr = lane & 15, fq = lane >> 4;
    const int nt = g.K / (BK * 2);
    unsigned voffA[2], voffB[2];
#pragma unroll
    for (int i = 0; i < 2; ++i) { int R, C; stage_rc(tid * 16 + i * 8192, R, C); const int Rb = Epi::PERM ? ((R & ~31) + perm32(R & 31)) : R;
        voffA[i] = (unsigned)(R * g.lda + C * 2); voffB[i] = (unsigned)(Rb * g.ldb + C * 2); }
    const size_t kstep = (size_t)(BK * 2);
    const size_t hstepA = (size_t)HALF * g.lda, hstepB = (size_t)HALF * g.ldb;
    const size_t tstepA = 2 * hstepA, tstepB = 2 * hstepB;
    const unsigned lds_base = (unsigned)(size_t)lds + (unsigned)wid * 1024u;
    const int aoff = lds_byte(wr * 64 + fr, fq * 8), boff = lds_byte(wc * 32 + fr, fq * 8);
#define PG8_SA(b, h) (((b) * 2 + (h)) * HTB)
#define PG8_SB(b, h) ((4 + (b) * 2 + (h)) * HTB)
#define PG8_STAGE(bufoff, gbase, voff) do { glds_s<(bufoff)>((const char*)(gbase), (voff)[0], lds_base); glds_s<(bufoff) + 8192>((const char*)(gbase), (voff)[1], lds_base); } while (0)
#define PG8_LDA(dst, b, h) do { _Pragma("unroll") for (int m = 0; m < 4; ++m) _Pragma("unroll") for (int k = 0; k < 2; ++k) dst[m][k] = *(const LAS bf16x8*)(lds + PG8_SA(b, h) + aoff + m * 2048 + k * 1024); } while (0)
#define PG8_LDB(dst, b, h) do { _Pragma("unroll") for (int n = 0; n < 2; ++n) _Pragma("unroll") for (int k = 0; k < 2; ++k) dst[n][k] = *(const LAS bf16x8*)(lds + PG8_SB(b, h) + boff + n * 2048 + k * 1024); } while (0)
#define PG8_MMA(ai, bj, At, Bt) do { __builtin_amdgcn_s_setprio(1); _Pragma("unroll") for (int m = 0; m < 4; ++m) _Pragma("unroll") for (int n = 0; n < 2; ++n) { \
        if constexpr (FP8) { const i32x4 b_lo = __builtin_bit_cast(i32x4, Bt[n][0]), b_hi = __builtin_bit_cast(i32x4, Bt[n][1]), a_lo = __builtin_bit_cast(i32x4, At[m][0]), a_hi = __builtin_bit_cast(i32x4, At[m][1]); \
            acc[ai][bj][m][n] = __builtin_amdgcn_mfma_scale_f32_16x16x128_f8f6f4(__builtin_shufflevector(b_lo, b_hi, 0, 1, 2, 3, 4, 5, 6, 7), __builtin_shufflevector(a_lo, a_hi, 0, 1, 2, 3, 4, 5, 6, 7), acc[ai][bj][m][n], 0, 0, 0, Epi::SCALE_B, 0, Epi::SCALE_A); } \
        else { _Pragma("unroll") for (int k = 0; k < 2; ++k) acc[ai][bj][m][n] = __builtin_amdgcn_mfma_f32_16x16x32_bf16(Bt[n][k], At[m][k], acc[ai][bj][m][n], 0, 0, 0); } } \
        __builtin_amdgcn_s_setprio(0); } while (0)
#define PG8_WAIT_V(n) asm volatile("s_waitcnt vmcnt(" #n ")" ::: "memory")
#define PG8_WAIT_L(n) asm volatile("s_waitcnt lgkmcnt(" #n ")" ::: "memory")
#define PG8_BAR __builtin_amdgcn_s_barrier()
#define PG8_SCHED __builtin_amdgcn_sched_barrier(0)
    Unit cur, nxt; int ui = 0;
    if (!S.next(0, cur)) return;
    f32x4 acc[2][2][4][2];
#pragma unroll
    for (int a = 0; a < 2; ++a)
#pragma unroll
        for (int b = 0; b < 2; ++b)
#pragma unroll
            for (int m = 0; m < 4; ++m)
#pragma unroll
                for (int n = 0; n < 2; ++n) acc[a][b][m][n] = (f32x4){0.f, 0.f, 0.f, 0.f};
    bf16x8 At[4][2], B0[2][2], B1[2][2];
    const char* cA = (const char*)g.A + (size_t)cur.pm * tstepA; const char* cB = (const char*)g.Bt + (size_t)cur.pn * tstepB;
    S.a_ready(cur);
    if constexpr (SP2) {
        PG8_STAGE(PG8_SB(0, 0), cB, voffB); PG8_STAGE(PG8_SB(0, 1), cB + hstepB, voffB); PG8_STAGE(PG8_SA(0, 0), cA, voffA); PG8_STAGE(PG8_SA(0, 1), cA + hstepA, voffA);
        if (wr == 1) PG8_BAR;
        PG8_WAIT_V(2); PG8_BAR;
        PG8_STAGE(PG8_SB(1, 0), cB + kstep, voffB); PG8_STAGE(PG8_SA(1, 0), cA + kstep, voffA); PG8_STAGE(PG8_SB(1, 1), cB + hstepB + kstep, voffB);
        PG8_WAIT_V(6); PG8_BAR;
    } else {
        PG8_STAGE(PG8_SB(0, 0), cB, voffB); PG8_STAGE(PG8_SA(0, 0), cA, voffA); PG8_STAGE(PG8_SB(0, 1), cB + hstepB, voffB); PG8_STAGE(PG8_SA(0, 1), cA + hstepA, voffA);
        if (wr == 1) PG8_BAR;
        PG8_WAIT_V(4); PG8_BAR;
        PG8_STAGE(PG8_SB(1, 0), cB + kstep, voffB); PG8_STAGE(PG8_SA(1, 0), cA + kstep, voffA); PG8_STAGE(PG8_SB(1, 1), cB + hstepB + kstep, voffB);
        PG8_WAIT_V(6); PG8_BAR;
    }
    for (;;) {
        const bool has_next = S.next(ui + 1, nxt);
        const char* nA = has_next ? (const char*)g.A + (size_t)nxt.pm * tstepA : cA; const char* nB = has_next ? (const char*)g.Bt + (size_t)nxt.pn * tstepB : cB;
#pragma clang loop unroll(disable)
        for (int t = 0; t < nt; t += 2) {
            const bool last = (t == nt - 2);
            const char* a1 = cA + (size_t)(t + 1) * kstep;
            const char* a2 = last ? nA : cA + (size_t)(t + 2) * kstep; const char* b2 = last ? nB : cB + (size_t)(t + 2) * kstep;
            const char* a3 = a2 + kstep; const char* b3 = b2 + kstep;
            if (last && has_next) S.a_ready(nxt);
            if constexpr (SP2) {
            PG8_LDB(B0, 0, 0); PG8_LDB(B1, 0, 1); PG8_SCHED; PG8_LDA(At, 0, 0); PG8_STAGE(PG8_SA(1, 1), a1 + hstepA, voffA);
            PG8_WAIT_V(8); PG8_WAIT_L(0); PG8_BAR; PG8_MMA(0, 0, At, B0); PG8_MMA(0, 1, At, B1); PG8_BAR; PG8_SCHED;
            PG8_LDA(At, 0, 1); PG8_STAGE(PG8_SB(0, 0), b2, voffB); PG8_STAGE(PG8_SB(0, 1), b2 + hstepB, voffB); PG8_STAGE(PG8_SA(0, 0), a2, voffA);
            PG8_WAIT_V(8); PG8_WAIT_L(0); PG8_BAR; PG8_MMA(1, 0, At, B0); PG8_MMA(1, 1, At, B1); PG8_BAR; PG8_SCHED;
            PG8_LDB(B0, 1, 0); PG8_LDB(B1, 1, 1); PG8_SCHED; PG8_LDA(At, 1, 0); PG8_STAGE(PG8_SA(0, 1), a2 + hstepA, voffA);
            PG8_WAIT_V(8); PG8_WAIT_L(0); PG8_BAR; PG8_MMA(0, 0, At, B0); PG8_MMA(0, 1, At, B1); PG8_BAR; PG8_SCHED;
            PG8_LDA(At, 1, 1); PG8_STAGE(PG8_SB(1, 0), b3, voffB); PG8_STAGE(PG8_SB(1, 1), b3 + hstepB, voffB); PG8_STAGE(PG8_SA(1, 0), a3, voffA);
            PG8_WAIT_V(8); PG8_WAIT_L(0); PG8_BAR; PG8_MMA(1, 0, At, B0); PG8_MMA(1, 1, At, B1); PG8_BAR; PG8_SCHED;
            } else {
            PG8_LDB(B0, 0, 0); PG8_SCHED; PG8_LDA(At, 0, 0); PG8_STAGE(PG8_SA(1, 1), a1 + hstepA, voffA);
            PG8_WAIT_L(8); PG8_BAR; PG8_WAIT_L(0); PG8_MMA(0, 0, At, B0); PG8_BAR; PG8_SCHED;
            PG8_LDB(B1, 0, 1); PG8_STAGE(PG8_SB(0, 0), b2, voffB);
            PG8_BAR; PG8_WAIT_L(0); PG8_MMA(0, 1, At, B1); PG8_BAR;
            PG8_LDA(At, 0, 1); PG8_STAGE(PG8_SA(0, 0), a2, voffA);
            PG8_BAR; PG8_WAIT_L(0); PG8_MMA(1, 0, At, B0); PG8_BAR; PG8_SCHED;
            PG8_STAGE(PG8_SB(0, 1), b2 + hstepB, voffB);
            PG8_WAIT_V(6); PG8_BAR; PG8_MMA(1, 1, At, B1); PG8_BAR;
            PG8_LDB(B0, 1, 0); PG8_SCHED; PG8_LDA(At, 1, 0); PG8_STAGE(PG8_SA(0, 1), a2 + hstepA, voffA);
            PG8_WAIT_L(8); PG8_BAR; PG8_WAIT_L(0); PG8_MMA(0, 0, At, B0); PG8_BAR; PG8_SCHED;
            PG8_LDB(B1, 1, 1); PG8_STAGE(PG8_SB(1, 0), b3, voffB);
            PG8_BAR; PG8_WAIT_L(0); PG8_MMA(0, 1, At, B1); PG8_BAR;
            PG8_LDA(At, 1, 1); PG8_STAGE(PG8_SA(1, 0), a3, voffA);
            PG8_BAR; PG8_WAIT_L(0); PG8_MMA(1, 0, At, B0); PG8_BAR; PG8_SCHED;
            PG8_STAGE(PG8_SB(1, 1), b3 + hstepB, voffB);
            PG8_WAIT_V(6); PG8_BAR; PG8_MMA(1, 1, At, B1); PG8_BAR;
            }
        }
        if constexpr (ALIGN_EPI) { if (wr == 0) PG8_BAR; }
        { int l2 = threadIdx.x; asm volatile("" : "+v"(l2)); l2 &= 63; E(acc, cur, wr, wc, l2 & 15, l2 >> 4); }
        S.done(cur);
        if (!has_next) break;
#pragma unroll
        for (int a = 0; a < 2; ++a)
#pragma unroll
            for (int b = 0; b < 2; ++b)
#pragma unroll
                for (int m = 0; m < 4; ++m)
#pragma unroll
                    for (int n = 0; n < 2; ++n) acc[a][b][m][n] = (f32x4){0.f, 0.f, 0.f, 0.f};
        cur = nxt; cA = nA; cB = nB; ++ui;
        if constexpr (ALIGN_EPI) { if (wr == 1) PG8_BAR; }
    }
    PG8_WAIT_V(0);
    if constexpr (!ALIGN_EPI) { if (wr == 0) PG8_BAR; }
    PG8_BAR;
#undef PG8_SA
#undef PG8_SB
#undef PG8_STAGE
#undef PG8_LDA
#undef PG8_LDB
#undef PG8_MMA
#undef PG8_WAIT_V
#undef PG8_WAIT_L
#undef PG8_BAR
#undef PG8_SCHED
}
}

#define XB_TMO      128
#define XB_XCNT(j)  (256  + 64 * (j))
#define XB_XSUB(j)  (1280 + 64 * (j))
#define XB_XGEN(j)  (2304 + 64 * (j))
#define XB_TOP      3328
#define XB_TOPGEN   3392
#define XCD_BAR_WORDS 3456
#define XB_SPIN_CAP (1u << 18)
__device__ __forceinline__ unsigned xb_ld(unsigned* p)              { return __hip_atomic_load(p, __ATOMIC_RELAXED, __HIP_MEMORY_SCOPE_AGENT); }
__device__ __forceinline__ unsigned xb_add(unsigned* p, unsigned v) { return __hip_atomic_fetch_add(p, v, __ATOMIC_RELAXED, __HIP_MEMORY_SCOPE_AGENT); }
__device__ __forceinline__ unsigned xb_xcc_id() { return (unsigned)__builtin_amdgcn_s_getreg((3 << 11) | 20) & 0xFu; }
#define XB_SPIN(cond, bar) do { unsigned _sp = 0; while (cond) { __builtin_amdgcn_s_sleep(1); \
    if ((++_sp & 255u) == 0u) { if (xb_ld(&(bar)[XB_TMO])) break; if (_sp > XB_SPIN_CAP) { atomicAdd(&(bar)[XB_TMO], 1u); break; } } } } while (0)
struct XcdBarrier { unsigned* bar; unsigned x; volatile LAS unsigned* st; };
__device__ __forceinline__ XcdBarrier xcd_barrier_post(unsigned* bar, volatile LAS unsigned* st) {
    XcdBarrier b; b.bar = bar; b.x = xb_xcc_id(); b.st = st;
    if (threadIdx.x == 0) (void)xb_add(&bar[XB_XCNT(b.x)], 1u);
    return b;
}
__device__ __forceinline__ void xcd_barrier_complete(unsigned* bar, unsigned x, unsigned& nloc, unsigned& nx) {
    const unsigned G = gridDim.x * gridDim.y * gridDim.z;
    unsigned sum, cnt, mine, sp = 0u;
    for (;;) {
        sum = 0u; cnt = 0u; mine = 0u;
#pragma unroll
        for (unsigned j = 0; j < 16; ++j) { const unsigned c = xb_ld(&bar[XB_XCNT(j)]); sum += c; cnt += (c > 0u) ? 1u : 0u; mine = (j == x) ? c : mine; }
        if (sum == G) break;
        __builtin_amdgcn_s_sleep(1);
        if ((++sp & 255u) == 0u) { if (xb_ld(&bar[XB_TMO])) break; if (sp > XB_SPIN_CAP) { atomicAdd(&bar[XB_TMO], 1u); break; } }
    }
    nloc = mine > 0u ? mine : 1u; nx = cnt > 0u ? cnt : 1u;
}
__device__ __forceinline__ void xcd_barrier(const XcdBarrier& b) {
    asm volatile("s_waitcnt vmcnt(0)" ::: "memory");
    __syncthreads();
    if (threadIdx.x == 0) {
        unsigned* bar = b.bar;
        __builtin_amdgcn_s_waitcnt(0);
        unsigned nloc = b.st[0], nx = b.st[1];
        if (nloc == 0u) { xcd_barrier_complete(bar, b.x, nloc, nx); b.st[0] = nloc; b.st[1] = nx; }
        const unsigned old = xb_add(&bar[XB_XSUB(b.x)], 1u);
        const unsigned gen = old / nloc;
        if (old + 1u == (gen + 1u) * nloc) {
            __builtin_amdgcn_fence(__ATOMIC_RELEASE, "agent");
            asm volatile("s_waitcnt vmcnt(0)" ::: "memory");
            const unsigned og = xb_add(&bar[XB_TOP], 1u);
            const unsigned tg = og / nx;
            if (og + 1u == (tg + 1u) * nx) xb_add(&bar[XB_TOPGEN], 1u);
            else XB_SPIN(xb_ld(&bar[XB_TOPGEN]) == tg, bar);
            __builtin_amdgcn_fence(__ATOMIC_ACQUIRE, "agent");
            xb_add(&bar[XB_XGEN(b.x)], 1u);
            asm volatile("s_waitcnt vmcnt(0)" ::: "memory");
        } else {
            XB_SPIN(xb_ld(&bar[XB_XGEN(b.x)]) == gen, bar);
            __builtin_amdgcn_fence(__ATOMIC_ACQUIRE, "agent");
            asm volatile("s_waitcnt vmcnt(0)" ::: "memory");
        }
    }
    __syncthreads();
}

struct Params { const float* in[24]; float* out; unsigned char* ws; int ph_lo, ph_hi; };
enum { I_X = 0, I_RELB, I_EVNM, I_WIN, I_POOLW, I_POOLS, I_CONVW, I_WOUT, I_EVNF, I_FG, I_FU, I_FD, I_ODNM, I_WQKV, I_BQKV, I_SINK, I_WO, I_BO, I_ODNF, I_ROUTER, I_EG, I_EU, I_ED, I_FINAL };

__device__ __forceinline__ void p0_tile(const float* __restrict__ src, int N, int k0, int n0, bf16_t* __restrict__ dst, int ldd, LAS unsigned char* scr, int lane) {
    const int n4 = (lane & 15) * 4, kp = lane >> 4;
    f32x4 a[8], b[8];
#pragma unroll
    for (int i = 0; i < 8; ++i) { const float* p = src + (size_t)(k0 + 8 * i + 2 * kp) * N + n0 + n4; a[i] = *(const f32x4*)p; b[i] = *(const f32x4*)(p + N); }
#pragma unroll
    for (int i = 0; i < 8; ++i) { const int k = 8 * i + 2 * kp;
#pragma unroll
        for (int q = 0; q < 4; ++q) *(LAS unsigned*)(scr + (n4 + q) * 136 + k * 2) = pk2(a[i][q], b[i][q]); }
    LDS_WAIT();
    const int c = lane & 7, nr = lane >> 3;
#pragma unroll
    for (int j = 0; j < 8; ++j) { const int n = 8 * j + nr; const u32x2 lo = *(const LAS u32x2*)(scr + n * 136 + 16 * c), hi = *(const LAS u32x2*)(scr + n * 136 + 16 * c + 8);
        u32x4 o; o.x = lo.x; o.y = lo.y; o.z = hi.x; o.w = hi.y; *(u32x4*)(dst + (size_t)n * ldd + 8 * c) = o; }
    LDS_WAIT();
}
__device__ __forceinline__ void p0_tile8(const float* __restrict__ src, int N, int k0, int n0, unsigned char* __restrict__ dst, int ldd, float scale, LAS unsigned char* scr, int lane) {
    const int n4 = (lane & 7) * 4, kq = lane >> 3;
    f32x4 a[4][4];
#pragma unroll
    for (int i = 0; i < 4; ++i)
#pragma unroll
        for (int j = 0; j < 4; ++j) a[i][j] = *(const f32x4*)(src + (size_t)(k0 + 32 * i + 4 * kq + j) * N + n0 + n4);
#pragma unroll
    for (int i = 0; i < 4; ++i)
#pragma unroll
        for (int q = 0; q < 4; ++q) *(LAS unsigned*)(scr + (n4 + q) * 144 + 32 * i + 4 * kq) = pg8::pk4_fp8(a[i][0][q] * scale, a[i][1][q] * scale, a[i][2][q] * scale, a[i][3][q] * scale);
    LDS_WAIT();
    const int c = lane & 7, nr = lane >> 3;
#pragma unroll
    for (int j = 0; j < 4; ++j) { const int n = 8 * j + nr; *(u32x4*)(dst + (size_t)n * ldd + 16 * c) = *(const LAS u32x4*)(scr + n * 144 + 16 * c); }
    LDS_WAIT();
}
__device__ __forceinline__ void norm_row_bf16(const float* __restrict__ xrow, const float* __restrict__ gain, bf16_t* __restrict__ orow, int lane, float (&y)[16]) {
    f32x4 v[4];
#pragma unroll
    for (int j = 0; j < 2; ++j) { v[2 * j] = *(const f32x4*)(xrow + 512 * j + 8 * lane); v[2 * j + 1] = *(const f32x4*)(xrow + 512 * j + 8 * lane + 4); }
    float s = 0.f;
#pragma unroll
    for (int j = 0; j < 4; ++j) s += (v[j][0] * v[j][0] + v[j][1] * v[j][1]) + (v[j][2] * v[j][2] + v[j][3] * v[j][3]);
    const float r = 1.0f / sqrtf(wave_sum(s) * (1.0f / D) + RMS_EPS);
#pragma unroll
    for (int j = 0; j < 2; ++j) { const f32x4 g0 = *(const f32x4*)(gain + 512 * j + 8 * lane), g1 = *(const f32x4*)(gain + 512 * j + 8 * lane + 4);
#pragma unroll
        for (int q = 0; q < 4; ++q) { y[8 * j + q] = v[2 * j][q] * r * g0[q]; y[8 * j + 4 + q] = v[2 * j + 1][q] * r * g1[q]; }
        u32x4 w; w.x = pk2(y[8 * j], y[8 * j + 1]); w.y = pk2(y[8 * j + 2], y[8 * j + 3]); w.z = pk2(y[8 * j + 4], y[8 * j + 5]); w.w = pk2(y[8 * j + 6], y[8 * j + 7]);
        *(u32x4*)(orow + 512 * j + 8 * lane) = w; }
}

__device__ __forceinline__ int t5_bucket(int rel) {
    const int n = rel < 0 ? -rel : rel; const int ret = rel > 0 ? 16 : 0;
    int v;
    if (n < 8) v = n; else if (n < 12) v = 8; else if (n < 16) v = 9; else if (n < 23) v = 10; else if (n < 32) v = 11; else if (n < 46) v = 12; else if (n < 64) v = 13; else if (n < 91) v = 14; else v = 15;
    return ret + v;
}

__global__ void __launch_bounds__(NTHR, 2) fwd_kernel(Params p) {
    extern __shared__ __attribute__((aligned(16))) unsigned char lds_raw[];
    LAS unsigned char* lds = (LAS unsigned char*)lds_raw;
    volatile LAS unsigned* MISC = (volatile LAS unsigned*)(lds + LDS_MISC_OFF);
    const int tid = threadIdx.x, lane = tid & 63, wave = __builtin_amdgcn_readfirstlane(tid >> 6);
    const int G = gridDim.x, bx = blockIdx.x;
    const int vcu = (G % 8 == 0) ? (bx % 8) * (G / 8) + bx / 8 : bx;
    const int gw = vcu * NWAVES + wave, NGW = G * NWAVES;
    unsigned char* ws = p.ws;
    unsigned* ctl = (unsigned*)(ws + WS_CTL);
    if (tid < 64) MISC[tid] = 0u;
    __syncthreads();
    XcdBarrier bar; bar.bar = ctl + CW_BAR; bar.x = 0; bar.st = nullptr;
    if (MK_N_LAUNCHES == 1) bar = xcd_barrier_post(ctl + CW_BAR, MISC + 8);
    const int lo = p.ph_lo, hi = p.ph_hi;
#define IN(k) (lo <= (k) && (k) < hi)
#define SEAM(k) do { if (MK_N_LAUNCHES == 1 && IN((k) + 1)) xcd_barrier(bar); } while (0)

    bf16_t* Win_t = (bf16_t*)(ws + WS_WIN); bf16_t* Wout_t = (bf16_t*)(ws + WS_WOUT); bf16_t* Wgu_t = (bf16_t*)(ws + WS_WGU); bf16_t* Wd_t = (bf16_t*)(ws + WS_WD);
    bf16_t* Wqkv_t = (bf16_t*)(ws + WS_WQKV); bf16_t* Wo_t = (bf16_t*)(ws + WS_WO); bf16_t* Wegu_t = (bf16_t*)(ws + WS_WEGU); bf16_t* Wed_t = (bf16_t*)(ws + WS_WED);
    bf16_t* XN = (bf16_t*)(ws + WS_XN); bf16_t* PROJ = (bf16_t*)(ws + WS_PROJ); bf16_t* MIXED = (bf16_t*)(ws + WS_MIXED); bf16_t* Hb = (bf16_t*)(ws + WS_H);
    bf16_t* QKV = (bf16_t*)(ws + WS_QKV); bf16_t* AO = (bf16_t*)(ws + WS_AO); bf16_t* HS = (bf16_t*)(ws + WS_HS); bf16_t* H2 = (bf16_t*)(ws + WS_H2);
    float* bias_tab = (float*)(ws + WS_BIAS); int* wgcnt = (int*)(ws + WS_WGCNT); int* tilemeta = (int*)(ws + WS_TILE);
    int* tok_e = (int*)(ws + WS_TOKE); float* tok_w = (float*)(ws + WS_TOKW); int* tok_r = (int*)(ws + WS_TOKR); int* slot_tok = (int*)(ws + WS_SLOTT); float* slot_w = (float*)(ws + WS_SLOTW);
    float* X = p.out;

    if (IN(0)) for (int rep_ = 0; rep_ < NREP(0); ++rep_) {
        const int tid = fresh_tid(), lane = tid & 63;
        LAS unsigned char* scr = lds + wave * 8704;
        constexpr int T_WIN = 16 * 32, T_WOUT = 8 * 16, T_FG = 16 * 44, T_FD = 44 * 16, T_QKV = 16 * 20, T_WO = 16 * 16;
        constexpr int T_EG = 8 * 112, T_ED = 28 * 32;
        constexpr int NT8 = NEXP * (2 * T_EG + T_ED);
        constexpr int NT = T_WIN + T_WOUT + 2 * T_FG + T_FD + T_QKV + T_WO;
        unsigned char* Wegu8 = (unsigned char*)Wegu_t; unsigned char* Wed8 = (unsigned char*)Wed_t;
        for (int it = gw; it < NT8; it += NGW) {
            const int per_e = 2 * T_EG + T_ED; const int e = it / per_e; int q = it % per_e;
            if (q < 2 * T_EG) { const int up = q >= T_EG; if (up) q -= T_EG; const int kb = q / 112, nb = q % 112, n0 = 32 * nb;
                p0_tile8(p.in[up ? I_EU : I_EG] + (size_t)e * D * DFE, DFE, 128 * kb, n0, Wegu8 + ((size_t)e * 2 * DFE + (n0 / 128) * 256 + (n0 % 128) + (up ? 128 : 0)) * D + 128 * kb, D, 64.f, scr, lane); }
            else { q -= 2 * T_EG; const int kb = q / 32, nb = q % 32;
                p0_tile8(p.in[I_ED] + (size_t)e * DFE * D, D, 128 * kb, 32 * nb, Wed8 + ((size_t)e * D + 32 * nb) * DFE + 128 * kb, DFE, 64.f, scr, lane); }
        }
        for (int it = gw; it < NT; it += NGW) {
            int r = it;
            if (r < T_WIN) { const int kb = r / 32, nb = r % 32; p0_tile(p.in[I_WIN], MIXN, 64 * kb, 64 * nb, Win_t + (size_t)(64 * nb) * D + 64 * kb, D, scr, lane); continue; } r -= T_WIN;
            if (r < T_WOUT) { const int kb = 8 + r / 16, nb = r % 16; p0_tile(p.in[I_WOUT], D, 64 * kb, 64 * nb, Wout_t + (size_t)(64 * nb) * D + 64 * kb, D, scr, lane); continue; } r -= T_WOUT;
            if (r < 2 * T_FG) { const int up = r >= T_FG; const int q = up ? r - T_FG : r; const int kb = q / 44, nb = q % 44, n0 = 64 * nb;
                p0_tile(p.in[up ? I_FU : I_FG], DFF, 64 * kb, n0, Wgu_t + (size_t)((n0 / 128) * 256 + (n0 % 128) + (up ? 128 : 0)) * D + 64 * kb, D, scr, lane); continue; } r -= 2 * T_FG;
            if (r < T_FD) { const int kb = r / 16, nb = r % 16; p0_tile(p.in[I_FD], D, 64 * kb, 64 * nb, Wd_t + (size_t)(64 * nb) * DFF + 64 * kb, DFF, scr, lane); continue; } r -= T_FD;
            if (r < T_QKV) { const int kb = r / 20, nb = r % 20; p0_tile(p.in[I_WQKV], QKVN, 64 * kb, 64 * nb, Wqkv_t + (size_t)(64 * nb) * D + 64 * kb, D, scr, lane); continue; } r -= T_QKV;
            { const int kb = r / 16, nb = r % 16; p0_tile(p.in[I_WO], D, 64 * kb, 64 * nb, Wo_t + (size_t)(64 * nb) * D + 64 * kb, D, scr, lane); }
        }
        for (int it = gw; it < 4 * 16 * 16; it += NGW) {
            const int g = it >> 8, cb = (it >> 4) & 15, nb = it & 15; const int n = 64 * nb + lane, c0 = 8 * cb;
            const float* wo = p.in[I_WOUT] + (size_t)(g * 128) * D + n; const float* ps = p.in[I_POOLS] + g * 128; const float* pw = p.in[I_POOLW] + (size_t)(g * 128 + c0) * 128;
            float acc[8];
#pragma unroll
            for (int cc = 0; cc < 8; ++cc) acc[cc] = 0.f;
            for (int d = 0; d < 128; ++d) { const float w = wo[(size_t)d * D] * ps[d];
#pragma unroll
                for (int cc = 0; cc < 8; ++cc) acc[cc] += pw[cc * 128 + d] * w; }
            *(u32x4*)(Wout_t + (size_t)n * D + g * 128 + c0) = pack8(acc);
        }
        for (int m = gw; m < M; m += NGW) { float y[16]; norm_row_bf16(p.in[I_X] + (size_t)m * D, p.in[I_EVNM], XN + (size_t)m * D, lane, y); }
        for (int i = bx * NTHR + tid; i < NQH * 256; i += G * NTHR) { const int h = i >> 8, idx = i & 255; bias_tab[i] = idx < 255 ? p.in[I_RELB][t5_bucket(idx - 191) * NQH + h] : 0.f; }
    }
    SEAM(0);

    if (IN(1)) for (int rep_ = 0; rep_ < NREP(1); ++rep_) { pg8::Gemm g{XN, Win_t, 2 * D, 2 * D, 2 * D}; pg8::DenseOrder S; S.init(M, MIXN, G, bx); pg8::EpiBf16 E{PROJ, MIXN, nullptr};
        pg8::gemm_phase<pg8::EpiBf16, pg8::DenseOrder>(lds, g, S, E); }
    SEAM(1);

    if (IN(2)) for (int rep_ = 0; rep_ < NREP(2); ++rep_) {
        const int tid = fresh_tid(), lane = tid & 63;
        for (int unit = gw; unit < (M / 32) * 2; unit += NGW) {
            const int rb = unit >> 1, half = unit & 1, r0 = rb * 32, bs = r0 & ~(SEQ - 1);
            if (half == 0) {
                const int w = 2 << (lane >> 4); const bf16_t* P = PROJ + 8 * lane;
                float s[8];
#pragma unroll
                for (int q = 0; q < 8; ++q) s[q] = 0.f;
                for (int j = 1; j <= 16; ++j) if (j <= w && r0 - j >= bs) { float f[8]; unpack8(*(const u32x4*)(P + (size_t)(r0 - j) * MIXN), f);
#pragma unroll
                    for (int q = 0; q < 8; ++q) s[q] += f[q]; }
#pragma unroll 4
                for (int r = r0; r < r0 + 32; ++r) {
                    float cur[8], old[8]; unpack8(*(const u32x4*)(P + (size_t)r * MIXN), cur);
                    const bool has_old = (r - w >= bs);
                    if (has_old) unpack8(*(const u32x4*)(P + (size_t)(r - w) * MIXN), old);
                    const int pos = r - bs + 1; const float inv = 1.0f / (float)(pos < w ? pos : w);
                    float o[8];
#pragma unroll
                    for (int q = 0; q < 8; ++q) { s[q] += cur[q]; if (has_old) s[q] -= old[q]; o[q] = s[q] * inv - cur[q]; }
                    *(u32x4*)(MIXED + (size_t)r * D + 8 * lane) = pack8(o);
                }
            } else {
                const bf16_t* P = PROJ + 8 * lane;
                float w0[8], w1[8], w2[8], z1[8], z2[8];
                { const float* cw = p.in[I_CONVW] + 8 * lane;
#pragma unroll
                  for (int q = 0; q < 8; ++q) { w0[q] = cw[q]; w1[q] = cw[512 + q]; w2[q] = cw[1024 + q]; z1[q] = 0.f; z2[q] = 0.f; } }
                if (r0 - 1 >= bs) { float a[8], b[8]; unpack8(*(const u32x4*)(P + (size_t)(r0 - 1) * MIXN + 1024), a); unpack8(*(const u32x4*)(P + (size_t)(r0 - 1) * MIXN + 1536), b);
#pragma unroll
                    for (int q = 0; q < 8; ++q) z1[q] = a[q] * b[q]; }
                if (r0 - 2 >= bs) { float a[8], b[8]; unpack8(*(const u32x4*)(P + (size_t)(r0 - 2) * MIXN + 1024), a); unpack8(*(const u32x4*)(P + (size_t)(r0 - 2) * MIXN + 1536), b);
#pragma unroll
                    for (int q = 0; q < 8; ++q) z2[q] = a[q] * b[q]; }
#pragma unroll 4
                for (int r = r0; r < r0 + 32; ++r) {
                    float gp[8], a[8], b[8], o[8];
                    unpack8(*(const u32x4*)(P + (size_t)r * MIXN + 512), gp); unpack8(*(const u32x4*)(P + (size_t)r * MIXN + 1024), a); unpack8(*(const u32x4*)(P + (size_t)r * MIXN + 1536), b);
#pragma unroll
                    for (int q = 0; q < 8; ++q) { const float zc = a[q] * b[q]; o[q] = gp[q] * (w0[q] * z2[q] + w1[q] * z1[q] + w2[q] * zc); z2[q] = z1[q]; z1[q] = zc; }
                    *(u32x4*)(MIXED + (size_t)r * D + 512 + 8 * lane) = pack8(o);
                }
            }
        }
    }
    SEAM(2);

    if (IN(3)) for (int rep_ = 0; rep_ < NREP(3); ++rep_) { pg8::Gemm g{MIXED, Wout_t, 2 * D, 2 * D, 2 * D}; pg8::DenseOrder S; S.init(M, D, G, bx); pg8::EpiResid E{p.in[I_X], X, nullptr};
        pg8::gemm_phase<pg8::EpiResid, pg8::DenseOrder>(lds, g, S, E); }
    SEAM(3);

    if (IN(4)) for (int rep_ = 0; rep_ < NREP(4); ++rep_) { const int lane = fresh_tid() & 63; for (int m = gw; m < M; m += NGW) { float y[16]; norm_row_bf16(X + (size_t)m * D, p.in[I_EVNF], XN + (size_t)m * D, lane, y); } }
    SEAM(4);

    if (IN(5)) for (int rep_ = 0; rep_ < NREP(5); ++rep_) { pg8::Gemm g{XN, Wgu_t, 2 * D, 2 * D, 2 * D}; pg8::DenseOrder S; S.init(M, 2 * DFF, G, bx); pg8::EpiSwiGLU E{Hb, DFF};
        pg8::gemm_phase<pg8::EpiSwiGLU, pg8::DenseOrder>(lds, g, S, E); }
    SEAM(5);

    if (IN(6)) for (int rep_ = 0; rep_ < NREP(6); ++rep_) { pg8::Gemm g{Hb, Wd_t, 2 * DFF, 2 * DFF, 2 * DFF}; pg8::DenseOrder S; S.init(M, D, G, bx); pg8::EpiResid E{X, X, nullptr};
        pg8::gemm_phase<pg8::EpiResid, pg8::DenseOrder>(lds, g, S, E); }
    SEAM(6);

    if (IN(7)) for (int rep_ = 0; rep_ < NREP(7); ++rep_) { const int lane = fresh_tid() & 63; for (int m = gw; m < M; m += NGW) { float y[16]; norm_row_bf16(X + (size_t)m * D, p.in[I_ODNM], XN + (size_t)m * D, lane, y); } }
    SEAM(7);

    if (IN(8)) for (int rep_ = 0; rep_ < NREP(8); ++rep_) { pg8::Gemm g{XN, Wqkv_t, 2 * D, 2 * D, 2 * D}; pg8::DenseOrder S; S.init(M, QKVN, G, bx); pg8::EpiBf16 E{QKV, QKVN, p.in[I_BQKV]};
        pg8::gemm_phase<pg8::EpiBf16, pg8::DenseOrder>(lds, g, S, E); }
    SEAM(8);

    if (IN(9)) for (int rep_ = 0; rep_ < NREP(9); ++rep_) {
        const int tid = fresh_tid(), lane = tid & 63;
        constexpr int KS_STR = 144, VT_STR = 392;
        constexpr int L_K = 0, L_VT = 192 * KS_STR, L_BT = L_VT + 64 * VT_STR, L_OST = L_BT + NQH * 256 * 4;
        static_assert(L_OST + NWAVES * 32 * 144 <= RING_BYTES, "attention LDS");
        for (int i = tid; i < NQH * 256; i += NTHR) *(LAS float*)(lds + L_BT + 4 * i) = bias_tab[i];
        const int r32 = lane & 31, hh = lane >> 5;
        for (int unit = vcu; unit < BATCH * (SEQ / CHUNK) * NKVH; unit += G) {
            const int kvh = unit & 1, n = (unit >> 1) & 255, b = unit >> 9;
            const int t0 = b * SEQ + n * CHUNK;
            __syncthreads();
#pragma unroll
            for (int i = 0; i < 3; ++i) { const int pc = tid + i * NTHR, j = pc >> 3, c = pc & 7; const bool valid = (n * CHUNK - 128 + j) >= 0;
                u32x4 kv = {0u, 0u, 0u, 0u}, vv = {0u, 0u, 0u, 0u};
                if (valid) { const bf16_t* src = QKV + (size_t)(t0 - 128 + j) * QKVN + 1024 + kvh * HD + 8 * c; kv = *(const u32x4*)src; vv = *(const u32x4*)(src + 128); }
                *(LAS u32x4*)(lds + L_K + j * KS_STR + 16 * c) = kv;
                const unsigned vw[4] = {vv.x, vv.y, vv.z, vv.w};
#pragma unroll
                for (int q = 0; q < 4; ++q) { *(LAS unsigned short*)(lds + L_VT + (8 * c + 2 * q) * VT_STR + 2 * j) = (unsigned short)(vw[q] & 0xffffu);
                                              *(LAS unsigned short*)(lds + L_VT + (8 * c + 2 * q + 1) * VT_STR + 2 * j) = (unsigned short)(vw[q] >> 16); } }
            __syncthreads();
            const int head = kvh * 8 + wave;
            const float sink = p.in[I_SINK][head];
            const LAS float* bt = (const LAS float*)(lds + L_BT + head * 1024);
            const int kb_min = n == 0 ? 4 : (n == 1 ? 2 : 0);
#pragma unroll 1
            for (int qb = 0; qb < 2; ++qb) {
                bf16x8 qf[4];
                { const bf16_t* qp = QKV + (size_t)(t0 + qb * 32 + r32) * QKVN + head * HD + 8 * hh;
#pragma unroll
                  for (int ks = 0; ks < 4; ++ks) qf[ks] = *(const bf16x8*)(qp + 16 * ks); }
                f32x16 st[6];
#pragma unroll
                for (int kb = 0; kb < 6; ++kb) {
#pragma unroll
                    for (int e = 0; e < 16; ++e) st[kb][e] = 0.f;
#pragma unroll
                    for (int ks = 0; ks < 4; ++ks) { const bf16x8 kf = *(const LAS bf16x8*)(lds + L_K + (kb * 32 + r32) * KS_STR + 32 * ks + 16 * hh);
                        st[kb] = __builtin_amdgcn_mfma_f32_32x32x16_bf16(kf, qf[ks], st[kb], 0, 0, 0); } }
                float mx = sink;
#pragma unroll
                for (int kb = 0; kb < 6; ++kb)
#pragma unroll
                    for (int e = 0; e < 16; ++e) { const int j = kb * 32 + (e & 3) + 8 * (e >> 2) + 4 * hh; const int idx = j - (qb * 32 + r32) + 63;
                        float sc = st[kb][e] * 0.125f + bt[idx]; sc = (kb < kb_min) ? -1e30f : sc; st[kb][e] = sc; mx = fmaxf(mx, sc); }
                mx = fmaxf(mx, __shfl_xor(mx, 32));
                float sum = 0.f;
#pragma unroll
                for (int kb = 0; kb < 6; ++kb)
#pragma unroll
                    for (int e = 0; e < 16; ++e) { const float pe = __builtin_amdgcn_exp2f((st[kb][e] - mx) * 1.44269504089f); st[kb][e] = pe; sum += pe; }
                sum += __shfl_xor(sum, 32);
                const float inv = 1.0f / (sum + __builtin_amdgcn_exp2f((sink - mx) * 1.44269504089f));
                f32x16 ot[2];
#pragma unroll
                for (int db = 0; db < 2; ++db)
#pragma unroll
                    for (int e = 0; e < 16; ++e) ot[db][e] = 0.f;
#pragma unroll
                for (int kb = 0; kb < 6; ++kb)
#pragma unroll
                    for (int s = 0; s < 2; ++s) {
                        u32x4 pw; pw.x = pk2(st[kb][8 * s], st[kb][8 * s + 1]); pw.y = pk2(st[kb][8 * s + 2], st[kb][8 * s + 3]); pw.z = pk2(st[kb][8 * s + 4], st[kb][8 * s + 5]); pw.w = pk2(st[kb][8 * s + 6], st[kb][8 * s + 7]);
                        const bf16x8 pf = __builtin_bit_cast(bf16x8, pw);
#pragma unroll
                        for (int db = 0; db < 2; ++db) { const LAS unsigned char* vp = lds + L_VT + (db * 32 + r32) * VT_STR + 2 * (kb * 32 + 16 * s + 4 * hh);
                            const u32x2 v0 = *(const LAS u32x2*)vp, v1 = *(const LAS u32x2*)(vp + 16);
                            u32x4 vw; vw.x = v0.x; vw.y = v0.y; vw.z = v1.x; vw.w = v1.y;
                            ot[db] = __builtin_amdgcn_mfma_f32_32x32x16_bf16(__builtin_bit_cast(bf16x8, vw), pf, ot[db], 0, 0, 0); } }
                LAS unsigned char* ost = lds + L_OST + wave * (32 * 144);
#pragma unroll
                for (int db = 0; db < 2; ++db)
#pragma unroll
                    for (int g4 = 0; g4 < 4; ++g4) { u32x2 w; w.x = pk2(ot[db][4 * g4] * inv, ot[db][4 * g4 + 1] * inv); w.y = pk2(ot[db][4 * g4 + 2] * inv, ot[db][4 * g4 + 3] * inv);
                        *(LAS u32x2*)(ost + r32 * 144 + 2 * (db * 32 + 8 * g4 + 4 * hh)) = w; }
                LDS_WAIT();
#pragma unroll
                for (int i = 0; i < 4; ++i) { const int q = 8 * i + (lane >> 3), c = lane & 7; const u32x4 w = *(const LAS u32x4*)(ost + q * 144 + 16 * c);
                    *(u32x4*)(AO + (size_t)(t0 + qb * 32 + q) * D + head * HD + 8 * c) = w; }
                LDS_WAIT();
            }
        }
        __syncthreads();
    }
    SEAM(9);

    if (IN(10)) for (int rep_ = 0; rep_ < NREP(10); ++rep_) { pg8::Gemm g{AO, Wo_t, 2 * D, 2 * D, 2 * D}; pg8::DenseOrder S; S.init(M, D, G, bx); pg8::EpiResid E{X, X, p.in[I_BO]};
        pg8::gemm_phase<pg8::EpiResid, pg8::DenseOrder>(lds, g, S, E); }
    SEAM(10);

    const int RPW = (M + G - 1) / G;
    constexpr int L_RW = 0, L_RE = 32768, L_RWT = L_RE + 1024 * 4, L_RRK = L_RWT + 1024 * 4, L_CNT = L_RRK + 1024 * 4, L_SB = L_CNT + 64, L_SLOT = L_SB + 256;
    unsigned char* XN8 = (unsigned char*)XN;
    if (IN(11)) for (int rep_ = 0; rep_ < NREP(11); ++rep_) {
        const int tid = fresh_tid(), lane = tid & 63;
        for (int i = tid; i < D * NEXP; i += NTHR) { const int c = i >> 3, e = i & 7; *(LAS float*)(lds + L_RW + 4 * (e * D + c)) = p.in[I_ROUTER][i] * p.in[I_ODNF][c]; }
        if (tid < 8) *(LAS int*)(lds + L_CNT + 4 * tid) = 0;
        __syncthreads();
        const int rbase = bx * RPW;
        const int nrows = (M - rbase) < RPW ? (M - rbase) : RPW;
        f32x4 gn[4];
#pragma unroll
        for (int j = 0; j < 4; ++j) gn[j] = *(const f32x4*)(p.in[I_ODNF] + 256 * j + 4 * lane);
        for (int rl0 = wave; rl0 < nrows; rl0 += 4 * NWAVES) {
            f32x4 v[4][4];
#pragma unroll
            for (int u = 0; u < 4; ++u) { const int rl = rl0 + 8 * u; const int m = rbase + (rl < nrows ? rl : rl0);
#pragma unroll
                for (int j = 0; j < 4; ++j) v[u][j] = *(const f32x4*)(X + (size_t)m * D + 256 * j + 4 * lane); }
#pragma unroll
            for (int u = 0; u < 4; ++u) { const int rl = rl0 + 8 * u; if (rl >= nrows) continue; const int m = rbase + rl;
                float s2 = 0.f;
#pragma unroll
                for (int j = 0; j < 4; ++j) s2 += (v[u][j][0] * v[u][j][0] + v[u][j][1] * v[u][j][1]) + (v[u][j][2] * v[u][j][2] + v[u][j][3] * v[u][j][3]);
                const float r = 1.0f / sqrtf(wave_sum(s2) * (1.0f / D) + RMS_EPS);
                float lg[8];
#pragma unroll
                for (int e = 0; e < 8; ++e) { float a = 0.f;
#pragma unroll
                    for (int j = 0; j < 4; ++j) { const f32x4 w = *(const LAS f32x4*)(lds + L_RW + 4096 * e + 1024 * j + 16 * lane); a += (v[u][j][0] * w[0] + v[u][j][1] * w[1]) + (v[u][j][2] * w[2] + v[u][j][3] * w[3]); }
                    lg[e] = a; }
#pragma unroll
                for (int e = 0; e < 8; ++e) lg[e] = wave_sum(lg[e]) * r;
#pragma unroll
                for (int j = 0; j < 4; ++j) { const f32x4 y = v[u][j] * r * gn[j]; *(unsigned*)(XN8 + (size_t)m * D + 256 * j + 4 * lane) = pg8::pk4_fp8(y[0], y[1], y[2], y[3]); }
                int e0 = 0; float v0 = lg[0];
#pragma unroll
                for (int e = 1; e < 8; ++e) if (lg[e] > v0) { v0 = lg[e]; e0 = e; }
                int e1 = -1; float v1 = -3.0e38f;
#pragma unroll
                for (int e = 0; e < 8; ++e) if (e != e0 && lg[e] > v1) { v1 = lg[e]; e1 = e; }
                const float wt0 = 1.0f / (1.0f + __expf(v1 - v0));
                if (lane == 0) { *(LAS int*)(lds + L_RE + 8 * rl) = e0; *(LAS int*)(lds + L_RE + 8 * rl + 4) = e1; *(LAS float*)(lds + L_RWT + 8 * rl) = wt0; *(LAS float*)(lds + L_RWT + 8 * rl + 4) = 1.0f - wt0; }
            }
        }
        __syncthreads();
        for (int en = tid; en < 2 * nrows; en += NTHR) {
            const int e = *(LAS int*)(lds + L_RE + 4 * en); int r = 0;
            for (int j = 0; j < en; ++j) r += (*(LAS int*)(lds + L_RE + 4 * j) == e);
            *(LAS int*)(lds + L_RRK + 4 * en) = r;
            __hip_atomic_fetch_add((LAS int*)(lds + L_CNT + 4 * e), 1, __ATOMIC_RELAXED, __HIP_MEMORY_SCOPE_WORKGROUP);
        }
        __syncthreads();
        if (tid < 8) wgcnt[bx * 8 + tid] = *(LAS int*)(lds + L_CNT + 4 * tid);
        __syncthreads();
    }
    SEAM(11);

    if (IN(12)) for (int rep_ = 0; rep_ < NREP(12); ++rep_) {
        const int tid = fresh_tid(), lane = tid & 63;
        LAS int* sb = (LAS int*)(lds + L_SB);
        if (tid < 32) sb[tid] = 0;
        __syncthreads();
        for (int i = tid; i < G * 2; i += NTHR) { const int w = i >> 1, h4 = (i & 1) * 4; const u32x4 c = *(const u32x4*)(wgcnt + w * 8 + h4); const unsigned cv[4] = {c.x, c.y, c.z, c.w};
#pragma unroll
            for (int q = 0; q < 4; ++q) { __hip_atomic_fetch_add(sb + 16 + h4 + q, (int)cv[q], __ATOMIC_RELAXED, __HIP_MEMORY_SCOPE_WORKGROUP); if (w < bx) __hip_atomic_fetch_add(sb + 8 + h4 + q, (int)cv[q], __ATOMIC_RELAXED, __HIP_MEMORY_SCOPE_WORKGROUP); } }
        __syncthreads();
        if (tid == 0) { int base = 0; for (int e = 0; e < 8; ++e) { sb[e] = base; base += (sb[16 + e] + 255) & ~255; } sb[24] = base; }
        __syncthreads();
        const int rbase = bx * RPW;
        const int nrows = (M - rbase) < RPW ? (M - rbase) : RPW;
        unsigned char* HS8 = (unsigned char*)HS;
        for (int en = tid; en < 2 * nrows; en += NTHR) { const int e = *(LAS int*)(lds + L_RE + 4 * en); const int slot = sb[e] + sb[8 + e] + *(LAS int*)(lds + L_RRK + 4 * en);
            *(LAS int*)(lds + L_SLOT + 4 * en) = slot; slot_tok[slot] = 2 * (rbase + (en >> 1)) + (en & 1); slot_w[slot] = *(LAS float*)(lds + L_RWT + 4 * en); }
        __syncthreads();
        for (int en0 = wave; en0 < 2 * nrows; en0 += 4 * NWAVES) {
            u32x4 t[4];
#pragma unroll
            for (int u = 0; u < 4; ++u) { const int en = en0 + 8 * u; if (en < 2 * nrows) t[u] = *(const u32x4*)(XN8 + (size_t)(rbase + (en >> 1)) * D + 16 * lane); }
#pragma unroll
            for (int u = 0; u < 4; ++u) { const int en = en0 + 8 * u; if (en < 2 * nrows) *(u32x4*)(HS8 + (size_t)(*(LAS int*)(lds + L_SLOT + 4 * en)) * D + 16 * lane) = t[u]; } }
        if (bx == 0) {
            for (int e = 0; e < 8; ++e) { const int b0 = sb[e] + sb[16 + e], b1 = sb[e] + ((sb[16 + e] + 255) & ~255); for (int i = b0 + tid; i < b1; i += NTHR) { slot_tok[i] = -1; slot_w[i] = 0.f; } }
            const int nt_all = sb[24] >> 8;
            for (int j = tid; j < nt_all; j += NTHR) { int e = 0; for (int q = 1; q < 8; ++q) if ((j << 8) >= sb[q]) e = q; tilemeta[8 + j] = e; }
            if (tid == 0) { tilemeta[0] = nt_all; tilemeta[1] = nt_all; }
        }
        __syncthreads();
    }
    SEAM(12);

    if (IN(13) || IN(14)) {
        const int tid = fresh_tid();
        for (int j = tid; j < 288; j += NTHR) *(LAS int*)(lds + LDS_TILE_OFF + 4 * j) = (j < MAXTILES + 8) ? tilemeta[j] : 0;
        __syncthreads();
    }
    const LAS int* tmeta = (const LAS int*)(lds + LDS_TILE_OFF);
    if (IN(13)) for (int rep_ = 0; rep_ < NREP(13); ++rep_) {
        const int nall = __builtin_amdgcn_readfirstlane(tmeta[0]);
        pg8::Gemm g{HS, Wegu_t, D, D, D}; pg8::MoeOrder S; S.T.init(nall, NFE_T, G, bx); S.tpe = NFE_T; S.tile_e = tmeta + 8;
        pg8::EpiSwiGLU8 E{(unsigned char*)H2, DFE};
        pg8::gemm_phase<pg8::EpiSwiGLU8, pg8::MoeOrder, true>(lds, g, S, E);
    }
    SEAM(13);
    if (IN(14)) {
        const int nall = __builtin_amdgcn_readfirstlane(tmeta[0]);
        pg8::Gemm g{H2, Wed_t, DFE, DFE, DFE}; pg8::MoeOrder S; S.T.init(nall, D / 256, G, bx); S.tpe = D / 256; S.tile_e = tmeta + 8;
        pg8::EpiMoeDown E{X, (bf16_t*)(ws + WS_Y0), slot_tok, slot_w};
        pg8::gemm_phase<pg8::EpiMoeDown, pg8::MoeOrder, true>(lds, g, S, E);
    }
    SEAM(14);

    if (IN(15)) {
        const int lane = fresh_tid() & 63;
        const bf16_t* Y0 = (const bf16_t*)(ws + WS_Y0);
        for (int m = gw; m < M; m += NGW) {
            float* xrow = X + (size_t)m * D; f32x4 v[4];
#pragma unroll
            for (int j = 0; j < 2; ++j) { v[2 * j] = *(const f32x4*)(xrow + 512 * j + 8 * lane); v[2 * j + 1] = *(const f32x4*)(xrow + 512 * j + 8 * lane + 4);
                float f[8]; unpack8(*(const u32x4*)(Y0 + (size_t)m * D + 512 * j + 8 * lane), f);
#pragma unroll
                for (int q = 0; q < 4; ++q) { v[2 * j][q] += f[q]; v[2 * j + 1][q] += f[4 + q]; } }
            float s2 = 0.f;
#pragma unroll
            for (int j = 0; j < 4; ++j) s2 += (v[j][0] * v[j][0] + v[j][1] * v[j][1]) + (v[j][2] * v[j][2] + v[j][3] * v[j][3]);
            const float r = 1.0f / sqrtf(wave_sum(s2) * (1.0f / D) + RMS_EPS);
#pragma unroll
            for (int j = 0; j < 2; ++j) { const f32x4 g0 = *(const f32x4*)(p.in[I_FINAL] + 512 * j + 8 * lane), g1 = *(const f32x4*)(p.in[I_FINAL] + 512 * j + 8 * lane + 4);
                *(f32x4*)(xrow + 512 * j + 8 * lane) = v[2 * j] * r * g0; *(f32x4*)(xrow + 512 * j + 8 * lane + 4) = v[2 * j + 1] * r * g1; }
        }
    }
#undef IN
#undef SEAM
}

extern "C" void kernel_launch(void* const* d_in, const int* in_sizes, int n_in, void* d_out, int out_size, void* d_ws, size_t ws_size, hipStream_t stream) {
    static int grid = 0;
    if (grid == 0) {
        if (n_in != 24 || in_sizes[0] != M * D || out_size != M * D || ws_size < WS_END) { fprintf(stderr, "kernel_launch: unexpected shapes (n_in %d, in0 %d, out %d, ws %zu < %zu)\n", n_in, n_in > 0 ? in_sizes[0] : -1, out_size, ws_size, (size_t)WS_END); grid = -1; return; }
        int dev = 0, cus = 0, per_cu = 0;
        if (hipGetDevice(&dev) != hipSuccess || hipDeviceGetAttribute(&cus, hipDeviceAttributeMultiprocessorCount, dev) != hipSuccess) { grid = -1; return; }
        if (hipFuncSetAttribute((const void*)fwd_kernel, hipFuncAttributeMaxDynamicSharedMemorySize, LDS_BYTES) != hipSuccess) { fprintf(stderr, "kernel_launch: hipFuncSetAttribute failed\n"); grid = -1; return; }
        if (hipOccupancyMaxActiveBlocksPerMultiprocessor(&per_cu, (const void*)fwd_kernel, NTHR, LDS_BYTES) != hipSuccess || per_cu < 1) fprintf(stderr, "kernel_launch: occupancy query reports %d\n", per_cu);
        (void)hipGetLastError();
        grid = cus < 256 ? cus : 256;
    }
    if (grid < 0) return;
    (void)hipMemsetAsync((char*)d_ws + WS_CTL, 0, CTL_ZERO_BYTES, stream);
    Params a{};
    for (int i = 0; i < 24; ++i) a.in[i] = (const float*)d_in[i];
    a.out = (float*)d_out; a.ws = (unsigned char*)d_ws;
    constexpr int NPH = 16;
    if (MK_N_LAUNCHES == 1) { a.ph_lo = 0; a.ph_hi = NPH; hipLaunchKernelGGL(fwd_kernel, dim3(grid), dim3(NTHR), LDS_BYTES, stream, a); }
    else for (int li = 0; li < NPH; ++li) { a.ph_lo = li; a.ph_hi = li + 1; hipLaunchKernelGGL(fwd_kernel, dim3(grid), dim3(NTHR), LDS_BYTES, stream, a); }
}
```

```cpp
#include <hip/hip_runtime.h>
#include <cstdio>
#include <cstdint>

#ifndef MK_N_LAUNCHES
#define MK_N_LAUNCHES 1
#endif

#ifndef REPMASK
#define REPMASK 0u
#endif
#define NREP(k) ((((REPMASK) >> (k)) & 1u) ? 2 : 1)
#define LAS __attribute__((address_space(3)))
#define GAS __attribute__((address_space(1)))
typedef unsigned short bf16_t;
typedef short bf16x8 __attribute__((ext_vector_type(8)));
typedef short s16x4 __attribute__((ext_vector_type(4)));
typedef float f32x2 __attribute__((ext_vector_type(2)));
typedef float f32x4 __attribute__((ext_vector_type(4)));
typedef float f32x16 __attribute__((ext_vector_type(16)));
typedef unsigned u32x2 __attribute__((ext_vector_type(2)));
typedef unsigned u32x4 __attribute__((ext_vector_type(4)));
typedef __bf16 hbf16x2 __attribute__((ext_vector_type(2)));
typedef int i32x4 __attribute__((ext_vector_type(4)));
typedef int i32x8 __attribute__((ext_vector_type(8)));

constexpr int D = 1024, BATCH = 2, SEQ = 16384, M = BATCH * SEQ;
constexpr int MIXN = 2048;
constexpr int DFF = 2816, NFF_T = DFF / 128;
constexpr int QKVN = 1280, NQH = 16, NKVH = 2, HD = 64, CHUNK = 64, KVSPAN = 192;
constexpr int NEXP = 8, DFE = 3584, NFE_T = DFE / 128;
constexpr float RMS_EPS = 1e-6f;
constexpr int MAXSLOT = 67328;
constexpr int MAXTILES = MAXSLOT / 256;
constexpr int NWAVES = 8, NTHR = 512;

constexpr size_t MiB = 1u << 20;
constexpr size_t WS_CTL = 0, CTL_ZERO_BYTES = 1 * MiB;
constexpr size_t WS_BIAS = 1 * MiB;
constexpr size_t WS_WGCNT = WS_BIAS + 16 * 256 * 4;
constexpr size_t WS_TILE = WS_WGCNT + 1024 * 16 * 4;
constexpr size_t WS_TOKE = WS_TILE + 4096;
constexpr size_t WS_TOKW = WS_TOKE + 2 * (size_t)M * 4;
constexpr size_t WS_TOKR = WS_TOKW + 2 * (size_t)M * 4;
constexpr size_t WS_SLOTT = WS_TOKR + 2 * (size_t)M * 4;
constexpr size_t WS_SLOTW = WS_SLOTT + (size_t)MAXSLOT * 4;
static_assert(WS_SLOTW + (size_t)MAXSLOT * 4 <= 4 * MiB, "route region");
constexpr size_t WS_WIN = 4 * MiB;
constexpr size_t WS_WOUT = WS_WIN + (size_t)MIXN * D * 2;
constexpr size_t WS_WGU = WS_WOUT + (size_t)D * D * 2;
constexpr size_t WS_WD = WS_WGU + (size_t)2 * DFF * D * 2;
constexpr size_t WS_WQKV = WS_WD + (size_t)D * DFF * 2;
constexpr size_t WS_WO = WS_WQKV + (size_t)QKVN * D * 2;
static_assert(WS_WO + (size_t)D * D * 2 <= 31 * MiB, "dense weights");
constexpr size_t WS_WEGU = 31 * MiB;
constexpr size_t WS_WED = WS_WEGU + (size_t)NEXP * 2 * DFE * D;
static_assert(WS_WED + (size_t)NEXP * D * DFE == 115 * MiB, "expert weights");
constexpr size_t WS_XN = 115 * MiB;
constexpr size_t WS_Y0 = WS_XN;
constexpr size_t WS_R = 179 * MiB;
constexpr size_t WS_PROJ = WS_R, WS_MIXED = WS_R + (size_t)M * MIXN * 2;
constexpr size_t WS_H = WS_R;
constexpr size_t WS_QKV = WS_R, WS_AO = WS_R + (size_t)M * QKVN * 2;
constexpr size_t WS_HS = WS_R, WS_H2 = WS_R + 66 * MiB;
static_assert((size_t)MAXSLOT * D <= 66 * MiB, "HS");
constexpr size_t WS_END = WS_H2 + (size_t)MAXSLOT * DFE;
static_assert(WS_END <= 543497280ull, "workspace");
static_assert(WS_MIXED + (size_t)M * D * 2 <= 543497280ull && WS_H + (size_t)M * DFF * 2 <= 543497280ull, "workspace");

constexpr int CW_BAR = 4096;
constexpr size_t WS_RSS = 480 * MiB;
static_assert(WS_RSS >= WS_END && WS_RSS + 2 * (size_t)M * 16 * 4 <= 543497280ull, "rss");

constexpr int RING_BYTES = 131072;
constexpr int LDS_TILE_OFF = RING_BYTES;
constexpr int LDS_MISC_OFF = RING_BYTES + 2048;
constexpr int LDS_BYTES = 147456;

__device__ __forceinline__ unsigned pk2(float lo, float hi) { f32x2 v = {lo, hi}; hbf16x2 b = __builtin_convertvector(v, hbf16x2); return __builtin_bit_cast(unsigned, b); }
__device__ __forceinline__ float bf_lo(unsigned w) { return __uint_as_float(w << 16); }
__device__ __forceinline__ float bf_hi(unsigned w) { return __uint_as_float(w & 0xffff0000u); }
__device__ __forceinline__ void unpack8(const u32x4 w, float (&f)[8]) { f[0] = bf_lo(w.x); f[1] = bf_hi(w.x); f[2] = bf_lo(w.y); f[3] = bf_hi(w.y); f[4] = bf_lo(w.z); f[5] = bf_hi(w.z); f[6] = bf_lo(w.w); f[7] = bf_hi(w.w); }
__device__ __forceinline__ u32x4 pack8(const float (&f)[8]) { u32x4 w; w.x = pk2(f[0], f[1]); w.y = pk2(f[2], f[3]); w.z = pk2(f[4], f[5]); w.w = pk2(f[6], f[7]); return w; }
__device__ __forceinline__ float wave_sum(float v) {
#pragma unroll
    for (int o = 1; o < 64; o <<= 1) v += __shfl_xor(v, o);
    return v;
}
__device__ __forceinline__ int fresh_tid() { int t = threadIdx.x; asm volatile("" : "+v"(t)); return t; }
#define LDS_WAIT() asm volatile("s_waitcnt lgkmcnt(0)" ::: "memory")
#define VM_WAIT() asm volatile("s_waitcnt vmcnt(0)" ::: "memory")

namespace pg8 {
constexpr int BM = 256, BK = 64, HALF = 128, HTB = HALF * BK * 2, STAGE_BYTES = 8 * HTB, NXCD = 8, WGM = 8;
__host__ __device__ __forceinline__ int lds_byte(int r, int c) { const int st = (r >> 4) * 2 + (c >> 5), rr = r & 15, cc = c & 31, ob = rr * 64 + cc * 2; return st * 1024 + (ob ^ (((ob >> 9) & 1) << 5)); }
__host__ __device__ __forceinline__ void stage_rc(int b, int& R, int& C) { const int st = b / 1024, sb = b % 1024, swz = sb ^ (((sb >> 9) & 1) << 5); R = (st >> 1) * 16 + swz / 64; C = (st & 1) * 32 + (swz % 64) / 2; }
__host__ __device__ __forceinline__ int perm32(int rho) { const int n = rho >> 4, i = rho & 15; return 8 * (i >> 2) + 4 * n + (i & 3); }

struct Unit { int pm, pn, rm, cn; };
struct Gemm { const void* A; const void* Bt; int lda, ldb, K; };

struct TileOrder {
    int nM, nN, nwg, G, c;
    __device__ __forceinline__ void init(int nM_, int nN_, int G_, int c_) { nM = nM_; nN = nN_; nwg = nM * nN; G = G_; c = c_; }
    __device__ __forceinline__ bool next(int i, int& m, int& n) const {
        const int L = i * G + c; if (L >= nwg) return false;
        int wgid = L; { const int q = nwg / NXCD, r = nwg % NXCD, xcd = wgid % NXCD, off = wgid / NXCD; wgid = (xcd < r ? xcd * (q + 1) : r * (q + 1) + (xcd - r) * q) + off; }
        const int nig = WGM * nN, gid = wgid / nig, fm = gid * WGM, gsz = (nM - fm) < WGM ? (nM - fm) : WGM;
        m = fm + ((wgid % nig) % gsz); n = (wgid % nig) / gsz; return true;
    }
};
struct DenseOrder {
    TileOrder T;
    __device__ __forceinline__ void init(int Mr, int N, int G, int c) { T.init(Mr / BM, N / BM, G, c); }
    __device__ __forceinline__ bool next(int i, Unit& u) const { int m, n; if (!T.next(i, m, n)) return false; u.pm = m; u.pn = n; u.rm = m; u.cn = n; return true; }
    __device__ __forceinline__ void a_ready(const Unit&) const {}
    __device__ __forceinline__ void done(const Unit&) const {}
};
struct MoeOrder {
    TileOrder T; int tpe; const LAS int* tile_e;
    __device__ __forceinline__ bool next(int i, Unit& u) const { int m, n; if (!T.next(i, m, n)) return false;
        const int e = __builtin_amdgcn_readfirstlane(tile_e[m]);
        u.pm = m; u.pn = e * tpe + n; u.rm = m; u.cn = n; return true; }
    __device__ __forceinline__ void a_ready(const Unit&) const {}
    __device__ __forceinline__ void done(const Unit&) const {}
};

__device__ __forceinline__ float rms_scale(const float* rss, int row) { if (!rss) return 1.0f; const f32x4* q = (const f32x4*)(rss + (size_t)row * 16); const f32x4 a = q[0], b = q[1], c = q[2], d = q[3];
    const float s = (((a[0] + a[1]) + (a[2] + a[3])) + ((b[0] + b[1]) + (b[2] + b[3]))) + (((c[0] + c[1]) + (c[2] + c[3])) + ((d[0] + d[1]) + (d[2] + d[3]))); return 1.0f / sqrtf(s * (1.0f / D) + RMS_EPS); }
struct EpiBf16 {
    static constexpr bool PERM = true;
    bf16_t* O; int ldc; const float* bias; const float* rss;
    __device__ __forceinline__ void operator()(const f32x4 (&acc)[2][2][4][2], const Unit& u, int wr, int wc, int fr, int fq) const {
        const int row0 = u.rm * BM + wr * 64 + fr, col0 = u.cn * BM + wc * 32 + 8 * fq;
        f32x4 bv[2][2];
#pragma unroll
        for (int bj = 0; bj < 2; ++bj)
#pragma unroll
            for (int n = 0; n < 2; ++n) bv[bj][n] = bias ? *(const f32x4*)(bias + col0 + bj * HALF + 4 * n) : (f32x4){0.f, 0.f, 0.f, 0.f};
#pragma unroll
        for (int ai = 0; ai < 2; ++ai)
#pragma unroll
            for (int m = 0; m < 4; ++m) { const int row = row0 + ai * HALF + m * 16; bf16_t* rowp = O + (size_t)row * ldc + col0; const float r = rms_scale(rss, row);
#pragma unroll
                for (int bj = 0; bj < 2; ++bj) { const f32x4 v0 = acc[ai][bj][m][0] * r + bv[bj][0], v1 = acc[ai][bj][m][1] * r + bv[bj][1];
                    u32x4 w; w.x = pk2(v0[0], v0[1]); w.y = pk2(v0[2], v0[3]); w.z = pk2(v1[0], v1[1]); w.w = pk2(v1[2], v1[3]);
                    *(u32x4*)(rowp + bj * HALF) = w; } }
    }
};
__device__ __forceinline__ float silu_mul(float g, float u) { return g * u * __builtin_amdgcn_rcpf(1.0f + __builtin_amdgcn_exp2f(-1.44269504089f * g)); }
struct EpiSwiGLU {
    static constexpr bool PERM = true;
    bf16_t* O; int ldc; const float* rss;
    __device__ __forceinline__ void operator()(const f32x4 (&acc)[2][2][4][2], const Unit& u, int wr, int wc, int fr, int fq) const {
        const int row0 = u.rm * BM + wr * 64 + fr, col0 = u.cn * HALF + wc * 32 + 8 * fq;
#pragma unroll
        for (int ai = 0; ai < 2; ++ai)
#pragma unroll
            for (int m = 0; m < 4; ++m) { const int row = row0 + ai * HALF + m * 16; bf16_t* rowp = O + (size_t)row * ldc + col0; const float r = rms_scale(rss, row);
                const f32x4 g0 = acc[ai][0][m][0] * r, g1 = acc[ai][0][m][1] * r, u0 = acc[ai][1][m][0] * r, u1 = acc[ai][1][m][1] * r;
                u32x4 w; w.x = pk2(silu_mul(g0[0], u0[0]), silu_mul(g0[1], u0[1])); w.y = pk2(silu_mul(g0[2], u0[2]), silu_mul(g0[3], u0[3]));
                w.z = pk2(silu_mul(g1[0], u1[0]), silu_mul(g1[1], u1[1])); w.w = pk2(silu_mul(g1[2], u1[2]), silu_mul(g1[3], u1[3]));
                *(u32x4*)rowp = w; }
    }
};
struct EpiResid {
    static constexpr bool PERM = true;
    const float* base; float* out; const float* bias; bf16_t* xb; float* rss;
    __device__ __forceinline__ void operator()(const f32x4 (&acc)[2][2][4][2], const Unit& u, int wr, int wc, int fr, int fq) const {
        const int row0 = u.rm * BM + wr * 64 + fr, col0 = u.cn * BM + wc * 32 + 8 * fq;
        f32x4 bv[2][2];
#pragma unroll
        for (int bj = 0; bj < 2; ++bj)
#pragma unroll
            for (int n = 0; n < 2; ++n) bv[bj][n] = bias ? *(const f32x4*)(bias + col0 + bj * HALF + 4 * n) : (f32x4){0.f, 0.f, 0.f, 0.f};
#pragma unroll
        for (int ai = 0; ai < 2; ++ai)
#pragma unroll
            for (int m = 0; m < 4; ++m) { const int row = row0 + ai * HALF + m * 16; const size_t off = (size_t)row * D + col0;
                f32x4 bs[2][2];
#pragma unroll
                for (int bj = 0; bj < 2; ++bj)
#pragma unroll
                    for (int n = 0; n < 2; ++n) bs[bj][n] = *(const f32x4*)(base + off + bj * HALF + 4 * n);
                float ss = 0.f;
#pragma unroll
                for (int bj = 0; bj < 2; ++bj) {
#pragma unroll
                    for (int n = 0; n < 2; ++n) { bs[bj][n] = bs[bj][n] + acc[ai][bj][m][n] + bv[bj][n]; *(f32x4*)(out + off + bj * HALF + 4 * n) = bs[bj][n];
                        ss += (bs[bj][n][0] * bs[bj][n][0] + bs[bj][n][1] * bs[bj][n][1]) + (bs[bj][n][2] * bs[bj][n][2] + bs[bj][n][3] * bs[bj][n][3]); }
                    if (xb) { u32x4 w; w.x = pk2(bs[bj][0][0], bs[bj][0][1]); w.y = pk2(bs[bj][0][2], bs[bj][0][3]); w.z = pk2(bs[bj][1][0], bs[bj][1][1]); w.w = pk2(bs[bj][1][2], bs[bj][1][3]);
                        *(u32x4*)(xb + off + bj * HALF) = w; } }
                if (xb) { ss += __shfl_xor(ss, 16); ss += __shfl_xor(ss, 32); if (fq == 0) rss[(size_t)row * 16 + u.cn * 4 + wc] = ss; }
                asm volatile("" ::: "memory"); }
    }
};
__device__ __forceinline__ unsigned pk4_fp8(float a, float b, float c, float d) {
    int w = __builtin_amdgcn_cvt_pk_fp8_f32(__builtin_amdgcn_fmed3f(a, -448.f, 448.f), __builtin_amdgcn_fmed3f(b, -448.f, 448.f), 0, false);
    w = __builtin_amdgcn_cvt_pk_fp8_f32(__builtin_amdgcn_fmed3f(c, -448.f, 448.f), __builtin_amdgcn_fmed3f(d, -448.f, 448.f), w, true);
    return (unsigned)w;
}
constexpr int E8M0_ONE = 0x7f7f7f7f, E8M0_2M6 = 0x79797979;
struct EpiSwiGLU8 {
    static constexpr bool PERM = true; static constexpr int SCALE_A = E8M0_ONE, SCALE_B = E8M0_2M6;
    unsigned char* O; int ldc;
    __device__ __forceinline__ void operator()(const f32x4 (&acc)[2][2][4][2], const Unit& u, int wr, int wc, int fr, int fq) const {
        const int row0 = u.rm * BM + wr * 64 + fr, col0 = u.cn * HALF + wc * 32 + 8 * fq;
#pragma unroll
        for (int ai = 0; ai < 2; ++ai)
#pragma unroll
            for (int m = 0; m < 4; ++m) { unsigned char* rowp = O + (size_t)(row0 + ai * HALF + m * 16) * ldc + col0;
                const f32x4 g0 = acc[ai][0][m][0], g1 = acc[ai][0][m][1], u0 = acc[ai][1][m][0], u1 = acc[ai][1][m][1];
                u32x2 w; w.x = pk4_fp8(silu_mul(g0[0], u0[0]), silu_mul(g0[1], u0[1]), silu_mul(g0[2], u0[2]), silu_mul(g0[3], u0[3]));
                w.y = pk4_fp8(silu_mul(g1[0], u1[0]), silu_mul(g1[1], u1[1]), silu_mul(g1[2], u1[2]), silu_mul(g1[3], u1[3]));
                *(u32x2*)rowp = w; }
    }
};
struct EpiMoeDown {
    static constexpr bool PERM = true; static constexpr int SCALE_A = E8M0_ONE, SCALE_B = E8M0_2M6;
    float* X; bf16_t* Y0; const int* slot_tok; const float* slot_w;
    __device__ __forceinline__ void operator()(const f32x4 (&acc)[2][2][4][2], const Unit& u, int wr, int wc, int fr, int fq) const {
        const int row0 = u.rm * BM + wr * 64 + fr, col0 = u.cn * BM + wc * 32 + 8 * fq;
#pragma unroll
        for (int ai = 0; ai < 2; ++ai)
#pragma unroll
            for (int m = 0; m < 4; ++m) { const int slot = row0 + ai * HALF + m * 16; const int meta = slot_tok[slot]; const float w = slot_w[slot];
                if (meta >= 0) { const size_t off = (size_t)(meta >> 1) * D + col0;
                    if (meta & 1) {
                        f32x4 bs[2][2];
#pragma unroll
                        for (int bj = 0; bj < 2; ++bj)
#pragma unroll
                            for (int n = 0; n < 2; ++n) bs[bj][n] = *(const f32x4*)(X + off + bj * HALF + 4 * n);
#pragma unroll
                        for (int bj = 0; bj < 2; ++bj)
#pragma unroll
                            for (int n = 0; n < 2; ++n) *(f32x4*)(X + off + bj * HALF + 4 * n) = bs[bj][n] + acc[ai][bj][m][n] * w;
                    } else {
#pragma unroll
                        for (int bj = 0; bj < 2; ++bj) { const f32x4 v0 = acc[ai][bj][m][0] * w, v1 = acc[ai][bj][m][1] * w;
                            u32x4 o; o.x = pk2(v0[0], v0[1]); o.y = pk2(v0[2], v0[3]); o.z = pk2(v1[0], v1[1]); o.w = pk2(v1[2], v1[3]);
                            *(u32x4*)(Y0 + off + bj * HALF) = o; }
                    } }
                asm volatile("" ::: "memory"); }
    }
};

template <int OFF> __device__ __forceinline__ void glds_s(const char* sbase, unsigned voff, unsigned lds_base) {
    unsigned keep;
    asm volatile("s_mov_b32 %0, m0\n\ts_add_u32 m0, %3, %4\n\ts_nop 0\n\tglobal_load_lds_dwordx4 %1, %2\n\ts_mov_b32 m0, %0" : "=&s"(keep) : "v"(voff), "s"(sbase), "s"(lds_base), "i"(OFF) : "memory", "scc");
}
template <class Epi, class Sched, bool FP8 = false, bool ALIGN_EPI = true, bool SP2 = true>
__device__ __forceinline__ void gemm_phase(LAS unsigned char* lds, const Gemm g, const Sched& S, const Epi& E) {
    const int tid = threadIdx.x, wid = __builtin_amdgcn_readfirstlane(tid >> 6), lane = tid & 63, wr = wid >> 2, wc = wid & 3, fr = lane & 15, fq = lane >> 4;
    const int nt = g.K / (BK * 2);
    unsigned voffA[2], voffB[2];
#pragma unroll
    for (int i = 0; i < 2; ++i) { int R, C; stage_rc(tid * 16 + i * 8192, R, C); const int Rb = Epi::PERM ? ((R & ~31) + perm32(R & 31)) : R;
        voffA[i] = (unsigned)(R * g.lda + C * 2); voffB[i] = (unsigned)(Rb * g.ldb + C * 2); }
    const size_t kstep = (size_t)(BK * 2);
    const size_t hstepA = (size_t)HALF * g.lda, hstepB = (size_t)HALF * g.ldb;
    const size_t tstepA = 2 * hstepA, tstepB = 2 * hstepB;
    const unsigned lds_base = (unsigned)(size_t)lds + (unsigned)wid * 1024u;
    const int aoff = lds_byte(wr * 64 + fr, fq * 8), boff = lds_byte(wc * 32 + fr, fq * 8);
#define PG8_SA(b, h) (((b) * 2 + (h)) * HTB)
#define PG8_SB(b, h) ((4 + (b) * 2 + (h)) * HTB)
#define PG8_STAGE(bufoff, gbase, voff) do { glds_s<(bufoff)>((const char*)(gbase), (voff)[0], lds_base); glds_s<(bufoff) + 8192>((const char*)(gbase), (voff)[1], lds_base); } while (0)
#define PG8_LDA(dst, b, h) do { _Pragma("unroll") for (int m = 0; m < 4; ++m) _Pragma("unroll") for (int k = 0; k < 2; ++k) dst[m][k] = *(const LAS bf16x8*)(lds + PG8_SA(b, h) + aoff + m * 2048 + k * 1024); } while (0)
#define PG8_LDB(dst, b, h) do { _Pragma("unroll") for (int n = 0; n < 2; ++n) _Pragma("unroll") for (int k = 0; k < 2; ++k) dst[n][k] = *(const LAS bf16x8*)(lds + PG8_SB(b, h) + boff + n * 2048 + k * 1024); } while (0)
#define PG8_MMA(ai, bj, At, Bt) do { __builtin_amdgcn_s_setprio(1); _Pragma("unroll") for (int m = 0; m < 4; ++m) _Pragma("unroll") for (int n = 0; n < 2; ++n) { \
        if constexpr (FP8) { const i32x4 b_lo = __builtin_bit_cast(i32x4, Bt[n][0]), b_hi = __builtin_bit_cast(i32x4, Bt[n][1]), a_lo = __builtin_bit_cast(i32x4, At[m][0]), a_hi = __builtin_bit_cast(i32x4, At[m][1]); \
            acc[ai][bj][m][n] = __builtin_amdgcn_mfma_scale_f32_16x16x128_f8f6f4(__builtin_shufflevector(b_lo, b_hi, 0, 1, 2, 3, 4, 5, 6, 7), __builtin_shufflevector(a_lo, a_hi, 0, 1, 2, 3, 4, 5, 6, 7), acc[ai][bj][m][n], 0, 0, 0, Epi::SCALE_B, 0, Epi::SCALE_A); } \
        else { _Pragma("unroll") for (int k = 0; k < 2; ++k) acc[ai][bj][m][n] = __builtin_amdgcn_mfma_f32_16x16x32_bf16(Bt[n][k], At[m][k], acc[ai][bj][m][n], 0, 0, 0); } } \
        __builtin_amdgcn_s_setprio(0); } while (0)
#define PG8_WAIT_V(n) asm volatile("s_waitcnt vmcnt(" #n ")" ::: "memory")
#define PG8_WAIT_L(n) asm volatile("s_waitcnt lgkmcnt(" #n ")" ::: "memory")
#define PG8_BAR __builtin_amdgcn_s_barrier()
#define PG8_SCHED __builtin_amdgcn_sched_barrier(0)
    Unit cur, nxt; int ui = 0;
    if (!S.next(0, cur)) return;
    f32x4 acc[2][2][4][2];
#pragma unroll
    for (int a = 0; a < 2; ++a)
#pragma unroll
        for (int b = 0; b < 2; ++b)
#pragma unroll
            for (int m = 0; m < 4; ++m)
#pragma unroll
                for (int n = 0; n < 2; ++n) acc[a][b][m][n] = (f32x4){0.f, 0.f, 0.f, 0.f};
    bf16x8 At[4][2], B0[2][2], B1[2][2];
    const char* cA = (const char*)g.A + (size_t)cur.pm * tstepA; const char* cB = (const char*)g.Bt + (size_t)cur.pn * tstepB;
    S.a_ready(cur);
    if constexpr (SP2) {
        PG8_STAGE(PG8_SB(0, 0), cB, voffB); PG8_STAGE(PG8_SB(0, 1), cB + hstepB, voffB); PG8_STAGE(PG8_SA(0, 0), cA, voffA); PG8_STAGE(PG8_SA(0, 1), cA + hstepA, voffA);
        if (wr == 1) PG8_BAR;
        PG8_WAIT_V(2); PG8_BAR;
        PG8_STAGE(PG8_SB(1, 0), cB + kstep, voffB); PG8_STAGE(PG8_SA(1, 0), cA + kstep, voffA); PG8_STAGE(PG8_SB(1, 1), cB + hstepB + kstep, voffB);
        PG8_WAIT_V(6); PG8_BAR;
    } else {
        PG8_STAGE(PG8_SB(0, 0), cB, voffB); PG8_STAGE(PG8_SA(0, 0), cA, voffA); PG8_STAGE(PG8_SB(0, 1), cB + hstepB, voffB); PG8_STAGE(PG8_SA(0, 1), cA + hstepA, voffA);
        if (wr == 1) PG8_BAR;
        PG8_WAIT_V(4); PG8_BAR;
        PG8_STAGE(PG8_SB(1, 0), cB + kstep, voffB); PG8_STAGE(PG8_SA(1, 0), cA + kstep, voffA); PG8_STAGE(PG8_SB(1, 1), cB + hstepB + kstep, voffB);
        PG8_WAIT_V(6); PG8_BAR;
    }
    for (;;) {
        const bool has_next = S.next(ui + 1, nxt);
        const char* nA = has_next ? (const char*)g.A + (size_t)nxt.pm * tstepA : cA; const char* nB = has_next ? (const char*)g.Bt + (size_t)nxt.pn * tstepB : cB;
#pragma clang loop unroll(disable)
        for (int t = 0; t < nt; t += 2) {
            const bool last = (t == nt - 2);
            const char* a1 = cA + (size_t)(t + 1) * kstep;
            const char* a2 = last ? nA : cA + (size_t)(t + 2) * kstep; const char* b2 = last ? nB : cB + (size_t)(t + 2) * kstep;
            const char* a3 = a2 + kstep; const char* b3 = b2 + kstep;
            if (last && has_next) S.a_ready(nxt);
            if constexpr (SP2) {
            PG8_LDB(B0, 0, 0); PG8_LDB(B1, 0, 1); PG8_SCHED; PG8_LDA(At, 0, 0); PG8_STAGE(PG8_SA(1, 1), a1 + hstepA, voffA);
            PG8_WAIT_V(8); PG8_WAIT_L(0); PG8_BAR; PG8_MMA(0, 0, At, B0); PG8_MMA(0, 1, At, B1); PG8_BAR; PG8_SCHED;
            PG8_LDA(At, 0, 1); PG8_STAGE(PG8_SB(0, 0), b2, voffB); PG8_STAGE(PG8_SB(0, 1), b2 + hstepB, voffB); PG8_STAGE(PG8_SA(0, 0), a2, voffA);
            PG8_WAIT_V(8); PG8_WAIT_L(0); PG8_BAR; PG8_MMA(1, 0, At, B0); PG8_MMA(1, 1, At, B1); PG8_BAR; PG8_SCHED;
            PG8_LDB(B0, 1, 0); PG8_LDB(B1, 1, 1); PG8_SCHED; PG8_LDA(At, 1, 0); PG8_STAGE(PG8_SA(0, 1), a2 + hstepA, voffA);
            PG8_WAIT_V(8); PG8_WAIT_L(0); PG8_BAR; PG8_MMA(0, 0, At, B0); PG8_MMA(0, 1, At, B1); PG8_BAR; PG8_SCHED;
            PG8_LDA(At, 1, 1); PG8_STAGE(PG8_SB(1, 0), b3, voffB); PG8_STAGE(PG8_SB(1, 1), b3 + hstepB, voffB); PG8_STAGE(PG8_SA(1, 0), a3, voffA);
            PG8_WAIT_V(8); PG8_WAIT_L(0); PG8_BAR; PG8_MMA(1, 0, At, B0); PG8_MMA(1, 1, At, B1); PG8_BAR; PG8_SCHED;
            } else {
            PG8_LDB(B0, 0, 0); PG8_SCHED; PG8_LDA(At, 0, 0); PG8_STAGE(PG8_SA(1, 1), a1 + hstepA, voffA);
            PG8_WAIT_L(8); PG8_BAR; PG8_WAIT_L(0); PG8_MMA(0, 0, At, B0); PG8_BAR; PG8_SCHED;
            PG8_LDB(B1, 0, 1); PG8_STAGE(PG8_SB(0, 0), b2, voffB);
            PG8_BAR; PG8_WAIT_L(0); PG8_MMA(0, 1, At, B1); PG8_BAR;
            PG8_LDA(At, 0, 1); PG8_STAGE(PG8_SA(0, 0), a2, voffA);
            PG8_BAR; PG8_WAIT_L(0); PG8_MMA(1, 0, At, B0); PG8_BAR; PG8_SCHED;
            PG8_STAGE(PG8_SB(0, 1), b2 + hstepB, voffB);
            PG8_WAIT_V(6); PG8_BAR; PG8_MMA(1, 1, At, B1); PG8_BAR;
            PG8_LDB(B0, 1, 0); PG8_SCHED; PG8_LDA(At, 1, 0); PG8_STAGE(PG8_SA(0, 1), a2 + hstepA, voffA);
            PG8_WAIT_L(8); PG8_BAR; PG8_WAIT_L(0); PG8_MMA(0, 0, At, B0); PG8_BAR; PG8_SCHED;
            PG8_LDB(B1, 1, 1); PG8_STAGE(PG8_SB(1, 0), b3, voffB);
            PG8_BAR; PG8_WAIT_L(0); PG8_MMA(0, 1, At, B1); PG8_BAR;
            PG8_LDA(At, 1, 1); PG8_STAGE(PG8_SA(1, 0), a3, voffA);
            PG8_BAR; PG8_WAIT_L(0); PG8_MMA(1, 0, At, B0); PG8_BAR; PG8_SCHED;
            PG8_STAGE(PG8_SB(1, 1), b3 + hstepB, voffB);
            PG8_WAIT_V(6); PG8_BAR; PG8_MMA(1, 1, At, B1); PG8_BAR;
            }
        }
        if constexpr (ALIGN_EPI) { if (wr == 0) PG8_BAR; }
        { int l2 = threadIdx.x; asm volatile("" : "+v"(l2)); l2 &= 63; E(acc, cur, wr, wc, l2 & 15, l2 >> 4); }
        S.done(cur);
        if (!has_next) break;
#pragma unroll
        for (int a = 0; a < 2; ++a)
#pragma unroll
            for (int b = 0; b < 2; ++b)
#pragma unroll
                for (int m = 0; m < 4; ++m)
#pragma unroll
                    for (int n = 0; n < 2; ++n) acc[a][b][m][n] = (f32x4){0.f, 0.f, 0.f, 0.f};
        cur = nxt; cA = nA; cB = nB; ++ui;
        if constexpr (ALIGN_EPI) { if (wr == 1) PG8_BAR; }
    }
    PG8_WAIT_V(0);
    if constexpr (!ALIGN_EPI) { if (wr == 0) PG8_BAR; }
    PG8_BAR;
#undef PG8_SA
#undef PG8_SB
#undef PG8_STAGE
#undef PG8_LDA
#undef PG8_LDB
#undef PG8_MMA
#undef PG8_WAIT_V
#undef PG8_WAIT_L
#undef PG8_BAR
#undef PG8_SCHED
}
}

#define XB_TMO      128
#define XB_XCNT(j)  (256  + 64 * (j))
#define XB_XSUB(j)  (1280 + 64 * (j))
#define XB_XGEN(j)  (2304 + 64 * (j))
#define XB_TOP      3328
#define XB_TOPGEN   3392
#define XCD_BAR_WORDS 3456
#define XB_SPIN_CAP (1u << 18)
__device__ __forceinline__ unsigned xb_ld(unsigned* p)              { return __hip_atomic_load(p, __ATOMIC_RELAXED, __HIP_MEMORY_SCOPE_AGENT); }
__device__ __forceinline__ unsigned xb_add(unsigned* p, unsigned v) { return __hip_atomic_fetch_add(p, v, __ATOMIC_RELAXED, __HIP_MEMORY_SCOPE_AGENT); }
__device__ __forceinline__ unsigned xb_xcc_id() { return (unsigned)__builtin_amdgcn_s_getreg((3 << 11) | 20) & 0xFu; }
#define XB_SPIN(cond, bar) do { unsigned _sp = 0; while (cond) { __builtin_amdgcn_s_sleep(1); \
    if ((++_sp & 255u) == 0u) { if (xb_ld(&(bar)[XB_TMO])) break; if (_sp > XB_SPIN_CAP) { atomicAdd(&(bar)[XB_TMO], 1u); break; } } } } while (0)
struct XcdBarrier { unsigned* bar; unsigned x; volatile LAS unsigned* st; };
__device__ __forceinline__ XcdBarrier xcd_barrier_post(unsigned* bar, volatile LAS unsigned* st) {
    XcdBarrier b; b.bar = bar; b.x = xb_xcc_id(); b.st = st;
    if (threadIdx.x == 0) (void)xb_add(&bar[XB_XCNT(b.x)], 1u);
    return b;
}
__device__ __forceinline__ void xcd_barrier_complete(unsigned* bar, unsigned x, unsigned& nloc, unsigned& nx) {
    const unsigned G = gridDim.x * gridDim.y * gridDim.z;
    unsigned sum, cnt, mine, sp = 0u;
    for (;;) {
        sum = 0u; cnt = 0u; mine = 0u;
#pragma unroll
        for (unsigned j = 0; j < 16; ++j) { const unsigned c = xb_ld(&bar[XB_XCNT(j)]); sum += c; cnt += (c > 0u) ? 1u : 0u; mine = (j == x) ? c : mine; }
        if (sum == G) break;
        __builtin_amdgcn_s_sleep(1);
        if ((++sp & 255u) == 0u) { if (xb_ld(&bar[XB_TMO])) break; if (sp > XB_SPIN_CAP) { atomicAdd(&bar[XB_TMO], 1u); break; } }
    }
    nloc = mine > 0u ? mine : 1u; nx = cnt > 0u ? cnt : 1u;
}
__device__ __forceinline__ void xcd_barrier(const XcdBarrier& b) {
    asm volatile("s_waitcnt vmcnt(0)" ::: "memory");
    __syncthreads();
    if (threadIdx.x == 0) {
        unsigned* bar = b.bar;
        __builtin_amdgcn_s_waitcnt(0);
        unsigned nloc = b.st[0], nx = b.st[1];
        if (nloc == 0u) { xcd_barrier_complete(bar, b.x, nloc, nx); b.st[0] = nloc; b.st[1] = nx; }
        const unsigned old = xb_add(&bar[XB_XSUB(b.x)], 1u);
        const unsigned gen = old / nloc;
        if (old + 1u == (gen + 1u) * nloc) {
            __builtin_amdgcn_fence(__ATOMIC_RELEASE, "agent");
            asm volatile("s_waitcnt vmcnt(0)" ::: "memory");
            const unsigned og = xb_add(&bar[XB_TOP], 1u);
            const unsigned tg = og / nx;
            if (og + 1u == (tg + 1u) * nx) xb_add(&bar[XB_TOPGEN], 1u);
            else XB_SPIN(xb_ld(&bar[XB_TOPGEN]) == tg, bar);
            __builtin_amdgcn_fence(__ATOMIC_ACQUIRE, "agent");
            xb_add(&bar[XB_XGEN(b.x)], 1u);
            asm volatile("s_waitcnt vmcnt(0)" ::: "memory");
        } else {
            XB_SPIN(xb_ld(&bar[XB_XGEN(b.x)]) == gen, bar);
            __builtin_amdgcn_fence(__ATOMIC_ACQUIRE, "agent");
            asm volatile("s_waitcnt vmcnt(0)" ::: "memory");
        }
    }
    __syncthreads();
}

struct Params { const float* in[24]; float* out; unsigned char* ws; int ph_lo, ph_hi; };
enum { I_X = 0, I_RELB, I_EVNM, I_WIN, I_POOLW, I_POOLS, I_CONVW, I_WOUT, I_EVNF, I_FG, I_FU, I_FD, I_ODNM, I_WQKV, I_BQKV, I_SINK, I_WO, I_BO, I_ODNF, I_ROUTER, I_EG, I_EU, I_ED, I_FINAL };

__device__ __forceinline__ void p0_tile(const float* __restrict__ src, int N, int k0, int n0, bf16_t* __restrict__ dst, int ldd, LAS unsigned char* scr, int lane, const float* __restrict__ gain = nullptr) {
    const int n4 = (lane & 15) * 4, kp = lane >> 4;
    f32x4 a[8], b[8];
#pragma unroll
    for (int i = 0; i < 8; ++i) { const float* p = src + (size_t)(k0 + 8 * i + 2 * kp) * N + n0 + n4; a[i] = *(const f32x4*)p; b[i] = *(const f32x4*)(p + N);
        if (gain) { a[i] = a[i] * gain[k0 + 8 * i + 2 * kp]; b[i] = b[i] * gain[k0 + 8 * i + 2 * kp + 1]; } }
#pragma unroll
    for (int i = 0; i < 8; ++i) { const int k = 8 * i + 2 * kp;
#pragma unroll
        for (int q = 0; q < 4; ++q) *(LAS unsigned*)(scr + (n4 + q) * 136 + k * 2) = pk2(a[i][q], b[i][q]); }
    LDS_WAIT();
    const int c = lane & 7, nr = lane >> 3;
#pragma unroll
    for (int j = 0; j < 8; ++j) { const int n = 8 * j + nr; const u32x2 lo = *(const LAS u32x2*)(scr + n * 136 + 16 * c), hi = *(const LAS u32x2*)(scr + n * 136 + 16 * c + 8);
        u32x4 o; o.x = lo.x; o.y = lo.y; o.z = hi.x; o.w = hi.y; *(u32x4*)(dst + (size_t)n * ldd + 8 * c) = o; }
    LDS_WAIT();
}
__device__ __forceinline__ void p0_tile8(const float* __restrict__ src, int N, int k0, int n0, unsigned char* __restrict__ dst, int ldd, float scale, LAS unsigned char* scr, int lane) {
    const int n4 = (lane & 7) * 4, kq = lane >> 3;
    f32x4 a[4][4];
#pragma unroll
    for (int i = 0; i < 4; ++i)
#pragma unroll
        for (int j = 0; j < 4; ++j) a[i][j] = *(const f32x4*)(src + (size_t)(k0 + 32 * i + 4 * kq + j) * N + n0 + n4);
#pragma unroll
    for (int i = 0; i < 4; ++i)
#pragma unroll
        for (int q = 0; q < 4; ++q) *(LAS unsigned*)(scr + (n4 + q) * 144 + 32 * i + 4 * kq) = pg8::pk4_fp8(a[i][0][q] * scale, a[i][1][q] * scale, a[i][2][q] * scale, a[i][3][q] * scale);
    LDS_WAIT();
    const int c = lane & 7, nr = lane >> 3;
#pragma unroll
    for (int j = 0; j < 4; ++j) { const int n = 8 * j + nr; *(u32x4*)(dst + (size_t)n * ldd + 16 * c) = *(const LAS u32x4*)(scr + n * 144 + 16 * c); }
    LDS_WAIT();
}
__device__ __forceinline__ void norm_row_bf16(const float* __restrict__ xrow, const float* __restrict__ gain, bf16_t* __restrict__ orow, int lane, float (&y)[16]) {
    f32x4 v[4];
#pragma unroll
    for (int j = 0; j < 2; ++j) { v[2 * j] = *(const f32x4*)(xrow + 512 * j + 8 * lane); v[2 * j + 1] = *(const f32x4*)(xrow + 512 * j + 8 * lane + 4); }
    float s = 0.f;
#pragma unroll
    for (int j = 0; j < 4; ++j) s += (v[j][0] * v[j][0] + v[j][1] * v[j][1]) + (v[j][2] * v[j][2] + v[j][3] * v[j][3]);
    const float r = 1.0f / sqrtf(wave_sum(s) * (1.0f / D) + RMS_EPS);
#pragma unroll
    for (int j = 0; j < 2; ++j) { const f32x4 g0 = *(const f32x4*)(gain + 512 * j + 8 * lane), g1 = *(const f32x4*)(gain + 512 * j + 8 * lane + 4);
#pragma unroll
        for (int q = 0; q < 4; ++q) { y[8 * j + q] = v[2 * j][q] * r * g0[q]; y[8 * j + 4 + q] = v[2 * j + 1][q] * r * g1[q]; }
        u32x4 w; w.x = pk2(y[8 * j], y[8 * j + 1]); w.y = pk2(y[8 * j + 2], y[8 * j + 3]); w.z = pk2(y[8 * j + 4], y[8 * j + 5]); w.w = pk2(y[8 * j + 6], y[8 * j + 7]);
        *(u32x4*)(orow + 512 * j + 8 * lane) = w; }
}

__device__ __forceinline__ int t5_bucket(int rel) {
    const int n = rel < 0 ? -rel : rel; const int ret = rel > 0 ? 16 : 0;
    int v;
    if (n < 8) v = n; else if (n < 12) v = 8; else if (n < 16) v = 9; else if (n < 23) v = 10; else if (n < 32) v = 11; else if (n < 46) v = 12; else if (n < 64) v = 13; else if (n < 91) v = 14; else v = 15;
    return ret + v;
}

__global__ void __launch_bounds__(NTHR, 2) fwd_kernel(Params p) {
    extern __shared__ __attribute__((aligned(16))) unsigned char lds_raw[];
    LAS unsigned char* lds = (LAS unsigned char*)lds_raw;
    volatile LAS unsigned* MISC = (volatile LAS unsigned*)(lds + LDS_MISC_OFF);
    const int tid = threadIdx.x, lane = tid & 63, wave = __builtin_amdgcn_readfirstlane(tid >> 6);
    const int G = gridDim.x, bx = blockIdx.x;
    const int vcu = (G % 8 == 0) ? (bx % 8) * (G / 8) + bx / 8 : bx;
    const int gw = vcu * NWAVES + wave, NGW = G * NWAVES;
    unsigned char* ws = p.ws;
    unsigned* ctl = (unsigned*)(ws + WS_CTL);
    if (tid < 64) MISC[tid] = 0u;
    __syncthreads();
    XcdBarrier bar; bar.bar = ctl + CW_BAR; bar.x = 0; bar.st = nullptr;
    if (MK_N_LAUNCHES == 1) bar = xcd_barrier_post(ctl + CW_BAR, MISC + 8);
    const int lo = p.ph_lo, hi = p.ph_hi;
#define IN(k) (lo <= (k) && (k) < hi)
#define SEAM(k) do { if (MK_N_LAUNCHES == 1 && IN((k) + 1)) xcd_barrier(bar); } while (0)

    bf16_t* Win_t = (bf16_t*)(ws + WS_WIN); bf16_t* Wout_t = (bf16_t*)(ws + WS_WOUT); bf16_t* Wgu_t = (bf16_t*)(ws + WS_WGU); bf16_t* Wd_t = (bf16_t*)(ws + WS_WD);
    bf16_t* Wqkv_t = (bf16_t*)(ws + WS_WQKV); bf16_t* Wo_t = (bf16_t*)(ws + WS_WO); bf16_t* Wegu_t = (bf16_t*)(ws + WS_WEGU); bf16_t* Wed_t = (bf16_t*)(ws + WS_WED);
    bf16_t* XN = (bf16_t*)(ws + WS_XN); bf16_t* PROJ = (bf16_t*)(ws + WS_PROJ); bf16_t* MIXED = (bf16_t*)(ws + WS_MIXED); bf16_t* Hb = (bf16_t*)(ws + WS_H);
    bf16_t* QKV = (bf16_t*)(ws + WS_QKV); bf16_t* AO = (bf16_t*)(ws + WS_AO); bf16_t* HS = (bf16_t*)(ws + WS_HS); bf16_t* H2 = (bf16_t*)(ws + WS_H2);
    float* bias_tab = (float*)(ws + WS_BIAS); int* wgcnt = (int*)(ws + WS_WGCNT); int* tilemeta = (int*)(ws + WS_TILE);
    int* tok_e = (int*)(ws + WS_TOKE); float* tok_w = (float*)(ws + WS_TOKW); int* tok_r = (int*)(ws + WS_TOKR); int* slot_tok = (int*)(ws + WS_SLOTT); float* slot_w = (float*)(ws + WS_SLOTW);
    float* rss = (float*)(ws + WS_RSS);
    float* X = p.out;

    if (IN(0)) for (int rep_ = 0; rep_ < NREP(0); ++rep_) {
        const int tid = fresh_tid(), lane = tid & 63;
        LAS unsigned char* scr = lds + wave * 8704;
        constexpr int T_WIN = 16 * 32, T_WOUT = 8 * 16, T_FG = 16 * 44, T_FD = 44 * 16, T_QKV = 16 * 20, T_WO = 16 * 16;
        constexpr int T_EG = 8 * 112, T_ED = 28 * 32;
        constexpr int NT8 = NEXP * (2 * T_EG + T_ED);
        constexpr int NT = T_WIN + T_WOUT + 2 * T_FG + T_FD + T_QKV + T_WO;
        unsigned char* Wegu8 = (unsigned char*)Wegu_t; unsigned char* Wed8 = (unsigned char*)Wed_t;
        for (int it = gw; it < NT8; it += NGW) {
            const int per_e = 2 * T_EG + T_ED; const int e = it / per_e; int q = it % per_e;
            if (q < 2 * T_EG) { const int up = q >= T_EG; if (up) q -= T_EG; const int kb = q / 112, nb = q % 112, n0 = 32 * nb;
                p0_tile8(p.in[up ? I_EU : I_EG] + (size_t)e * D * DFE, DFE, 128 * kb, n0, Wegu8 + ((size_t)e * 2 * DFE + (n0 / 128) * 256 + (n0 % 128) + (up ? 128 : 0)) * D + 128 * kb, D, 64.f, scr, lane); }
            else { q -= 2 * T_EG; const int kb = q / 32, nb = q % 32;
                p0_tile8(p.in[I_ED] + (size_t)e * DFE * D, D, 128 * kb, 32 * nb, Wed8 + ((size_t)e * D + 32 * nb) * DFE + 128 * kb, DFE, 64.f, scr, lane); }
        }
        for (int it = gw; it < NT; it += NGW) {
            int r = it;
            if (r < T_WIN) { const int kb = r / 32, nb = r % 32; p0_tile(p.in[I_WIN], MIXN, 64 * kb, 64 * nb, Win_t + (size_t)(64 * nb) * D + 64 * kb, D, scr, lane); continue; } r -= T_WIN;
            if (r < T_WOUT) { const int kb = 8 + r / 16, nb = r % 16; p0_tile(p.in[I_WOUT], D, 64 * kb, 64 * nb, Wout_t + (size_t)(64 * nb) * D + 64 * kb, D, scr, lane); continue; } r -= T_WOUT;
            if (r < 2 * T_FG) { const int up = r >= T_FG; const int q = up ? r - T_FG : r; const int kb = q / 44, nb = q % 44, n0 = 64 * nb;
                p0_tile(p.in[up ? I_FU : I_FG], DFF, 64 * kb, n0, Wgu_t + (size_t)((n0 / 128) * 256 + (n0 % 128) + (up ? 128 : 0)) * D + 64 * kb, D, scr, lane, p.in[I_EVNF]); continue; } r -= 2 * T_FG;
            if (r < T_FD) { const int kb = r / 16, nb = r % 16; p0_tile(p.in[I_FD], D, 64 * kb, 64 * nb, Wd_t + (size_t)(64 * nb) * DFF + 64 * kb, DFF, scr, lane); continue; } r -= T_FD;
            if (r < T_QKV) { const int kb = r / 20, nb = r % 20; p0_tile(p.in[I_WQKV], QKVN, 64 * kb, 64 * nb, Wqkv_t + (size_t)(64 * nb) * D + 64 * kb, D, scr, lane, p.in[I_ODNM]); continue; } r -= T_QKV;
            { const int kb = r / 16, nb = r % 16; p0_tile(p.in[I_WO], D, 64 * kb, 64 * nb, Wo_t + (size_t)(64 * nb) * D + 64 * kb, D, scr, lane); }
        }
        for (int it = gw; it < 4 * 16 * 16; it += NGW) {
            const int g = it >> 8, cb = (it >> 4) & 15, nb = it & 15; const int n = 64 * nb + lane, c0 = 8 * cb;
            const float* wo = p.in[I_WOUT] + (size_t)(g * 128) * D + n; const float* ps = p.in[I_POOLS] + g * 128; const float* pw = p.in[I_POOLW] + (size_t)(g * 128 + c0) * 128;
            float acc[8];
#pragma unroll
            for (int cc = 0; cc < 8; ++cc) acc[cc] = 0.f;
            for (int d = 0; d < 128; ++d) { const float w = wo[(size_t)d * D] * ps[d];
#pragma unroll
                for (int cc = 0; cc < 8; ++cc) acc[cc] += pw[cc * 128 + d] * w; }
            *(u32x4*)(Wout_t + (size_t)n * D + g * 128 + c0) = pack8(acc);
        }
        for (int m = gw; m < M; m += NGW) { float y[16]; norm_row_bf16(p.in[I_X] + (size_t)m * D, p.in[I_EVNM], XN + (size_t)m * D, lane, y); }
        for (int i = bx * NTHR + tid; i < NQH * 256; i += G * NTHR) { const int h = i >> 8, idx = i & 255; bias_tab[i] = idx < 255 ? p.in[I_RELB][t5_bucket(idx - 191) * NQH + h] : 0.f; }
    }
    SEAM(0);

    if (IN(1)) for (int rep_ = 0; rep_ < NREP(1); ++rep_) { pg8::Gemm g{XN, Win_t, 2 * D, 2 * D, 2 * D}; pg8::DenseOrder S; S.init(M, MIXN, G, bx); pg8::EpiBf16 E{PROJ, MIXN, nullptr, nullptr};
        pg8::gemm_phase<pg8::EpiBf16, pg8::DenseOrder>(lds, g, S, E); }
    SEAM(1);

    if (IN(2)) for (int rep_ = 0; rep_ < NREP(2); ++rep_) {
        const int tid = fresh_tid(), lane = tid & 63;
        for (int unit = gw; unit < (M / 32) * 2; unit += NGW) {
            const int rb = unit >> 1, half = unit & 1, r0 = rb * 32, bs = r0 & ~(SEQ - 1);
            if (half == 0) {
                const int w = 2 << (lane >> 4); const bf16_t* P = PROJ + 8 * lane;
                float s[8];
#pragma unroll
                for (int q = 0; q < 8; ++q) s[q] = 0.f;
                for (int j = 1; j <= 16; ++j) if (j <= w && r0 - j >= bs) { float f[8]; unpack8(*(const u32x4*)(P + (size_t)(r0 - j) * MIXN), f);
#pragma unroll
                    for (int q = 0; q < 8; ++q) s[q] += f[q]; }
#pragma unroll 4
                for (int r = r0; r < r0 + 32; ++r) {
                    float cur[8], old[8]; unpack8(*(const u32x4*)(P + (size_t)r * MIXN), cur);
                    const bool has_old = (r - w >= bs);
                    if (has_old) unpack8(*(const u32x4*)(P + (size_t)(r - w) * MIXN), old);
                    const int pos = r - bs + 1; const float inv = 1.0f / (float)(pos < w ? pos : w);
                    float o[8];
#pragma unroll
                    for (int q = 0; q < 8; ++q) { s[q] += cur[q]; if (has_old) s[q] -= old[q]; o[q] = s[q] * inv - cur[q]; }
                    *(u32x4*)(MIXED + (size_t)r * D + 8 * lane) = pack8(o);
                }
            } else {
                const bf16_t* P = PROJ + 8 * lane;
                float w0[8], w1[8], w2[8], z1[8], z2[8];
                { const float* cw = p.in[I_CONVW] + 8 * lane;
#pragma unroll
                  for (int q = 0; q < 8; ++q) { w0[q] = cw[q]; w1[q] = cw[512 + q]; w2[q] = cw[1024 + q]; z1[q] = 0.f; z2[q] = 0.f; } }
                if (r0 - 1 >= bs) { float a[8], b[8]; unpack8(*(const u32x4*)(P + (size_t)(r0 - 1) * MIXN + 1024), a); unpack8(*(const u32x4*)(P + (size_t)(r0 - 1) * MIXN + 1536), b);
#pragma unroll
                    for (int q = 0; q < 8; ++q) z1[q] = a[q] * b[q]; }
                if (r0 - 2 >= bs) { float a[8], b[8]; unpack8(*(const u32x4*)(P + (size_t)(r0 - 2) * MIXN + 1024), a); unpack8(*(const u32x4*)(P + (size_t)(r0 - 2) * MIXN + 1536), b);
#pragma unroll
                    for (int q = 0; q < 8; ++q) z2[q] = a[q] * b[q]; }
#pragma unroll 4
                for (int r = r0; r < r0 + 32; ++r) {
                    float gp[8], a[8], b[8], o[8];
                    unpack8(*(const u32x4*)(P + (size_t)r * MIXN + 512), gp); unpack8(*(const u32x4*)(P + (size_t)r * MIXN + 1024), a); unpack8(*(const u32x4*)(P + (size_t)r * MIXN + 1536), b);
#pragma unroll
                    for (int q = 0; q < 8; ++q) { const float zc = a[q] * b[q]; o[q] = gp[q] * (w0[q] * z2[q] + w1[q] * z1[q] + w2[q] * zc); z2[q] = z1[q]; z1[q] = zc; }
                    *(u32x4*)(MIXED + (size_t)r * D + 512 + 8 * lane) = pack8(o);
                }
            }
        }
    }
    SEAM(2);

    if (IN(3)) for (int rep_ = 0; rep_ < NREP(3); ++rep_) { pg8::Gemm g{MIXED, Wout_t, 2 * D, 2 * D, 2 * D}; pg8::DenseOrder S; S.init(M, D, G, bx); pg8::EpiResid E{p.in[I_X], X, nullptr, XN, rss};
        pg8::gemm_phase<pg8::EpiResid, pg8::DenseOrder>(lds, g, S, E); }
    SEAM(3);


    if (IN(5)) for (int rep_ = 0; rep_ < NREP(5); ++rep_) { pg8::Gemm g{XN, Wgu_t, 2 * D, 2 * D, 2 * D}; pg8::DenseOrder S; S.init(M, 2 * DFF, G, bx); pg8::EpiSwiGLU E{Hb, DFF, rss};
        pg8::gemm_phase<pg8::EpiSwiGLU, pg8::DenseOrder>(lds, g, S, E); }
    SEAM(5);

    if (IN(6)) for (int rep_ = 0; rep_ < NREP(6); ++rep_) { pg8::Gemm g{Hb, Wd_t, 2 * DFF, 2 * DFF, 2 * DFF}; pg8::DenseOrder S; S.init(M, D, G, bx); pg8::EpiResid E{X, X, nullptr, XN, rss + (size_t)M * 16};
        pg8::gemm_phase<pg8::EpiResid, pg8::DenseOrder>(lds, g, S, E); }
    SEAM(6);


    if (IN(8)) for (int rep_ = 0; rep_ < NREP(8); ++rep_) { pg8::Gemm g{XN, Wqkv_t, 2 * D, 2 * D, 2 * D}; pg8::DenseOrder S; S.init(M, QKVN, G, bx); pg8::EpiBf16 E{QKV, QKVN, p.in[I_BQKV], rss + (size_t)M * 16};
        pg8::gemm_phase<pg8::EpiBf16, pg8::DenseOrder>(lds, g, S, E); }
    SEAM(8);

    if (IN(9)) for (int rep_ = 0; rep_ < NREP(9); ++rep_) {
        const int tid = fresh_tid(), lane = tid & 63;
        constexpr int KS_STR = 144, VT_STR = 392;
        constexpr int L_K = 0, L_VT = 192 * KS_STR, L_BT = L_VT + 64 * VT_STR, L_OST = L_BT + NQH * 256 * 4;
        static_assert(L_OST + NWAVES * 32 * 144 <= RING_BYTES, "attention LDS");
        for (int i = tid; i < NQH * 256; i += NTHR) *(LAS float*)(lds + L_BT + 4 * i) = bias_tab[i];
        const int r32 = lane & 31, hh = lane >> 5;
        for (int unit = vcu; unit < BATCH * (SEQ / CHUNK) * NKVH; unit += G) {
            const int kvh = unit & 1, n = (unit >> 1) & 255, b = unit >> 9;
            const int t0 = b * SEQ + n * CHUNK;
            __syncthreads();
#pragma unroll
            for (int i = 0; i < 3; ++i) { const int pc = tid + i * NTHR, j = pc >> 3, c = pc & 7; const bool valid = (n * CHUNK - 128 + j) >= 0;
                u32x4 kv = {0u, 0u, 0u, 0u}, vv = {0u, 0u, 0u, 0u};
                if (valid) { const bf16_t* src = QKV + (size_t)(t0 - 128 + j) * QKVN + 1024 + kvh * HD + 8 * c; kv = *(const u32x4*)src; vv = *(const u32x4*)(src + 128); }
                *(LAS u32x4*)(lds + L_K + j * KS_STR + 16 * c) = kv;
                const unsigned vw[4] = {vv.x, vv.y, vv.z, vv.w};
#pragma unroll
                for (int q = 0; q < 4; ++q) { *(LAS unsigned short*)(lds + L_VT + (8 * c + 2 * q) * VT_STR + 2 * j) = (unsigned short)(vw[q] & 0xffffu);
                                              *(LAS unsigned short*)(lds + L_VT + (8 * c + 2 * q + 1) * VT_STR + 2 * j) = (unsigned short)(vw[q] >> 16); } }
            __syncthreads();
            const int head = kvh * 8 + wave;
            const float sink = p.in[I_SINK][head];
            const LAS float* bt = (const LAS float*)(lds + L_BT + head * 1024);
            const int kb_min = n == 0 ? 4 : (n == 1 ? 2 : 0);
#pragma unroll 1
            for (int qb = 0; qb < 2; ++qb) {
                bf16x8 qf[4];
                { const bf16_t* qp = QKV + (size_t)(t0 + qb * 32 + r32) * QKVN + head * HD + 8 * hh;
#pragma unroll
                  for (int ks = 0; ks < 4; ++ks) qf[ks] = *(const bf16x8*)(qp + 16 * ks); }
                f32x16 st[6];
#pragma unroll
                for (int kb = 0; kb < 6; ++kb) {
#pragma unroll
                    for (int e = 0; e < 16; ++e) st[kb][e] = 0.f;
#pragma unroll
                    for (int ks = 0; ks < 4; ++ks) { const bf16x8 kf = *(const LAS bf16x8*)(lds + L_K + (kb * 32 + r32) * KS_STR + 32 * ks + 16 * hh);
                        st[kb] = __builtin_amdgcn_mfma_f32_32x32x16_bf16(kf, qf[ks], st[kb], 0, 0, 0); } }
                float mx = sink;
#pragma unroll
                for (int kb = 0; kb < 6; ++kb)
#pragma unroll
                    for (int e = 0; e < 16; ++e) { const int j = kb * 32 + (e & 3) + 8 * (e >> 2) + 4 * hh; const int idx = j - (qb * 32 + r32) + 63;
                        float sc = st[kb][e] * 0.125f + bt[idx]; sc = (kb < kb_min) ? -1e30f : sc; st[kb][e] = sc; mx = fmaxf(mx, sc); }
                mx = fmaxf(mx, __shfl_xor(mx, 32));
                float sum = 0.f;
#pragma unroll
                for (int kb = 0; kb < 6; ++kb)
#pragma unroll
                    for (int e = 0; e < 16; ++e) { const float pe = __builtin_amdgcn_exp2f((st[kb][e] - mx) * 1.44269504089f); st[kb][e] = pe; sum += pe; }
                sum += __shfl_xor(sum, 32);
                const float inv = 1.0f / (sum + __builtin_amdgcn_exp2f((sink - mx) * 1.44269504089f));
                f32x16 ot[2];
#pragma unroll
                for (int db = 0; db < 2; ++db)
#pragma unroll
                    for (int e = 0; e < 16; ++e) ot[db][e] = 0.f;
#pragma unroll
                for (int kb = 0; kb < 6; ++kb)
#pragma unroll
                    for (int s = 0; s < 2; ++s) {
                        u32x4 pw; pw.x = pk2(st[kb][8 * s], st[kb][8 * s + 1]); pw.y = pk2(st[kb][8 * s + 2], st[kb][8 * s + 3]); pw.z = pk2(st[kb][8 * s + 4], st[kb][8 * s + 5]); pw.w = pk2(st[kb][8 * s + 6], st[kb][8 * s + 7]);
                        const bf16x8 pf = __builtin_bit_cast(bf16x8, pw);
#pragma unroll
                        for (int db = 0; db < 2; ++db) { const LAS unsigned char* vp = lds + L_VT + (db * 32 + r32) * VT_STR + 2 * (kb * 32 + 16 * s + 4 * hh);
                            const u32x2 v0 = *(const LAS u32x2*)vp, v1 = *(const LAS u32x2*)(vp + 16);
                            u32x4 vw; vw.x = v0.x; vw.y = v0.y; vw.z = v1.x; vw.w = v1.y;
                            ot[db] = __builtin_amdgcn_mfma_f32_32x32x16_bf16(__builtin_bit_cast(bf16x8, vw), pf, ot[db], 0, 0, 0); } }
                LAS unsigned char* ost = lds + L_OST + wave * (32 * 144);
#pragma unroll
                for (int db = 0; db < 2; ++db)
#pragma unroll
                    for (int g4 = 0; g4 < 4; ++g4) { u32x2 w; w.x = pk2(ot[db][4 * g4] * inv, ot[db][4 * g4 + 1] * inv); w.y = pk2(ot[db][4 * g4 + 2] * inv, ot[db][4 * g4 + 3] * inv);
                        *(LAS u32x2*)(ost + r32 * 144 + 2 * (db * 32 + 8 * g4 + 4 * hh)) = w; }
                LDS_WAIT();
#pragma unroll
                for (int i = 0; i < 4; ++i) { const int q = 8 * i + (lane >> 3), c = lane & 7; const u32x4 w = *(const LAS u32x4*)(ost + q * 144 + 16 * c);
                    *(u32x4*)(AO + (size_t)(t0 + qb * 32 + q) * D + head * HD + 8 * c) = w; }
                LDS_WAIT();
            }
        }
        __syncthreads();
    }
    SEAM(9);

    if (IN(10)) for (int rep_ = 0; rep_ < NREP(10); ++rep_) { pg8::Gemm g{AO, Wo_t, 2 * D, 2 * D, 2 * D}; pg8::DenseOrder S; S.init(M, D, G, bx); pg8::EpiResid E{X, X, p.in[I_BO], nullptr, nullptr};
        pg8::gemm_phase<pg8::EpiResid, pg8::DenseOrder>(lds, g, S, E); }
    SEAM(10);

    const int RPW = (M + G - 1) / G;
    constexpr int L_RW = 0, L_RE = 32768, L_RWT = L_RE + 1024 * 4, L_RRK = L_RWT + 1024 * 4, L_CNT = L_RRK + 1024 * 4, L_SB = L_CNT + 64, L_SLOT = L_SB + 256;
    unsigned char* XN8 = (unsigned char*)XN;
    if (IN(11)) for (int rep_ = 0; rep_ < NREP(11); ++rep_) {
        const int tid = fresh_tid(), lane = tid & 63;
        for (int i = tid; i < D * NEXP; i += NTHR) { const int c = i >> 3, e = i & 7; *(LAS float*)(lds + L_RW + 4 * (e * D + c)) = p.in[I_ROUTER][i] * p.in[I_ODNF][c]; }
        if (tid < 8) *(LAS int*)(lds + L_CNT + 4 * tid) = 0;
        __syncthreads();
        const int rbase = bx * RPW;
        const int nrows = (M - rbase) < RPW ? (M - rbase) : RPW;
        f32x4 gn[4];
#pragma unroll
        for (int j = 0; j < 4; ++j) gn[j] = *(const f32x4*)(p.in[I_ODNF] + 256 * j + 4 * lane);
        for (int rl0 = wave; rl0 < nrows; rl0 += 4 * NWAVES) {
            f32x4 v[4][4];
#pragma unroll
            for (int u = 0; u < 4; ++u) { const int rl = rl0 + 8 * u; const int m = rbase + (rl < nrows ? rl : rl0);
#pragma unroll
                for (int j = 0; j < 4; ++j) v[u][j] = *(const f32x4*)(X + (size_t)m * D + 256 * j + 4 * lane); }
#pragma unroll
            for (int u = 0; u < 4; ++u) { const int rl = rl0 + 8 * u; if (rl >= nrows) continue; const int m = rbase + rl;
                float s2 = 0.f;
#pragma unroll
                for (int j = 0; j < 4; ++j) s2 += (v[u][j][0] * v[u][j][0] + v[u][j][1] * v[u][j][1]) + (v[u][j][2] * v[u][j][2] + v[u][j][3] * v[u][j][3]);
                const float r = 1.0f / sqrtf(wave_sum(s2) * (1.0f / D) + RMS_EPS);
                float lg[8];
#pragma unroll
                for (int e = 0; e < 8; ++e) { float a = 0.f;
#pragma unroll
                    for (int j = 0; j < 4; ++j) { const f32x4 w = *(const LAS f32x4*)(lds + L_RW + 4096 * e + 1024 * j + 16 * lane); a += (v[u][j][0] * w[0] + v[u][j][1] * w[1]) + (v[u][j][2] * w[2] + v[u][j][3] * w[3]); }
                    lg[e] = a; }
#pragma unroll
                for (int e = 0; e < 8; ++e) lg[e] = wave_sum(lg[e]) * r;
#pragma unroll
                for (int j = 0; j < 4; ++j) { const f32x4 y = v[u][j] * r * gn[j]; *(unsigned*)(XN8 + (size_t)m * D + 256 * j + 4 * lane) = pg8::pk4_fp8(y[0], y[1], y[2], y[3]); }
                int e0 = 0; float v0 = lg[0];
#pragma unroll
                for (int e = 1; e < 8; ++e) if (lg[e] > v0) { v0 = lg[e]; e0 = e; }
                int e1 = -1; float v1 = -3.0e38f;
#pragma unroll
                for (int e = 0; e < 8; ++e) if (e != e0 && lg[e] > v1) { v1 = lg[e]; e1 = e; }
                const float wt0 = 1.0f / (1.0f + __expf(v1 - v0));
                if (lane == 0) { *(LAS int*)(lds + L_RE + 8 * rl) = e0; *(LAS int*)(lds + L_RE + 8 * rl + 4) = e1; *(LAS float*)(lds + L_RWT + 8 * rl) = wt0; *(LAS float*)(lds + L_RWT + 8 * rl + 4) = 1.0f - wt0; }
            }
        }
        __syncthreads();
        for (int en = tid; en < 2 * nrows; en += NTHR) {
            const int e = *(LAS int*)(lds + L_RE + 4 * en); int r = 0;
            for (int j = 0; j < en; ++j) r += (*(LAS int*)(lds + L_RE + 4 * j) == e);
            *(LAS int*)(lds + L_RRK + 4 * en) = r;
            __hip_atomic_fetch_add((LAS int*)(lds + L_CNT + 4 * e), 1, __ATOMIC_RELAXED, __HIP_MEMORY_SCOPE_WORKGROUP);
        }
        __syncthreads();
        if (tid < 8) wgcnt[bx * 8 + tid] = *(LAS int*)(lds + L_CNT + 4 * tid);
        __syncthreads();
    }
    SEAM(11);

    if (IN(12)) for (int rep_ = 0; rep_ < NREP(12); ++rep_) {
        const int tid = fresh_tid(), lane = tid & 63;
        LAS int* sb = (LAS int*)(lds + L_SB);
        if (tid < 32) sb[tid] = 0;
        __syncthreads();
        for (int i = tid; i < G * 2; i += NTHR) { const int w = i >> 1, h4 = (i & 1) * 4; const u32x4 c = *(const u32x4*)(wgcnt + w * 8 + h4); const unsigned cv[4] = {c.x, c.y, c.z, c.w};
#pragma unroll
            for (int q = 0; q < 4; ++q) { __hip_atomic_fetch_add(sb + 16 + h4 + q, (int)cv[q], __ATOMIC_RELAXED, __HIP_MEMORY_SCOPE_WORKGROUP); if (w < bx) __hip_atomic_fetch_add(sb + 8 + h4 + q, (int)cv[q], __ATOMIC_RELAXED, __HIP_MEMORY_SCOPE_WORKGROUP); } }
        __syncthreads();
        if (tid == 0) { int base = 0; for (int e = 0; e < 8; ++e) { sb[e] = base; base += (sb[16 + e] + 255) & ~255; } sb[24] = base; }
        __syncthreads();
        const int rbase = bx * RPW;
        const int nrows = (M - rbase) < RPW ? (M - rbase) : RPW;
        unsigned char* HS8 = (unsigned char*)HS;
        for (int en = tid; en < 2 * nrows; en += NTHR) { const int e = *(LAS int*)(lds + L_RE + 4 * en); const int slot = sb[e] + sb[8 + e] + *(LAS int*)(lds + L_RRK + 4 * en);
            *(LAS int*)(lds + L_SLOT + 4 * en) = slot; slot_tok[slot] = 2 * (rbase + (en >> 1)) + (en & 1); slot_w[slot] = *(LAS float*)(lds + L_RWT + 4 * en); }
        __syncthreads();
        for (int en0 = wave; en0 < 2 * nrows; en0 += 4 * NWAVES) {
            u32x4 t[4];
#pragma unroll
            for (int u = 0; u < 4; ++u) { const int en = en0 + 8 * u; if (en < 2 * nrows) t[u] = *(const u32x4*)(XN8 + (size_t)(rbase + (en >> 1)) * D + 16 * lane); }
#pragma unroll
            for (int u = 0; u < 4; ++u) { const int en = en0 + 8 * u; if (en < 2 * nrows) *(u32x4*)(HS8 + (size_t)(*(LAS int*)(lds + L_SLOT + 4 * en)) * D + 16 * lane) = t[u]; } }
        if (bx == 0) {
            for (int e = 0; e < 8; ++e) { const int b0 = sb[e] + sb[16 + e], b1 = sb[e] + ((sb[16 + e] + 255) & ~255); for (int i = b0 + tid; i < b1; i += NTHR) { slot_tok[i] = -1; slot_w[i] = 0.f; } }
            const int nt_all = sb[24] >> 8;
            for (int j = tid; j < nt_all; j += NTHR) { int e = 0; for (int q = 1; q < 8; ++q) if ((j << 8) >= sb[q]) e = q; tilemeta[8 + j] = e; }
            if (tid == 0) { tilemeta[0] = nt_all; tilemeta[1] = nt_all; }
        }
        __syncthreads();
    }
    SEAM(12);

    if (IN(13) || IN(14)) {
        const int tid = fresh_tid();
        for (int j = tid; j < 288; j += NTHR) *(LAS int*)(lds + LDS_TILE_OFF + 4 * j) = (j < MAXTILES + 8) ? tilemeta[j] : 0;
        __syncthreads();
    }
    const LAS int* tmeta = (const LAS int*)(lds + LDS_TILE_OFF);
    if (IN(13)) for (int rep_ = 0; rep_ < NREP(13); ++rep_) {
        const int nall = __builtin_amdgcn_readfirstlane(tmeta[0]);
        pg8::Gemm g{HS, Wegu_t, D, D, D}; pg8::MoeOrder S; S.T.init(nall, NFE_T, G, bx); S.tpe = NFE_T; S.tile_e = tmeta + 8;
        pg8::EpiSwiGLU8 E{(unsigned char*)H2, DFE};
        pg8::gemm_phase<pg8::EpiSwiGLU8, pg8::MoeOrder, true>(lds, g, S, E);
    }
    SEAM(13);
    if (IN(14)) {
        const int nall = __builtin_amdgcn_readfirstlane(tmeta[0]);
        pg8::Gemm g{H2, Wed_t, DFE, DFE, DFE}; pg8::MoeOrder S; S.T.init(nall, D / 256, G, bx); S.tpe = D / 256; S.tile_e = tmeta + 8;
        pg8::EpiMoeDown E{X, (bf16_t*)(ws + WS_Y0), slot_tok, slot_w};
        pg8::gemm_phase<pg8::EpiMoeDown, pg8::MoeOrder, true>(lds, g, S, E);
    }
    SEAM(14);

    if (IN(15)) {
        const int lane = fresh_tid() & 63;
        const bf16_t* Y0 = (const bf16_t*)(ws + WS_Y0);
        for (int m = gw; m < M; m += NGW) {
            float* xrow = X + (size_t)m * D; f32x4 v[4];
#pragma unroll
            for (int j = 0; j < 2; ++j) { v[2 * j] = *(const f32x4*)(xrow + 512 * j + 8 * lane); v[2 * j + 1] = *(const f32x4*)(xrow + 512 * j + 8 * lane + 4);
                float f[8]; unpack8(*(const u32x4*)(Y0 + (size_t)m * D + 512 * j + 8 * lane), f);
#pragma unroll
                for (int q = 0; q < 4; ++q) { v[2 * j][q] += f[q]; v[2 * j + 1][q] += f[4 + q]; } }
            float s2 = 0.f;
#pragma unroll
            for (int j = 0; j < 4; ++j) s2 += (v[j][0] * v[j][0] + v[j][1] * v[j][1]) + (v[j][2] * v[j][2] + v[j][3] * v[j][3]);
            const float r = 1.0f / sqrtf(wave_sum(s2) * (1.0f / D) + RMS_EPS);
#pragma unroll
            for (int j = 0; j < 2; ++j) { const f32x4 g0 = *(const f32x4*)(p.in[I_FINAL] + 512 * j + 8 * lane), g1 = *(const f32x4*)(p.in[I_FINAL] + 512 * j + 8 * lane + 4);
                *(f32x4*)(xrow + 512 * j + 8 * lane) = v[2 * j] * r * g0; *(f32x4*)(xrow + 512 * j + 8 * lane + 4) = v[2 * j + 1] * r * g1; }
        }
    }
#undef IN
#undef SEAM
}

extern "C" void kernel_launch(void* const* d_in, const int* in_sizes, int n_in, void* d_out, int out_size, void* d_ws, size_t ws_size, hipStream_t stream) {
    static int grid = 0;
    if (grid == 0) {
        if (n_in != 24 || in_sizes[0] != M * D || out_size != M * D || ws_size < WS_END) { fprintf(stderr, "kernel_launch: unexpected shapes (n_in %d, in0 %d, out %d, ws %zu < %zu)\n", n_in, n_in > 0 ? in_sizes[0] : -1, out_size, ws_size, (size_t)WS_END); grid = -1; return; }
        int dev = 0, cus = 0, per_cu = 0;
        if (hipGetDevice(&dev) != hipSuccess || hipDeviceGetAttribute(&cus, hipDeviceAttributeMultiprocessorCount, dev) != hipSuccess) { grid = -1; return; }
        if (hipFuncSetAttribute((const void*)fwd_kernel, hipFuncAttributeMaxDynamicSharedMemorySize, LDS_BYTES) != hipSuccess) { fprintf(stderr, "kernel_launch: hipFuncSetAttribute failed\n"); grid = -1; return; }
        if (hipOccupancyMaxActiveBlocksPerMultiprocessor(&per_cu, (const void*)fwd_kernel, NTHR, LDS_BYTES) != hipSuccess || per_cu < 1) fprintf(stderr, "kernel_launch: occupancy query reports %d\n", per_cu);
        (void)hipGetLastError();
        grid = cus < 256 ? cus : 256;
    }
    if (grid < 0) return;
    (void)hipMemsetAsync((char*)d_ws + WS_CTL, 0, CTL_ZERO_BYTES, stream);
    Params a{};
    for (int i = 0; i < 24; ++i) a.in[i] = (const float*)d_in[i];
    a.out = (float*)d_out; a.ws = (unsigned char*)d_ws;
    constexpr int NPH = 16;
    if (MK_N_LAUNCHES == 1) { a.ph_lo = 0; a.ph_hi = NPH; hipLaunchKernelGGL(fwd_kernel, dim3(grid), dim3(NTHR), LDS_BYTES, stream, a); }
    else for (int li = 0; li < NPH; ++li) { a.ph_lo = li; a.ph_hi = li + 1; hipLaunchKernelGGL(fwd_kernel, dim3(grid), dim3(NTHR), LDS_BYTES, stream, a); }
}
```

```cpp
#include <hip/hip_runtime.h>
#include <cstdio>
#include <cstdint>

#ifndef MK_N_LAUNCHES
#define MK_N_LAUNCHES 1
#endif

#ifndef REPMASK
#define REPMASK 0u
#endif
#define NREP(k) ((((REPMASK) >> (k)) & 1u) ? 2 : 1)
#define LAS __attribute__((address_space(3)))
#define GAS __attribute__((address_space(1)))
typedef unsigned short bf16_t;
typedef short bf16x8 __attribute__((ext_vector_type(8)));
typedef short s16x4 __attribute__((ext_vector_type(4)));
typedef float f32x2 __attribute__((ext_vector_type(2)));
typedef float f32x4 __attribute__((ext_vector_type(4)));
typedef float f32x16 __attribute__((ext_vector_type(16)));
typedef unsigned u32x2 __attribute__((ext_vector_type(2)));
typedef unsigned u32x4 __attribute__((ext_vector_type(4)));
typedef __bf16 hbf16x2 __attribute__((ext_vector_type(2)));
typedef int i32x4 __attribute__((ext_vector_type(4)));
typedef int i32x8 __attribute__((ext_vector_type(8)));

constexpr int D = 1024, BATCH = 2, SEQ = 16384, M = BATCH * SEQ;
constexpr int MIXN = 2048;
constexpr int DFF = 2816, NFF_T = DFF / 128;
constexpr int QKVN = 1280, NQH = 16, NKVH = 2, HD = 64, CHUNK = 64, KVSPAN = 192;
constexpr int NEXP = 8, DFE = 3584, NFE_T = DFE / 128;
constexpr float RMS_EPS = 1e-6f;
constexpr int MAXSLOT = 67328;
constexpr int MAXTILES = MAXSLOT / 256;
constexpr int NWAVES = 8, NTHR = 512;

constexpr size_t MiB = 1u << 20;
constexpr size_t WS_CTL = 0, CTL_ZERO_BYTES = 1 * MiB;
constexpr size_t WS_BIAS = 1 * MiB;
constexpr size_t WS_WGCNT = WS_BIAS + 16 * 256 * 4;
constexpr size_t WS_TILE = WS_WGCNT + 1024 * 16 * 4;
constexpr size_t WS_TOKE = WS_TILE + 4096;
constexpr size_t WS_TOKW = WS_TOKE + 2 * (size_t)M * 4;
constexpr size_t WS_TOKR = WS_TOKW + 2 * (size_t)M * 4;
constexpr size_t WS_SLOTT = WS_TOKR + 2 * (size_t)M * 4;
constexpr size_t WS_SLOTW = WS_SLOTT + (size_t)MAXSLOT * 4;
static_assert(WS_SLOTW + (size_t)MAXSLOT * 4 <= 4 * MiB, "route region");
constexpr size_t WS_WIN = 4 * MiB;
constexpr size_t WS_WOUT = WS_WIN + (size_t)MIXN * D * 2;
constexpr size_t WS_WGU = WS_WOUT + (size_t)D * D * 2;
constexpr size_t WS_WD = WS_WGU + (size_t)2 * DFF * D * 2;
constexpr size_t WS_WQKV = WS_WD + (size_t)D * DFF * 2;
constexpr size_t WS_WO = WS_WQKV + (size_t)QKVN * D * 2;
static_assert(WS_WO + (size_t)D * D * 2 <= 31 * MiB, "dense weights");
constexpr size_t WS_WEGU = 31 * MiB;
constexpr size_t WS_WED = WS_WEGU + (size_t)NEXP * 2 * DFE * D;
static_assert(WS_WED + (size_t)NEXP * D * DFE == 115 * MiB, "expert weights");
constexpr size_t WS_XN = 115 * MiB;
constexpr size_t WS_Y0 = WS_XN;
constexpr size_t WS_R = 179 * MiB;
constexpr size_t WS_PROJ = WS_R, WS_MIXED = WS_R + (size_t)M * MIXN * 2;
constexpr size_t WS_H = WS_R;
constexpr size_t WS_QKV = WS_R, WS_AO = WS_R + (size_t)M * QKVN * 2;
constexpr size_t WS_HS = WS_R, WS_H2 = WS_R + 66 * MiB;
static_assert((size_t)MAXSLOT * D <= 66 * MiB, "HS");
constexpr size_t WS_END = WS_H2 + (size_t)MAXSLOT * DFE;
static_assert(WS_END <= 543497280ull, "workspace");
static_assert(WS_MIXED + (size_t)M * D * 2 <= 543497280ull && WS_H + (size_t)M * DFF * 2 <= 543497280ull, "workspace");

constexpr int CW_BAR = 4096;
constexpr size_t WS_RSS = 480 * MiB;
static_assert(WS_RSS >= WS_END && WS_RSS + 2 * (size_t)M * 4 * 4 <= 543497280ull, "rss");

constexpr int RING_BYTES = 131072;
constexpr int LDS_TILE_OFF = RING_BYTES;
constexpr int LDS_MISC_OFF = RING_BYTES + 2048;
constexpr int LDS_XTAB_OFF = RING_BYTES + 4096;
constexpr int LDS_BYTES = 147456;

__device__ __forceinline__ unsigned pk2(float lo, float hi) { f32x2 v = {lo, hi}; hbf16x2 b = __builtin_convertvector(v, hbf16x2); return __builtin_bit_cast(unsigned, b); }
__device__ __forceinline__ float bf_lo(unsigned w) { return __uint_as_float(w << 16); }
__device__ __forceinline__ float bf_hi(unsigned w) { return __uint_as_float(w & 0xffff0000u); }
__device__ __forceinline__ void unpack8(const u32x4 w, float (&f)[8]) { f[0] = bf_lo(w.x); f[1] = bf_hi(w.x); f[2] = bf_lo(w.y); f[3] = bf_hi(w.y); f[4] = bf_lo(w.z); f[5] = bf_hi(w.z); f[6] = bf_lo(w.w); f[7] = bf_hi(w.w); }
__device__ __forceinline__ u32x4 pack8(const float (&f)[8]) { u32x4 w; w.x = pk2(f[0], f[1]); w.y = pk2(f[2], f[3]); w.z = pk2(f[4], f[5]); w.w = pk2(f[6], f[7]); return w; }
__device__ __forceinline__ float wave_sum(float v) {
#pragma unroll
    for (int o = 1; o < 64; o <<= 1) v += __shfl_xor(v, o);
    return v;
}
__device__ __forceinline__ int fresh_tid() { int t = threadIdx.x; asm volatile("" : "+v"(t)); return t; }
#define LDS_WAIT() asm volatile("s_waitcnt lgkmcnt(0)" ::: "memory")
#define VM_WAIT() asm volatile("s_waitcnt vmcnt(0)" ::: "memory")

namespace pg8 {
constexpr int BM = 256, BK = 64, HALF = 128, HTB = HALF * BK * 2, STAGE_BYTES = 8 * HTB, NXCD = 8, WGM = 8;
__host__ __device__ __forceinline__ int lds_byte(int r, int c) { const int st = (r >> 4) * 2 + (c >> 5), rr = r & 15, cc = c & 31, ob = rr * 64 + cc * 2; return st * 1024 + (ob ^ (((ob >> 9) & 1) << 5)); }
__host__ __device__ __forceinline__ void stage_rc(int b, int& R, int& C) { const int st = b / 1024, sb = b % 1024, swz = sb ^ (((sb >> 9) & 1) << 5); R = (st >> 1) * 16 + swz / 64; C = (st & 1) * 32 + (swz % 64) / 2; }
__host__ __device__ __forceinline__ int perm32(int rho) { const int n = rho >> 4, i = rho & 15; return 8 * (i >> 2) + 4 * n + (i & 3); }

struct Unit { int pm, pn, rm, cn; };
struct Gemm { const void* A; const void* Bt; int lda, ldb, K; };

struct TileOrder {
    int nM, nN, nwg, G, c;
    __device__ __forceinline__ void init(int nM_, int nN_, int G_, int c_) { nM = nM_; nN = nN_; nwg = nM * nN; G = G_; c = c_; }
    __device__ __forceinline__ bool next(int i, int& m, int& n) const {
        const int L = i * G + c; if (L >= nwg) return false;
        int wgid = L; { const int q = nwg / NXCD, r = nwg % NXCD, xcd = wgid % NXCD, off = wgid / NXCD; wgid = (xcd < r ? xcd * (q + 1) : r * (q + 1) + (xcd - r) * q) + off; }
        const int nig = WGM * nN, gid = wgid / nig, fm = gid * WGM, gsz = (nM - fm) < WGM ? (nM - fm) : WGM;
        m = fm + ((wgid % nig) % gsz); n = (wgid % nig) / gsz; return true;
    }
};
struct DenseOrder {
    TileOrder T;
    __device__ __forceinline__ void init(int Mr, int N, int G, int c) { T.init(Mr / BM, N / BM, G, c); }
    __device__ __forceinline__ bool next(int i, Unit& u) const { int m, n; if (!T.next(i, m, n)) return false; u.pm = m; u.pn = n; u.rm = m; u.cn = n; return true; }
    __device__ __forceinline__ void a_ready(const Unit&) const {}
    __device__ __forceinline__ void done(const Unit&) const {}
};
struct MoeOrder {
    TileOrder T; int tpe; const LAS int* tile_e;
    __device__ __forceinline__ bool next(int i, Unit& u) const { int m, n; if (!T.next(i, m, n)) return false;
        const int e = __builtin_amdgcn_readfirstlane(tile_e[m]);
        u.pm = m; u.pn = e * tpe + n; u.rm = m; u.cn = n; return true; }
    __device__ __forceinline__ void a_ready(const Unit&) const {}
    __device__ __forceinline__ void done(const Unit&) const {}
};

__device__ __forceinline__ float rms_scale(const float* rss, int row) { if (!rss) return 1.0f; const f32x4 a = *(const f32x4*)(rss + (size_t)row * 4);
    return 1.0f / sqrtf(((a[0] + a[1]) + (a[2] + a[3])) * (1.0f / D) + RMS_EPS); }
struct EpiBf16 {
    static constexpr bool PERM = true;
    bf16_t* O; int ldc; const float* bias; const float* rss;
    __device__ __forceinline__ void operator()(const f32x4 (&acc)[2][2][4][2], const Unit& u, int wr, int wc, int fr, int fq) const {
        const int row0 = u.rm * BM + wr * 64 + fr, col0 = u.cn * BM + wc * 32 + 8 * fq;
        f32x4 bv[2][2];
#pragma unroll
        for (int bj = 0; bj < 2; ++bj)
#pragma unroll
            for (int n = 0; n < 2; ++n) bv[bj][n] = bias ? *(const f32x4*)(bias + col0 + bj * HALF + 4 * n) : (f32x4){0.f, 0.f, 0.f, 0.f};
        float rs[2][4];
#pragma unroll
        for (int ai = 0; ai < 2; ++ai)
#pragma unroll
            for (int m = 0; m < 4; ++m) rs[ai][m] = rms_scale(rss, row0 + ai * HALF + m * 16);
#pragma unroll
        for (int ai = 0; ai < 2; ++ai)
#pragma unroll
            for (int m = 0; m < 4; ++m) { const int row = row0 + ai * HALF + m * 16; bf16_t* rowp = O + (size_t)row * ldc + col0; const float r = rs[ai][m];
#pragma unroll
                for (int bj = 0; bj < 2; ++bj) { const f32x4 v0 = acc[ai][bj][m][0] * r + bv[bj][0], v1 = acc[ai][bj][m][1] * r + bv[bj][1];
                    u32x4 w; w.x = pk2(v0[0], v0[1]); w.y = pk2(v0[2], v0[3]); w.z = pk2(v1[0], v1[1]); w.w = pk2(v1[2], v1[3]);
                    *(u32x4*)(rowp + bj * HALF) = w; } }
    }
};
__device__ __forceinline__ float silu_mul(float g, float u) { return g * u * __builtin_amdgcn_rcpf(1.0f + __builtin_amdgcn_exp2f(-1.44269504089f * g)); }
struct EpiSwiGLU {
    static constexpr bool PERM = true;
    bf16_t* O; int ldc; const float* rss;
    __device__ __forceinline__ void operator()(const f32x4 (&acc)[2][2][4][2], const Unit& u, int wr, int wc, int fr, int fq) const {
        const int row0 = u.rm * BM + wr * 64 + fr, col0 = u.cn * HALF + wc * 32 + 8 * fq;
        float rs[2][4];
#pragma unroll
        for (int ai = 0; ai < 2; ++ai)
#pragma unroll
            for (int m = 0; m < 4; ++m) rs[ai][m] = rms_scale(rss, row0 + ai * HALF + m * 16);
#pragma unroll
        for (int ai = 0; ai < 2; ++ai)
#pragma unroll
            for (int m = 0; m < 4; ++m) { const int row = row0 + ai * HALF + m * 16; bf16_t* rowp = O + (size_t)row * ldc + col0; const float r = rs[ai][m];
                const f32x4 g0 = acc[ai][0][m][0] * r, g1 = acc[ai][0][m][1] * r, u0 = acc[ai][1][m][0] * r, u1 = acc[ai][1][m][1] * r;
                u32x4 w; w.x = pk2(silu_mul(g0[0], u0[0]), silu_mul(g0[1], u0[1])); w.y = pk2(silu_mul(g0[2], u0[2]), silu_mul(g0[3], u0[3]));
                w.z = pk2(silu_mul(g1[0], u1[0]), silu_mul(g1[1], u1[1])); w.w = pk2(silu_mul(g1[2], u1[2]), silu_mul(g1[3], u1[3]));
                *(u32x4*)rowp = w; }
    }
};
struct EpiResid {
    static constexpr bool PERM = true;
    const float* base; float* out; const float* bias; bf16_t* xb; float* rss; LAS unsigned char* xlds;
    __device__ __forceinline__ void operator()(const f32x4 (&acc)[2][2][4][2], const Unit& u, int wr, int wc, int fr, int fq) const {
        const int row0 = u.rm * BM + wr * 64 + fr, col0 = u.cn * BM + wc * 32 + 8 * fq;
        f32x4 bv[2][2];
#pragma unroll
        for (int bj = 0; bj < 2; ++bj)
#pragma unroll
            for (int n = 0; n < 2; ++n) bv[bj][n] = bias ? *(const f32x4*)(bias + col0 + bj * HALF + 4 * n) : (f32x4){0.f, 0.f, 0.f, 0.f};
#pragma unroll
        for (int ai = 0; ai < 2; ++ai)
#pragma unroll
            for (int m = 0; m < 4; ++m) { const int row = row0 + ai * HALF + m * 16; const size_t off = (size_t)row * D + col0;
                f32x4 bs[2][2];
#pragma unroll
                for (int bj = 0; bj < 2; ++bj)
#pragma unroll
                    for (int n = 0; n < 2; ++n) bs[bj][n] = *(const f32x4*)(base + off + bj * HALF + 4 * n);
                float ss = 0.f;
#pragma unroll
                for (int bj = 0; bj < 2; ++bj) {
#pragma unroll
                    for (int n = 0; n < 2; ++n) { bs[bj][n] = bs[bj][n] + acc[ai][bj][m][n] + bv[bj][n]; *(f32x4*)(out + off + bj * HALF + 4 * n) = bs[bj][n];
                        ss += (bs[bj][n][0] * bs[bj][n][0] + bs[bj][n][1] * bs[bj][n][1]) + (bs[bj][n][2] * bs[bj][n][2] + bs[bj][n][3] * bs[bj][n][3]); }
                    if (xb) { u32x4 w; w.x = pk2(bs[bj][0][0], bs[bj][0][1]); w.y = pk2(bs[bj][0][2], bs[bj][0][3]); w.z = pk2(bs[bj][1][0], bs[bj][1][1]); w.w = pk2(bs[bj][1][2], bs[bj][1][3]);
                        *(u32x4*)(xb + off + bj * HALF) = w; } }
                if (xb) { ss += __shfl_xor(ss, 16); ss += __shfl_xor(ss, 32); if (fq == 0) *(LAS float*)(xlds + 16 * (wr * 64 + ai * HALF + m * 16 + fr) + 4 * wc) = ss; }
                asm volatile("" ::: "memory"); }
        if (xb) { asm volatile("s_waitcnt lgkmcnt(0)" ::: "memory"); __builtin_amdgcn_s_barrier(); asm volatile("" ::: "memory");
            const int t = wr * 256 + wc * 64 + fq * 16 + fr;
            if (t < 256) { const f32x4 a = *(const LAS f32x4*)(xlds + 16 * t); rss[(size_t)(u.rm * BM + t) * 4 + u.cn] = (a[0] + a[1]) + (a[2] + a[3]); } }
    }
};
__device__ __forceinline__ unsigned pk4_fp8(float a, float b, float c, float d) {
    int w = __builtin_amdgcn_cvt_pk_fp8_f32(__builtin_amdgcn_fmed3f(a, -448.f, 448.f), __builtin_amdgcn_fmed3f(b, -448.f, 448.f), 0, false);
    w = __builtin_amdgcn_cvt_pk_fp8_f32(__builtin_amdgcn_fmed3f(c, -448.f, 448.f), __builtin_amdgcn_fmed3f(d, -448.f, 448.f), w, true);
    return (unsigned)w;
}
constexpr int E8M0_ONE = 0x7f7f7f7f, E8M0_2M6 = 0x79797979;
struct EpiSwiGLU8 {
    static constexpr bool PERM = true; static constexpr int SCALE_A = E8M0_ONE, SCALE_B = E8M0_2M6;
    unsigned char* O; int ldc;
    __device__ __forceinline__ void operator()(const f32x4 (&acc)[2][2][4][2], const Unit& u, int wr, int wc, int fr, int fq) const {
        const int row0 = u.rm * BM + wr * 64 + fr, col0 = u.cn * HALF + wc * 32 + 8 * fq;
#pragma unroll
        for (int ai = 0; ai < 2; ++ai)
#pragma unroll
            for (int m = 0; m < 4; ++m) { unsigned char* rowp = O + (size_t)(row0 + ai * HALF + m * 16) * ldc + col0;
                const f32x4 g0 = acc[ai][0][m][0], g1 = acc[ai][0][m][1], u0 = acc[ai][1][m][0], u1 = acc[ai][1][m][1];
                u32x2 w; w.x = pk4_fp8(silu_mul(g0[0], u0[0]), silu_mul(g0[1], u0[1]), silu_mul(g0[2], u0[2]), silu_mul(g0[3], u0[3]));
                w.y = pk4_fp8(silu_mul(g1[0], u1[0]), silu_mul(g1[1], u1[1]), silu_mul(g1[2], u1[2]), silu_mul(g1[3], u1[3]));
                *(u32x2*)rowp = w; }
    }
};
struct EpiMoeDown {
    static constexpr bool PERM = true; static constexpr int SCALE_A = E8M0_ONE, SCALE_B = E8M0_2M6;
    float* X; bf16_t* Y0; const int* slot_tok; const float* slot_w;
    __device__ __forceinline__ void operator()(const f32x4 (&acc)[2][2][4][2], const Unit& u, int wr, int wc, int fr, int fq) const {
        const int row0 = u.rm * BM + wr * 64 + fr, col0 = u.cn * BM + wc * 32 + 8 * fq;
#pragma unroll
        for (int ai = 0; ai < 2; ++ai)
#pragma unroll
            for (int m = 0; m < 4; ++m) { const int slot = row0 + ai * HALF + m * 16; const int meta = slot_tok[slot]; const float w = slot_w[slot];
                if (meta >= 0) { const size_t off = (size_t)(meta >> 1) * D + col0;
                    if (meta & 1) {
                        f32x4 bs[2][2];
#pragma unroll
                        for (int bj = 0; bj < 2; ++bj)
#pragma unroll
                            for (int n = 0; n < 2; ++n) bs[bj][n] = *(const f32x4*)(X + off + bj * HALF + 4 * n);
#pragma unroll
                        for (int bj = 0; bj < 2; ++bj)
#pragma unroll
                            for (int n = 0; n < 2; ++n) *(f32x4*)(X + off + bj * HALF + 4 * n) = bs[bj][n] + acc[ai][bj][m][n] * w;
                    } else {
#pragma unroll
                        for (int bj = 0; bj < 2; ++bj) { const f32x4 v0 = acc[ai][bj][m][0] * w, v1 = acc[ai][bj][m][1] * w;
                            u32x4 o; o.x = pk2(v0[0], v0[1]); o.y = pk2(v0[2], v0[3]); o.z = pk2(v1[0], v1[1]); o.w = pk2(v1[2], v1[3]);
                            *(u32x4*)(Y0 + off + bj * HALF) = o; }
                    } }
                asm volatile("" ::: "memory"); }
    }
};

template <int OFF> __device__ __forceinline__ void glds_s(const char* sbase, unsigned voff, unsigned lds_base) {
    unsigned keep;
    asm volatile("s_mov_b32 %0, m0\n\ts_add_u32 m0, %3, %4\n\ts_nop 0\n\tglobal_load_lds_dwordx4 %1, %2\n\ts_mov_b32 m0, %0" : "=&s"(keep) : "v"(voff), "s"(sbase), "s"(lds_base), "i"(OFF) : "memory", "scc");
}
template <class Epi, class Sched, bool FP8 = false, bool ALIGN_EPI = true, bool SP2 = true>
__device__ __forceinline__ void gemm_phase(LAS unsigned char* lds, const Gemm g, const Sched& S, const Epi& E) {
    const int tid = threadIdx.x, wid = __builtin_amdgcn_readfirstlane(tid >> 6), lane = tid & 63, wr = wid >> 2, wc = wid & 3, fr = lane & 15, fq = lane >> 4;
    const int nt = g.K / (BK * 2);
    unsigned voffA[2], voffB[2];
#pragma unroll
    for (int i = 0; i < 2; ++i) { int R, C; stage_rc(tid * 16 + i * 8192, R, C); const int Rb = Epi::PERM ? ((R & ~31) + perm32(R & 31)) : R;
        voffA[i] = (unsigned)(R * g.lda + C * 2); voffB[i] = (unsigned)(Rb * g.ldb + C * 2); }
    const size_t kstep = (size_t)(BK * 2);
    const size_t hstepA = (size_t)HALF * g.lda, hstepB = (size_t)HALF * g.ldb;
    const size_t tstepA = 2 * hstepA, tstepB = 2 * hstepB;
    const unsigned lds_base = (unsigned)(size_t)lds + (unsigned)wid * 1024u;
    const int aoff = lds_byte(wr * 64 + fr, fq * 8), boff = lds_byte(wc * 32 + fr, fq * 8);
#define PG8_SA(b, h) (((b) * 2 + (h)) * HTB)
#define PG8_SB(b, h) ((4 + (b) * 2 + (h)) * HTB)
#define PG8_STAGE(bufoff, gbase, voff) do { glds_s<(bufoff)>((const char*)(gbase), (voff)[0], lds_base); glds_s<(bufoff) + 8192>((const char*)(gbase), (voff)[1], lds_base); } while (0)
#define PG8_LDA(dst, b, h) do { _Pragma("unroll") for (int m = 0; m < 4; ++m) _Pragma("unroll") for (int k = 0; k < 2; ++k) dst[m][k] = *(const LAS bf16x8*)(lds + PG8_SA(b, h) + aoff + m * 2048 + k * 1024); } while (0)
#define PG8_LDB(dst, b, h) do { _Pragma("unroll") for (int n = 0; n < 2; ++n) _Pragma("unroll") for (int k = 0; k < 2; ++k) dst[n][k] = *(const LAS bf16x8*)(lds + PG8_SB(b, h) + boff + n * 2048 + k * 1024); } while (0)
#define PG8_MMA(ai, bj, At, Bt) do { __builtin_amdgcn_s_setprio(1); _Pragma("unroll") for (int m = 0; m < 4; ++m) _Pragma("unroll") for (int n = 0; n < 2; ++n) { \
        if constexpr (FP8) { const i32x4 b_lo = __builtin_bit_cast(i32x4, Bt[n][0]), b_hi = __builtin_bit_cast(i32x4, Bt[n][1]), a_lo = __builtin_bit_cast(i32x4, At[m][0]), a_hi = __builtin_bit_cast(i32x4, At[m][1]); \
            acc[ai][bj][m][n] = __builtin_amdgcn_mfma_scale_f32_16x16x128_f8f6f4(__builtin_shufflevector(b_lo, b_hi, 0, 1, 2, 3, 4, 5, 6, 7), __builtin_shufflevector(a_lo, a_hi, 0, 1, 2, 3, 4, 5, 6, 7), acc[ai][bj][m][n], 0, 0, 0, Epi::SCALE_B, 0, Epi::SCALE_A); } \
        else { _Pragma("unroll") for (int k = 0; k < 2; ++k) acc[ai][bj][m][n] = __builtin_amdgcn_mfma_f32_16x16x32_bf16(Bt[n][k], At[m][k], acc[ai][bj][m][n], 0, 0, 0); } } \
        __builtin_amdgcn_s_setprio(0); } while (0)
#define PG8_WAIT_V(n) asm volatile("s_waitcnt vmcnt(" #n ")" ::: "memory")
#define PG8_WAIT_L(n) asm volatile("s_waitcnt lgkmcnt(" #n ")" ::: "memory")
#define PG8_BAR __builtin_amdgcn_s_barrier()
#define PG8_SCHED __builtin_amdgcn_sched_barrier(0)
    Unit cur, nxt; int ui = 0;
    if (!S.next(0, cur)) return;
    f32x4 acc[2][2][4][2];
#pragma unroll
    for (int a = 0; a < 2; ++a)
#pragma unroll
        for (int b = 0; b < 2; ++b)
#pragma unroll
            for (int m = 0; m < 4; ++m)
#pragma unroll
                for (int n = 0; n < 2; ++n) acc[a][b][m][n] = (f32x4){0.f, 0.f, 0.f, 0.f};
    bf16x8 At[4][2], B0[2][2], B1[2][2];
    const char* cA = (const char*)g.A + (size_t)cur.pm * tstepA; const char* cB = (const char*)g.Bt + (size_t)cur.pn * tstepB;
    S.a_ready(cur);
    if constexpr (SP2) {
        PG8_STAGE(PG8_SB(0, 0), cB, voffB); PG8_STAGE(PG8_SB(0, 1), cB + hstepB, voffB); PG8_STAGE(PG8_SA(0, 0), cA, voffA); PG8_STAGE(PG8_SA(0, 1), cA + hstepA, voffA);
        if (wr == 1) PG8_BAR;
        PG8_WAIT_V(2); PG8_BAR;
        PG8_STAGE(PG8_SB(1, 0), cB + kstep, voffB); PG8_STAGE(PG8_SA(1, 0), cA + kstep, voffA); PG8_STAGE(PG8_SB(1, 1), cB + hstepB + kstep, voffB);
        PG8_WAIT_V(6); PG8_BAR;
    } else {
        PG8_STAGE(PG8_SB(0, 0), cB, voffB); PG8_STAGE(PG8_SA(0, 0), cA, voffA); PG8_STAGE(PG8_SB(0, 1), cB + hstepB, voffB); PG8_STAGE(PG8_SA(0, 1), cA + hstepA, voffA);
        if (wr == 1) PG8_BAR;
        PG8_WAIT_V(4); PG8_BAR;
        PG8_STAGE(PG8_SB(1, 0), cB + kstep, voffB); PG8_STAGE(PG8_SA(1, 0), cA + kstep, voffA); PG8_STAGE(PG8_SB(1, 1), cB + hstepB + kstep, voffB);
        PG8_WAIT_V(6); PG8_BAR;
    }
    for (;;) {
        const bool has_next = S.next(ui + 1, nxt);
        const char* nA = has_next ? (const char*)g.A + (size_t)nxt.pm * tstepA : cA; const char* nB = has_next ? (const char*)g.Bt + (size_t)nxt.pn * tstepB : cB;
#pragma clang loop unroll(disable)
        for (int t = 0; t < nt; t += 2) {
            const bool last = (t == nt - 2);
            const char* a1 = cA + (size_t)(t + 1) * kstep;
            const char* a2 = last ? nA : cA + (size_t)(t + 2) * kstep; const char* b2 = last ? nB : cB + (size_t)(t + 2) * kstep;
            const char* a3 = a2 + kstep; const char* b3 = b2 + kstep;
            if (last && has_next) S.a_ready(nxt);
            if constexpr (SP2) {
            PG8_LDB(B0, 0, 0); PG8_LDB(B1, 0, 1); PG8_SCHED; PG8_LDA(At, 0, 0); PG8_STAGE(PG8_SA(1, 1), a1 + hstepA, voffA);
            PG8_WAIT_V(8); PG8_WAIT_L(0); PG8_BAR; PG8_MMA(0, 0, At, B0); PG8_MMA(0, 1, At, B1); PG8_BAR; PG8_SCHED;
            PG8_LDA(At, 0, 1); PG8_STAGE(PG8_SB(0, 0), b2, voffB); PG8_STAGE(PG8_SB(0, 1), b2 + hstepB, voffB); PG8_STAGE(PG8_SA(0, 0), a2, voffA);
            PG8_WAIT_V(8); PG8_WAIT_L(0); PG8_BAR; PG8_MMA(1, 0, At, B0); PG8_MMA(1, 1, At, B1); PG8_BAR; PG8_SCHED;
            PG8_LDB(B0, 1, 0); PG8_LDB(B1, 1, 1); PG8_SCHED; PG8_LDA(At, 1, 0); PG8_STAGE(PG8_SA(0, 1), a2 + hstepA, voffA);
            PG8_WAIT_V(8); PG8_WAIT_L(0); PG8_BAR; PG8_MMA(0, 0, At, B0); PG8_MMA(0, 1, At, B1); PG8_BAR; PG8_SCHED;
            PG8_LDA(At, 1, 1); PG8_STAGE(PG8_SB(1, 0), b3, voffB); PG8_STAGE(PG8_SB(1, 1), b3 + hstepB, voffB); PG8_STAGE(PG8_SA(1, 0), a3, voffA);
            PG8_WAIT_V(8); PG8_WAIT_L(0); PG8_BAR; PG8_MMA(1, 0, At, B0); PG8_MMA(1, 1, At, B1); PG8_BAR; PG8_SCHED;
            } else {
            PG8_LDB(B0, 0, 0); PG8_SCHED; PG8_LDA(At, 0, 0); PG8_STAGE(PG8_SA(1, 1), a1 + hstepA, voffA);
            PG8_WAIT_L(8); PG8_BAR; PG8_WAIT_L(0); PG8_MMA(0, 0, At, B0); PG8_BAR; PG8_SCHED;
            PG8_LDB(B1, 0, 1); PG8_STAGE(PG8_SB(0, 0), b2, voffB);
            PG8_BAR; PG8_WAIT_L(0); PG8_MMA(0, 1, At, B1); PG8_BAR;
            PG8_LDA(At, 0, 1); PG8_STAGE(PG8_SA(0, 0), a2, voffA);
            PG8_BAR; PG8_WAIT_L(0); PG8_MMA(1, 0, At, B0); PG8_BAR; PG8_SCHED;
            PG8_STAGE(PG8_SB(0, 1), b2 + hstepB, voffB);
            PG8_WAIT_V(6); PG8_BAR; PG8_MMA(1, 1, At, B1); PG8_BAR;
            PG8_LDB(B0, 1, 0); PG8_SCHED; PG8_LDA(At, 1, 0); PG8_STAGE(PG8_SA(0, 1), a2 + hstepA, voffA);
            PG8_WAIT_L(8); PG8_BAR; PG8_WAIT_L(0); PG8_MMA(0, 0, At, B0); PG8_BAR; PG8_SCHED;
            PG8_LDB(B1, 1, 1); PG8_STAGE(PG8_SB(1, 0), b3, voffB);
            PG8_BAR; PG8_WAIT_L(0); PG8_MMA(0, 1, At, B1); PG8_BAR;
            PG8_LDA(At, 1, 1); PG8_STAGE(PG8_SA(1, 0), a3, voffA);
            PG8_BAR; PG8_WAIT_L(0); PG8_MMA(1, 0, At, B0); PG8_BAR; PG8_SCHED;
            PG8_STAGE(PG8_SB(1, 1), b3 + hstepB, voffB);
            PG8_WAIT_V(6); PG8_BAR; PG8_MMA(1, 1, At, B1); PG8_BAR;
            }
        }
        if constexpr (ALIGN_EPI) { if (wr == 0) PG8_BAR; }
        { int l2 = threadIdx.x; asm volatile("" : "+v"(l2)); l2 &= 63; E(acc, cur, wr, wc, l2 & 15, l2 >> 4); }
        S.done(cur);
        if (!has_next) break;
#pragma unroll
        for (int a = 0; a < 2; ++a)
#pragma unroll
            for (int b = 0; b < 2; ++b)
#pragma unroll
                for (int m = 0; m < 4; ++m)
#pragma unroll
                    for (int n = 0; n < 2; ++n) acc[a][b][m][n] = (f32x4){0.f, 0.f, 0.f, 0.f};
        cur = nxt; cA = nA; cB = nB; ++ui;
        if constexpr (ALIGN_EPI) { if (wr == 1) PG8_BAR; }
    }
    PG8_WAIT_V(0);
    if constexpr (!ALIGN_EPI) { if (wr == 0) PG8_BAR; }
    PG8_BAR;
#undef PG8_SA
#undef PG8_SB
#undef PG8_STAGE
#undef PG8_LDA
#undef PG8_LDB
#undef PG8_MMA
#undef PG8_WAIT_V
#undef PG8_WAIT_L
#undef PG8_BAR
#undef PG8_SCHED
}
}

#define XB_TMO      128
#define XB_XCNT(j)  (256  + 64 * (j))
#define XB_XSUB(j)  (1280 + 64 * (j))
#define XB_XGEN(j)  (2304 + 64 * (j))
#define XB_TOP      3328
#define XB_TOPGEN   3392
#define XCD_BAR_WORDS 3456
#define XB_SPIN_CAP (1u << 18)
__device__ __forceinline__ unsigned xb_ld(unsigned* p)              { return __hip_atomic_load(p, __ATOMIC_RELAXED, __HIP_MEMORY_SCOPE_AGENT); }
__device__ __forceinline__ unsigned xb_add(unsigned* p, unsigned v) { return __hip_atomic_fetch_add(p, v, __ATOMIC_RELAXED, __HIP_MEMORY_SCOPE_AGENT); }
__device__ __forceinline__ unsigned xb_xcc_id() { return (unsigned)__builtin_amdgcn_s_getreg((3 << 11) | 20) & 0xFu; }
#define XB_SPIN(cond, bar) do { unsigned _sp = 0; while (cond) { __builtin_amdgcn_s_sleep(1); \
    if ((++_sp & 255u) == 0u) { if (xb_ld(&(bar)[XB_TMO])) break; if (_sp > XB_SPIN_CAP) { atomicAdd(&(bar)[XB_TMO], 1u); break; } } } } while (0)
struct XcdBarrier { unsigned* bar; unsigned x; volatile LAS unsigned* st; };
__device__ __forceinline__ XcdBarrier xcd_barrier_post(unsigned* bar, volatile LAS unsigned* st) {
    XcdBarrier b; b.bar = bar; b.x = xb_xcc_id(); b.st = st;
    if (threadIdx.x == 0) (void)xb_add(&bar[XB_XCNT(b.x)], 1u);
    return b;
}
__device__ __forceinline__ void xcd_barrier_complete(unsigned* bar, unsigned x, unsigned& nloc, unsigned& nx) {
    const unsigned G = gridDim.x * gridDim.y * gridDim.z;
    unsigned sum, cnt, mine, sp = 0u;
    for (;;) {
        sum = 0u; cnt = 0u; mine = 0u;
#pragma unroll
        for (unsigned j = 0; j < 16; ++j) { const unsigned c = xb_ld(&bar[XB_XCNT(j)]); sum += c; cnt += (c > 0u) ? 1u : 0u; mine = (j == x) ? c : mine; }
        if (sum == G) break;
        __builtin_amdgcn_s_sleep(1);
        if ((++sp & 255u) == 0u) { if (xb_ld(&bar[XB_TMO])) break; if (sp > XB_SPIN_CAP) { atomicAdd(&bar[XB_TMO], 1u); break; } }
    }
    nloc = mine > 0u ? mine : 1u; nx = cnt > 0u ? cnt : 1u;
}
__device__ __forceinline__ void xcd_barrier(const XcdBarrier& b) {
    asm volatile("s_waitcnt vmcnt(0)" ::: "memory");
    __syncthreads();
    if (threadIdx.x == 0) {
        unsigned* bar = b.bar;
        __builtin_amdgcn_s_waitcnt(0);
        unsigned nloc = b.st[0], nx = b.st[1];
        if (nloc == 0u) { xcd_barrier_complete(bar, b.x, nloc, nx); b.st[0] = nloc; b.st[1] = nx; }
        const unsigned old = xb_add(&bar[XB_XSUB(b.x)], 1u);
        const unsigned gen = old / nloc;
        if (old + 1u == (gen + 1u) * nloc) {
            __builtin_amdgcn_fence(__ATOMIC_RELEASE, "agent");
            asm volatile("s_waitcnt vmcnt(0)" ::: "memory");
            const unsigned og = xb_add(&bar[XB_TOP], 1u);
            const unsigned tg = og / nx;
            if (og + 1u == (tg + 1u) * nx) xb_add(&bar[XB_TOPGEN], 1u);
            else XB_SPIN(xb_ld(&bar[XB_TOPGEN]) == tg, bar);
            __builtin_amdgcn_fence(__ATOMIC_ACQUIRE, "agent");
            xb_add(&bar[XB_XGEN(b.x)], 1u);
            asm volatile("s_waitcnt vmcnt(0)" ::: "memory");
        } else {
            XB_SPIN(xb_ld(&bar[XB_XGEN(b.x)]) == gen, bar);
            __builtin_amdgcn_fence(__ATOMIC_ACQUIRE, "agent");
            asm volatile("s_waitcnt vmcnt(0)" ::: "memory");
        }
    }
    __syncthreads();
}

struct Params { const float* in[24]; float* out; unsigned char* ws; int ph_lo, ph_hi; };
enum { I_X = 0, I_RELB, I_EVNM, I_WIN, I_POOLW, I_POOLS, I_CONVW, I_WOUT, I_EVNF, I_FG, I_FU, I_FD, I_ODNM, I_WQKV, I_BQKV, I_SINK, I_WO, I_BO, I_ODNF, I_ROUTER, I_EG, I_EU, I_ED, I_FINAL };

__device__ __forceinline__ void p0_tile(const float* __restrict__ src, int N, int k0, int n0, bf16_t* __restrict__ dst, int ldd, LAS unsigned char* scr, int lane, const float* __restrict__ gain = nullptr) {
    const int n4 = (lane & 15) * 4, kp = lane >> 4;
    f32x4 a[8], b[8];
#pragma unroll
    for (int i = 0; i < 8; ++i) { const float* p = src + (size_t)(k0 + 8 * i + 2 * kp) * N + n0 + n4; a[i] = *(const f32x4*)p; b[i] = *(const f32x4*)(p + N);
        if (gain) { a[i] = a[i] * gain[k0 + 8 * i + 2 * kp]; b[i] = b[i] * gain[k0 + 8 * i + 2 * kp + 1]; } }
#pragma unroll
    for (int i = 0; i < 8; ++i) { const int k = 8 * i + 2 * kp;
#pragma unroll
        for (int q = 0; q < 4; ++q) *(LAS unsigned*)(scr + (n4 + q) * 136 + k * 2) = pk2(a[i][q], b[i][q]); }
    LDS_WAIT();
    const int c = lane & 7, nr = lane >> 3;
#pragma unroll
    for (int j = 0; j < 8; ++j) { const int n = 8 * j + nr; const u32x2 lo = *(const LAS u32x2*)(scr + n * 136 + 16 * c), hi = *(const LAS u32x2*)(scr + n * 136 + 16 * c + 8);
        u32x4 o; o.x = lo.x; o.y = lo.y; o.z = hi.x; o.w = hi.y; *(u32x4*)(dst + (size_t)n * ldd + 8 * c) = o; }
    LDS_WAIT();
}
__device__ __forceinline__ void p0_tile8(const float* __restrict__ src, int N, int k0, int n0, unsigned char* __restrict__ dst, int ldd, float scale, LAS unsigned char* scr, int lane) {
    const int n4 = (lane & 7) * 4, kq = lane >> 3;
    f32x4 a[4][4];
#pragma unroll
    for (int i = 0; i < 4; ++i)
#pragma unroll
        for (int j = 0; j < 4; ++j) a[i][j] = *(const f32x4*)(src + (size_t)(k0 + 32 * i + 4 * kq + j) * N + n0 + n4);
#pragma unroll
    for (int i = 0; i < 4; ++i)
#pragma unroll
        for (int q = 0; q < 4; ++q) *(LAS unsigned*)(scr + (n4 + q) * 144 + 32 * i + 4 * kq) = pg8::pk4_fp8(a[i][0][q] * scale, a[i][1][q] * scale, a[i][2][q] * scale, a[i][3][q] * scale);
    LDS_WAIT();
    const int c = lane & 7, nr = lane >> 3;
#pragma unroll
    for (int j = 0; j < 4; ++j) { const int n = 8 * j + nr; *(u32x4*)(dst + (size_t)n * ldd + 16 * c) = *(const LAS u32x4*)(scr + n * 144 + 16 * c); }
    LDS_WAIT();
}
__device__ __forceinline__ void norm_row_bf16(const float* __restrict__ xrow, const float* __restrict__ gain, bf16_t* __restrict__ orow, int lane, float (&y)[16]) {
    f32x4 v[4];
#pragma unroll
    for (int j = 0; j < 2; ++j) { v[2 * j] = *(const f32x4*)(xrow + 512 * j + 8 * lane); v[2 * j + 1] = *(const f32x4*)(xrow + 512 * j + 8 * lane + 4); }
    float s = 0.f;
#pragma unroll
    for (int j = 0; j < 4; ++j) s += (v[j][0] * v[j][0] + v[j][1] * v[j][1]) + (v[j][2] * v[j][2] + v[j][3] * v[j][3]);
    const float r = 1.0f / sqrtf(wave_sum(s) * (1.0f / D) + RMS_EPS);
#pragma unroll
    for (int j = 0; j < 2; ++j) { const f32x4 g0 = *(const f32x4*)(gain + 512 * j + 8 * lane), g1 = *(const f32x4*)(gain + 512 * j + 8 * lane + 4);
#pragma unroll
        for (int q = 0; q < 4; ++q) { y[8 * j + q] = v[2 * j][q] * r * g0[q]; y[8 * j + 4 + q] = v[2 * j + 1][q] * r * g1[q]; }
        u32x4 w; w.x = pk2(y[8 * j], y[8 * j + 1]); w.y = pk2(y[8 * j + 2], y[8 * j + 3]); w.z = pk2(y[8 * j + 4], y[8 * j + 5]); w.w = pk2(y[8 * j + 6], y[8 * j + 7]);
        *(u32x4*)(orow + 512 * j + 8 * lane) = w; }
}

__device__ __forceinline__ int t5_bucket(int rel) {
    const int n = rel < 0 ? -rel : rel; const int ret = rel > 0 ? 16 : 0;
    int v;
    if (n < 8) v = n; else if (n < 12) v = 8; else if (n < 16) v = 9; else if (n < 23) v = 10; else if (n < 32) v = 11; else if (n < 46) v = 12; else if (n < 64) v = 13; else if (n < 91) v = 14; else v = 15;
    return ret + v;
}

__global__ void __launch_bounds__(NTHR, 2) fwd_kernel(Params p) {
    extern __shared__ __attribute__((aligned(16))) unsigned char lds_raw[];
    LAS unsigned char* lds = (LAS unsigned char*)lds_raw;
    volatile LAS unsigned* MISC = (volatile LAS unsigned*)(lds + LDS_MISC_OFF);
    const int tid = threadIdx.x, lane = tid & 63, wave = __builtin_amdgcn_readfirstlane(tid >> 6);
    const int G = gridDim.x, bx = blockIdx.x;
    const int vcu = (G % 8 == 0) ? (bx % 8) * (G / 8) + bx / 8 : bx;
    const int gw = vcu * NWAVES + wave, NGW = G * NWAVES;
    unsigned char* ws = p.ws;
    unsigned* ctl = (unsigned*)(ws + WS_CTL);
    if (tid < 64) MISC[tid] = 0u;
    __syncthreads();
    XcdBarrier bar; bar.bar = ctl + CW_BAR; bar.x = 0; bar.st = nullptr;
    if (MK_N_LAUNCHES == 1) bar = xcd_barrier_post(ctl + CW_BAR, MISC + 8);
    const int lo = p.ph_lo, hi = p.ph_hi;
#define IN(k) (lo <= (k) && (k) < hi)
#define SEAM(k) do { if (MK_N_LAUNCHES == 1 && IN((k) + 1)) xcd_barrier(bar); } while (0)

    bf16_t* Win_t = (bf16_t*)(ws + WS_WIN); bf16_t* Wout_t = (bf16_t*)(ws + WS_WOUT); bf16_t* Wgu_t = (bf16_t*)(ws + WS_WGU); bf16_t* Wd_t = (bf16_t*)(ws + WS_WD);
    bf16_t* Wqkv_t = (bf16_t*)(ws + WS_WQKV); bf16_t* Wo_t = (bf16_t*)(ws + WS_WO); bf16_t* Wegu_t = (bf16_t*)(ws + WS_WEGU); bf16_t* Wed_t = (bf16_t*)(ws + WS_WED);
    bf16_t* XN = (bf16_t*)(ws + WS_XN); bf16_t* PROJ = (bf16_t*)(ws + WS_PROJ); bf16_t* MIXED = (bf16_t*)(ws + WS_MIXED); bf16_t* Hb = (bf16_t*)(ws + WS_H);
    bf16_t* QKV = (bf16_t*)(ws + WS_QKV); bf16_t* AO = (bf16_t*)(ws + WS_AO); bf16_t* HS = (bf16_t*)(ws + WS_HS); bf16_t* H2 = (bf16_t*)(ws + WS_H2);
    float* bias_tab = (float*)(ws + WS_BIAS); int* wgcnt = (int*)(ws + WS_WGCNT); int* tilemeta = (int*)(ws + WS_TILE);
    int* tok_e = (int*)(ws + WS_TOKE); float* tok_w = (float*)(ws + WS_TOKW); int* tok_r = (int*)(ws + WS_TOKR); int* slot_tok = (int*)(ws + WS_SLOTT); float* slot_w = (float*)(ws + WS_SLOTW);
    float* rss = (float*)(ws + WS_RSS);
    float* X = p.out;

    if (IN(0)) for (int rep_ = 0; rep_ < NREP(0); ++rep_) {
        const int tid = fresh_tid(), lane = tid & 63;
        LAS unsigned char* scr = lds + wave * 8704;
        constexpr int T_WIN = 16 * 32, T_WOUT = 8 * 16, T_FG = 16 * 44, T_FD = 44 * 16, T_QKV = 16 * 20, T_WO = 16 * 16;
        constexpr int T_EG = 8 * 112, T_ED = 28 * 32;
        constexpr int NT8 = NEXP * (2 * T_EG + T_ED);
        constexpr int NT = T_WIN + T_WOUT + 2 * T_FG + T_FD + T_QKV + T_WO;
        unsigned char* Wegu8 = (unsigned char*)Wegu_t; unsigned char* Wed8 = (unsigned char*)Wed_t;
        for (int it = gw; it < NT8; it += NGW) {
            const int per_e = 2 * T_EG + T_ED; const int e = it / per_e; int q = it % per_e;
            if (q < 2 * T_EG) { const int up = q >= T_EG; if (up) q -= T_EG; const int kb = q / 112, nb = q % 112, n0 = 32 * nb;
                p0_tile8(p.in[up ? I_EU : I_EG] + (size_t)e * D * DFE, DFE, 128 * kb, n0, Wegu8 + ((size_t)e * 2 * DFE + (n0 / 128) * 256 + (n0 % 128) + (up ? 128 : 0)) * D + 128 * kb, D, 64.f, scr, lane); }
            else { q -= 2 * T_EG; const int kb = q / 32, nb = q % 32;
                p0_tile8(p.in[I_ED] + (size_t)e * DFE * D, D, 128 * kb, 32 * nb, Wed8 + ((size_t)e * D + 32 * nb) * DFE + 128 * kb, DFE, 64.f, scr, lane); }
        }
        for (int it = gw; it < NT; it += NGW) {
            int r = it;
            if (r < T_WIN) { const int kb = r / 32, nb = r % 32; p0_tile(p.in[I_WIN], MIXN, 64 * kb, 64 * nb, Win_t + (size_t)(64 * nb) * D + 64 * kb, D, scr, lane); continue; } r -= T_WIN;
            if (r < T_WOUT) { const int kb = 8 + r / 16, nb = r % 16; p0_tile(p.in[I_WOUT], D, 64 * kb, 64 * nb, Wout_t + (size_t)(64 * nb) * D + 64 * kb, D, scr, lane); continue; } r -= T_WOUT;
            if (r < 2 * T_FG) { const int up = r >= T_FG; const int q = up ? r - T_FG : r; const int kb = q / 44, nb = q % 44, n0 = 64 * nb;
                p0_tile(p.in[up ? I_FU : I_FG], DFF, 64 * kb, n0, Wgu_t + (size_t)((n0 / 128) * 256 + (n0 % 128) + (up ? 128 : 0)) * D + 64 * kb, D, scr, lane, p.in[I_EVNF]); continue; } r -= 2 * T_FG;
            if (r < T_FD) { const int kb = r / 16, nb = r % 16; p0_tile(p.in[I_FD], D, 64 * kb, 64 * nb, Wd_t + (size_t)(64 * nb) * DFF + 64 * kb, DFF, scr, lane); continue; } r -= T_FD;
            if (r < T_QKV) { const int kb = r / 20, nb = r % 20; p0_tile(p.in[I_WQKV], QKVN, 64 * kb, 64 * nb, Wqkv_t + (size_t)(64 * nb) * D + 64 * kb, D, scr, lane, p.in[I_ODNM]); continue; } r -= T_QKV;
            { const int kb = r / 16, nb = r % 16; p0_tile(p.in[I_WO], D, 64 * kb, 64 * nb, Wo_t + (size_t)(64 * nb) * D + 64 * kb, D, scr, lane); }
        }
        for (int it = gw; it < 4 * 16 * 16; it += NGW) {
            const int g = it >> 8, cb = (it >> 4) & 15, nb = it & 15; const int n = 64 * nb + lane, c0 = 8 * cb;
            const float* wo = p.in[I_WOUT] + (size_t)(g * 128) * D + n; const float* ps = p.in[I_POOLS] + g * 128; const float* pw = p.in[I_POOLW] + (size_t)(g * 128 + c0) * 128;
            float acc[8];
#pragma unroll
            for (int cc = 0; cc < 8; ++cc) acc[cc] = 0.f;
            for (int d = 0; d < 128; ++d) { const float w = wo[(size_t)d * D] * ps[d];
#pragma unroll
                for (int cc = 0; cc < 8; ++cc) acc[cc] += pw[cc * 128 + d] * w; }
            *(u32x4*)(Wout_t + (size_t)n * D + g * 128 + c0) = pack8(acc);
        }
        for (int m = gw; m < M; m += NGW) { float y[16]; norm_row_bf16(p.in[I_X] + (size_t)m * D, p.in[I_EVNM], XN + (size_t)m * D, lane, y); }
        for (int i = bx * NTHR + tid; i < NQH * 256; i += G * NTHR) { const int h = i >> 8, idx = i & 255; bias_tab[i] = idx < 255 ? p.in[I_RELB][t5_bucket(idx - 191) * NQH + h] : 0.f; }
    }
    SEAM(0);

    if (IN(1)) for (int rep_ = 0; rep_ < NREP(1); ++rep_) { pg8::Gemm g{XN, Win_t, 2 * D, 2 * D, 2 * D}; pg8::DenseOrder S; S.init(M, MIXN, G, bx); pg8::EpiBf16 E{PROJ, MIXN, nullptr, nullptr};
        pg8::gemm_phase<pg8::EpiBf16, pg8::DenseOrder>(lds, g, S, E); }
    SEAM(1);

    if (IN(2)) for (int rep_ = 0; rep_ < NREP(2); ++rep_) {
        const int tid = fresh_tid(), lane = tid & 63;
        for (int unit = gw; unit < (M / 32) * 2; unit += NGW) {
            const int rb = unit >> 1, half = unit & 1, r0 = rb * 32, bs = r0 & ~(SEQ - 1);
            if (half == 0) {
                const int w = 2 << (lane >> 4); const bf16_t* P = PROJ + 8 * lane;
                float s[8];
#pragma unroll
                for (int q = 0; q < 8; ++q) s[q] = 0.f;
                for (int j = 1; j <= 16; ++j) if (j <= w && r0 - j >= bs) { float f[8]; unpack8(*(const u32x4*)(P + (size_t)(r0 - j) * MIXN), f);
#pragma unroll
                    for (int q = 0; q < 8; ++q) s[q] += f[q]; }
#pragma unroll 4
                for (int r = r0; r < r0 + 32; ++r) {
                    float cur[8], old[8]; unpack8(*(const u32x4*)(P + (size_t)r * MIXN), cur);
                    const bool has_old = (r - w >= bs);
                    if (has_old) unpack8(*(const u32x4*)(P + (size_t)(r - w) * MIXN), old);
                    const int pos = r - bs + 1; const float inv = 1.0f / (float)(pos < w ? pos : w);
                    float o[8];
#pragma unroll
                    for (int q = 0; q < 8; ++q) { s[q] += cur[q]; if (has_old) s[q] -= old[q]; o[q] = s[q] * inv - cur[q]; }
                    *(u32x4*)(MIXED + (size_t)r * D + 8 * lane) = pack8(o);
                }
            } else {
                const bf16_t* P = PROJ + 8 * lane;
                float w0[8], w1[8], w2[8], z1[8], z2[8];
                { const float* cw = p.in[I_CONVW] + 8 * lane;
#pragma unroll
                  for (int q = 0; q < 8; ++q) { w0[q] = cw[q]; w1[q] = cw[512 + q]; w2[q] = cw[1024 + q]; z1[q] = 0.f; z2[q] = 0.f; } }
                if (r0 - 1 >= bs) { float a[8], b[8]; unpack8(*(const u32x4*)(P + (size_t)(r0 - 1) * MIXN + 1024), a); unpack8(*(const u32x4*)(P + (size_t)(r0 - 1) * MIXN + 1536), b);
#pragma unroll
                    for (int q = 0; q < 8; ++q) z1[q] = a[q] * b[q]; }
                if (r0 - 2 >= bs) { float a[8], b[8]; unpack8(*(const u32x4*)(P + (size_t)(r0 - 2) * MIXN + 1024), a); unpack8(*(const u32x4*)(P + (size_t)(r0 - 2) * MIXN + 1536), b);
#pragma unroll
                    for (int q = 0; q < 8; ++q) z2[q] = a[q] * b[q]; }
#pragma unroll 4
                for (int r = r0; r < r0 + 32; ++r) {
                    float gp[8], a[8], b[8], o[8];
                    unpack8(*(const u32x4*)(P + (size_t)r * MIXN + 512), gp); unpack8(*(const u32x4*)(P + (size_t)r * MIXN + 1024), a); unpack8(*(const u32x4*)(P + (size_t)r * MIXN + 1536), b);
#pragma unroll
                    for (int q = 0; q < 8; ++q) { const float zc = a[q] * b[q]; o[q] = gp[q] * (w0[q] * z2[q] + w1[q] * z1[q] + w2[q] * zc); z2[q] = z1[q]; z1[q] = zc; }
                    *(u32x4*)(MIXED + (size_t)r * D + 512 + 8 * lane) = pack8(o);
                }
            }
        }
    }
    SEAM(2);

    if (IN(3)) for (int rep_ = 0; rep_ < NREP(3); ++rep_) { pg8::Gemm g{MIXED, Wout_t, 2 * D, 2 * D, 2 * D}; pg8::DenseOrder S; S.init(M, D, G, bx); pg8::EpiResid E{p.in[I_X], X, nullptr, XN, rss, lds + LDS_XTAB_OFF};
        pg8::gemm_phase<pg8::EpiResid, pg8::DenseOrder>(lds, g, S, E); }
    SEAM(3);


    if (IN(5)) for (int rep_ = 0; rep_ < NREP(5); ++rep_) { pg8::Gemm g{XN, Wgu_t, 2 * D, 2 * D, 2 * D}; pg8::DenseOrder S; S.init(M, 2 * DFF, G, bx); pg8::EpiSwiGLU E{Hb, DFF, rss};
        pg8::gemm_phase<pg8::EpiSwiGLU, pg8::DenseOrder>(lds, g, S, E); }
    SEAM(5);

    if (IN(6)) for (int rep_ = 0; rep_ < NREP(6); ++rep_) { pg8::Gemm g{Hb, Wd_t, 2 * DFF, 2 * DFF, 2 * DFF}; pg8::DenseOrder S; S.init(M, D, G, bx); pg8::EpiResid E{X, X, nullptr, XN, rss + (size_t)M * 4, lds + LDS_XTAB_OFF};
        pg8::gemm_phase<pg8::EpiResid, pg8::DenseOrder>(lds, g, S, E); }
    SEAM(6);


    if (IN(8)) for (int rep_ = 0; rep_ < NREP(8); ++rep_) { pg8::Gemm g{XN, Wqkv_t, 2 * D, 2 * D, 2 * D}; pg8::DenseOrder S; S.init(M, QKVN, G, bx); pg8::EpiBf16 E{QKV, QKVN, p.in[I_BQKV], rss + (size_t)M * 4};
        pg8::gemm_phase<pg8::EpiBf16, pg8::DenseOrder>(lds, g, S, E); }
    SEAM(8);

    if (IN(9)) for (int rep_ = 0; rep_ < NREP(9); ++rep_) {
        const int tid = fresh_tid(), lane = tid & 63;
        constexpr int KS_STR = 144, VT_STR = 392;
        constexpr int L_K = 0, L_VT = 192 * KS_STR, L_BT = L_VT + 64 * VT_STR, L_OST = L_BT + NQH * 256 * 4;
        static_assert(L_OST + NWAVES * 32 * 144 <= RING_BYTES, "attention LDS");
        for (int i = tid; i < NQH * 256; i += NTHR) *(LAS float*)(lds + L_BT + 4 * i) = bias_tab[i];
        const int r32 = lane & 31, hh = lane >> 5;
        for (int unit = vcu; unit < BATCH * (SEQ / CHUNK) * NKVH; unit += G) {
            const int kvh = unit & 1, n = (unit >> 1) & 255, b = unit >> 9;
            const int t0 = b * SEQ + n * CHUNK;
            __syncthreads();
#pragma unroll
            for (int i = 0; i < 3; ++i) { const int pc = tid + i * NTHR, j = pc >> 3, c = pc & 7; const bool valid = (n * CHUNK - 128 + j) >= 0;
                u32x4 kv = {0u, 0u, 0u, 0u}, vv = {0u, 0u, 0u, 0u};
                if (valid) { const bf16_t* src = QKV + (size_t)(t0 - 128 + j) * QKVN + 1024 + kvh * HD + 8 * c; kv = *(const u32x4*)src; vv = *(const u32x4*)(src + 128); }
                *(LAS u32x4*)(lds + L_K + j * KS_STR + 16 * c) = kv;
                const unsigned vw[4] = {vv.x, vv.y, vv.z, vv.w};
#pragma unroll
                for (int q = 0; q < 4; ++q) { *(LAS unsigned short*)(lds + L_VT + (8 * c + 2 * q) * VT_STR + 2 * j) = (unsigned short)(vw[q] & 0xffffu);
                                              *(LAS unsigned short*)(lds + L_VT + (8 * c + 2 * q + 1) * VT_STR + 2 * j) = (unsigned short)(vw[q] >> 16); } }
            __syncthreads();
            const int head = kvh * 8 + wave;
            const float sink = p.in[I_SINK][head];
            const LAS float* bt = (const LAS float*)(lds + L_BT + head * 1024);
            const int kb_min = n == 0 ? 4 : (n == 1 ? 2 : 0);
#pragma unroll 1
            for (int qb = 0; qb < 2; ++qb) {
                bf16x8 qf[4];
                { const bf16_t* qp = QKV + (size_t)(t0 + qb * 32 + r32) * QKVN + head * HD + 8 * hh;
#pragma unroll
                  for (int ks = 0; ks < 4; ++ks) qf[ks] = *(const bf16x8*)(qp + 16 * ks); }
                f32x16 st[6];
#pragma unroll
                for (int kb = 0; kb < 6; ++kb) {
#pragma unroll
                    for (int e = 0; e < 16; ++e) st[kb][e] = 0.f;
#pragma unroll
                    for (int ks = 0; ks < 4; ++ks) { const bf16x8 kf = *(const LAS bf16x8*)(lds + L_K + (kb * 32 + r32) * KS_STR + 32 * ks + 16 * hh);
                        st[kb] = __builtin_amdgcn_mfma_f32_32x32x16_bf16(kf, qf[ks], st[kb], 0, 0, 0); } }
                float mx = sink;
#pragma unroll
                for (int kb = 0; kb < 6; ++kb)
#pragma unroll
                    for (int e = 0; e < 16; ++e) { const int j = kb * 32 + (e & 3) + 8 * (e >> 2) + 4 * hh; const int idx = j - (qb * 32 + r32) + 63;
                        float sc = st[kb][e] * 0.125f + bt[idx]; sc = (kb < kb_min) ? -1e30f : sc; st[kb][e] = sc; mx = fmaxf(mx, sc); }
                mx = fmaxf(mx, __shfl_xor(mx, 32));
                float sum = 0.f;
#pragma unroll
                for (int kb = 0; kb < 6; ++kb)
#pragma unroll
                    for (int e = 0; e < 16; ++e) { const float pe = __builtin_amdgcn_exp2f((st[kb][e] - mx) * 1.44269504089f); st[kb][e] = pe; sum += pe; }
                sum += __shfl_xor(sum, 32);
                const float inv = 1.0f / (sum + __builtin_amdgcn_exp2f((sink - mx) * 1.44269504089f));
                f32x16 ot[2];
#pragma unroll
                for (int db = 0; db < 2; ++db)
#pragma unroll
                    for (int e = 0; e < 16; ++e) ot[db][e] = 0.f;
#pragma unroll
                for (int kb = 0; kb < 6; ++kb)
#pragma unroll
                    for (int s = 0; s < 2; ++s) {
                        u32x4 pw; pw.x = pk2(st[kb][8 * s], st[kb][8 * s + 1]); pw.y = pk2(st[kb][8 * s + 2], st[kb][8 * s + 3]); pw.z = pk2(st[kb][8 * s + 4], st[kb][8 * s + 5]); pw.w = pk2(st[kb][8 * s + 6], st[kb][8 * s + 7]);
                        const bf16x8 pf = __builtin_bit_cast(bf16x8, pw);
#pragma unroll
                        for (int db = 0; db < 2; ++db) { const LAS unsigned char* vp = lds + L_VT + (db * 32 + r32) * VT_STR + 2 * (kb * 32 + 16 * s + 4 * hh);
                            const u32x2 v0 = *(const LAS u32x2*)vp, v1 = *(const LAS u32x2*)(vp + 16);
                            u32x4 vw; vw.x = v0.x; vw.y = v0.y; vw.z = v1.x; vw.w = v1.y;
                            ot[db] = __builtin_amdgcn_mfma_f32_32x32x16_bf16(__builtin_bit_cast(bf16x8, vw), pf, ot[db], 0, 0, 0); } }
                LAS unsigned char* ost = lds + L_OST + wave * (32 * 144);
#pragma unroll
                for (int db = 0; db < 2; ++db)
#pragma unroll
                    for (int g4 = 0; g4 < 4; ++g4) { u32x2 w; w.x = pk2(ot[db][4 * g4] * inv, ot[db][4 * g4 + 1] * inv); w.y = pk2(ot[db][4 * g4 + 2] * inv, ot[db][4 * g4 + 3] * inv);
                        *(LAS u32x2*)(ost + r32 * 144 + 2 * (db * 32 + 8 * g4 + 4 * hh)) = w; }
                LDS_WAIT();
#pragma unroll
                for (int i = 0; i < 4; ++i) { const int q = 8 * i + (lane >> 3), c = lane & 7; const u32x4 w = *(const LAS u32x4*)(ost + q * 144 + 16 * c);
                    *(u32x4*)(AO + (size_t)(t0 + qb * 32 + q) * D + head * HD + 8 * c) = w; }
                LDS_WAIT();
            }
        }
        __syncthreads();
    }
    SEAM(9);

    if (IN(10)) for (int rep_ = 0; rep_ < NREP(10); ++rep_) { pg8::Gemm g{AO, Wo_t, 2 * D, 2 * D, 2 * D}; pg8::DenseOrder S; S.init(M, D, G, bx); pg8::EpiResid E{X, X, p.in[I_BO], nullptr, nullptr, nullptr};
        pg8::gemm_phase<pg8::EpiResid, pg8::DenseOrder>(lds, g, S, E); }
    SEAM(10);

    const int RPW = (M + G - 1) / G;
    constexpr int L_RW = 0, L_RE = 32768, L_RWT = L_RE + 1024 * 4, L_RRK = L_RWT + 1024 * 4, L_CNT = L_RRK + 1024 * 4, L_SB = L_CNT + 64, L_SLOT = L_SB + 256;
    unsigned char* XN8 = (unsigned char*)XN;
    if (IN(11)) for (int rep_ = 0; rep_ < NREP(11); ++rep_) {
        const int tid = fresh_tid(), lane = tid & 63;
        for (int i = tid; i < D * NEXP; i += NTHR) { const int c = i >> 3, e = i & 7; *(LAS float*)(lds + L_RW + 4 * (e * D + c)) = p.in[I_ROUTER][i] * p.in[I_ODNF][c]; }
        if (tid < 8) *(LAS int*)(lds + L_CNT + 4 * tid) = 0;
        __syncthreads();
        const int rbase = bx * RPW;
        const int nrows = (M - rbase) < RPW ? (M - rbase) : RPW;
        f32x4 gn[4];
#pragma unroll
        for (int j = 0; j < 4; ++j) gn[j] = *(const f32x4*)(p.in[I_ODNF] + 256 * j + 4 * lane);
        for (int rl0 = wave; rl0 < nrows; rl0 += 4 * NWAVES) {
            f32x4 v[4][4];
#pragma unroll
            for (int u = 0; u < 4; ++u) { const int rl = rl0 + 8 * u; const int m = rbase + (rl < nrows ? rl : rl0);
#pragma unroll
                for (int j = 0; j < 4; ++j) v[u][j] = *(const f32x4*)(X + (size_t)m * D + 256 * j + 4 * lane); }
#pragma unroll
            for (int u = 0; u < 4; ++u) { const int rl = rl0 + 8 * u; if (rl >= nrows) continue; const int m = rbase + rl;
                float s2 = 0.f;
#pragma unroll
                for (int j = 0; j < 4; ++j) s2 += (v[u][j][0] * v[u][j][0] + v[u][j][1] * v[u][j][1]) + (v[u][j][2] * v[u][j][2] + v[u][j][3] * v[u][j][3]);
                const float r = 1.0f / sqrtf(wave_sum(s2) * (1.0f / D) + RMS_EPS);
                float lg[8];
#pragma unroll
                for (int e = 0; e < 8; ++e) { float a = 0.f;
#pragma unroll
                    for (int j = 0; j < 4; ++j) { const f32x4 w = *(const LAS f32x4*)(lds + L_RW + 4096 * e + 1024 * j + 16 * lane); a += (v[u][j][0] * w[0] + v[u][j][1] * w[1]) + (v[u][j][2] * w[2] + v[u][j][3] * w[3]); }
                    lg[e] = a; }
#pragma unroll
                for (int e = 0; e < 8; ++e) lg[e] = wave_sum(lg[e]) * r;
#pragma unroll
                for (int j = 0; j < 4; ++j) { const f32x4 y = v[u][j] * r * gn[j]; *(unsigned*)(XN8 + (size_t)m * D + 256 * j + 4 * lane) = pg8::pk4_fp8(y[0], y[1], y[2], y[3]); }
                int e0 = 0; float v0 = lg[0];
#pragma unroll
                for (int e = 1; e < 8; ++e) if (lg[e] > v0) { v0 = lg[e]; e0 = e; }
                int e1 = -1; float v1 = -3.0e38f;
#pragma unroll
                for (int e = 0; e < 8; ++e) if (e != e0 && lg[e] > v1) { v1 = lg[e]; e1 = e; }
                const float wt0 = 1.0f / (1.0f + __expf(v1 - v0));
                if (lane == 0) { *(LAS int*)(lds + L_RE + 8 * rl) = e0; *(LAS int*)(lds + L_RE + 8 * rl + 4) = e1; *(LAS float*)(lds + L_RWT + 8 * rl) = wt0; *(LAS float*)(lds + L_RWT + 8 * rl + 4) = 1.0f - wt0; }
            }
        }
        __syncthreads();
        for (int en = tid; en < 2 * nrows; en += NTHR) {
            const int e = *(LAS int*)(lds + L_RE + 4 * en); int r = 0;
            for (int j = 0; j < en; ++j) r += (*(LAS int*)(lds + L_RE + 4 * j) == e);
            *(LAS int*)(lds + L_RRK + 4 * en) = r;
            __hip_atomic_fetch_add((LAS int*)(lds + L_CNT + 4 * e), 1, __ATOMIC_RELAXED, __HIP_MEMORY_SCOPE_WORKGROUP);
        }
        __syncthreads();
        if (tid < 8) wgcnt[bx * 8 + tid] = *(LAS int*)(lds + L_CNT + 4 * tid);
        __syncthreads();
    }
    SEAM(11);

    if (IN(12)) for (int rep_ = 0; rep_ < NREP(12); ++rep_) {
        const int tid = fresh_tid(), lane = tid & 63;
        LAS int* sb = (LAS int*)(lds + L_SB);
        if (tid < 32) sb[tid] = 0;
        __syncthreads();
        for (int i = tid; i < G * 2; i += NTHR) { const int w = i >> 1, h4 = (i & 1) * 4; const u32x4 c = *(const u32x4*)(wgcnt + w * 8 + h4); const unsigned cv[4] = {c.x, c.y, c.z, c.w};
#pragma unroll
            for (int q = 0; q < 4; ++q) { __hip_atomic_fetch_add(sb + 16 + h4 + q, (int)cv[q], __ATOMIC_RELAXED, __HIP_MEMORY_SCOPE_WORKGROUP); if (w < bx) __hip_atomic_fetch_add(sb + 8 + h4 + q, (int)cv[q], __ATOMIC_RELAXED, __HIP_MEMORY_SCOPE_WORKGROUP); } }
        __syncthreads();
        if (tid == 0) { int base = 0; for (int e = 0; e < 8; ++e) { sb[e] = base; base += (sb[16 + e] + 255) & ~255; } sb[24] = base; }
        __syncthreads();
        const int rbase = bx * RPW;
        const int nrows = (M - rbase) < RPW ? (M - rbase) : RPW;
        unsigned char* HS8 = (unsigned char*)HS;
        for (int en = tid; en < 2 * nrows; en += NTHR) { const int e = *(LAS int*)(lds + L_RE + 4 * en); const int slot = sb[e] + sb[8 + e] + *(LAS int*)(lds + L_RRK + 4 * en);
            *(LAS int*)(lds + L_SLOT + 4 * en) = slot; slot_tok[slot] = 2 * (rbase + (en >> 1)) + (en & 1); slot_w[slot] = *(LAS float*)(lds + L_RWT + 4 * en); }
        __syncthreads();
        for (int en0 = wave; en0 < 2 * nrows; en0 += 4 * NWAVES) {
            u32x4 t[4];
#pragma unroll
            for (int u = 0; u < 4; ++u) { const int en = en0 + 8 * u; if (en < 2 * nrows) t[u] = *(const u32x4*)(XN8 + (size_t)(rbase + (en >> 1)) * D + 16 * lane); }
#pragma unroll
            for (int u = 0; u < 4; ++u) { const int en = en0 + 8 * u; if (en < 2 * nrows) *(u32x4*)(HS8 + (size_t)(*(LAS int*)(lds + L_SLOT + 4 * en)) * D + 16 * lane) = t[u]; } }
        if (bx == 0) {
            for (int e = 0; e < 8; ++e) { const int b0 = sb[e] + sb[16 + e], b1 = sb[e] + ((sb[16 + e] + 255) & ~255); for (int i = b0 + tid; i < b1; i += NTHR) { slot_tok[i] = -1; slot_w[i] = 0.f; } }
            const int nt_all = sb[24] >> 8;
            for (int j = tid; j < nt_all; j += NTHR) { int e = 0; for (int q = 1; q < 8; ++q) if ((j << 8) >= sb[q]) e = q; tilemeta[8 + j] = e; }
            if (tid == 0) { tilemeta[0] = nt_all; tilemeta[1] = nt_all; }
        }
        __syncthreads();
    }
    SEAM(12);

    if (IN(13) || IN(14)) {
        const int tid = fresh_tid();
        for (int j = tid; j < 288; j += NTHR) *(LAS int*)(lds + LDS_TILE_OFF + 4 * j) = (j < MAXTILES + 8) ? tilemeta[j] : 0;
        __syncthreads();
    }
    const LAS int* tmeta = (const LAS int*)(lds + LDS_TILE_OFF);
    if (IN(13)) for (int rep_ = 0; rep_ < NREP(13); ++rep_) {
        const int nall = __builtin_amdgcn_readfirstlane(tmeta[0]);
        pg8::Gemm g{HS, Wegu_t, D, D, D}; pg8::MoeOrder S; S.T.init(nall, NFE_T, G, bx); S.tpe = NFE_T; S.tile_e = tmeta + 8;
        pg8::EpiSwiGLU8 E{(unsigned char*)H2, DFE};
        pg8::gemm_phase<pg8::EpiSwiGLU8, pg8::MoeOrder, true>(lds, g, S, E);
    }
    SEAM(13);
    if (IN(14)) {
        const int nall = __builtin_amdgcn_readfirstlane(tmeta[0]);
        pg8::Gemm g{H2, Wed_t, DFE, DFE, DFE}; pg8::MoeOrder S; S.T.init(nall, D / 256, G, bx); S.tpe = D / 256; S.tile_e = tmeta + 8;
        pg8::EpiMoeDown E{X, (bf16_t*)(ws + WS_Y0), slot_tok, slot_w};
        pg8::gemm_phase<pg8::EpiMoeDown, pg8::MoeOrder, true>(lds, g, S, E);
    }
    SEAM(14);

    if (IN(15)) {
        const int lane = fresh_tid() & 63;
        const bf16_t* Y0 = (const bf16_t*)(ws + WS_Y0);
        for (int m = gw; m < M; m += NGW) {
            float* xrow = X + (size_t)m * D; f32x4 v[4];
#pragma unroll
            for (int j = 0; j < 2; ++j) { v[2 * j] = *(const f32x4*)(xrow + 512 * j + 8 * lane); v[2 * j + 1] = *(const f32x4*)(xrow + 512 * j + 8 * lane + 4);
                float f[8]; unpack8(*(const u32x4*)(Y0 + (size_t)m * D + 512 * j + 8 * lane), f);
#pragma unroll
                for (int q = 0; q < 4; ++q) { v[2 * j][q] += f[q]; v[2 * j + 1][q] += f[4 + q]; } }
            float s2 = 0.f;
#pragma unroll
            for (int j = 0; j < 4; ++j) s2 += (v[j][0] * v[j][0] + v[j][1] * v[j][1]) + (v[j][2] * v[j][2] + v[j][3] * v[j][3]);
            const float r = 1.0f / sqrtf(wave_sum(s2) * (1.0f / D) + RMS_EPS);
#pragma unroll
            for (int j = 0; j < 2; ++j) { const f32x4 g0 = *(const f32x4*)(p.in[I_FINAL] + 512 * j + 8 * lane), g1 = *(const f32x4*)(p.in[I_FINAL] + 512 * j + 8 * lane + 4);
                *(f32x4*)(xrow + 512 * j + 8 * lane) = v[2 * j] * r * g0; *(f32x4*)(xrow + 512 * j + 8 * lane + 4) = v[2 * j + 1] * r * g1; }
        }
    }
#undef IN
#undef SEAM
}

extern "C" void kernel_launch(void* const* d_in, const int* in_sizes, int n_in, void* d_out, int out_size, void* d_ws, size_t ws_size, hipStream_t stream) {
    static int grid = 0;
    if (grid == 0) {
        if (n_in != 24 || in_sizes[0] != M * D || out_size != M * D || ws_size < WS_END) { fprintf(stderr, "kernel_launch: unexpected shapes (n_in %d, in0 %d, out %d, ws %zu < %zu)\n", n_in, n_in > 0 ? in_sizes[0] : -1, out_size, ws_size, (size_t)WS_END); grid = -1; return; }
        int dev = 0, cus = 0, per_cu = 0;
        if (hipGetDevice(&dev) != hipSuccess || hipDeviceGetAttribute(&cus, hipDeviceAttributeMultiprocessorCount, dev) != hipSuccess) { grid = -1; return; }
        if (hipFuncSetAttribute((const void*)fwd_kernel, hipFuncAttributeMaxDynamicSharedMemorySize, LDS_BYTES) != hipSuccess) { fprintf(stderr, "kernel_launch: hipFuncSetAttribute failed\n"); grid = -1; return; }
        if (hipOccupancyMaxActiveBlocksPerMultiprocessor(&per_cu, (const void*)fwd_kernel, NTHR, LDS_BYTES) != hipSuccess || per_cu < 1) fprintf(stderr, "kernel_launch: occupancy query reports %d\n", per_cu);
        (void)hipGetLastError();
        grid = cus < 256 ? cus : 256;
    }
    if (grid < 0) return;
    (void)hipMemsetAsync((char*)d_ws + WS_CTL, 0, CTL_ZERO_BYTES, stream);
    Params a{};
    for (int i = 0; i < 24; ++i) a.in[i] = (const float*)d_in[i];
    a.out = (float*)d_out; a.ws = (unsigned char*)d_ws;
    constexpr int NPH = 16;
    if (MK_N_LAUNCHES == 1) { a.ph_lo = 0; a.ph_hi = NPH; hipLaunchKernelGGL(fwd_kernel, dim3(grid), dim3(NTHR), LDS_BYTES, stream, a); }
    else for (int li = 0; li < NPH; ++li) { a.ph_lo = li; a.ph_hi = li + 1; hipLaunchKernelGGL(fwd_kernel, dim3(grid), dim3(NTHR), LDS_BYTES, stream, a); }
}
```

```cpp
#include <hip/hip_runtime.h>
#include <cstdio>
#include <cstdint>

#ifndef MK_N_LAUNCHES
#define MK_N_LAUNCHES 1
#endif

#ifndef PROBE_KLOOP
#define PROBE_KLOOP 0
#endif
#ifndef PROBE_FOLD
#define PROBE_FOLD 3
#endif
#ifndef REPMASK
#define REPMASK 0u
#endif
#define NREP(k) ((((REPMASK) >> (k)) & 1u) ? 2 : 1)
#define LAS __attribute__((address_space(3)))
#define GAS __attribute__((address_space(1)))
typedef unsigned short bf16_t;
typedef short bf16x8 __attribute__((ext_vector_type(8)));
typedef short s16x4 __attribute__((ext_vector_type(4)));
typedef float f32x2 __attribute__((ext_vector_type(2)));
typedef float f32x4 __attribute__((ext_vector_type(4)));
typedef float f32x16 __attribute__((ext_vector_type(16)));
typedef unsigned u32x2 __attribute__((ext_vector_type(2)));
typedef unsigned u32x4 __attribute__((ext_vector_type(4)));
typedef __bf16 hbf16x2 __attribute__((ext_vector_type(2)));
typedef int i32x4 __attribute__((ext_vector_type(4)));
typedef int i32x8 __attribute__((ext_vector_type(8)));

constexpr int D = 1024, BATCH = 2, SEQ = 16384, M = BATCH * SEQ;
constexpr int MIXN = 2048;
constexpr int DFF = 2816, NFF_T = DFF / 128;
constexpr int QKVN = 1280, NQH = 16, NKVH = 2, HD = 64, CHUNK = 64, KVSPAN = 192;
constexpr int NEXP = 8, DFE = 3584, NFE_T = DFE / 128;
constexpr float RMS_EPS = 1e-6f;
constexpr int MAXSLOT = 67328;
constexpr int MAXTILES = MAXSLOT / 256;
constexpr int NWAVES = 8, NTHR = 512;

constexpr size_t MiB = 1u << 20;
constexpr size_t WS_CTL = 0, CTL_ZERO_BYTES = 1 * MiB;
constexpr size_t WS_BIAS = 1 * MiB;
constexpr size_t WS_WGCNT = WS_BIAS + 16 * 256 * 4;
constexpr size_t WS_TILE = WS_WGCNT + 1024 * 16 * 4;
constexpr size_t WS_TOKE = WS_TILE + 4096;
constexpr size_t WS_TOKW = WS_TOKE + 2 * (size_t)M * 4;
constexpr size_t WS_TOKR = WS_TOKW + 2 * (size_t)M * 4;
constexpr size_t WS_SLOTT = WS_TOKR + 2 * (size_t)M * 4;
constexpr size_t WS_SLOTW = WS_SLOTT + (size_t)MAXSLOT * 4;
static_assert(WS_SLOTW + (size_t)MAXSLOT * 4 <= 4 * MiB, "route region");
constexpr size_t WS_WIN = 4 * MiB;
constexpr size_t WS_WOUT = WS_WIN + (size_t)MIXN * D * 2;
constexpr size_t WS_WGU = WS_WOUT + (size_t)D * D * 2;
constexpr size_t WS_WD = WS_WGU + (size_t)2 * DFF * D * 2;
constexpr size_t WS_WQKV = WS_WD + (size_t)D * DFF * 2;
constexpr size_t WS_WO = WS_WQKV + (size_t)QKVN * D * 2;
static_assert(WS_WO + (size_t)D * D * 2 <= 31 * MiB, "dense weights");
constexpr size_t WS_WEGU = 31 * MiB;
constexpr size_t WS_WED = WS_WEGU + (size_t)NEXP * 2 * DFE * D;
static_assert(WS_WED + (size_t)NEXP * D * DFE == 115 * MiB, "expert weights");
constexpr size_t WS_XN = 115 * MiB;
constexpr size_t WS_Y0 = WS_XN;
constexpr size_t WS_R = 179 * MiB;
constexpr size_t WS_PROJ = WS_R, WS_MIXED = WS_R + (size_t)M * MIXN * 2;
constexpr size_t WS_H = WS_R;
constexpr size_t WS_QKV = WS_R, WS_AO = WS_R + (size_t)M * QKVN * 2;
constexpr size_t WS_HS = WS_R, WS_H2 = WS_R + 66 * MiB;
static_assert((size_t)MAXSLOT * D <= 66 * MiB, "HS");
constexpr size_t WS_END = WS_H2 + (size_t)MAXSLOT * DFE;
static_assert(WS_END <= 543497280ull, "workspace");
static_assert(WS_MIXED + (size_t)M * D * 2 <= 543497280ull && WS_H + (size_t)M * DFF * 2 <= 543497280ull, "workspace");

constexpr int CW_BAR = 4096;
constexpr size_t WS_RSS = 480 * MiB;
static_assert(WS_RSS >= WS_END && WS_RSS + 2 * (size_t)M * 4 * 4 <= 543497280ull, "rss");

constexpr int RING_BYTES = 131072;
constexpr int LDS_TILE_OFF = RING_BYTES;
constexpr int LDS_MISC_OFF = RING_BYTES + 2048;
constexpr int LDS_XTAB_OFF = RING_BYTES + 4096;
constexpr int LDS_BYTES = 147456;

__device__ __forceinline__ unsigned pk2(float lo, float hi) { f32x2 v = {lo, hi}; hbf16x2 b = __builtin_convertvector(v, hbf16x2); return __builtin_bit_cast(unsigned, b); }
__device__ __forceinline__ float bf_lo(unsigned w) { return __uint_as_float(w << 16); }
__device__ __forceinline__ float bf_hi(unsigned w) { return __uint_as_float(w & 0xffff0000u); }
__device__ __forceinline__ void unpack8(const u32x4 w, float (&f)[8]) { f[0] = bf_lo(w.x); f[1] = bf_hi(w.x); f[2] = bf_lo(w.y); f[3] = bf_hi(w.y); f[4] = bf_lo(w.z); f[5] = bf_hi(w.z); f[6] = bf_lo(w.w); f[7] = bf_hi(w.w); }
__device__ __forceinline__ u32x4 pack8(const float (&f)[8]) { u32x4 w; w.x = pk2(f[0], f[1]); w.y = pk2(f[2], f[3]); w.z = pk2(f[4], f[5]); w.w = pk2(f[6], f[7]); return w; }
__device__ __forceinline__ float wave_sum(float v) {
#pragma unroll
    for (int o = 1; o < 64; o <<= 1) v += __shfl_xor(v, o);
    return v;
}
__device__ __forceinline__ int fresh_tid() { int t = threadIdx.x; asm volatile("" : "+v"(t)); return t; }
#define LDS_WAIT() asm volatile("s_waitcnt lgkmcnt(0)" ::: "memory")
#define VM_WAIT() asm volatile("s_waitcnt vmcnt(0)" ::: "memory")

namespace pg8 {
constexpr int BM = 256, BK = 64, HALF = 128, HTB = HALF * BK * 2, STAGE_BYTES = 8 * HTB, NXCD = 8, WGM = 8;
__host__ __device__ __forceinline__ int lds_byte(int r, int c) { const int st = (r >> 4) * 2 + (c >> 5), rr = r & 15, cc = c & 31, ob = rr * 64 + cc * 2; return st * 1024 + (ob ^ (((ob >> 9) & 1) << 5)); }
__host__ __device__ __forceinline__ void stage_rc(int b, int& R, int& C) { const int st = b / 1024, sb = b % 1024, swz = sb ^ (((sb >> 9) & 1) << 5); R = (st >> 1) * 16 + swz / 64; C = (st & 1) * 32 + (swz % 64) / 2; }
__host__ __device__ __forceinline__ int perm32(int rho) { const int n = rho >> 4, i = rho & 15; return 8 * (i >> 2) + 4 * n + (i & 3); }

struct Unit { int pm, pn, rm, cn; };
struct Gemm { const void* A; const void* Bt; int lda, ldb, K; };

struct TileOrder {
    int nM, nN, nwg, G, c;
    __device__ __forceinline__ void init(int nM_, int nN_, int G_, int c_) { nM = nM_; nN = nN_; nwg = nM * nN; G = G_; c = c_; }
    __device__ __forceinline__ bool next(int i, int& m, int& n) const {
        const int L = i * G + c; if (L >= nwg) return false;
        int wgid = L; { const int q = nwg / NXCD, r = nwg % NXCD, xcd = wgid % NXCD, off = wgid / NXCD; wgid = (xcd < r ? xcd * (q + 1) : r * (q + 1) + (xcd - r) * q) + off; }
        const int nig = WGM * nN, gid = wgid / nig, fm = gid * WGM, gsz = (nM - fm) < WGM ? (nM - fm) : WGM;
        m = fm + ((wgid % nig) % gsz); n = (wgid % nig) / gsz; return true;
    }
};
struct DenseOrder {
    TileOrder T;
    __device__ __forceinline__ void init(int Mr, int N, int G, int c) { T.init(Mr / BM, N / BM, G, c); }
    __device__ __forceinline__ bool next(int i, Unit& u) const { int m, n; if (!T.next(i, m, n)) return false; u.pm = m; u.pn = n; u.rm = m; u.cn = n; return true; }
    __device__ __forceinline__ void a_ready(const Unit&) const {}
    __device__ __forceinline__ void done(const Unit&) const {}
};
struct MoeOrder {
    TileOrder T; int tpe; const LAS int* tile_e;
    __device__ __forceinline__ bool next(int i, Unit& u) const { int m, n; if (!T.next(i, m, n)) return false;
        const int e = __builtin_amdgcn_readfirstlane(tile_e[m]);
        u.pm = m; u.pn = e * tpe + n; u.rm = m; u.cn = n; return true; }
    __device__ __forceinline__ void a_ready(const Unit&) const {}
    __device__ __forceinline__ void done(const Unit&) const {}
};

__device__ __forceinline__ float rms_scale(const float* rss, int row) { if (!rss) return 1.0f; const f32x4 a = *(const f32x4*)(rss + (size_t)row * 4);
    return 1.0f / sqrtf(((a[0] + a[1]) + (a[2] + a[3])) * (1.0f / D) + RMS_EPS); }
struct EpiBf16 {
    static constexpr bool PERM = true;
    bf16_t* O; int ldc; const float* bias; const float* rss;
    __device__ __forceinline__ void operator()(const f32x4 (&acc)[2][2][4][2], const Unit& u, int wr, int wc, int fr, int fq) const {
        const int row0 = u.rm * BM + wr * 64 + fr, col0 = u.cn * BM + wc * 32 + 8 * fq;
        f32x4 bv[2][2];
#pragma unroll
        for (int bj = 0; bj < 2; ++bj)
#pragma unroll
            for (int n = 0; n < 2; ++n) bv[bj][n] = bias ? *(const f32x4*)(bias + col0 + bj * HALF + 4 * n) : (f32x4){0.f, 0.f, 0.f, 0.f};
        float rs[2][4];
#pragma unroll
        for (int ai = 0; ai < 2; ++ai)
#pragma unroll
            for (int m = 0; m < 4; ++m) rs[ai][m] = rms_scale(rss, row0 + ai * HALF + m * 16);
#pragma unroll
        for (int ai = 0; ai < 2; ++ai)
#pragma unroll
            for (int m = 0; m < 4; ++m) { const int row = row0 + ai * HALF + m * 16; bf16_t* rowp = O + (size_t)row * ldc + col0; const float r = rs[ai][m];
#pragma unroll
                for (int bj = 0; bj < 2; ++bj) { const f32x4 v0 = acc[ai][bj][m][0] * r + bv[bj][0], v1 = acc[ai][bj][m][1] * r + bv[bj][1];
                    u32x4 w; w.x = pk2(v0[0], v0[1]); w.y = pk2(v0[2], v0[3]); w.z = pk2(v1[0], v1[1]); w.w = pk2(v1[2], v1[3]);
                    *(u32x4*)(rowp + bj * HALF) = w; } }
    }
};
__device__ __forceinline__ float silu_mul(float g, float u) { return g * u * __builtin_amdgcn_rcpf(1.0f + __builtin_amdgcn_exp2f(-1.44269504089f * g)); }
struct EpiSwiGLU {
    static constexpr bool PERM = true;
    bf16_t* O; int ldc; const float* rss;
    __device__ __forceinline__ void operator()(const f32x4 (&acc)[2][2][4][2], const Unit& u, int wr, int wc, int fr, int fq) const {
        const int row0 = u.rm * BM + wr * 64 + fr, col0 = u.cn * HALF + wc * 32 + 8 * fq;
        float rs[2][4];
#pragma unroll
        for (int ai = 0; ai < 2; ++ai)
#pragma unroll
            for (int m = 0; m < 4; ++m) rs[ai][m] = rms_scale(rss, row0 + ai * HALF + m * 16);
#pragma unroll
        for (int ai = 0; ai < 2; ++ai)
#pragma unroll
            for (int m = 0; m < 4; ++m) { const int row = row0 + ai * HALF + m * 16; bf16_t* rowp = O + (size_t)row * ldc + col0; const float r = rs[ai][m];
                const f32x4 g0 = acc[ai][0][m][0] * r, g1 = acc[ai][0][m][1] * r, u0 = acc[ai][1][m][0] * r, u1 = acc[ai][1][m][1] * r;
                u32x4 w; w.x = pk2(silu_mul(g0[0], u0[0]), silu_mul(g0[1], u0[1])); w.y = pk2(silu_mul(g0[2], u0[2]), silu_mul(g0[3], u0[3]));
                w.z = pk2(silu_mul(g1[0], u1[0]), silu_mul(g1[1], u1[1])); w.w = pk2(silu_mul(g1[2], u1[2]), silu_mul(g1[3], u1[3]));
                *(u32x4*)rowp = w; }
    }
};
struct EpiResid {
    static constexpr bool PERM = true;
    const float* base; float* out; const float* bias; bf16_t* xb; float* rss; LAS unsigned char* xlds;
    __device__ __forceinline__ void operator()(const f32x4 (&acc)[2][2][4][2], const Unit& u, int wr, int wc, int fr, int fq) const {
        const int row0 = u.rm * BM + wr * 64 + fr, col0 = u.cn * BM + wc * 32 + 8 * fq;
        f32x4 bv[2][2];
#pragma unroll
        for (int bj = 0; bj < 2; ++bj)
#pragma unroll
            for (int n = 0; n < 2; ++n) bv[bj][n] = bias ? *(const f32x4*)(bias + col0 + bj * HALF + 4 * n) : (f32x4){0.f, 0.f, 0.f, 0.f};
#pragma unroll
        for (int ai = 0; ai < 2; ++ai)
#pragma unroll
            for (int m = 0; m < 4; ++m) { const int row = row0 + ai * HALF + m * 16; const size_t off = (size_t)row * D + col0;
                f32x4 bs[2][2];
#pragma unroll
                for (int bj = 0; bj < 2; ++bj)
#pragma unroll
                    for (int n = 0; n < 2; ++n) bs[bj][n] = *(const f32x4*)(base + off + bj * HALF + 4 * n);
                float ss = 0.f;
#pragma unroll
                for (int bj = 0; bj < 2; ++bj) {
#pragma unroll
                    for (int n = 0; n < 2; ++n) { bs[bj][n] = bs[bj][n] + acc[ai][bj][m][n] + bv[bj][n]; *(f32x4*)(out + off + bj * HALF + 4 * n) = bs[bj][n];
                        ss += (bs[bj][n][0] * bs[bj][n][0] + bs[bj][n][1] * bs[bj][n][1]) + (bs[bj][n][2] * bs[bj][n][2] + bs[bj][n][3] * bs[bj][n][3]); }
                    if (xb) { u32x4 w; w.x = pk2(bs[bj][0][0], bs[bj][0][1]); w.y = pk2(bs[bj][0][2], bs[bj][0][3]); w.z = pk2(bs[bj][1][0], bs[bj][1][1]); w.w = pk2(bs[bj][1][2], bs[bj][1][3]);
                        *(u32x4*)(xb + off + bj * HALF) = w; } }
                if (xb) { ss += __shfl_xor(ss, 16); ss += __shfl_xor(ss, 32); if (fq == 0) *(LAS float*)(xlds + 16 * (wr * 64 + ai * HALF + m * 16 + fr) + 4 * wc) = ss; }
                asm volatile("" ::: "memory"); }
        if (xb) { asm volatile("s_waitcnt lgkmcnt(0)" ::: "memory"); __builtin_amdgcn_s_barrier(); asm volatile("" ::: "memory");
            const int t = wr * 256 + wc * 64 + fq * 16 + fr;
            if (t < 256) { const f32x4 a = *(const LAS f32x4*)(xlds + 16 * t); rss[(size_t)(u.rm * BM + t) * 4 + u.cn] = (a[0] + a[1]) + (a[2] + a[3]); } }
    }
};
__device__ __forceinline__ unsigned pk4_fp8(float a, float b, float c, float d) {
    int w = __builtin_amdgcn_cvt_pk_fp8_f32(__builtin_amdgcn_fmed3f(a, -448.f, 448.f), __builtin_amdgcn_fmed3f(b, -448.f, 448.f), 0, false);
    w = __builtin_amdgcn_cvt_pk_fp8_f32(__builtin_amdgcn_fmed3f(c, -448.f, 448.f), __builtin_amdgcn_fmed3f(d, -448.f, 448.f), w, true);
    return (unsigned)w;
}
constexpr int E8M0_ONE = 0x7f7f7f7f, E8M0_2M6 = 0x79797979;
struct EpiSwiGLU8 {
    static constexpr bool PERM = true; static constexpr int SCALE_A = E8M0_ONE, SCALE_B = E8M0_2M6;
    unsigned char* O; int ldc;
    __device__ __forceinline__ void operator()(const f32x4 (&acc)[2][2][4][2], const Unit& u, int wr, int wc, int fr, int fq) const {
        const int row0 = u.rm * BM + wr * 64 + fr, col0 = u.cn * HALF + wc * 32 + 8 * fq;
#pragma unroll
        for (int ai = 0; ai < 2; ++ai)
#pragma unroll
            for (int m = 0; m < 4; ++m) { unsigned char* rowp = O + (size_t)(row0 + ai * HALF + m * 16) * ldc + col0;
                const f32x4 g0 = acc[ai][0][m][0], g1 = acc[ai][0][m][1], u0 = acc[ai][1][m][0], u1 = acc[ai][1][m][1];
                u32x2 w; w.x = pk4_fp8(silu_mul(g0[0], u0[0]), silu_mul(g0[1], u0[1]), silu_mul(g0[2], u0[2]), silu_mul(g0[3], u0[3]));
                w.y = pk4_fp8(silu_mul(g1[0], u1[0]), silu_mul(g1[1], u1[1]), silu_mul(g1[2], u1[2]), silu_mul(g1[3], u1[3]));
                *(u32x2*)rowp = w; }
    }
};
struct EpiNull8 {
    static constexpr bool PERM = true; static constexpr int SCALE_A = E8M0_ONE, SCALE_B = E8M0_2M6;
    float* sink;
    __device__ __forceinline__ void operator()(const f32x4 (&acc)[2][2][4][2], const Unit& u, int wr, int wc, int fr, int fq) const {
        float s = 0.f;
#pragma unroll
        for (int ai = 0; ai < 2; ++ai)
#pragma unroll
            for (int bj = 0; bj < 2; ++bj)
#pragma unroll
                for (int m = 0; m < 4; ++m)
#pragma unroll
                    for (int n = 0; n < 2; ++n) s += (acc[ai][bj][m][n][0] + acc[ai][bj][m][n][1]) + (acc[ai][bj][m][n][2] + acc[ai][bj][m][n][3]);
        if (s == 12345.678f) sink[0] = s;
    }
};
struct EpiMoeDown {
    static constexpr bool PERM = true; static constexpr int SCALE_A = E8M0_ONE, SCALE_B = E8M0_2M6;
    float* X; bf16_t* Y0; const int* slot_tok; const float* slot_w;
    __device__ __forceinline__ void operator()(const f32x4 (&acc)[2][2][4][2], const Unit& u, int wr, int wc, int fr, int fq) const {
        const int row0 = u.rm * BM + wr * 64 + fr, col0 = u.cn * BM + wc * 32 + 8 * fq;
#pragma unroll
        for (int ai = 0; ai < 2; ++ai)
#pragma unroll
            for (int m = 0; m < 4; ++m) { const int slot = row0 + ai * HALF + m * 16; const int meta = slot_tok[slot]; const float w = slot_w[slot];
                if (meta >= 0) { const size_t off = (size_t)(meta >> 1) * D + col0;
                    if (meta & 1) {
                        f32x4 bs[2][2];
#pragma unroll
                        for (int bj = 0; bj < 2; ++bj)
#pragma unroll
                            for (int n = 0; n < 2; ++n) bs[bj][n] = *(const f32x4*)(X + off + bj * HALF + 4 * n);
#pragma unroll
                        for (int bj = 0; bj < 2; ++bj)
#pragma unroll
                            for (int n = 0; n < 2; ++n) *(f32x4*)(X + off + bj * HALF + 4 * n) = bs[bj][n] + acc[ai][bj][m][n] * w;
                    } else {
#pragma unroll
                        for (int bj = 0; bj < 2; ++bj) { const f32x4 v0 = acc[ai][bj][m][0] * w, v1 = acc[ai][bj][m][1] * w;
                            u32x4 o; o.x = pk2(v0[0], v0[1]); o.y = pk2(v0[2], v0[3]); o.z = pk2(v1[0], v1[1]); o.w = pk2(v1[2], v1[3]);
                            *(u32x4*)(Y0 + off + bj * HALF) = o; }
                    } }
                asm volatile("" ::: "memory"); }
    }
};

template <int OFF> __device__ __forceinline__ void glds_s(const char* sbase, unsigned voff, unsigned lds_base) {
    unsigned keep;
    asm volatile("s_mov_b32 %0, m0\n\ts_add_u32 m0, %3, %4\n\ts_nop 0\n\tglobal_load_lds_dwordx4 %1, %2\n\ts_mov_b32 m0, %0" : "=&s"(keep) : "v"(voff), "s"(sbase), "s"(lds_base), "i"(OFF) : "memory", "scc");
}
template <class Epi, class Sched, bool FP8 = false, bool ALIGN_EPI = true, bool SP2 = true>
__device__ __forceinline__ void gemm_phase(LAS unsigned char* lds, const Gemm g, const Sched& S, const Epi& E) {
    const int tid = threadIdx.x, wid = __builtin_amdgcn_readfirstlane(tid >> 6), lane = tid & 63, wr = wid >> 2, wc = wid & 3, fr = lane & 15, fq = lane >> 4;
    const int nt = g.K / (BK * 2);
    unsigned voffA[2], voffB[2];
#pragma unroll
    for (int i = 0; i < 2; ++i) { int R, C; stage_rc(tid * 16 + i * 8192, R, C); const int Rb = Epi::PERM ? ((R & ~31) + perm32(R & 31)) : R;
        voffA[i] = (unsigned)(R * g.lda + C * 2); voffB[i] = (unsigned)(Rb * g.ldb + C * 2); }
    const size_t kstep = (size_t)(BK * 2);
    const size_t hstepA = (size_t)HALF * g.lda, hstepB = (size_t)HALF * g.ldb;
    const size_t tstepA = 2 * hstepA, tstepB = 2 * hstepB;
    const unsigned lds_base = (unsigned)(size_t)lds + (unsigned)wid * 1024u;
    const int aoff = lds_byte(wr * 64 + fr, fq * 8), boff = lds_byte(wc * 32 + fr, fq * 8);
#define PG8_SA(b, h) (((b) * 2 + (h)) * HTB)
#define PG8_SB(b, h) ((4 + (b) * 2 + (h)) * HTB)
#define PG8_STAGE(bufoff, gbase, voff) do { glds_s<(bufoff)>((const char*)(gbase), (voff)[0], lds_base); glds_s<(bufoff) + 8192>((const char*)(gbase), (voff)[1], lds_base); } while (0)
#define PG8_LDA(dst, b, h) do { _Pragma("unroll") for (int m = 0; m < 4; ++m) _Pragma("unroll") for (int k = 0; k < 2; ++k) dst[m][k] = *(const LAS bf16x8*)(lds + PG8_SA(b, h) + aoff + m * 2048 + k * 1024); } while (0)
#define PG8_LDB(dst, b, h) do { _Pragma("unroll") for (int n = 0; n < 2; ++n) _Pragma("unroll") for (int k = 0; k < 2; ++k) dst[n][k] = *(const LAS bf16x8*)(lds + PG8_SB(b, h) + boff + n * 2048 + k * 1024); } while (0)
#define PG8_MMA(ai, bj, At, Bt) do { __builtin_amdgcn_s_setprio(1); _Pragma("unroll") for (int m = 0; m < 4; ++m) _Pragma("unroll") for (int n = 0; n < 2; ++n) { \
        if constexpr (FP8) { const i32x4 b_lo = __builtin_bit_cast(i32x4, Bt[n][0]), b_hi = __builtin_bit_cast(i32x4, Bt[n][1]), a_lo = __builtin_bit_cast(i32x4, At[m][0]), a_hi = __builtin_bit_cast(i32x4, At[m][1]); \
            acc[ai][bj][m][n] = __builtin_amdgcn_mfma_scale_f32_16x16x128_f8f6f4(__builtin_shufflevector(b_lo, b_hi, 0, 1, 2, 3, 4, 5, 6, 7), __builtin_shufflevector(a_lo, a_hi, 0, 1, 2, 3, 4, 5, 6, 7), acc[ai][bj][m][n], 0, 0, 0, Epi::SCALE_B, 0, Epi::SCALE_A); } \
        else { _Pragma("unroll") for (int k = 0; k < 2; ++k) acc[ai][bj][m][n] = __builtin_amdgcn_mfma_f32_16x16x32_bf16(Bt[n][k], At[m][k], acc[ai][bj][m][n], 0, 0, 0); } } \
        __builtin_amdgcn_s_setprio(0); } while (0)
#define PG8_WAIT_V(n) asm volatile("s_waitcnt vmcnt(" #n ")" ::: "memory")
#define PG8_WAIT_L(n) asm volatile("s_waitcnt lgkmcnt(" #n ")" ::: "memory")
#define PG8_BAR __builtin_amdgcn_s_barrier()
#define PG8_SCHED __builtin_amdgcn_sched_barrier(0)
    Unit cur, nxt; int ui = 0;
    if (!S.next(0, cur)) return;
    f32x4 acc[2][2][4][2];
#pragma unroll
    for (int a = 0; a < 2; ++a)
#pragma unroll
        for (int b = 0; b < 2; ++b)
#pragma unroll
            for (int m = 0; m < 4; ++m)
#pragma unroll
                for (int n = 0; n < 2; ++n) acc[a][b][m][n] = (f32x4){0.f, 0.f, 0.f, 0.f};
    bf16x8 At[4][2], B0[2][2], B1[2][2];
    const char* cA = (const char*)g.A + (size_t)cur.pm * tstepA; const char* cB = (const char*)g.Bt + (size_t)cur.pn * tstepB;
    S.a_ready(cur);
    if constexpr (SP2) {
        PG8_STAGE(PG8_SB(0, 0), cB, voffB); PG8_STAGE(PG8_SB(0, 1), cB + hstepB, voffB); PG8_STAGE(PG8_SA(0, 0), cA, voffA); PG8_STAGE(PG8_SA(0, 1), cA + hstepA, voffA);
        if (wr == 1) PG8_BAR;
        PG8_WAIT_V(2); PG8_BAR;
        PG8_STAGE(PG8_SB(1, 0), cB + kstep, voffB); PG8_STAGE(PG8_SA(1, 0), cA + kstep, voffA); PG8_STAGE(PG8_SB(1, 1), cB + hstepB + kstep, voffB);
        PG8_WAIT_V(6); PG8_BAR;
    } else {
        PG8_STAGE(PG8_SB(0, 0), cB, voffB); PG8_STAGE(PG8_SA(0, 0), cA, voffA); PG8_STAGE(PG8_SB(0, 1), cB + hstepB, voffB); PG8_STAGE(PG8_SA(0, 1), cA + hstepA, voffA);
        if (wr == 1) PG8_BAR;
        PG8_WAIT_V(4); PG8_BAR;
        PG8_STAGE(PG8_SB(1, 0), cB + kstep, voffB); PG8_STAGE(PG8_SA(1, 0), cA + kstep, voffA); PG8_STAGE(PG8_SB(1, 1), cB + hstepB + kstep, voffB);
        PG8_WAIT_V(6); PG8_BAR;
    }
    for (;;) {
        const bool has_next = S.next(ui + 1, nxt);
        const char* nA = has_next ? (const char*)g.A + (size_t)nxt.pm * tstepA : cA; const char* nB = has_next ? (const char*)g.Bt + (size_t)nxt.pn * tstepB : cB;
#pragma clang loop unroll(disable)
        for (int t = 0; t < nt; t += 2) {
            const bool last = (t == nt - 2);
            const char* a1 = cA + (size_t)(t + 1) * kstep;
            const char* a2 = last ? nA : cA + (size_t)(t + 2) * kstep; const char* b2 = last ? nB : cB + (size_t)(t + 2) * kstep;
            const char* a3 = a2 + kstep; const char* b3 = b2 + kstep;
            if (last && has_next) S.a_ready(nxt);
            if constexpr (SP2) {
            PG8_LDB(B0, 0, 0); PG8_LDB(B1, 0, 1); PG8_SCHED; PG8_LDA(At, 0, 0); PG8_STAGE(PG8_SA(1, 1), a1 + hstepA, voffA);
            PG8_WAIT_V(8); PG8_WAIT_L(0); PG8_BAR; PG8_MMA(0, 0, At, B0); PG8_MMA(0, 1, At, B1); PG8_BAR; PG8_SCHED;
            PG8_LDA(At, 0, 1); PG8_STAGE(PG8_SB(0, 0), b2, voffB); PG8_STAGE(PG8_SB(0, 1), b2 + hstepB, voffB); PG8_STAGE(PG8_SA(0, 0), a2, voffA);
            PG8_WAIT_V(8); PG8_WAIT_L(0); PG8_BAR; PG8_MMA(1, 0, At, B0); PG8_MMA(1, 1, At, B1); PG8_BAR; PG8_SCHED;
            PG8_LDB(B0, 1, 0); PG8_LDB(B1, 1, 1); PG8_SCHED; PG8_LDA(At, 1, 0); PG8_STAGE(PG8_SA(0, 1), a2 + hstepA, voffA);
            PG8_WAIT_V(8); PG8_WAIT_L(0); PG8_BAR; PG8_MMA(0, 0, At, B0); PG8_MMA(0, 1, At, B1); PG8_BAR; PG8_SCHED;
            PG8_LDA(At, 1, 1); PG8_STAGE(PG8_SB(1, 0), b3, voffB); PG8_STAGE(PG8_SB(1, 1), b3 + hstepB, voffB); PG8_STAGE(PG8_SA(1, 0), a3, voffA);
            PG8_WAIT_V(8); PG8_WAIT_L(0); PG8_BAR; PG8_MMA(1, 0, At, B0); PG8_MMA(1, 1, At, B1); PG8_BAR; PG8_SCHED;
            } else {
            PG8_LDB(B0, 0, 0); PG8_SCHED; PG8_LDA(At, 0, 0); PG8_STAGE(PG8_SA(1, 1), a1 + hstepA, voffA);
            PG8_WAIT_L(8); PG8_BAR; PG8_WAIT_L(0); PG8_MMA(0, 0, At, B0); PG8_BAR; PG8_SCHED;
            PG8_LDB(B1, 0, 1); PG8_STAGE(PG8_SB(0, 0), b2, voffB);
            PG8_BAR; PG8_WAIT_L(0); PG8_MMA(0, 1, At, B1); PG8_BAR;
            PG8_LDA(At, 0, 1); PG8_STAGE(PG8_SA(0, 0), a2, voffA);
            PG8_BAR; PG8_WAIT_L(0); PG8_MMA(1, 0, At, B0); PG8_BAR; PG8_SCHED;
            PG8_STAGE(PG8_SB(0, 1), b2 + hstepB, voffB);
            PG8_WAIT_V(6); PG8_BAR; PG8_MMA(1, 1, At, B1); PG8_BAR;
            PG8_LDB(B0, 1, 0); PG8_SCHED; PG8_LDA(At, 1, 0); PG8_STAGE(PG8_SA(0, 1), a2 + hstepA, voffA);
            PG8_WAIT_L(8); PG8_BAR; PG8_WAIT_L(0); PG8_MMA(0, 0, At, B0); PG8_BAR; PG8_SCHED;
            PG8_LDB(B1, 1, 1); PG8_STAGE(PG8_SB(1, 0), b3, voffB);
            PG8_BAR; PG8_WAIT_L(0); PG8_MMA(0, 1, At, B1); PG8_BAR;
            PG8_LDA(At, 1, 1); PG8_STAGE(PG8_SA(1, 0), a3, voffA);
            PG8_BAR; PG8_WAIT_L(0); PG8_MMA(1, 0, At, B0); PG8_BAR; PG8_SCHED;
            PG8_STAGE(PG8_SB(1, 1), b3 + hstepB, voffB);
            PG8_WAIT_V(6); PG8_BAR; PG8_MMA(1, 1, At, B1); PG8_BAR;
            }
        }
        if constexpr (ALIGN_EPI) { if (wr == 0) PG8_BAR; }
        { int l2 = threadIdx.x; asm volatile("" : "+v"(l2)); l2 &= 63; E(acc, cur, wr, wc, l2 & 15, l2 >> 4); }
        S.done(cur);
        if (!has_next) break;
#pragma unroll
        for (int a = 0; a < 2; ++a)
#pragma unroll
            for (int b = 0; b < 2; ++b)
#pragma unroll
                for (int m = 0; m < 4; ++m)
#pragma unroll
                    for (int n = 0; n < 2; ++n) acc[a][b][m][n] = (f32x4){0.f, 0.f, 0.f, 0.f};
        cur = nxt; cA = nA; cB = nB; ++ui;
        if constexpr (ALIGN_EPI) { if (wr == 1) PG8_BAR; }
    }
    PG8_WAIT_V(0);
    if constexpr (!ALIGN_EPI) { if (wr == 0) PG8_BAR; }
    PG8_BAR;
#undef PG8_SA
#undef PG8_SB
#undef PG8_STAGE
#undef PG8_LDA
#undef PG8_LDB
#undef PG8_MMA
#undef PG8_WAIT_V
#undef PG8_WAIT_L
#undef PG8_BAR
#undef PG8_SCHED
}
}

#define XB_TMO      128
#define XB_XCNT(j)  (256  + 64 * (j))
#define XB_XSUB(j)  (1280 + 64 * (j))
#define XB_XGEN(j)  (2304 + 64 * (j))
#define XB_TOP      3328
#define XB_TOPGEN   3392
#define XCD_BAR_WORDS 3456
#define XB_SPIN_CAP (1u << 18)
__device__ __forceinline__ unsigned xb_ld(unsigned* p)              { return __hip_atomic_load(p, __ATOMIC_RELAXED, __HIP_MEMORY_SCOPE_AGENT); }
__device__ __forceinline__ unsigned xb_add(unsigned* p, unsigned v) { return __hip_atomic_fetch_add(p, v, __ATOMIC_RELAXED, __HIP_MEMORY_SCOPE_AGENT); }
__device__ __forceinline__ unsigned xb_xcc_id() { return (unsigned)__builtin_amdgcn_s_getreg((3 << 11) | 20) & 0xFu; }
#define XB_SPIN(cond, bar) do { unsigned _sp = 0; while (cond) { __builtin_amdgcn_s_sleep(1); \
    if ((++_sp & 255u) == 0u) { if (xb_ld(&(bar)[XB_TMO])) break; if (_sp > XB_SPIN_CAP) { atomicAdd(&(bar)[XB_TMO], 1u); break; } } } } while (0)
struct XcdBarrier { unsigned* bar; unsigned x; volatile LAS unsigned* st; };
__device__ __forceinline__ XcdBarrier xcd_barrier_post(unsigned* bar, volatile LAS unsigned* st) {
    XcdBarrier b; b.bar = bar; b.x = xb_xcc_id(); b.st = st;
    if (threadIdx.x == 0) (void)xb_add(&bar[XB_XCNT(b.x)], 1u);
    return b;
}
__device__ __forceinline__ void xcd_barrier_complete(unsigned* bar, unsigned x, unsigned& nloc, unsigned& nx) {
    const unsigned G = gridDim.x * gridDim.y * gridDim.z;
    unsigned sum, cnt, mine, sp = 0u;
    for (;;) {
        sum = 0u; cnt = 0u; mine = 0u;
#pragma unroll
        for (unsigned j = 0; j < 16; ++j) { const unsigned c = xb_ld(&bar[XB_XCNT(j)]); sum += c; cnt += (c > 0u) ? 1u : 0u; mine = (j == x) ? c : mine; }
        if (sum == G) break;
        __builtin_amdgcn_s_sleep(1);
        if ((++sp & 255u) == 0u) { if (xb_ld(&bar[XB_TMO])) break; if (sp > XB_SPIN_CAP) { atomicAdd(&bar[XB_TMO], 1u); break; } }
    }
    nloc = mine > 0u ? mine : 1u; nx = cnt > 0u ? cnt : 1u;
}
__device__ __forceinline__ void xcd_barrier(const XcdBarrier& b) {
    asm volatile("s_waitcnt vmcnt(0)" ::: "memory");
    __syncthreads();
    if (threadIdx.x == 0) {
        unsigned* bar = b.bar;
        __builtin_amdgcn_s_waitcnt(0);
        unsigned nloc = b.st[0], nx = b.st[1];
        if (nloc == 0u) { xcd_barrier_complete(bar, b.x, nloc, nx); b.st[0] = nloc; b.st[1] = nx; }
        const unsigned old = xb_add(&bar[XB_XSUB(b.x)], 1u);
        const unsigned gen = old / nloc;
        if (old + 1u == (gen + 1u) * nloc) {
            __builtin_amdgcn_fence(__ATOMIC_RELEASE, "agent");
            asm volatile("s_waitcnt vmcnt(0)" ::: "memory");
            const unsigned og = xb_add(&bar[XB_TOP], 1u);
            const unsigned tg = og / nx;
            if (og + 1u == (tg + 1u) * nx) xb_add(&bar[XB_TOPGEN], 1u);
            else XB_SPIN(xb_ld(&bar[XB_TOPGEN]) == tg, bar);
            __builtin_amdgcn_fence(__ATOMIC_ACQUIRE, "agent");
            xb_add(&bar[XB_XGEN(b.x)], 1u);
            asm volatile("s_waitcnt vmcnt(0)" ::: "memory");
        } else {
            XB_SPIN(xb_ld(&bar[XB_XGEN(b.x)]) == gen, bar);
            __builtin_amdgcn_fence(__ATOMIC_ACQUIRE, "agent");
            asm volatile("s_waitcnt vmcnt(0)" ::: "memory");
        }
    }
    __syncthreads();
}

struct Params { const float* in[24]; float* out; unsigned char* ws; int ph_lo, ph_hi; };
enum { I_X = 0, I_RELB, I_EVNM, I_WIN, I_POOLW, I_POOLS, I_CONVW, I_WOUT, I_EVNF, I_FG, I_FU, I_FD, I_ODNM, I_WQKV, I_BQKV, I_SINK, I_WO, I_BO, I_ODNF, I_ROUTER, I_EG, I_EU, I_ED, I_FINAL };

__device__ __forceinline__ void p0_tile(const float* __restrict__ src, int N, int k0, int n0, bf16_t* __restrict__ dst, int ldd, LAS unsigned char* scr, int lane, const float* __restrict__ gain = nullptr) {
    const int n4 = (lane & 15) * 4, kp = lane >> 4;
    f32x4 a[8], b[8];
#pragma unroll
    for (int i = 0; i < 8; ++i) { const float* p = src + (size_t)(k0 + 8 * i + 2 * kp) * N + n0 + n4; a[i] = *(const f32x4*)p; b[i] = *(const f32x4*)(p + N);
        if (gain) { a[i] = a[i] * gain[k0 + 8 * i + 2 * kp]; b[i] = b[i] * gain[k0 + 8 * i + 2 * kp + 1]; } }
#pragma unroll
    for (int i = 0; i < 8; ++i) { const int k = 8 * i + 2 * kp;
#pragma unroll
        for (int q = 0; q < 4; ++q) *(LAS unsigned*)(scr + (n4 + q) * 136 + k * 2) = pk2(a[i][q], b[i][q]); }
    LDS_WAIT();
    const int c = lane & 7, nr = lane >> 3;
#pragma unroll
    for (int j = 0; j < 8; ++j) { const int n = 8 * j + nr; const u32x2 lo = *(const LAS u32x2*)(scr + n * 136 + 16 * c), hi = *(const LAS u32x2*)(scr + n * 136 + 16 * c + 8);
        u32x4 o; o.x = lo.x; o.y = lo.y; o.z = hi.x; o.w = hi.y; *(u32x4*)(dst + (size_t)n * ldd + 8 * c) = o; }
    LDS_WAIT();
}
__device__ __forceinline__ void p0_tile8_load(const float* __restrict__ src, int N, int k0, int n0, int lane, f32x4 (&a)[4][4]) {
    const int n4 = (lane & 7) * 4, kq = lane >> 3;
#pragma unroll
    for (int i = 0; i < 4; ++i)
#pragma unroll
        for (int j = 0; j < 4; ++j) a[i][j] = *(const f32x4*)(src + (size_t)(k0 + 32 * i + 4 * kq + j) * N + n0 + n4);
}
__device__ __forceinline__ void p0_tile8_store(const f32x4 (&a)[4][4], unsigned char* __restrict__ dst, int ldd, float scale, LAS unsigned char* scr, int lane) {
    const int n4 = (lane & 7) * 4, kq = lane >> 3;
#pragma unroll
    for (int i = 0; i < 4; ++i)
#pragma unroll
        for (int q = 0; q < 4; ++q) *(LAS unsigned*)(scr + (n4 + q) * 144 + 32 * i + 4 * kq) = pg8::pk4_fp8(a[i][0][q] * scale, a[i][1][q] * scale, a[i][2][q] * scale, a[i][3][q] * scale);
    LDS_WAIT();
    const int c = lane & 7, nr = lane >> 3;
#pragma unroll
    for (int j = 0; j < 4; ++j) { const int n = 8 * j + nr; *(u32x4*)(dst + (size_t)n * ldd + 16 * c) = *(const LAS u32x4*)(scr + n * 144 + 16 * c); }
    LDS_WAIT();
}
struct P0Tile8 { const float* src; unsigned char* dst; int N, k0, n0, ldd; };
__device__ __forceinline__ P0Tile8 p0_tile8_desc(int it, const float* eg, const float* eu, const float* ed, unsigned char* Wegu8, unsigned char* Wed8) {
    constexpr int T_EG = 8 * 112, T_ED = 28 * 32, per_e = 2 * T_EG + T_ED;
    const int e = it / per_e; int q = it % per_e; P0Tile8 t;
    if (q < 2 * T_EG) { const int up = q >= T_EG; if (up) q -= T_EG; const int kb = q / 112, nb = q % 112, n0 = 32 * nb;
        t.src = (up ? eu : eg) + (size_t)e * D * DFE; t.N = DFE; t.k0 = 128 * kb; t.n0 = n0; t.dst = Wegu8 + ((size_t)e * 2 * DFE + (n0 / 128) * 256 + (n0 % 128) + (up ? 128 : 0)) * D + 128 * kb; t.ldd = D; }
    else { q -= 2 * T_EG; const int kb = q / 32, nb = q % 32;
        t.src = ed + (size_t)e * DFE * D; t.N = D; t.k0 = 128 * kb; t.n0 = 32 * nb; t.dst = Wed8 + ((size_t)e * D + 32 * nb) * DFE + 128 * kb; t.ldd = DFE; }
    return t;
}
__device__ __forceinline__ void norm_row_bf16(const float* __restrict__ xrow, const float* __restrict__ gain, bf16_t* __restrict__ orow, int lane, float (&y)[16]) {
    f32x4 v[4];
#pragma unroll
    for (int j = 0; j < 2; ++j) { v[2 * j] = *(const f32x4*)(xrow + 512 * j + 8 * lane); v[2 * j + 1] = *(const f32x4*)(xrow + 512 * j + 8 * lane + 4); }
    float s = 0.f;
#pragma unroll
    for (int j = 0; j < 4; ++j) s += (v[j][0] * v[j][0] + v[j][1] * v[j][1]) + (v[j][2] * v[j][2] + v[j][3] * v[j][3]);
    const float r = 1.0f / sqrtf(wave_sum(s) * (1.0f / D) + RMS_EPS);
#pragma unroll
    for (int j = 0; j < 2; ++j) { const f32x4 g0 = *(const f32x4*)(gain + 512 * j + 8 * lane), g1 = *(const f32x4*)(gain + 512 * j + 8 * lane + 4);
#pragma unroll
        for (int q = 0; q < 4; ++q) { y[8 * j + q] = v[2 * j][q] * r * g0[q]; y[8 * j + 4 + q] = v[2 * j + 1][q] * r * g1[q]; }
        u32x4 w; w.x = pk2(y[8 * j], y[8 * j + 1]); w.y = pk2(y[8 * j + 2], y[8 * j + 3]); w.z = pk2(y[8 * j + 4], y[8 * j + 5]); w.w = pk2(y[8 * j + 6], y[8 * j + 7]);
        *(u32x4*)(orow + 512 * j + 8 * lane) = w; }
}

__device__ __forceinline__ int t5_bucket(int rel) {
    const int n = rel < 0 ? -rel : rel; const int ret = rel > 0 ? 16 : 0;
    int v;
    if (n < 8) v = n; else if (n < 12) v = 8; else if (n < 16) v = 9; else if (n < 23) v = 10; else if (n < 32) v = 11; else if (n < 46) v = 12; else if (n < 64) v = 13; else if (n < 91) v = 14; else v = 15;
    return ret + v;
}

__global__ void __launch_bounds__(NTHR, 2) fwd_kernel(Params p) {
    extern __shared__ __attribute__((aligned(16))) unsigned char lds_raw[];
    LAS unsigned char* lds = (LAS unsigned char*)lds_raw;
    volatile LAS unsigned* MISC = (volatile LAS unsigned*)(lds + LDS_MISC_OFF);
    const int tid = threadIdx.x, lane = tid & 63, wave = __builtin_amdgcn_readfirstlane(tid >> 6);
    const int G = gridDim.x, bx = blockIdx.x;
    const int vcu = (G % 8 == 0) ? (bx % 8) * (G / 8) + bx / 8 : bx;
    const int gw = vcu * NWAVES + wave, NGW = G * NWAVES;
    unsigned char* ws = p.ws;
    unsigned* ctl = (unsigned*)(ws + WS_CTL);
    if (tid < 64) MISC[tid] = 0u;
    __syncthreads();
    XcdBarrier bar; bar.bar = ctl + CW_BAR; bar.x = 0; bar.st = nullptr;
    if (MK_N_LAUNCHES == 1) bar = xcd_barrier_post(ctl + CW_BAR, MISC + 8);
    const int lo = p.ph_lo, hi = p.ph_hi;
#define IN(k) (lo <= (k) && (k) < hi)
#define SEAM(k) do { if (MK_N_LAUNCHES == 1 && IN((k) + 1)) xcd_barrier(bar); } while (0)

    bf16_t* Win_t = (bf16_t*)(ws + WS_WIN); bf16_t* Wout_t = (bf16_t*)(ws + WS_WOUT); bf16_t* Wgu_t = (bf16_t*)(ws + WS_WGU); bf16_t* Wd_t = (bf16_t*)(ws + WS_WD);
    bf16_t* Wqkv_t = (bf16_t*)(ws + WS_WQKV); bf16_t* Wo_t = (bf16_t*)(ws + WS_WO); bf16_t* Wegu_t = (bf16_t*)(ws + WS_WEGU); bf16_t* Wed_t = (bf16_t*)(ws + WS_WED);
    bf16_t* XN = (bf16_t*)(ws + WS_XN); bf16_t* PROJ = (bf16_t*)(ws + WS_PROJ); bf16_t* MIXED = (bf16_t*)(ws + WS_MIXED); bf16_t* Hb = (bf16_t*)(ws + WS_H);
    bf16_t* QKV = (bf16_t*)(ws + WS_QKV); bf16_t* AO = (bf16_t*)(ws + WS_AO); bf16_t* HS = (bf16_t*)(ws + WS_HS); bf16_t* H2 = (bf16_t*)(ws + WS_H2);
    float* bias_tab = (float*)(ws + WS_BIAS); int* wgcnt = (int*)(ws + WS_WGCNT); int* tilemeta = (int*)(ws + WS_TILE);
    int* tok_e = (int*)(ws + WS_TOKE); float* tok_w = (float*)(ws + WS_TOKW); int* tok_r = (int*)(ws + WS_TOKR); int* slot_tok = (int*)(ws + WS_SLOTT); float* slot_w = (float*)(ws + WS_SLOTW);
    float* rss = (float*)(ws + WS_RSS);
    float* X = p.out;

    if (IN(0)) for (int rep_ = 0; rep_ < NREP(0); ++rep_) {
        const int tid = fresh_tid(), lane = tid & 63;
        LAS unsigned char* scr = lds + wave * 8704;
        constexpr int T_WIN = 16 * 32, T_WOUT = 8 * 16, T_FG = 16 * 44, T_FD = 44 * 16, T_QKV = 16 * 20, T_WO = 16 * 16;
        constexpr int T_EG = 8 * 112, T_ED = 28 * 32;
        constexpr int NT8 = NEXP * (2 * T_EG + T_ED);
        constexpr int NT = T_WIN + T_WOUT + 2 * T_FG + T_FD + T_QKV + T_WO;
        unsigned char* Wegu8 = (unsigned char*)Wegu_t; unsigned char* Wed8 = (unsigned char*)Wed_t;
        {
            f32x4 ta[4][4], tb[4][4];
            int it = gw;
            P0Tile8 da{}, db{};
            if (it < NT8) { da = p0_tile8_desc(it, p.in[I_EG], p.in[I_EU], p.in[I_ED], Wegu8, Wed8); p0_tile8_load(da.src, da.N, da.k0, da.n0, lane, ta); }
            while (it < NT8) {
                const int itb = it + NGW;
                if (itb < NT8) { db = p0_tile8_desc(itb, p.in[I_EG], p.in[I_EU], p.in[I_ED], Wegu8, Wed8); p0_tile8_load(db.src, db.N, db.k0, db.n0, lane, tb); }
                p0_tile8_store(ta, da.dst, da.ldd, 64.f, scr, lane);
                if (itb >= NT8) break;
                const int ita = itb + NGW;
                if (ita < NT8) { da = p0_tile8_desc(ita, p.in[I_EG], p.in[I_EU], p.in[I_ED], Wegu8, Wed8); p0_tile8_load(da.src, da.N, da.k0, da.n0, lane, ta); }
                p0_tile8_store(tb, db.dst, db.ldd, 64.f, scr, lane);
                it = ita;
            }
        }
        for (int it = gw; it < NT; it += NGW) {
            int r = it;
            if (r < T_WIN) { const int kb = r / 32, nb = r % 32; p0_tile(p.in[I_WIN], MIXN, 64 * kb, 64 * nb, Win_t + (size_t)(64 * nb) * D + 64 * kb, D, scr, lane); continue; } r -= T_WIN;
            if (r < T_WOUT) { const int kb = 8 + r / 16, nb = r % 16; p0_tile(p.in[I_WOUT], D, 64 * kb, 64 * nb, Wout_t + (size_t)(64 * nb) * D + 64 * kb, D, scr, lane); continue; } r -= T_WOUT;
            if (r < 2 * T_FG) { const int up = r >= T_FG; const int q = up ? r - T_FG : r; const int kb = q / 44, nb = q % 44, n0 = 64 * nb;
                p0_tile(p.in[up ? I_FU : I_FG], DFF, 64 * kb, n0, Wgu_t + (size_t)((n0 / 128) * 256 + (n0 % 128) + (up ? 128 : 0)) * D + 64 * kb, D, scr, lane, p.in[I_EVNF]); continue; } r -= 2 * T_FG;
            if (r < T_FD) { const int kb = r / 16, nb = r % 16; p0_tile(p.in[I_FD], D, 64 * kb, 64 * nb, Wd_t + (size_t)(64 * nb) * DFF + 64 * kb, DFF, scr, lane); continue; } r -= T_FD;
            if (r < T_QKV) { const int kb = r / 20, nb = r % 20; p0_tile(p.in[I_WQKV], QKVN, 64 * kb, 64 * nb, Wqkv_t + (size_t)(64 * nb) * D + 64 * kb, D, scr, lane, p.in[I_ODNM]); continue; } r -= T_QKV;
            { const int kb = r / 16, nb = r % 16; p0_tile(p.in[I_WO], D, 64 * kb, 64 * nb, Wo_t + (size_t)(64 * nb) * D + 64 * kb, D, scr, lane); }
        }
        for (int it = gw; it < 4 * 32 * 16; it += NGW) {
            const int g = it >> 9, cb = (it >> 4) & 31, nb = it & 15; const int n = 64 * nb + lane, c0 = 4 * cb;
            const float* wo = p.in[I_WOUT] + (size_t)(g * 128) * D + n; const float* ps = p.in[I_POOLS] + g * 128; const float* pw = p.in[I_POOLW] + (size_t)(g * 128 + c0) * 128;
            float acc[4] = {0.f, 0.f, 0.f, 0.f};
            for (int d0 = 0; d0 < 128; d0 += 16) {
                float w[16];
#pragma unroll
                for (int j = 0; j < 16; ++j) w[j] = wo[(size_t)(d0 + j) * D];
#pragma unroll
                for (int j = 0; j < 16; ++j) { const float ww = w[j] * ps[d0 + j];
#pragma unroll
                    for (int cc = 0; cc < 4; ++cc) acc[cc] += pw[cc * 128 + d0 + j] * ww; } }
            u32x2 o; o.x = pk2(acc[0], acc[1]); o.y = pk2(acc[2], acc[3]);
            *(u32x2*)(Wout_t + (size_t)n * D + g * 128 + c0) = o;
        }
#pragma unroll 2
        for (int m = gw; m < M; m += NGW) { float y[16]; norm_row_bf16(p.in[I_X] + (size_t)m * D, p.in[I_EVNM], XN + (size_t)m * D, lane, y); }
        for (int i = bx * NTHR + tid; i < NQH * 256; i += G * NTHR) { const int h = i >> 8, idx = i & 255; bias_tab[i] = idx < 255 ? p.in[I_RELB][t5_bucket(idx - 191) * NQH + h] : 0.f; }
    }
    SEAM(0);

    if (IN(1)) for (int rep_ = 0; rep_ < NREP(1); ++rep_) { pg8::Gemm g{XN, Win_t, 2 * D, 2 * D, 2 * D}; pg8::DenseOrder S; S.init(M, MIXN, G, bx); pg8::EpiBf16 E{PROJ, MIXN, nullptr, nullptr};
        pg8::gemm_phase<pg8::EpiBf16, pg8::DenseOrder>(lds, g, S, E); }
    SEAM(1);

    if (IN(2)) for (int rep_ = 0; rep_ < NREP(2); ++rep_) {
        const int tid = fresh_tid(), lane = tid & 63;
        for (int unit = gw; unit < (M / 32) * 2; unit += NGW) {
            const int rb = unit >> 1, half = unit & 1, r0 = rb * 32, bs = r0 & ~(SEQ - 1);
            if (half == 0) {
                const int w = 2 << (lane >> 4); const bf16_t* P = PROJ + 8 * lane;
                float s[8];
#pragma unroll
                for (int q = 0; q < 8; ++q) s[q] = 0.f;
                for (int j = 1; j <= 16; ++j) if (j <= w && r0 - j >= bs) { float f[8]; unpack8(*(const u32x4*)(P + (size_t)(r0 - j) * MIXN), f);
#pragma unroll
                    for (int q = 0; q < 8; ++q) s[q] += f[q]; }
#pragma unroll 4
                for (int r = r0; r < r0 + 32; ++r) {
                    float cur[8], old[8]; unpack8(*(const u32x4*)(P + (size_t)r * MIXN), cur);
                    const bool has_old = (r - w >= bs);
                    if (has_old) unpack8(*(const u32x4*)(P + (size_t)(r - w) * MIXN), old);
                    const int pos = r - bs + 1; const float inv = 1.0f / (float)(pos < w ? pos : w);
                    float o[8];
#pragma unroll
                    for (int q = 0; q < 8; ++q) { s[q] += cur[q]; if (has_old) s[q] -= old[q]; o[q] = s[q] * inv - cur[q]; }
                    *(u32x4*)(MIXED + (size_t)r * D + 8 * lane) = pack8(o);
                }
            } else {
                const bf16_t* P = PROJ + 8 * lane;
                float w0[8], w1[8], w2[8], z1[8], z2[8];
                { const float* cw = p.in[I_CONVW] + 8 * lane;
#pragma unroll
                  for (int q = 0; q < 8; ++q) { w0[q] = cw[q]; w1[q] = cw[512 + q]; w2[q] = cw[1024 + q]; z1[q] = 0.f; z2[q] = 0.f; } }
                if (r0 - 1 >= bs) { float a[8], b[8]; unpack8(*(const u32x4*)(P + (size_t)(r0 - 1) * MIXN + 1024), a); unpack8(*(const u32x4*)(P + (size_t)(r0 - 1) * MIXN + 1536), b);
#pragma unroll
                    for (int q = 0; q < 8; ++q) z1[q] = a[q] * b[q]; }
                if (r0 - 2 >= bs) { float a[8], b[8]; unpack8(*(const u32x4*)(P + (size_t)(r0 - 2) * MIXN + 1024), a); unpack8(*(const u32x4*)(P + (size_t)(r0 - 2) * MIXN + 1536), b);
#pragma unroll
                    for (int q = 0; q < 8; ++q) z2[q] = a[q] * b[q]; }
#pragma unroll 4
                for (int r = r0; r < r0 + 32; ++r) {
                    float gp[8], a[8], b[8], o[8];
                    unpack8(*(const u32x4*)(P + (size_t)r * MIXN + 512), gp); unpack8(*(const u32x4*)(P + (size_t)r * MIXN + 1024), a); unpack8(*(const u32x4*)(P + (size_t)r * MIXN + 1536), b);
#pragma unroll
                    for (int q = 0; q < 8; ++q) { const float zc = a[q] * b[q]; o[q] = gp[q] * (w0[q] * z2[q] + w1[q] * z1[q] + w2[q] * zc); z2[q] = z1[q]; z1[q] = zc; }
                    *(u32x4*)(MIXED + (size_t)r * D + 512 + 8 * lane) = pack8(o);
                }
            }
        }
    }
    SEAM(2);

    if (IN(3)) for (int rep_ = 0; rep_ < NREP(3); ++rep_) { pg8::Gemm g{MIXED, Wout_t, 2 * D, 2 * D, 2 * D}; pg8::DenseOrder S; S.init(M, D, G, bx); pg8::EpiResid E{p.in[I_X], X, nullptr, XN, rss, lds + LDS_XTAB_OFF};
        pg8::gemm_phase<pg8::EpiResid, pg8::DenseOrder>(lds, g, S, E); }
    SEAM(3);


    if (IN(5)) for (int rep_ = 0; rep_ < NREP(5); ++rep_) { pg8::Gemm g{XN, Wgu_t, 2 * D, 2 * D, 2 * D}; pg8::DenseOrder S; S.init(M, 2 * DFF, G, bx); pg8::EpiSwiGLU E{Hb, DFF, rss};
        pg8::gemm_phase<pg8::EpiSwiGLU, pg8::DenseOrder>(lds, g, S, E); }
    SEAM(5);

    if (IN(6)) for (int rep_ = 0; rep_ < NREP(6); ++rep_) { pg8::Gemm g{Hb, Wd_t, 2 * DFF, 2 * DFF, 2 * DFF}; pg8::DenseOrder S; S.init(M, D, G, bx); pg8::EpiResid E{X, X, nullptr, XN, rss + (size_t)M * 4, lds + LDS_XTAB_OFF};
        pg8::gemm_phase<pg8::EpiResid, pg8::DenseOrder>(lds, g, S, E); }
    SEAM(6);


    if (IN(8)) for (int rep_ = 0; rep_ < NREP(8); ++rep_) { pg8::Gemm g{XN, Wqkv_t, 2 * D, 2 * D, 2 * D}; pg8::DenseOrder S; S.init(M, QKVN, G, bx); pg8::EpiBf16 E{QKV, QKVN, p.in[I_BQKV], rss + (size_t)M * 4};
        pg8::gemm_phase<pg8::EpiBf16, pg8::DenseOrder>(lds, g, S, E); }
    SEAM(8);

    if (IN(9)) for (int rep_ = 0; rep_ < NREP(9); ++rep_) {
        const int tid = fresh_tid(), lane = tid & 63;
        constexpr int KS_STR = 144, VT_STR = 392;
        constexpr int L_K = 0, L_VT = 192 * KS_STR, L_BT = L_VT + 64 * VT_STR, L_OST = L_BT + NQH * 256 * 4;
        static_assert(L_OST + NWAVES * 32 * 144 <= RING_BYTES, "attention LDS");
        for (int i = tid; i < NQH * 256; i += NTHR) *(LAS float*)(lds + L_BT + 4 * i) = bias_tab[i];
        const int r32 = lane & 31, hh = lane >> 5;
        for (int unit = vcu; unit < BATCH * (SEQ / CHUNK) * NKVH; unit += G) {
            const int kvh = unit & 1, n = (unit >> 1) & 255, b = unit >> 9;
            const int t0 = b * SEQ + n * CHUNK;
            __syncthreads();
#pragma unroll
            for (int i = 0; i < 3; ++i) { const int pc = tid + i * NTHR, j = pc >> 3, c = pc & 7; const bool valid = (n * CHUNK - 128 + j) >= 0;
                u32x4 kv = {0u, 0u, 0u, 0u}, vv = {0u, 0u, 0u, 0u};
                if (valid) { const bf16_t* src = QKV + (size_t)(t0 - 128 + j) * QKVN + 1024 + kvh * HD + 8 * c; kv = *(const u32x4*)src; vv = *(const u32x4*)(src + 128); }
                *(LAS u32x4*)(lds + L_K + j * KS_STR + 16 * c) = kv;
                const unsigned vw[4] = {vv.x, vv.y, vv.z, vv.w};
#pragma unroll
                for (int q = 0; q < 4; ++q) { *(LAS unsigned short*)(lds + L_VT + (8 * c + 2 * q) * VT_STR + 2 * j) = (unsigned short)(vw[q] & 0xffffu);
                                              *(LAS unsigned short*)(lds + L_VT + (8 * c + 2 * q + 1) * VT_STR + 2 * j) = (unsigned short)(vw[q] >> 16); } }
            __syncthreads();
            const int head = kvh * 8 + wave;
            const float sink = p.in[I_SINK][head];
            const LAS float* bt = (const LAS float*)(lds + L_BT + head * 1024);
            const int kb_min = n == 0 ? 4 : (n == 1 ? 2 : 0);
#pragma unroll 1
            for (int qb = 0; qb < 2; ++qb) {
                bf16x8 qf[4];
                { const bf16_t* qp = QKV + (size_t)(t0 + qb * 32 + r32) * QKVN + head * HD + 8 * hh;
#pragma unroll
                  for (int ks = 0; ks < 4; ++ks) qf[ks] = *(const bf16x8*)(qp + 16 * ks); }
                f32x16 st[6];
#pragma unroll
                for (int kb = 0; kb < 6; ++kb) {
#pragma unroll
                    for (int e = 0; e < 16; ++e) st[kb][e] = 0.f;
#pragma unroll
                    for (int ks = 0; ks < 4; ++ks) { const bf16x8 kf = *(const LAS bf16x8*)(lds + L_K + (kb * 32 + r32) * KS_STR + 32 * ks + 16 * hh);
                        st[kb] = __builtin_amdgcn_mfma_f32_32x32x16_bf16(kf, qf[ks], st[kb], 0, 0, 0); } }
                float mx = sink;
#pragma unroll
                for (int kb = 0; kb < 6; ++kb)
#pragma unroll
                    for (int e = 0; e < 16; ++e) { const int j = kb * 32 + (e & 3) + 8 * (e >> 2) + 4 * hh; const int idx = j - (qb * 32 + r32) + 63;
                        float sc = st[kb][e] * 0.125f + bt[idx]; sc = (kb < kb_min) ? -1e30f : sc; st[kb][e] = sc; mx = fmaxf(mx, sc); }
                mx = fmaxf(mx, __shfl_xor(mx, 32));
                float sum = 0.f;
#pragma unroll
                for (int kb = 0; kb < 6; ++kb)
#pragma unroll
                    for (int e = 0; e < 16; ++e) { const float pe = __builtin_amdgcn_exp2f((st[kb][e] - mx) * 1.44269504089f); st[kb][e] = pe; sum += pe; }
                sum += __shfl_xor(sum, 32);
                const float inv = 1.0f / (sum + __builtin_amdgcn_exp2f((sink - mx) * 1.44269504089f));
                f32x16 ot[2];
#pragma unroll
                for (int db = 0; db < 2; ++db)
#pragma unroll
                    for (int e = 0; e < 16; ++e) ot[db][e] = 0.f;
#pragma unroll
                for (int kb = 0; kb < 6; ++kb)
#pragma unroll
                    for (int s = 0; s < 2; ++s) {
                        u32x4 pw; pw.x = pk2(st[kb][8 * s], st[kb][8 * s + 1]); pw.y = pk2(st[kb][8 * s + 2], st[kb][8 * s + 3]); pw.z = pk2(st[kb][8 * s + 4], st[kb][8 * s + 5]); pw.w = pk2(st[kb][8 * s + 6], st[kb][8 * s + 7]);
                        const bf16x8 pf = __builtin_bit_cast(bf16x8, pw);
#pragma unroll
                        for (int db = 0; db < 2; ++db) { const LAS unsigned char* vp = lds + L_VT + (db * 32 + r32) * VT_STR + 2 * (kb * 32 + 16 * s + 4 * hh);
                            const u32x2 v0 = *(const LAS u32x2*)vp, v1 = *(const LAS u32x2*)(vp + 16);
                            u32x4 vw; vw.x = v0.x; vw.y = v0.y; vw.z = v1.x; vw.w = v1.y;
                            ot[db] = __builtin_amdgcn_mfma_f32_32x32x16_bf16(__builtin_bit_cast(bf16x8, vw), pf, ot[db], 0, 0, 0); } }
                LAS unsigned char* ost = lds + L_OST + wave * (32 * 144);
#pragma unroll
                for (int db = 0; db < 2; ++db)
#pragma unroll
                    for (int g4 = 0; g4 < 4; ++g4) { u32x2 w; w.x = pk2(ot[db][4 * g4] * inv, ot[db][4 * g4 + 1] * inv); w.y = pk2(ot[db][4 * g4 + 2] * inv, ot[db][4 * g4 + 3] * inv);
                        *(LAS u32x2*)(ost + r32 * 144 + 2 * (db * 32 + 8 * g4 + 4 * hh)) = w; }
                LDS_WAIT();
#pragma unroll
                for (int i = 0; i < 4; ++i) { const int q = 8 * i + (lane >> 3), c = lane & 7; const u32x4 w = *(const LAS u32x4*)(ost + q * 144 + 16 * c);
                    *(u32x4*)(AO + (size_t)(t0 + qb * 32 + q) * D + head * HD + 8 * c) = w; }
                LDS_WAIT();
            }
        }
        __syncthreads();
    }
    SEAM(9);

    if (IN(10)) for (int rep_ = 0; rep_ < NREP(10); ++rep_) { pg8::Gemm g{AO, Wo_t, 2 * D, 2 * D, 2 * D}; pg8::DenseOrder S; S.init(M, D, G, bx); pg8::EpiResid E{X, X, p.in[I_BO], nullptr, nullptr, nullptr};
        pg8::gemm_phase<pg8::EpiResid, pg8::DenseOrder>(lds, g, S, E); }
    SEAM(10);

    const int RPW = (M + G - 1) / G;
    constexpr int L_RW = 0, L_RE = 32768, L_RWT = L_RE + 1024 * 4, L_RRK = L_RWT + 1024 * 4, L_CNT = L_RRK + 1024 * 4, L_SB = L_CNT + 64, L_SLOT = L_SB + 256;
    unsigned char* XN8 = (unsigned char*)XN;
    if (IN(11)) for (int rep_ = 0; rep_ < NREP(11); ++rep_) {
        const int tid = fresh_tid(), lane = tid & 63;
        for (int i = tid; i < D * NEXP; i += NTHR) { const int c = i >> 3, e = i & 7; *(LAS float*)(lds + L_RW + 4 * (e * D + c)) = p.in[I_ROUTER][i] * p.in[I_ODNF][c]; }
        if (tid < 8) *(LAS int*)(lds + L_CNT + 4 * tid) = 0;
        __syncthreads();
        const int rbase = bx * RPW;
        const int nrows = (M - rbase) < RPW ? (M - rbase) : RPW;
        f32x4 gn[4];
#pragma unroll
        for (int j = 0; j < 4; ++j) gn[j] = *(const f32x4*)(p.in[I_ODNF] + 256 * j + 4 * lane);
        for (int rl0 = wave; rl0 < nrows; rl0 += 4 * NWAVES) {
            f32x4 v[4][4];
#pragma unroll
            for (int u = 0; u < 4; ++u) { const int rl = rl0 + 8 * u; const int m = rbase + (rl < nrows ? rl : rl0);
#pragma unroll
                for (int j = 0; j < 4; ++j) v[u][j] = *(const f32x4*)(X + (size_t)m * D + 256 * j + 4 * lane); }
#pragma unroll
            for (int u = 0; u < 4; ++u) { const int rl = rl0 + 8 * u; if (rl >= nrows) continue; const int m = rbase + rl;
                float s2 = 0.f;
#pragma unroll
                for (int j = 0; j < 4; ++j) s2 += (v[u][j][0] * v[u][j][0] + v[u][j][1] * v[u][j][1]) + (v[u][j][2] * v[u][j][2] + v[u][j][3] * v[u][j][3]);
                const float r = 1.0f / sqrtf(wave_sum(s2) * (1.0f / D) + RMS_EPS);
                float lg[8];
#pragma unroll
                for (int e = 0; e < 8; ++e) { float a = 0.f;
#pragma unroll
                    for (int j = 0; j < 4; ++j) { const f32x4 w = *(const LAS f32x4*)(lds + L_RW + 4096 * e + 1024 * j + 16 * lane); a += (v[u][j][0] * w[0] + v[u][j][1] * w[1]) + (v[u][j][2] * w[2] + v[u][j][3] * w[3]); }
                    lg[e] = a; }
#pragma unroll
                for (int e = 0; e < 8; ++e) lg[e] = wave_sum(lg[e]) * r;
#pragma unroll
                for (int j = 0; j < 4; ++j) { const f32x4 y = v[u][j] * r * gn[j]; *(unsigned*)(XN8 + (size_t)m * D + 256 * j + 4 * lane) = pg8::pk4_fp8(y[0], y[1], y[2], y[3]); }
                int e0 = 0; float v0 = lg[0];
#pragma unroll
                for (int e = 1; e < 8; ++e) if (lg[e] > v0) { v0 = lg[e]; e0 = e; }
                int e1 = -1; float v1 = -3.0e38f;
#pragma unroll
                for (int e = 0; e < 8; ++e) if (e != e0 && lg[e] > v1) { v1 = lg[e]; e1 = e; }
                const float wt0 = 1.0f / (1.0f + __expf(v1 - v0));
                if (lane == 0) { *(LAS int*)(lds + L_RE + 8 * rl) = e0; *(LAS int*)(lds + L_RE + 8 * rl + 4) = e1; *(LAS float*)(lds + L_RWT + 8 * rl) = wt0; *(LAS float*)(lds + L_RWT + 8 * rl + 4) = 1.0f - wt0; }
            }
        }
        __syncthreads();
        for (int en = tid; en < 2 * nrows; en += NTHR) {
            const int e = *(LAS int*)(lds + L_RE + 4 * en); int r = 0;
            for (int j = 0; j < en; ++j) r += (*(LAS int*)(lds + L_RE + 4 * j) == e);
            *(LAS int*)(lds + L_RRK + 4 * en) = r;
            __hip_atomic_fetch_add((LAS int*)(lds + L_CNT + 4 * e), 1, __ATOMIC_RELAXED, __HIP_MEMORY_SCOPE_WORKGROUP);
        }
        __syncthreads();
        if (tid < 8) wgcnt[bx * 8 + tid] = *(LAS int*)(lds + L_CNT + 4 * tid);
        __syncthreads();
    }
    SEAM(11);

    if (IN(12)) for (int rep_ = 0; rep_ < NREP(12); ++rep_) {
        const int tid = fresh_tid(), lane = tid & 63;
        LAS int* sb = (LAS int*)(lds + L_SB);
        if (tid < 32) sb[tid] = 0;
        __syncthreads();
        for (int i = tid; i < G * 2; i += NTHR) { const int w = i >> 1, h4 = (i & 1) * 4; const u32x4 c = *(const u32x4*)(wgcnt + w * 8 + h4); const unsigned cv[4] = {c.x, c.y, c.z, c.w};
#pragma unroll
            for (int q = 0; q < 4; ++q) { __hip_atomic_fetch_add(sb + 16 + h4 + q, (int)cv[q], __ATOMIC_RELAXED, __HIP_MEMORY_SCOPE_WORKGROUP); if (w < bx) __hip_atomic_fetch_add(sb + 8 + h4 + q, (int)cv[q], __ATOMIC_RELAXED, __HIP_MEMORY_SCOPE_WORKGROUP); } }
        __syncthreads();
        if (tid == 0) { int base = 0; for (int e = 0; e < 8; ++e) { sb[e] = base; base += (sb[16 + e] + 255) & ~255; } sb[24] = base; }
        __syncthreads();
        const int rbase = bx * RPW;
        const int nrows = (M - rbase) < RPW ? (M - rbase) : RPW;
        unsigned char* HS8 = (unsigned char*)HS;
        for (int en = tid; en < 2 * nrows; en += NTHR) { const int e = *(LAS int*)(lds + L_RE + 4 * en); const int slot = sb[e] + sb[8 + e] + *(LAS int*)(lds + L_RRK + 4 * en);
            *(LAS int*)(lds + L_SLOT + 4 * en) = slot; slot_tok[slot] = 2 * (rbase + (en >> 1)) + (en & 1); slot_w[slot] = *(LAS float*)(lds + L_RWT + 4 * en); }
        __syncthreads();
        for (int en0 = wave; en0 < 2 * nrows; en0 += 4 * NWAVES) {
            u32x4 t[4];
#pragma unroll
            for (int u = 0; u < 4; ++u) { const int en = en0 + 8 * u; if (en < 2 * nrows) t[u] = *(const u32x4*)(XN8 + (size_t)(rbase + (en >> 1)) * D + 16 * lane); }
#pragma unroll
            for (int u = 0; u < 4; ++u) { const int en = en0 + 8 * u; if (en < 2 * nrows) *(u32x4*)(HS8 + (size_t)(*(LAS int*)(lds + L_SLOT + 4 * en)) * D + 16 * lane) = t[u]; } }
        if (bx == 0) {
            for (int e = 0; e < 8; ++e) { const int b0 = sb[e] + sb[16 + e], b1 = sb[e] + ((sb[16 + e] + 255) & ~255); for (int i = b0 + tid; i < b1; i += NTHR) { slot_tok[i] = -1; slot_w[i] = 0.f; } }
            const int nt_all = sb[24] >> 8;
            for (int j = tid; j < nt_all; j += NTHR) { int e = 0; for (int q = 1; q < 8; ++q) if ((j << 8) >= sb[q]) e = q; tilemeta[8 + j] = e; }
            if (tid == 0) { tilemeta[0] = nt_all; tilemeta[1] = nt_all; }
        }
        __syncthreads();
    }
    SEAM(12);

    if (IN(13) || IN(14)) {
        const int tid = fresh_tid();
        for (int j = tid; j < 288; j += NTHR) *(LAS int*)(lds + LDS_TILE_OFF + 4 * j) = (j < MAXTILES + 8) ? tilemeta[j] : 0;
        __syncthreads();
    }
    const LAS int* tmeta = (const LAS int*)(lds + LDS_TILE_OFF);
    if (IN(13)) for (int rep_ = 0; rep_ < NREP(13); ++rep_) {
        const int nall = __builtin_amdgcn_readfirstlane(tmeta[0]);
        pg8::Gemm g{HS, Wegu_t, D, D, D}; pg8::MoeOrder S; S.T.init(nall, NFE_T, G, bx); S.tpe = NFE_T; S.tile_e = tmeta + 8;
        pg8::EpiSwiGLU8 E{(unsigned char*)H2, DFE};
        pg8::gemm_phase<pg8::EpiSwiGLU8, pg8::MoeOrder, true>(lds, g, S, E);
#if PROBE_KLOOP
        { pg8::EpiNull8 E2{(float*)(ws + WS_RSS)}; pg8::gemm_phase<pg8::EpiNull8, pg8::MoeOrder, true>(lds, g, S, E2); }
#endif
    }
    SEAM(13);
    if (IN(14)) {
        const int nall = __builtin_amdgcn_readfirstlane(tmeta[0]);
        pg8::Gemm g{H2, Wed_t, DFE, DFE, DFE}; pg8::MoeOrder S; S.T.init(nall, D / 256, G, bx); S.tpe = D / 256; S.tile_e = tmeta + 8;
        pg8::EpiMoeDown E{X, (bf16_t*)(ws + WS_Y0), slot_tok, slot_w};
        pg8::gemm_phase<pg8::EpiMoeDown, pg8::MoeOrder, true>(lds, g, S, E);
    }
    SEAM(14);

    if (IN(15)) {
        const int lane = fresh_tid() & 63;
        const bf16_t* Y0 = (const bf16_t*)(ws + WS_Y0);
        for (int m = gw; m < M; m += NGW) {
            float* xrow = X + (size_t)m * D; f32x4 v[4];
#pragma unroll
            for (int j = 0; j < 2; ++j) { v[2 * j] = *(const f32x4*)(xrow + 512 * j + 8 * lane); v[2 * j + 1] = *(const f32x4*)(xrow + 512 * j + 8 * lane + 4);
                float f[8]; unpack8(*(const u32x4*)(Y0 + (size_t)m * D + 512 * j + 8 * lane), f);
#pragma unroll
                for (int q = 0; q < 4; ++q) { v[2 * j][q] += f[q]; v[2 * j + 1][q] += f[4 + q]; } }
            float s2 = 0.f;
#pragma unroll
            for (int j = 0; j < 4; ++j) s2 += (v[j][0] * v[j][0] + v[j][1] * v[j][1]) + (v[j][2] * v[j][2] + v[j][3] * v[j][3]);
            const float r = 1.0f / sqrtf(wave_sum(s2) * (1.0f / D) + RMS_EPS);
#pragma unroll
            for (int j = 0; j < 2; ++j) { const f32x4 g0 = *(const f32x4*)(p.in[I_FINAL] + 512 * j + 8 * lane), g1 = *(const f32x4*)(p.in[I_FINAL] + 512 * j + 8 * lane + 4);
                *(f32x4*)(xrow + 512 * j + 8 * lane) = v[2 * j] * r * g0; *(f32x4*)(xrow + 512 * j + 8 * lane + 4) = v[2 * j + 1] * r * g1; }
        }
    }
#undef IN
#undef SEAM
}

extern "C" void kernel_launch(void* const* d_in, const int* in_sizes, int n_in, void* d_out, int out_size, void* d_ws, size_t ws_size, hipStream_t stream) {
    static int grid = 0;
    if (grid == 0) {
        if (n_in != 24 || in_sizes[0] != M * D || out_size != M * D || ws_size < WS_END) { fprintf(stderr, "kernel_launch: unexpected shapes (n_in %d, in0 %d, out %d, ws %zu < %zu)\n", n_in, n_in > 0 ? in_sizes[0] : -1, out_size, ws_size, (size_t)WS_END); grid = -1; return; }
        int dev = 0, cus = 0, per_cu = 0;
        if (hipGetDevice(&dev) != hipSuccess || hipDeviceGetAttribute(&cus, hipDeviceAttributeMultiprocessorCount, dev) != hipSuccess) { grid = -1; return; }
        if (hipFuncSetAttribute((const void*)fwd_kernel, hipFuncAttributeMaxDynamicSharedMemorySize, LDS_BYTES) != hipSuccess) { fprintf(stderr, "kernel_launch: hipFuncSetAttribute failed\n"); grid = -1; return; }
        if (hipOccupancyMaxActiveBlocksPerMultiprocessor(&per_cu, (const void*)fwd_kernel, NTHR, LDS_BYTES) != hipSuccess || per_cu < 1) fprintf(stderr, "kernel_launch: occupancy query reports %d\n", per_cu);
        (void)hipGetLastError();
        grid = cus < 256 ? cus : 256;
    }
    if (grid < 0) return;
    (void)hipMemsetAsync((char*)d_ws + WS_CTL, 0, CTL_ZERO_BYTES, stream);
    Params a{};
    for (int i = 0; i < 24; ++i) a.in[i] = (const float*)d_in[i];
    a.out = (float*)d_out; a.ws = (unsigned char*)d_ws;
    constexpr int NPH = 16;
    if (MK_N_LAUNCHES == 1) { a.ph_lo = 0; a.ph_hi = NPH; hipLaunchKernelGGL(fwd_kernel, dim3(grid), dim3(NTHR), LDS_BYTES, stream, a); }
    else for (int li = 0; li < NPH; ++li) { a.ph_lo = li; a.ph_hi = li + 1; hipLaunchKernelGGL(fwd_kernel, dim3(grid), dim3(NTHR), LDS_BYTES, stream, a); }
}
```

```cpp
#include <hip/hip_runtime.h>
#include <cstdio>
#include <cstdint>

#ifndef MK_N_LAUNCHES
#define MK_N_LAUNCHES 1
#endif

#ifndef PROBE_KLOOP
#define PROBE_KLOOP 0
#endif
#ifndef PROBE_FOLD
#define PROBE_FOLD 3
#endif
#ifndef REPMASK
#define REPMASK 0u
#endif
#define NREP(k) ((((REPMASK) >> (k)) & 1u) ? 2 : 1)
#define LAS __attribute__((address_space(3)))
#define GAS __attribute__((address_space(1)))
typedef unsigned short bf16_t;
typedef short bf16x8 __attribute__((ext_vector_type(8)));
typedef short s16x4 __attribute__((ext_vector_type(4)));
typedef float f32x2 __attribute__((ext_vector_type(2)));
typedef float f32x4 __attribute__((ext_vector_type(4)));
typedef float f32x16 __attribute__((ext_vector_type(16)));
typedef unsigned u32x2 __attribute__((ext_vector_type(2)));
typedef unsigned u32x4 __attribute__((ext_vector_type(4)));
typedef __bf16 hbf16x2 __attribute__((ext_vector_type(2)));
typedef int i32x4 __attribute__((ext_vector_type(4)));
typedef int i32x8 __attribute__((ext_vector_type(8)));

constexpr int D = 1024, BATCH = 2, SEQ = 16384, M = BATCH * SEQ;
constexpr int MIXN = 2048;
constexpr int DFF = 2816, NFF_T = DFF / 128;
constexpr int QKVN = 1280, NQH = 16, NKVH = 2, HD = 64, CHUNK = 64, KVSPAN = 192;
constexpr int NEXP = 8, DFE = 3584, NFE_T = DFE / 128;
constexpr float RMS_EPS = 1e-6f;
constexpr int MAXSLOT = 67328;
constexpr int MAXTILES = MAXSLOT / 256;
constexpr int NWAVES = 8, NTHR = 512;

constexpr size_t MiB = 1u << 20;
constexpr size_t WS_CTL = 0, CTL_ZERO_BYTES = 1 * MiB;
constexpr size_t WS_BIAS = 1 * MiB;
constexpr size_t WS_WGCNT = WS_BIAS + 16 * 256 * 4;
constexpr size_t WS_TILE = WS_WGCNT + 1024 * 16 * 4;
constexpr size_t WS_TOKE = WS_TILE + 4096;
constexpr size_t WS_TOKW = WS_TOKE + 2 * (size_t)M * 4;
constexpr size_t WS_TOKR = WS_TOKW + 2 * (size_t)M * 4;
constexpr size_t WS_SLOTT = WS_TOKR + 2 * (size_t)M * 4;
constexpr size_t WS_SLOTW = WS_SLOTT + (size_t)MAXSLOT * 4;
static_assert(WS_SLOTW + (size_t)MAXSLOT * 4 <= 4 * MiB, "route region");
constexpr size_t WS_WIN = 4 * MiB;
constexpr size_t WS_WOUT = WS_WIN + (size_t)MIXN * D * 2;
constexpr size_t WS_WGU = WS_WOUT + (size_t)D * D * 2;
constexpr size_t WS_WD = WS_WGU + (size_t)2 * DFF * D * 2;
constexpr size_t WS_WQKV = WS_WD + (size_t)D * DFF * 2;
constexpr size_t WS_WO = WS_WQKV + (size_t)QKVN * D * 2;
static_assert(WS_WO + (size_t)D * D * 2 <= 31 * MiB, "dense weights");
constexpr size_t WS_WEGU = 31 * MiB;
constexpr size_t WS_WED = WS_WEGU + (size_t)NEXP * 2 * DFE * D;
static_assert(WS_WED + (size_t)NEXP * D * DFE == 115 * MiB, "expert weights");
constexpr size_t WS_XN = 115 * MiB;
constexpr size_t WS_Y0 = WS_XN;
constexpr size_t WS_R = 179 * MiB;
constexpr size_t WS_PROJ = WS_R, WS_MIXED = WS_R + (size_t)M * MIXN * 2;
constexpr size_t WS_H = WS_R;
constexpr size_t WS_QKV = WS_R, WS_AO = WS_R + (size_t)M * QKVN * 2;
constexpr size_t WS_HS = WS_R, WS_H2 = WS_R + 66 * MiB;
static_assert((size_t)MAXSLOT * D <= 66 * MiB, "HS");
constexpr size_t WS_END = WS_H2 + (size_t)MAXSLOT * DFE;
static_assert(WS_END <= 543497280ull, "workspace");
static_assert(WS_MIXED + (size_t)M * D * 2 <= 543497280ull && WS_H + (size_t)M * DFF * 2 <= 543497280ull, "workspace");

constexpr int CW_BAR = 4096;
constexpr size_t WS_RSS = 480 * MiB;
static_assert(WS_RSS >= WS_END && WS_RSS + 2 * (size_t)M * 4 * 4 <= 543497280ull, "rss");

constexpr int RING_BYTES = 131072;
constexpr int LDS_TILE_OFF = RING_BYTES;
constexpr int LDS_MISC_OFF = RING_BYTES + 2048;
constexpr int LDS_XTAB_OFF = RING_BYTES + 4096;
constexpr int LDS_BYTES = 147456;

__device__ __forceinline__ unsigned pk2(float lo, float hi) { f32x2 v = {lo, hi}; hbf16x2 b = __builtin_convertvector(v, hbf16x2); return __builtin_bit_cast(unsigned, b); }
__device__ __forceinline__ float bf_lo(unsigned w) { return __uint_as_float(w << 16); }
__device__ __forceinline__ float bf_hi(unsigned w) { return __uint_as_float(w & 0xffff0000u); }
__device__ __forceinline__ void unpack8(const u32x4 w, float (&f)[8]) { f[0] = bf_lo(w.x); f[1] = bf_hi(w.x); f[2] = bf_lo(w.y); f[3] = bf_hi(w.y); f[4] = bf_lo(w.z); f[5] = bf_hi(w.z); f[6] = bf_lo(w.w); f[7] = bf_hi(w.w); }
__device__ __forceinline__ u32x4 pack8(const float (&f)[8]) { u32x4 w; w.x = pk2(f[0], f[1]); w.y = pk2(f[2], f[3]); w.z = pk2(f[4], f[5]); w.w = pk2(f[6], f[7]); return w; }
__device__ __forceinline__ float wave_sum(float v) {
#pragma unroll
    for (int o = 1; o < 64; o <<= 1) v += __shfl_xor(v, o);
    return v;
}
__device__ __forceinline__ int fresh_tid() { int t = threadIdx.x; asm volatile("" : "+v"(t)); return t; }
#define LDS_WAIT() asm volatile("s_waitcnt lgkmcnt(0)" ::: "memory")
#define VM_WAIT() asm volatile("s_waitcnt vmcnt(0)" ::: "memory")

namespace pg8 {
constexpr int BM = 256, BK = 64, HALF = 128, HTB = HALF * BK * 2, STAGE_BYTES = 8 * HTB, NXCD = 8, WGM = 8;
__host__ __device__ __forceinline__ int lds_byte(int r, int c) { const int st = (r >> 4) * 2 + (c >> 5), rr = r & 15, cc = c & 31, ob = rr * 64 + cc * 2; return st * 1024 + (ob ^ (((ob >> 9) & 1) << 5)); }
__host__ __device__ __forceinline__ void stage_rc(int b, int& R, int& C) { const int st = b / 1024, sb = b % 1024, swz = sb ^ (((sb >> 9) & 1) << 5); R = (st >> 1) * 16 + swz / 64; C = (st & 1) * 32 + (swz % 64) / 2; }
__host__ __device__ __forceinline__ int perm32(int rho) { const int n = rho >> 4, i = rho & 15; return 8 * (i >> 2) + 4 * n + (i & 3); }

struct Unit { int pm, pn, rm, cn; };
struct Gemm { const void* A; const void* Bt; int lda, ldb, K; };

struct TileOrder {
    int nM, nN, nwg, G, c;
    __device__ __forceinline__ void init(int nM_, int nN_, int G_, int c_) { nM = nM_; nN = nN_; nwg = nM * nN; G = G_; c = c_; }
    __device__ __forceinline__ bool next(int i, int& m, int& n) const {
        const int L = i * G + c; if (L >= nwg) return false;
        int wgid = L; { const int q = nwg / NXCD, r = nwg % NXCD, xcd = wgid % NXCD, off = wgid / NXCD; wgid = (xcd < r ? xcd * (q + 1) : r * (q + 1) + (xcd - r) * q) + off; }
        const int nig = WGM * nN, gid = wgid / nig, fm = gid * WGM, gsz = (nM - fm) < WGM ? (nM - fm) : WGM;
        m = fm + ((wgid % nig) % gsz); n = (wgid % nig) / gsz; return true;
    }
};
struct DenseOrder {
    TileOrder T;
    __device__ __forceinline__ void init(int Mr, int N, int G, int c) { T.init(Mr / BM, N / BM, G, c); }
    __device__ __forceinline__ bool next(int i, Unit& u) const { int m, n; if (!T.next(i, m, n)) return false; u.pm = m; u.pn = n; u.rm = m; u.cn = n; return true; }
    __device__ __forceinline__ void a_ready(const Unit&) const {}
    __device__ __forceinline__ void done(const Unit&) const {}
};
struct MoeOrder {
    TileOrder T; int tpe; const LAS int* tile_e;
    __device__ __forceinline__ bool next(int i, Unit& u) const { int m, n; if (!T.next(i, m, n)) return false;
        const int e = __builtin_amdgcn_readfirstlane(tile_e[m]);
        u.pm = m; u.pn = e * tpe + n; u.rm = m; u.cn = n; return true; }
    __device__ __forceinline__ void a_ready(const Unit&) const {}
    __device__ __forceinline__ void done(const Unit&) const {}
};

__device__ __forceinline__ float rms_scale(const float* rss, int row) { if (!rss) return 1.0f; const f32x4 a = *(const f32x4*)(rss + (size_t)row * 4);
    return 1.0f / sqrtf(((a[0] + a[1]) + (a[2] + a[3])) * (1.0f / D) + RMS_EPS); }
struct EpiBf16 {
    static constexpr bool PERM = true;
    bf16_t* O; int ldc; const float* bias; const float* rss;
    __device__ __forceinline__ void operator()(const f32x4 (&acc)[2][2][4][2], const Unit& u, int wr, int wc, int fr, int fq) const {
        const int row0 = u.rm * BM + wr * 64 + fr, col0 = u.cn * BM + wc * 32 + 8 * fq;
        f32x4 bv[2][2];
#pragma unroll
        for (int bj = 0; bj < 2; ++bj)
#pragma unroll
            for (int n = 0; n < 2; ++n) bv[bj][n] = bias ? *(const f32x4*)(bias + col0 + bj * HALF + 4 * n) : (f32x4){0.f, 0.f, 0.f, 0.f};
        float rs[2][4];
#pragma unroll
        for (int ai = 0; ai < 2; ++ai)
#pragma unroll
            for (int m = 0; m < 4; ++m) rs[ai][m] = rms_scale(rss, row0 + ai * HALF + m * 16);
#pragma unroll
        for (int ai = 0; ai < 2; ++ai)
#pragma unroll
            for (int m = 0; m < 4; ++m) { const int row = row0 + ai * HALF + m * 16; bf16_t* rowp = O + (size_t)row * ldc + col0; const float r = rs[ai][m];
#pragma unroll
                for (int bj = 0; bj < 2; ++bj) { const f32x4 v0 = acc[ai][bj][m][0] * r + bv[bj][0], v1 = acc[ai][bj][m][1] * r + bv[bj][1];
                    u32x4 w; w.x = pk2(v0[0], v0[1]); w.y = pk2(v0[2], v0[3]); w.z = pk2(v1[0], v1[1]); w.w = pk2(v1[2], v1[3]);
                    *(u32x4*)(rowp + bj * HALF) = w; } }
    }
};
__device__ __forceinline__ float silu_mul(float g, float u) { return g * u * __builtin_amdgcn_rcpf(1.0f + __builtin_amdgcn_exp2f(-1.44269504089f * g)); }
struct EpiSwiGLU {
    static constexpr bool PERM = true;
    bf16_t* O; int ldc; const float* rss;
    __device__ __forceinline__ void operator()(const f32x4 (&acc)[2][2][4][2], const Unit& u, int wr, int wc, int fr, int fq) const {
        const int row0 = u.rm * BM + wr * 64 + fr, col0 = u.cn * HALF + wc * 32 + 8 * fq;
        float rs[2][4];
#pragma unroll
        for (int ai = 0; ai < 2; ++ai)
#pragma unroll
            for (int m = 0; m < 4; ++m) rs[ai][m] = rms_scale(rss, row0 + ai * HALF + m * 16);
#pragma unroll
        for (int ai = 0; ai < 2; ++ai)
#pragma unroll
            for (int m = 0; m < 4; ++m) { const int row = row0 + ai * HALF + m * 16; bf16_t* rowp = O + (size_t)row * ldc + col0; const float r = rs[ai][m];
                const f32x4 g0 = acc[ai][0][m][0] * r, g1 = acc[ai][0][m][1] * r, u0 = acc[ai][1][m][0] * r, u1 = acc[ai][1][m][1] * r;
                u32x4 w; w.x = pk2(silu_mul(g0[0], u0[0]), silu_mul(g0[1], u0[1])); w.y = pk2(silu_mul(g0[2], u0[2]), silu_mul(g0[3], u0[3]));
                w.z = pk2(silu_mul(g1[0], u1[0]), silu_mul(g1[1], u1[1])); w.w = pk2(silu_mul(g1[2], u1[2]), silu_mul(g1[3], u1[3]));
                *(u32x4*)rowp = w; }
    }
};
struct EpiResid {
    static constexpr bool PERM = true;
    const float* base; float* out; const float* bias; bf16_t* xb; float* rss; LAS unsigned char* xlds;
    __device__ __forceinline__ void operator()(const f32x4 (&acc)[2][2][4][2], const Unit& u, int wr, int wc, int fr, int fq) const {
        const int row0 = u.rm * BM + wr * 64 + fr, col0 = u.cn * BM + wc * 32 + 8 * fq;
        f32x4 bv[2][2];
#pragma unroll
        for (int bj = 0; bj < 2; ++bj)
#pragma unroll
            for (int n = 0; n < 2; ++n) bv[bj][n] = bias ? *(const f32x4*)(bias + col0 + bj * HALF + 4 * n) : (f32x4){0.f, 0.f, 0.f, 0.f};
#pragma unroll
        for (int ai = 0; ai < 2; ++ai)
#pragma unroll
            for (int m = 0; m < 4; ++m) { const int row = row0 + ai * HALF + m * 16; const size_t off = (size_t)row * D + col0;
                f32x4 bs[2][2];
#pragma unroll
                for (int bj = 0; bj < 2; ++bj)
#pragma unroll
                    for (int n = 0; n < 2; ++n) bs[bj][n] = *(const f32x4*)(base + off + bj * HALF + 4 * n);
                float ss = 0.f;
#pragma unroll
                for (int bj = 0; bj < 2; ++bj) {
#pragma unroll
                    for (int n = 0; n < 2; ++n) { bs[bj][n] = bs[bj][n] + acc[ai][bj][m][n] + bv[bj][n]; *(f32x4*)(out + off + bj * HALF + 4 * n) = bs[bj][n];
                        ss += (bs[bj][n][0] * bs[bj][n][0] + bs[bj][n][1] * bs[bj][n][1]) + (bs[bj][n][2] * bs[bj][n][2] + bs[bj][n][3] * bs[bj][n][3]); }
                    if (xb) { u32x4 w; w.x = pk2(bs[bj][0][0], bs[bj][0][1]); w.y = pk2(bs[bj][0][2], bs[bj][0][3]); w.z = pk2(bs[bj][1][0], bs[bj][1][1]); w.w = pk2(bs[bj][1][2], bs[bj][1][3]);
                        *(u32x4*)(xb + off + bj * HALF) = w; } }
                if (xb) { ss += __shfl_xor(ss, 16); ss += __shfl_xor(ss, 32); if (fq == 0) *(LAS float*)(xlds + 16 * (wr * 64 + ai * HALF + m * 16 + fr) + 4 * wc) = ss; }
                asm volatile("" ::: "memory"); }
        if (xb) { asm volatile("s_waitcnt lgkmcnt(0)" ::: "memory"); __builtin_amdgcn_s_barrier(); asm volatile("" ::: "memory");
            const int t = wr * 256 + wc * 64 + fq * 16 + fr;
            if (t < 256) { const f32x4 a = *(const LAS f32x4*)(xlds + 16 * t); rss[(size_t)(u.rm * BM + t) * 4 + u.cn] = (a[0] + a[1]) + (a[2] + a[3]); } }
    }
};
__device__ __forceinline__ unsigned pk4_fp8(float a, float b, float c, float d) {
    int w = __builtin_amdgcn_cvt_pk_fp8_f32(__builtin_amdgcn_fmed3f(a, -448.f, 448.f), __builtin_amdgcn_fmed3f(b, -448.f, 448.f), 0, false);
    w = __builtin_amdgcn_cvt_pk_fp8_f32(__builtin_amdgcn_fmed3f(c, -448.f, 448.f), __builtin_amdgcn_fmed3f(d, -448.f, 448.f), w, true);
    return (unsigned)w;
}
constexpr int E8M0_ONE = 0x7f7f7f7f, E8M0_2M6 = 0x79797979;
struct EpiSwiGLU8 {
    static constexpr bool PERM = true; static constexpr int SCALE_A = E8M0_ONE, SCALE_B = E8M0_2M6;
    unsigned char* O; int ldc;
    __device__ __forceinline__ void operator()(const f32x4 (&acc)[2][2][4][2], const Unit& u, int wr, int wc, int fr, int fq) const {
        const int row0 = u.rm * BM + wr * 64 + fr, col0 = u.cn * HALF + wc * 32 + 8 * fq;
#pragma unroll
        for (int ai = 0; ai < 2; ++ai)
#pragma unroll
            for (int m = 0; m < 4; ++m) { unsigned char* rowp = O + (size_t)(row0 + ai * HALF + m * 16) * ldc + col0;
                const f32x4 g0 = acc[ai][0][m][0], g1 = acc[ai][0][m][1], u0 = acc[ai][1][m][0], u1 = acc[ai][1][m][1];
                u32x2 w; w.x = pk4_fp8(silu_mul(g0[0], u0[0]), silu_mul(g0[1], u0[1]), silu_mul(g0[2], u0[2]), silu_mul(g0[3], u0[3]));
                w.y = pk4_fp8(silu_mul(g1[0], u1[0]), silu_mul(g1[1], u1[1]), silu_mul(g1[2], u1[2]), silu_mul(g1[3], u1[3]));
                *(u32x2*)rowp = w; }
    }
};
struct EpiNull8 {
    static constexpr bool PERM = true; static constexpr int SCALE_A = E8M0_ONE, SCALE_B = E8M0_2M6;
    float* sink;
    __device__ __forceinline__ void operator()(const f32x4 (&acc)[2][2][4][2], const Unit& u, int wr, int wc, int fr, int fq) const {
        float s = 0.f;
#pragma unroll
        for (int ai = 0; ai < 2; ++ai)
#pragma unroll
            for (int bj = 0; bj < 2; ++bj)
#pragma unroll
                for (int m = 0; m < 4; ++m)
#pragma unroll
                    for (int n = 0; n < 2; ++n) s += (acc[ai][bj][m][n][0] + acc[ai][bj][m][n][1]) + (acc[ai][bj][m][n][2] + acc[ai][bj][m][n][3]);
        if (s == 12345.678f) sink[0] = s;
    }
};
struct EpiMoeDown {
    static constexpr bool PERM = true; static constexpr int SCALE_A = E8M0_ONE, SCALE_B = E8M0_2M6;
    float* X; bf16_t* Y0; const int* slot_tok; const float* slot_w;
    __device__ __forceinline__ void operator()(const f32x4 (&acc)[2][2][4][2], const Unit& u, int wr, int wc, int fr, int fq) const {
        const int row0 = u.rm * BM + wr * 64 + fr, col0 = u.cn * BM + wc * 32 + 8 * fq;
#pragma unroll
        for (int ai = 0; ai < 2; ++ai)
#pragma unroll
            for (int m = 0; m < 4; ++m) { const int slot = row0 + ai * HALF + m * 16; const int meta = slot_tok[slot]; const float w = slot_w[slot];
                if (meta >= 0) { const size_t off = (size_t)(meta >> 1) * D + col0;
                    if (meta & 1) {
                        f32x4 bs[2][2];
#pragma unroll
                        for (int bj = 0; bj < 2; ++bj)
#pragma unroll
                            for (int n = 0; n < 2; ++n) bs[bj][n] = *(const f32x4*)(X + off + bj * HALF + 4 * n);
#pragma unroll
                        for (int bj = 0; bj < 2; ++bj)
#pragma unroll
                            for (int n = 0; n < 2; ++n) *(f32x4*)(X + off + bj * HALF + 4 * n) = bs[bj][n] + acc[ai][bj][m][n] * w;
                    } else {
#pragma unroll
                        for (int bj = 0; bj < 2; ++bj) { const f32x4 v0 = acc[ai][bj][m][0] * w, v1 = acc[ai][bj][m][1] * w;
                            u32x4 o; o.x = pk2(v0[0], v0[1]); o.y = pk2(v0[2], v0[3]); o.z = pk2(v1[0], v1[1]); o.w = pk2(v1[2], v1[3]);
                            *(u32x4*)(Y0 + off + bj * HALF) = o; }
                    } }
                asm volatile("" ::: "memory"); }
    }
};

template <int OFF> __device__ __forceinline__ void glds_s(const char* sbase, unsigned voff, unsigned lds_base) {
    unsigned keep;
    asm volatile("s_mov_b32 %0, m0\n\ts_add_u32 m0, %3, %4\n\ts_nop 0\n\tglobal_load_lds_dwordx4 %1, %2\n\ts_mov_b32 m0, %0" : "=&s"(keep) : "v"(voff), "s"(sbase), "s"(lds_base), "i"(OFF) : "memory", "scc");
}
template <class Epi, class Sched, bool FP8 = false, bool ALIGN_EPI = true, bool SP2 = true>
__device__ __forceinline__ void gemm_phase(LAS unsigned char* lds, const Gemm g, const Sched& S, const Epi& E) {
    const int tid = threadIdx.x, wid = __builtin_amdgcn_readfirstlane(tid >> 6), lane = tid & 63, wr = wid >> 2, wc = wid & 3, fr = lane & 15, fq = lane >> 4;
    const int nt = g.K / (BK * 2);
    unsigned voffA[2], voffB[2];
#pragma unroll
    for (int i = 0; i < 2; ++i) { int R, C; stage_rc(tid * 16 + i * 8192, R, C); const int Rb = Epi::PERM ? ((R & ~31) + perm32(R & 31)) : R;
        voffA[i] = (unsigned)(R * g.lda + C * 2); voffB[i] = (unsigned)(Rb * g.ldb + C * 2); }
    const size_t kstep = (size_t)(BK * 2);
    const size_t hstepA = (size_t)HALF * g.lda, hstepB = (size_t)HALF * g.ldb;
    const size_t tstepA = 2 * hstepA, tstepB = 2 * hstepB;
    const unsigned lds_base = (unsigned)(size_t)lds + (unsigned)wid * 1024u;
    const int aoff = lds_byte(wr * 64 + fr, fq * 8), boff = lds_byte(wc * 32 + fr, fq * 8);
#define PG8_SA(b, h) (((b) * 2 + (h)) * HTB)
#define PG8_SB(b, h) ((4 + (b) * 2 + (h)) * HTB)
#define PG8_STAGE(bufoff, gbase, voff) do { glds_s<(bufoff)>((const char*)(gbase), (voff)[0], lds_base); glds_s<(bufoff) + 8192>((const char*)(gbase), (voff)[1], lds_base); } while (0)
#define PG8_LDA(dst, b, h) do { _Pragma("unroll") for (int m = 0; m < 4; ++m) _Pragma("unroll") for (int k = 0; k < 2; ++k) dst[m][k] = *(const LAS bf16x8*)(lds + PG8_SA(b, h) + aoff + m * 2048 + k * 1024); } while (0)
#define PG8_LDB(dst, b, h) do { _Pragma("unroll") for (int n = 0; n < 2; ++n) _Pragma("unroll") for (int k = 0; k < 2; ++k) dst[n][k] = *(const LAS bf16x8*)(lds + PG8_SB(b, h) + boff + n * 2048 + k * 1024); } while (0)
#define PG8_MMA(ai, bj, At, Bt) do { __builtin_amdgcn_s_setprio(1); _Pragma("unroll") for (int m = 0; m < 4; ++m) _Pragma("unroll") for (int n = 0; n < 2; ++n) { \
        if constexpr (FP8) { const i32x4 b_lo = __builtin_bit_cast(i32x4, Bt[n][0]), b_hi = __builtin_bit_cast(i32x4, Bt[n][1]), a_lo = __builtin_bit_cast(i32x4, At[m][0]), a_hi = __builtin_bit_cast(i32x4, At[m][1]); \
            acc[ai][bj][m][n] = __builtin_amdgcn_mfma_scale_f32_16x16x128_f8f6f4(__builtin_shufflevector(b_lo, b_hi, 0, 1, 2, 3, 4, 5, 6, 7), __builtin_shufflevector(a_lo, a_hi, 0, 1, 2, 3, 4, 5, 6, 7), acc[ai][bj][m][n], 0, 0, 0, Epi::SCALE_B, 0, Epi::SCALE_A); } \
        else { _Pragma("unroll") for (int k = 0; k < 2; ++k) acc[ai][bj][m][n] = __builtin_amdgcn_mfma_f32_16x16x32_bf16(Bt[n][k], At[m][k], acc[ai][bj][m][n], 0, 0, 0); } } \
        __builtin_amdgcn_s_setprio(0); } while (0)
#define PG8_WAIT_V(n) asm volatile("s_waitcnt vmcnt(" #n ")" ::: "memory")
#define PG8_WAIT_L(n) asm volatile("s_waitcnt lgkmcnt(" #n ")" ::: "memory")
#define PG8_BAR __builtin_amdgcn_s_barrier()
#define PG8_SCHED __builtin_amdgcn_sched_barrier(0)
    Unit cur, nxt; int ui = 0;
    if (!S.next(0, cur)) return;
    f32x4 acc[2][2][4][2];
#pragma unroll
    for (int a = 0; a < 2; ++a)
#pragma unroll
        for (int b = 0; b < 2; ++b)
#pragma unroll
            for (int m = 0; m < 4; ++m)
#pragma unroll
                for (int n = 0; n < 2; ++n) acc[a][b][m][n] = (f32x4){0.f, 0.f, 0.f, 0.f};
    bf16x8 At[4][2], B0[2][2], B1[2][2];
    const char* cA = (const char*)g.A + (size_t)cur.pm * tstepA; const char* cB = (const char*)g.Bt + (size_t)cur.pn * tstepB;
    S.a_ready(cur);
    if constexpr (SP2) {
        PG8_STAGE(PG8_SB(0, 0), cB, voffB); PG8_STAGE(PG8_SB(0, 1), cB + hstepB, voffB); PG8_STAGE(PG8_SA(0, 0), cA, voffA); PG8_STAGE(PG8_SA(0, 1), cA + hstepA, voffA);
        if (wr == 1) PG8_BAR;
        PG8_WAIT_V(2); PG8_BAR;
        PG8_STAGE(PG8_SB(1, 0), cB + kstep, voffB); PG8_STAGE(PG8_SA(1, 0), cA + kstep, voffA); PG8_STAGE(PG8_SB(1, 1), cB + hstepB + kstep, voffB);
        PG8_WAIT_V(6); PG8_BAR;
    } else {
        PG8_STAGE(PG8_SB(0, 0), cB, voffB); PG8_STAGE(PG8_SA(0, 0), cA, voffA); PG8_STAGE(PG8_SB(0, 1), cB + hstepB, voffB); PG8_STAGE(PG8_SA(0, 1), cA + hstepA, voffA);
        if (wr == 1) PG8_BAR;
        PG8_WAIT_V(4); PG8_BAR;
        PG8_STAGE(PG8_SB(1, 0), cB + kstep, voffB); PG8_STAGE(PG8_SA(1, 0), cA + kstep, voffA); PG8_STAGE(PG8_SB(1, 1), cB + hstepB + kstep, voffB);
        PG8_WAIT_V(6); PG8_BAR;
    }
    for (;;) {
        const bool has_next = S.next(ui + 1, nxt);
        const char* nA = has_next ? (const char*)g.A + (size_t)nxt.pm * tstepA : cA; const char* nB = has_next ? (const char*)g.Bt + (size_t)nxt.pn * tstepB : cB;
#pragma clang loop unroll(disable)
        for (int t = 0; t < nt; t += 2) {
            const bool last = (t == nt - 2);
            const char* a1 = cA + (size_t)(t + 1) * kstep;
            const char* a2 = last ? nA : cA + (size_t)(t + 2) * kstep; const char* b2 = last ? nB : cB + (size_t)(t + 2) * kstep;
            const char* a3 = a2 + kstep; const char* b3 = b2 + kstep;
            if (last && has_next) S.a_ready(nxt);
            if constexpr (SP2) {
            PG8_LDB(B0, 0, 0); PG8_LDB(B1, 0, 1); PG8_SCHED; PG8_LDA(At, 0, 0); PG8_STAGE(PG8_SA(1, 1), a1 + hstepA, voffA);
            PG8_WAIT_V(8); PG8_WAIT_L(0); PG8_BAR; PG8_MMA(0, 0, At, B0); PG8_MMA(0, 1, At, B1); PG8_BAR; PG8_SCHED;
            PG8_LDA(At, 0, 1); PG8_STAGE(PG8_SB(0, 0), b2, voffB); PG8_STAGE(PG8_SB(0, 1), b2 + hstepB, voffB); PG8_STAGE(PG8_SA(0, 0), a2, voffA);
            PG8_WAIT_V(8); PG8_WAIT_L(0); PG8_BAR; PG8_MMA(1, 0, At, B0); PG8_MMA(1, 1, At, B1); PG8_BAR; PG8_SCHED;
            PG8_LDB(B0, 1, 0); PG8_LDB(B1, 1, 1); PG8_SCHED; PG8_LDA(At, 1, 0); PG8_STAGE(PG8_SA(0, 1), a2 + hstepA, voffA);
            PG8_WAIT_V(8); PG8_WAIT_L(0); PG8_BAR; PG8_MMA(0, 0, At, B0); PG8_MMA(0, 1, At, B1); PG8_BAR; PG8_SCHED;
            PG8_LDA(At, 1, 1); PG8_STAGE(PG8_SB(1, 0), b3, voffB); PG8_STAGE(PG8_SB(1, 1), b3 + hstepB, voffB); PG8_STAGE(PG8_SA(1, 0), a3, voffA);
            PG8_WAIT_V(8); PG8_WAIT_L(0); PG8_BAR; PG8_MMA(1, 0, At, B0); PG8_MMA(1, 1, At, B1); PG8_BAR; PG8_SCHED;
            } else {
            PG8_LDB(B0, 0, 0); PG8_SCHED; PG8_LDA(At, 0, 0); PG8_STAGE(PG8_SA(1, 1), a1 + hstepA, voffA);
            PG8_WAIT_L(8); PG8_BAR; PG8_WAIT_L(0); PG8_MMA(0, 0, At, B0); PG8_BAR; PG8_SCHED;
            PG8_LDB(B1, 0, 1); PG8_STAGE(PG8_SB(0, 0), b2, voffB);
            PG8_BAR; PG8_WAIT_L(0); PG8_MMA(0, 1, At, B1); PG8_BAR;
            PG8_LDA(At, 0, 1); PG8_STAGE(PG8_SA(0, 0), a2, voffA);
            PG8_BAR; PG8_WAIT_L(0); PG8_MMA(1, 0, At, B0); PG8_BAR; PG8_SCHED;
            PG8_STAGE(PG8_SB(0, 1), b2 + hstepB, voffB);
            PG8_WAIT_V(6); PG8_BAR; PG8_MMA(1, 1, At, B1); PG8_BAR;
            PG8_LDB(B0, 1, 0); PG8_SCHED; PG8_LDA(At, 1, 0); PG8_STAGE(PG8_SA(0, 1), a2 + hstepA, voffA);
            PG8_WAIT_L(8); PG8_BAR; PG8_WAIT_L(0); PG8_MMA(0, 0, At, B0); PG8_BAR; PG8_SCHED;
            PG8_LDB(B1, 1, 1); PG8_STAGE(PG8_SB(1, 0), b3, voffB);
            PG8_BAR; PG8_WAIT_L(0); PG8_MMA(0, 1, At, B1); PG8_BAR;
            PG8_LDA(At, 1, 1); PG8_STAGE(PG8_SA(1, 0), a3, voffA);
            PG8_BAR; PG8_WAIT_L(0); PG8_MMA(1, 0, At, B0); PG8_BAR; PG8_SCHED;
            PG8_STAGE(PG8_SB(1, 1), b3 + hstepB, voffB);
            PG8_WAIT_V(6); PG8_BAR; PG8_MMA(1, 1, At, B1); PG8_BAR;
            }
        }
        if constexpr (ALIGN_EPI) { if (wr == 0) PG8_BAR; }
        { int l2 = threadIdx.x; asm volatile("" : "+v"(l2)); l2 &= 63; E(acc, cur, wr, wc, l2 & 15, l2 >> 4); }
        S.done(cur);
        if (!has_next) break;
#pragma unroll
        for (int a = 0; a < 2; ++a)
#pragma unroll
            for (int b = 0; b < 2; ++b)
#pragma unroll
                for (int m = 0; m < 4; ++m)
#pragma unroll
                    for (int n = 0; n < 2; ++n) acc[a][b][m][n] = (f32x4){0.f, 0.f, 0.f, 0.f};
        cur = nxt; cA = nA; cB = nB; ++ui;
        if constexpr (ALIGN_EPI) { if (wr == 1) PG8_BAR; }
    }
    PG8_WAIT_V(0);
    if constexpr (!ALIGN_EPI) { if (wr == 0) PG8_BAR; }
    PG8_BAR;
#undef PG8_SA
#undef PG8_SB
#undef PG8_STAGE
#undef PG8_LDA
#undef PG8_LDB
#undef PG8_MMA
#undef PG8_WAIT_V
#undef PG8_WAIT_L
#undef PG8_BAR
#undef PG8_SCHED
}
}

#define XB_TMO      128
#define XB_XCNT(j)  (256  + 64 * (j))
#define XB_XSUB(j)  (1280 + 64 * (j))
#define XB_XGEN(j)  (2304 + 64 * (j))
#define XB_TOP      3328
#define XB_TOPGEN   3392
#define XCD_BAR_WORDS 3456
#define XB_SPIN_CAP (1u << 18)
__device__ __forceinline__ unsigned xb_ld(unsigned* p)              { return __hip_atomic_load(p, __ATOMIC_RELAXED, __HIP_MEMORY_SCOPE_AGENT); }
__device__ __forceinline__ unsigned xb_add(unsigned* p, unsigned v) { return __hip_atomic_fetch_add(p, v, __ATOMIC_RELAXED, __HIP_MEMORY_SCOPE_AGENT); }
__device__ __forceinline__ unsigned xb_xcc_id() { return (unsigned)__builtin_amdgcn_s_getreg((3 << 11) | 20) & 0xFu; }
#define XB_SPIN(cond, bar) do { unsigned _sp = 0; while (cond) { __builtin_amdgcn_s_sleep(1); \
    if ((++_sp & 255u) == 0u) { if (xb_ld(&(bar)[XB_TMO])) break; if (_sp > XB_SPIN_CAP) { atomicAdd(&(bar)[XB_TMO], 1u); break; } } } } while (0)
struct XcdBarrier { unsigned* bar; unsigned x; volatile LAS unsigned* st; };
__device__ __forceinline__ XcdBarrier xcd_barrier_post(unsigned* bar, volatile LAS unsigned* st) {
    XcdBarrier b; b.bar = bar; b.x = xb_xcc_id(); b.st = st;
    if (threadIdx.x == 0) (void)xb_add(&bar[XB_XCNT(b.x)], 1u);
    return b;
}
__device__ __forceinline__ void xcd_barrier_complete(unsigned* bar, unsigned x, unsigned& nloc, unsigned& nx) {
    const unsigned G = gridDim.x * gridDim.y * gridDim.z;
    unsigned sum, cnt, mine, sp = 0u;
    for (;;) {
        sum = 0u; cnt = 0u; mine = 0u;
#pragma unroll
        for (unsigned j = 0; j < 16; ++j) { const unsigned c = xb_ld(&bar[XB_XCNT(j)]); sum += c; cnt += (c > 0u) ? 1u : 0u; mine = (j == x) ? c : mine; }
        if (sum == G) break;
        __builtin_amdgcn_s_sleep(1);
        if ((++sp & 255u) == 0u) { if (xb_ld(&bar[XB_TMO])) break; if (sp > XB_SPIN_CAP) { atomicAdd(&bar[XB_TMO], 1u); break; } }
    }
    nloc = mine > 0u ? mine : 1u; nx = cnt > 0u ? cnt : 1u;
}
__device__ __forceinline__ void xcd_barrier(const XcdBarrier& b) {
    asm volatile("s_waitcnt vmcnt(0)" ::: "memory");
    __syncthreads();
    if (threadIdx.x == 0) {
        unsigned* bar = b.bar;
        __builtin_amdgcn_s_waitcnt(0);
        unsigned nloc = b.st[0], nx = b.st[1];
        if (nloc == 0u) { xcd_barrier_complete(bar, b.x, nloc, nx); b.st[0] = nloc; b.st[1] = nx; }
        const unsigned old = xb_add(&bar[XB_XSUB(b.x)], 1u);
        const unsigned gen = old / nloc;
        if (old + 1u == (gen + 1u) * nloc) {
            __builtin_amdgcn_fence(__ATOMIC_RELEASE, "agent");
            asm volatile("s_waitcnt vmcnt(0)" ::: "memory");
            const unsigned og = xb_add(&bar[XB_TOP], 1u);
            const unsigned tg = og / nx;
            if (og + 1u == (tg + 1u) * nx) xb_add(&bar[XB_TOPGEN], 1u);
            else XB_SPIN(xb_ld(&bar[XB_TOPGEN]) == tg, bar);
            __builtin_amdgcn_fence(__ATOMIC_ACQUIRE, "agent");
            xb_add(&bar[XB_XGEN(b.x)], 1u);
            asm volatile("s_waitcnt vmcnt(0)" ::: "memory");
        } else {
            XB_SPIN(xb_ld(&bar[XB_XGEN(b.x)]) == gen, bar);
            __builtin_amdgcn_fence(__ATOMIC_ACQUIRE, "agent");
            asm volatile("s_waitcnt vmcnt(0)" ::: "memory");
        }
    }
    __syncthreads();
}

struct Params { const float* in[24]; float* out; unsigned char* ws; int ph_lo, ph_hi; };
enum { I_X = 0, I_RELB, I_EVNM, I_WIN, I_POOLW, I_POOLS, I_CONVW, I_WOUT, I_EVNF, I_FG, I_FU, I_FD, I_ODNM, I_WQKV, I_BQKV, I_SINK, I_WO, I_BO, I_ODNF, I_ROUTER, I_EG, I_EU, I_ED, I_FINAL };

__device__ __forceinline__ void p0_tile(const float* __restrict__ src, int N, int k0, int n0, bf16_t* __restrict__ dst, int ldd, LAS unsigned char* scr, int lane, const float* __restrict__ gain = nullptr) {
    const int n4 = (lane & 15) * 4, kp = lane >> 4;
    f32x4 a[8], b[8];
#pragma unroll
    for (int i = 0; i < 8; ++i) { const float* p = src + (size_t)(k0 + 8 * i + 2 * kp) * N + n0 + n4; a[i] = *(const f32x4*)p; b[i] = *(const f32x4*)(p + N);
        if (gain) { a[i] = a[i] * gain[k0 + 8 * i + 2 * kp]; b[i] = b[i] * gain[k0 + 8 * i + 2 * kp + 1]; } }
#pragma unroll
    for (int i = 0; i < 8; ++i) { const int k = 8 * i + 2 * kp;
#pragma unroll
        for (int q = 0; q < 4; ++q) *(LAS unsigned*)(scr + (n4 + q) * 136 + k * 2) = pk2(a[i][q], b[i][q]); }
    LDS_WAIT();
    const int c = lane & 7, nr = lane >> 3;
#pragma unroll
    for (int j = 0; j < 8; ++j) { const int n = 8 * j + nr; const u32x2 lo = *(const LAS u32x2*)(scr + n * 136 + 16 * c), hi = *(const LAS u32x2*)(scr + n * 136 + 16 * c + 8);
        u32x4 o; o.x = lo.x; o.y = lo.y; o.z = hi.x; o.w = hi.y; *(u32x4*)(dst + (size_t)n * ldd + 8 * c) = o; }
    LDS_WAIT();
}
__device__ __forceinline__ void p0_tile8_load(const float* __restrict__ src, int N, int k0, int n0, int lane, f32x4 (&a)[4][4]) {
    const int n4 = (lane & 7) * 4, kq = lane >> 3;
#pragma unroll
    for (int i = 0; i < 4; ++i)
#pragma unroll
        for (int j = 0; j < 4; ++j) a[i][j] = *(const f32x4*)(src + (size_t)(k0 + 32 * i + 4 * kq + j) * N + n0 + n4);
}
__device__ __forceinline__ void p0_tile8_store(const f32x4 (&a)[4][4], unsigned char* __restrict__ dst, int ldd, float scale, LAS unsigned char* scr, int lane) {
    const int n4 = (lane & 7) * 4, kq = lane >> 3;
#pragma unroll
    for (int i = 0; i < 4; ++i)
#pragma unroll
        for (int q = 0; q < 4; ++q) *(LAS unsigned*)(scr + (n4 + q) * 144 + 32 * i + 4 * kq) = pg8::pk4_fp8(a[i][0][q] * scale, a[i][1][q] * scale, a[i][2][q] * scale, a[i][3][q] * scale);
    LDS_WAIT();
    const int c = lane & 7, nr = lane >> 3;
#pragma unroll
    for (int j = 0; j < 4; ++j) { const int n = 8 * j + nr; *(u32x4*)(dst + (size_t)n * ldd + 16 * c) = *(const LAS u32x4*)(scr + n * 144 + 16 * c); }
    LDS_WAIT();
}
struct P0Tile8 { const float* src; unsigned char* dst; int N, k0, n0, ldd; };
__device__ __forceinline__ P0Tile8 p0_tile8_desc(int it, const float* eg, const float* eu, const float* ed, unsigned char* Wegu8, unsigned char* Wed8) {
    constexpr int T_EG = 8 * 112, T_ED = 28 * 32, per_e = 2 * T_EG + T_ED;
    const int e = it / per_e; int q = it % per_e; P0Tile8 t;
    if (q < 2 * T_EG) { const int up = q >= T_EG; if (up) q -= T_EG; const int kb = q / 112, nb = q % 112, n0 = 32 * nb;
        t.src = (up ? eu : eg) + (size_t)e * D * DFE; t.N = DFE; t.k0 = 128 * kb; t.n0 = n0; t.dst = Wegu8 + ((size_t)e * 2 * DFE + (n0 / 128) * 256 + (n0 % 128) + (up ? 128 : 0)) * D + 128 * kb; t.ldd = D; }
    else { q -= 2 * T_EG; const int kb = q / 32, nb = q % 32;
        t.src = ed + (size_t)e * DFE * D; t.N = D; t.k0 = 128 * kb; t.n0 = 32 * nb; t.dst = Wed8 + ((size_t)e * D + 32 * nb) * DFE + 128 * kb; t.ldd = DFE; }
    return t;
}
__device__ __forceinline__ void norm_row_bf16(const float* __restrict__ xrow, const float* __restrict__ gain, bf16_t* __restrict__ orow, int lane, float (&y)[16]) {
    f32x4 v[4];
#pragma unroll
    for (int j = 0; j < 2; ++j) { v[2 * j] = *(const f32x4*)(xrow + 512 * j + 8 * lane); v[2 * j + 1] = *(const f32x4*)(xrow + 512 * j + 8 * lane + 4); }
    float s = 0.f;
#pragma unroll
    for (int j = 0; j < 4; ++j) s += (v[j][0] * v[j][0] + v[j][1] * v[j][1]) + (v[j][2] * v[j][2] + v[j][3] * v[j][3]);
    const float r = 1.0f / sqrtf(wave_sum(s) * (1.0f / D) + RMS_EPS);
#pragma unroll
    for (int j = 0; j < 2; ++j) { const f32x4 g0 = *(const f32x4*)(gain + 512 * j + 8 * lane), g1 = *(const f32x4*)(gain + 512 * j + 8 * lane + 4);
#pragma unroll
        for (int q = 0; q < 4; ++q) { y[8 * j + q] = v[2 * j][q] * r * g0[q]; y[8 * j + 4 + q] = v[2 * j + 1][q] * r * g1[q]; }
        u32x4 w; w.x = pk2(y[8 * j], y[8 * j + 1]); w.y = pk2(y[8 * j + 2], y[8 * j + 3]); w.z = pk2(y[8 * j + 4], y[8 * j + 5]); w.w = pk2(y[8 * j + 6], y[8 * j + 7]);
        *(u32x4*)(orow + 512 * j + 8 * lane) = w; }
}

__device__ __forceinline__ int t5_bucket(int rel) {
    const int n = rel < 0 ? -rel : rel; const int ret = rel > 0 ? 16 : 0;
    int v;
    if (n < 8) v = n; else if (n < 12) v = 8; else if (n < 16) v = 9; else if (n < 23) v = 10; else if (n < 32) v = 11; else if (n < 46) v = 12; else if (n < 64) v = 13; else if (n < 91) v = 14; else v = 15;
    return ret + v;
}

constexpr int AT_KS_STR = 144, AT_VT_STR = 392;
constexpr int AT_L_K = 0, AT_L_VT = 192 * AT_KS_STR, AT_L_BT = AT_L_VT + 64 * AT_VT_STR, AT_L_OST = AT_L_BT + NQH * 256 * 4;
static_assert(AT_L_OST + NWAVES * 32 * 144 <= RING_BYTES, "attention LDS");
__device__ __forceinline__ void attn_qblock(LAS unsigned char* lds, const bf16x8 (&qf)[4], bf16_t* __restrict__ orow0, int head, int qb, int kb_min, float sink, int wave, int lane) {
    const int r32 = lane & 31, hh = lane >> 5;
    const LAS float* bt = (const LAS float*)(lds + AT_L_BT + head * 1024);
    f32x16 st[6];
#pragma unroll
    for (int kb = 0; kb < 6; ++kb) {
#pragma unroll
        for (int e = 0; e < 16; ++e) st[kb][e] = 0.f;
#pragma unroll
        for (int ks = 0; ks < 4; ++ks) { const bf16x8 kf = *(const LAS bf16x8*)(lds + AT_L_K + (kb * 32 + r32) * AT_KS_STR + 32 * ks + 16 * hh);
            st[kb] = __builtin_amdgcn_mfma_f32_32x32x16_bf16(kf, qf[ks], st[kb], 0, 0, 0); } }
    float mx = sink;
#pragma unroll
    for (int kb = 0; kb < 6; ++kb)
#pragma unroll
        for (int e = 0; e < 16; ++e) { const int j = kb * 32 + (e & 3) + 8 * (e >> 2) + 4 * hh; const int idx = j - (qb * 32 + r32) + 63;
            float sc = st[kb][e] * 0.125f + bt[idx]; sc = (kb < kb_min) ? -1e30f : sc; st[kb][e] = sc; mx = fmaxf(mx, sc); }
    mx = fmaxf(mx, __shfl_xor(mx, 32));
    float sum = 0.f;
#pragma unroll
    for (int kb = 0; kb < 6; ++kb)
#pragma unroll
        for (int e = 0; e < 16; ++e) { const float pe = __builtin_amdgcn_exp2f((st[kb][e] - mx) * 1.44269504089f); st[kb][e] = pe; sum += pe; }
    sum += __shfl_xor(sum, 32);
    const float inv = 1.0f / (sum + __builtin_amdgcn_exp2f((sink - mx) * 1.44269504089f));
    f32x16 ot[2];
#pragma unroll
    for (int db = 0; db < 2; ++db)
#pragma unroll
        for (int e = 0; e < 16; ++e) ot[db][e] = 0.f;
#pragma unroll
    for (int kb = 0; kb < 6; ++kb)
#pragma unroll
        for (int s = 0; s < 2; ++s) {
            u32x4 pw; pw.x = pk2(st[kb][8 * s], st[kb][8 * s + 1]); pw.y = pk2(st[kb][8 * s + 2], st[kb][8 * s + 3]); pw.z = pk2(st[kb][8 * s + 4], st[kb][8 * s + 5]); pw.w = pk2(st[kb][8 * s + 6], st[kb][8 * s + 7]);
            const bf16x8 pf = __builtin_bit_cast(bf16x8, pw);
#pragma unroll
            for (int db = 0; db < 2; ++db) { const LAS unsigned char* vp = lds + AT_L_VT + (db * 32 + r32) * AT_VT_STR + 2 * (kb * 32 + 16 * s + 4 * hh);
                const u32x2 v0 = *(const LAS u32x2*)vp, v1 = *(const LAS u32x2*)(vp + 16);
                u32x4 vw; vw.x = v0.x; vw.y = v0.y; vw.z = v1.x; vw.w = v1.y;
                ot[db] = __builtin_amdgcn_mfma_f32_32x32x16_bf16(__builtin_bit_cast(bf16x8, vw), pf, ot[db], 0, 0, 0); } }
    LAS unsigned char* ost = lds + AT_L_OST + wave * (32 * 144);
#pragma unroll
    for (int db = 0; db < 2; ++db)
#pragma unroll
        for (int g4 = 0; g4 < 4; ++g4) { u32x2 w; w.x = pk2(ot[db][4 * g4] * inv, ot[db][4 * g4 + 1] * inv); w.y = pk2(ot[db][4 * g4 + 2] * inv, ot[db][4 * g4 + 3] * inv);
            *(LAS u32x2*)(ost + r32 * 144 + 2 * (db * 32 + 8 * g4 + 4 * hh)) = w; }
    LDS_WAIT();
#pragma unroll
    for (int i = 0; i < 4; ++i) { const int q = 8 * i + (lane >> 3), c = lane & 7; const u32x4 w = *(const LAS u32x4*)(ost + q * 144 + 16 * c);
        *(u32x4*)(orow0 + (size_t)q * D + 8 * c) = w; }
    LDS_WAIT();
}

__global__ void __launch_bounds__(NTHR, 2) fwd_kernel(Params p) {
    extern __shared__ __attribute__((aligned(16))) unsigned char lds_raw[];
    LAS unsigned char* lds = (LAS unsigned char*)lds_raw;
    volatile LAS unsigned* MISC = (volatile LAS unsigned*)(lds + LDS_MISC_OFF);
    const int tid = threadIdx.x, lane = tid & 63, wave = __builtin_amdgcn_readfirstlane(tid >> 6);
    const int G = gridDim.x, bx = blockIdx.x;
    const int vcu = (G % 8 == 0) ? (bx % 8) * (G / 8) + bx / 8 : bx;
    const int gw = vcu * NWAVES + wave, NGW = G * NWAVES;
    unsigned char* ws = p.ws;
    unsigned* ctl = (unsigned*)(ws + WS_CTL);
    if (tid < 64) MISC[tid] = 0u;
    __syncthreads();
    XcdBarrier bar; bar.bar = ctl + CW_BAR; bar.x = 0; bar.st = nullptr;
    if (MK_N_LAUNCHES == 1) bar = xcd_barrier_post(ctl + CW_BAR, MISC + 8);
    const int lo = p.ph_lo, hi = p.ph_hi;
#define IN(k) (lo <= (k) && (k) < hi)
#define SEAM(k) do { if (MK_N_LAUNCHES == 1 && IN((k) + 1)) xcd_barrier(bar); } while (0)

    bf16_t* Win_t = (bf16_t*)(ws + WS_WIN); bf16_t* Wout_t = (bf16_t*)(ws + WS_WOUT); bf16_t* Wgu_t = (bf16_t*)(ws + WS_WGU); bf16_t* Wd_t = (bf16_t*)(ws + WS_WD);
    bf16_t* Wqkv_t = (bf16_t*)(ws + WS_WQKV); bf16_t* Wo_t = (bf16_t*)(ws + WS_WO); bf16_t* Wegu_t = (bf16_t*)(ws + WS_WEGU); bf16_t* Wed_t = (bf16_t*)(ws + WS_WED);
    bf16_t* XN = (bf16_t*)(ws + WS_XN); bf16_t* PROJ = (bf16_t*)(ws + WS_PROJ); bf16_t* MIXED = (bf16_t*)(ws + WS_MIXED); bf16_t* Hb = (bf16_t*)(ws + WS_H);
    bf16_t* QKV = (bf16_t*)(ws + WS_QKV); bf16_t* AO = (bf16_t*)(ws + WS_AO); bf16_t* HS = (bf16_t*)(ws + WS_HS); bf16_t* H2 = (bf16_t*)(ws + WS_H2);
    float* bias_tab = (float*)(ws + WS_BIAS); int* wgcnt = (int*)(ws + WS_WGCNT); int* tilemeta = (int*)(ws + WS_TILE);
    int* tok_e = (int*)(ws + WS_TOKE); float* tok_w = (float*)(ws + WS_TOKW); int* tok_r = (int*)(ws + WS_TOKR); int* slot_tok = (int*)(ws + WS_SLOTT); float* slot_w = (float*)(ws + WS_SLOTW);
    float* rss = (float*)(ws + WS_RSS);
    float* X = p.out;

    if (IN(0)) for (int rep_ = 0; rep_ < NREP(0); ++rep_) {
        const int tid = fresh_tid(), lane = tid & 63;
        LAS unsigned char* scr = lds + wave * 8704;
        constexpr int T_WIN = 16 * 32, T_WOUT = 8 * 16, T_FG = 16 * 44, T_FD = 44 * 16, T_QKV = 16 * 20, T_WO = 16 * 16;
        constexpr int T_EG = 8 * 112, T_ED = 28 * 32;
        constexpr int NT8 = NEXP * (2 * T_EG + T_ED);
        constexpr int NT = T_WIN + T_WOUT + 2 * T_FG + T_FD + T_QKV + T_WO;
        unsigned char* Wegu8 = (unsigned char*)Wegu_t; unsigned char* Wed8 = (unsigned char*)Wed_t;
        {
            f32x4 ta[4][4], tb[4][4];
            int it = gw;
            P0Tile8 da{}, db{};
            if (it < NT8) { da = p0_tile8_desc(it, p.in[I_EG], p.in[I_EU], p.in[I_ED], Wegu8, Wed8); p0_tile8_load(da.src, da.N, da.k0, da.n0, lane, ta); }
            while (it < NT8) {
                const int itb = it + NGW;
                if (itb < NT8) { db = p0_tile8_desc(itb, p.in[I_EG], p.in[I_EU], p.in[I_ED], Wegu8, Wed8); p0_tile8_load(db.src, db.N, db.k0, db.n0, lane, tb); }
                p0_tile8_store(ta, da.dst, da.ldd, 64.f, scr, lane);
                if (itb >= NT8) break;
                const int ita = itb + NGW;
                if (ita < NT8) { da = p0_tile8_desc(ita, p.in[I_EG], p.in[I_EU], p.in[I_ED], Wegu8, Wed8); p0_tile8_load(da.src, da.N, da.k0, da.n0, lane, ta); }
                p0_tile8_store(tb, db.dst, db.ldd, 64.f, scr, lane);
                it = ita;
            }
        }
        for (int it = gw; it < NT; it += NGW) {
            int r = it;
            if (r < T_WIN) { const int kb = r / 32, nb = r % 32; p0_tile(p.in[I_WIN], MIXN, 64 * kb, 64 * nb, Win_t + (size_t)(64 * nb) * D + 64 * kb, D, scr, lane); continue; } r -= T_WIN;
            if (r < T_WOUT) { const int kb = 8 + r / 16, nb = r % 16; p0_tile(p.in[I_WOUT], D, 64 * kb, 64 * nb, Wout_t + (size_t)(64 * nb) * D + 64 * kb, D, scr, lane); continue; } r -= T_WOUT;
            if (r < 2 * T_FG) { const int up = r >= T_FG; const int q = up ? r - T_FG : r; const int kb = q / 44, nb = q % 44, n0 = 64 * nb;
                p0_tile(p.in[up ? I_FU : I_FG], DFF, 64 * kb, n0, Wgu_t + (size_t)((n0 / 128) * 256 + (n0 % 128) + (up ? 128 : 0)) * D + 64 * kb, D, scr, lane, p.in[I_EVNF]); continue; } r -= 2 * T_FG;
            if (r < T_FD) { const int kb = r / 16, nb = r % 16; p0_tile(p.in[I_FD], D, 64 * kb, 64 * nb, Wd_t + (size_t)(64 * nb) * DFF + 64 * kb, DFF, scr, lane); continue; } r -= T_FD;
            if (r < T_QKV) { const int kb = r / 20, nb = r % 20; p0_tile(p.in[I_WQKV], QKVN, 64 * kb, 64 * nb, Wqkv_t + (size_t)(64 * nb) * D + 64 * kb, D, scr, lane, p.in[I_ODNM]); continue; } r -= T_QKV;
            { const int kb = r / 16, nb = r % 16; p0_tile(p.in[I_WO], D, 64 * kb, 64 * nb, Wo_t + (size_t)(64 * nb) * D + 64 * kb, D, scr, lane); }
        }
        for (int it = gw; it < 4 * 32 * 16; it += NGW) {
            const int g = it >> 9, cb = (it >> 4) & 31, nb = it & 15; const int n = 64 * nb + lane, c0 = 4 * cb;
            const float* wo = p.in[I_WOUT] + (size_t)(g * 128) * D + n; const float* ps = p.in[I_POOLS] + g * 128; const float* pw = p.in[I_POOLW] + (size_t)(g * 128 + c0) * 128;
            float acc[4] = {0.f, 0.f, 0.f, 0.f};
            for (int d0 = 0; d0 < 128; d0 += 16) {
                float w[16];
#pragma unroll
                for (int j = 0; j < 16; ++j) w[j] = wo[(size_t)(d0 + j) * D];
#pragma unroll
                for (int j = 0; j < 16; ++j) { const float ww = w[j] * ps[d0 + j];
#pragma unroll
                    for (int cc = 0; cc < 4; ++cc) acc[cc] += pw[cc * 128 + d0 + j] * ww; } }
            u32x2 o; o.x = pk2(acc[0], acc[1]); o.y = pk2(acc[2], acc[3]);
            *(u32x2*)(Wout_t + (size_t)n * D + g * 128 + c0) = o;
        }
#pragma unroll 2
        for (int m = gw; m < M; m += NGW) { float y[16]; norm_row_bf16(p.in[I_X] + (size_t)m * D, p.in[I_EVNM], XN + (size_t)m * D, lane, y); }
        for (int i = bx * NTHR + tid; i < NQH * 256; i += G * NTHR) { const int h = i >> 8, idx = i & 255; bias_tab[i] = idx < 255 ? p.in[I_RELB][t5_bucket(idx - 191) * NQH + h] : 0.f; }
    }
    SEAM(0);

    if (IN(1)) for (int rep_ = 0; rep_ < NREP(1); ++rep_) { pg8::Gemm g{XN, Win_t, 2 * D, 2 * D, 2 * D}; pg8::DenseOrder S; S.init(M, MIXN, G, bx); pg8::EpiBf16 E{PROJ, MIXN, nullptr, nullptr};
        pg8::gemm_phase<pg8::EpiBf16, pg8::DenseOrder>(lds, g, S, E); }
    SEAM(1);

    if (IN(2)) for (int rep_ = 0; rep_ < NREP(2); ++rep_) {
        const int tid = fresh_tid(), lane = tid & 63;
        for (int unit = gw; unit < (M / 32) * 2; unit += NGW) {
            const int rb = unit >> 1, half = unit & 1, r0 = rb * 32, bs = r0 & ~(SEQ - 1);
            if (half == 0) {
                const int w = 2 << (lane >> 4); const bf16_t* P = PROJ + 8 * lane;
                float s[8];
#pragma unroll
                for (int q = 0; q < 8; ++q) s[q] = 0.f;
                for (int j = 1; j <= 16; ++j) if (j <= w && r0 - j >= bs) { float f[8]; unpack8(*(const u32x4*)(P + (size_t)(r0 - j) * MIXN), f);
#pragma unroll
                    for (int q = 0; q < 8; ++q) s[q] += f[q]; }
#pragma unroll 4
                for (int r = r0; r < r0 + 32; ++r) {
                    float cur[8], old[8]; unpack8(*(const u32x4*)(P + (size_t)r * MIXN), cur);
                    const bool has_old = (r - w >= bs);
                    if (has_old) unpack8(*(const u32x4*)(P + (size_t)(r - w) * MIXN), old);
                    const int pos = r - bs + 1; const float inv = 1.0f / (float)(pos < w ? pos : w);
                    float o[8];
#pragma unroll
                    for (int q = 0; q < 8; ++q) { s[q] += cur[q]; if (has_old) s[q] -= old[q]; o[q] = s[q] * inv - cur[q]; }
                    *(u32x4*)(MIXED + (size_t)r * D + 8 * lane) = pack8(o);
                }
            } else {
                const bf16_t* P = PROJ + 8 * lane;
                float w0[8], w1[8], w2[8], z1[8], z2[8];
                { const float* cw = p.in[I_CONVW] + 8 * lane;
#pragma unroll
                  for (int q = 0; q < 8; ++q) { w0[q] = cw[q]; w1[q] = cw[512 + q]; w2[q] = cw[1024 + q]; z1[q] = 0.f; z2[q] = 0.f; } }
                if (r0 - 1 >= bs) { float a[8], b[8]; unpack8(*(const u32x4*)(P + (size_t)(r0 - 1) * MIXN + 1024), a); unpack8(*(const u32x4*)(P + (size_t)(r0 - 1) * MIXN + 1536), b);
#pragma unroll
                    for (int q = 0; q < 8; ++q) z1[q] = a[q] * b[q]; }
                if (r0 - 2 >= bs) { float a[8], b[8]; unpack8(*(const u32x4*)(P + (size_t)(r0 - 2) * MIXN + 1024), a); unpack8(*(const u32x4*)(P + (size_t)(r0 - 2) * MIXN + 1536), b);
#pragma unroll
                    for (int q = 0; q < 8; ++q) z2[q] = a[q] * b[q]; }
#pragma unroll 4
                for (int r = r0; r < r0 + 32; ++r) {
                    float gp[8], a[8], b[8], o[8];
                    unpack8(*(const u32x4*)(P + (size_t)r * MIXN + 512), gp); unpack8(*(const u32x4*)(P + (size_t)r * MIXN + 1024), a); unpack8(*(const u32x4*)(P + (size_t)r * MIXN + 1536), b);
#pragma unroll
                    for (int q = 0; q < 8; ++q) { const float zc = a[q] * b[q]; o[q] = gp[q] * (w0[q] * z2[q] + w1[q] * z1[q] + w2[q] * zc); z2[q] = z1[q]; z1[q] = zc; }
                    *(u32x4*)(MIXED + (size_t)r * D + 512 + 8 * lane) = pack8(o);
                }
            }
        }
    }
    SEAM(2);

    if (IN(3)) for (int rep_ = 0; rep_ < NREP(3); ++rep_) { pg8::Gemm g{MIXED, Wout_t, 2 * D, 2 * D, 2 * D}; pg8::DenseOrder S; S.init(M, D, G, bx); pg8::EpiResid E{p.in[I_X], X, nullptr, XN, rss, lds + LDS_XTAB_OFF};
        pg8::gemm_phase<pg8::EpiResid, pg8::DenseOrder>(lds, g, S, E); }
    SEAM(3);


    if (IN(5)) for (int rep_ = 0; rep_ < NREP(5); ++rep_) { pg8::Gemm g{XN, Wgu_t, 2 * D, 2 * D, 2 * D}; pg8::DenseOrder S; S.init(M, 2 * DFF, G, bx); pg8::EpiSwiGLU E{Hb, DFF, rss};
        pg8::gemm_phase<pg8::EpiSwiGLU, pg8::DenseOrder>(lds, g, S, E); }
    SEAM(5);

    if (IN(6)) for (int rep_ = 0; rep_ < NREP(6); ++rep_) { pg8::Gemm g{Hb, Wd_t, 2 * DFF, 2 * DFF, 2 * DFF}; pg8::DenseOrder S; S.init(M, D, G, bx); pg8::EpiResid E{X, X, nullptr, XN, rss + (size_t)M * 4, lds + LDS_XTAB_OFF};
        pg8::gemm_phase<pg8::EpiResid, pg8::DenseOrder>(lds, g, S, E); }
    SEAM(6);


    if (IN(8)) for (int rep_ = 0; rep_ < NREP(8); ++rep_) { pg8::Gemm g{XN, Wqkv_t, 2 * D, 2 * D, 2 * D}; pg8::DenseOrder S; S.init(M, QKVN, G, bx); pg8::EpiBf16 E{QKV, QKVN, p.in[I_BQKV], rss + (size_t)M * 4};
        pg8::gemm_phase<pg8::EpiBf16, pg8::DenseOrder>(lds, g, S, E); }
    SEAM(8);

    if (IN(9)) for (int rep_ = 0; rep_ < NREP(9); ++rep_) {
        const int tid = fresh_tid(), lane = tid & 63;
        for (int i = tid; i < NQH * 256; i += NTHR) *(LAS float*)(lds + AT_L_BT + 4 * i) = bias_tab[i];
        const int r32 = lane & 31, hh = lane >> 5;
        constexpr int NUNIT = BATCH * (SEQ / CHUNK) * NKVH;
        u32x4 kr[3], vr[3]; bf16x8 qfA[4], qfB[4];
#define AT_KV_LOAD(unit_) do { const int tid_ = fresh_tid(); const int kvh_ = (unit_) & 1, n_ = ((unit_) >> 1) & 255, t0_ = ((unit_) >> 9) * SEQ + n_ * CHUNK; _Pragma("unroll") for (int i = 0; i < 3; ++i) { const int pc = tid_ + i * NTHR, j = pc >> 3, c = pc & 7; \
            kr[i] = (u32x4){0u, 0u, 0u, 0u}; vr[i] = (u32x4){0u, 0u, 0u, 0u}; \
            if (n_ * CHUNK - 128 + j >= 0) { const bf16_t* src = QKV + (size_t)(t0_ - 128 + j) * QKVN + 1024 + kvh_ * HD + 8 * c; kr[i] = *(const u32x4*)src; vr[i] = *(const u32x4*)(src + 128); } } } while (0)
#define AT_Q_LOAD(qf_, unit_, qb_) do { const int l_ = fresh_tid() & 63; const int r32 = l_ & 31, hh = l_ >> 5; const int kvh_ = (unit_) & 1, n_ = ((unit_) >> 1) & 255, t0_ = ((unit_) >> 9) * SEQ + n_ * CHUNK; \
            const bf16_t* qp = QKV + (size_t)(t0_ + (qb_) * 32 + r32) * QKVN + (kvh_ * 8 + wave) * HD + 8 * hh; _Pragma("unroll") for (int ks = 0; ks < 4; ++ks) qf_[ks] = *(const bf16x8*)(qp + 16 * ks); } while (0)
        int unit = vcu;
        if (unit < NUNIT) { AT_KV_LOAD(unit); }
        for (; unit < NUNIT; unit += G) {
            const int kvh = unit & 1, n = (unit >> 1) & 255, b = unit >> 9;
            const int t0 = b * SEQ + n * CHUNK;
            const bool has_next = unit + G < NUNIT;
            __syncthreads();
            const int tid_s = fresh_tid();
#pragma unroll
            for (int i = 0; i < 3; ++i) { const int pc = tid_s + i * NTHR, j = pc >> 3, c = pc & 7;
                *(LAS u32x4*)(lds + AT_L_K + j * AT_KS_STR + 16 * c) = kr[i];
                const unsigned vw[4] = {vr[i].x, vr[i].y, vr[i].z, vr[i].w};
#pragma unroll
                for (int q = 0; q < 4; ++q) { *(LAS unsigned short*)(lds + AT_L_VT + (8 * c + 2 * q) * AT_VT_STR + 2 * j) = (unsigned short)(vw[q] & 0xffffu);
                                              *(LAS unsigned short*)(lds + AT_L_VT + (8 * c + 2 * q + 1) * AT_VT_STR + 2 * j) = (unsigned short)(vw[q] >> 16); } }
            AT_Q_LOAD(qfA, unit, 0); AT_Q_LOAD(qfB, unit, 1);
            __syncthreads();
            const int head = kvh * 8 + wave;
            const float sink = p.in[I_SINK][head];
            const int kb_min = n == 0 ? 4 : (n == 1 ? 2 : 0);
            attn_qblock(lds, qfA, AO + (size_t)t0 * D + head * HD, head, 0, kb_min, sink, wave, fresh_tid() & 63);
            if (has_next) AT_KV_LOAD(unit + G);
            attn_qblock(lds, qfB, AO + (size_t)(t0 + 32) * D + head * HD, head, 1, kb_min, sink, wave, fresh_tid() & 63);
        }
#undef AT_KV_LOAD
#undef AT_Q_LOAD
        __syncthreads();
    }
    SEAM(9);

    if (IN(10)) for (int rep_ = 0; rep_ < NREP(10); ++rep_) { pg8::Gemm g{AO, Wo_t, 2 * D, 2 * D, 2 * D}; pg8::DenseOrder S; S.init(M, D, G, bx); pg8::EpiResid E{X, X, p.in[I_BO], nullptr, nullptr, nullptr};
        pg8::gemm_phase<pg8::EpiResid, pg8::DenseOrder>(lds, g, S, E); }
    SEAM(10);

    const int RPW = (M + G - 1) / G;
    constexpr int L_RW = 0, L_RE = 32768, L_RWT = L_RE + 1024 * 4, L_RRK = L_RWT + 1024 * 4, L_CNT = L_RRK + 1024 * 4, L_SB = L_CNT + 64, L_SLOT = L_SB + 256;
    unsigned char* XN8 = (unsigned char*)XN;
    if (IN(11)) for (int rep_ = 0; rep_ < NREP(11); ++rep_) {
        const int tid = fresh_tid(), lane = tid & 63;
        for (int i = tid; i < D * NEXP; i += NTHR) { const int c = i >> 3, e = i & 7; *(LAS float*)(lds + L_RW + 4 * (e * D + c)) = p.in[I_ROUTER][i] * p.in[I_ODNF][c]; }
        if (tid < 8) *(LAS int*)(lds + L_CNT + 4 * tid) = 0;
        __syncthreads();
        const int rbase = bx * RPW;
        const int nrows = (M - rbase) < RPW ? (M - rbase) : RPW;
        f32x4 gn[4];
#pragma unroll
        for (int j = 0; j < 4; ++j) gn[j] = *(const f32x4*)(p.in[I_ODNF] + 256 * j + 4 * lane);
        for (int rl0 = wave; rl0 < nrows; rl0 += 4 * NWAVES) {
            f32x4 v[4][4];
#pragma unroll
            for (int u = 0; u < 4; ++u) { const int rl = rl0 + 8 * u; const int m = rbase + (rl < nrows ? rl : rl0);
#pragma unroll
                for (int j = 0; j < 4; ++j) v[u][j] = *(const f32x4*)(X + (size_t)m * D + 256 * j + 4 * lane); }
#pragma unroll
            for (int u = 0; u < 4; ++u) { const int rl = rl0 + 8 * u; if (rl >= nrows) continue; const int m = rbase + rl;
                float s2 = 0.f;
#pragma unroll
                for (int j = 0; j < 4; ++j) s2 += (v[u][j][0] * v[u][j][0] + v[u][j][1] * v[u][j][1]) + (v[u][j][2] * v[u][j][2] + v[u][j][3] * v[u][j][3]);
                const float r = 1.0f / sqrtf(wave_sum(s2) * (1.0f / D) + RMS_EPS);
                float lg[8];
#pragma unroll
                for (int e = 0; e < 8; ++e) { float a = 0.f;
#pragma unroll
                    for (int j = 0; j < 4; ++j) { const f32x4 w = *(const LAS f32x4*)(lds + L_RW + 4096 * e + 1024 * j + 16 * lane); a += (v[u][j][0] * w[0] + v[u][j][1] * w[1]) + (v[u][j][2] * w[2] + v[u][j][3] * w[3]); }
                    lg[e] = a; }
#pragma unroll
                for (int e = 0; e < 8; ++e) lg[e] = wave_sum(lg[e]) * r;
#pragma unroll
                for (int j = 0; j < 4; ++j) { const f32x4 y = v[u][j] * r * gn[j]; *(unsigned*)(XN8 + (size_t)m * D + 256 * j + 4 * lane) = pg8::pk4_fp8(y[0], y[1], y[2], y[3]); }
                int e0 = 0; float v0 = lg[0];
#pragma unroll
                for (int e = 1; e < 8; ++e) if (lg[e] > v0) { v0 = lg[e]; e0 = e; }
                int e1 = -1; float v1 = -3.0e38f;
#pragma unroll
                for (int e = 0; e < 8; ++e) if (e != e0 && lg[e] > v1) { v1 = lg[e]; e1 = e; }
                const float wt0 = 1.0f / (1.0f + __expf(v1 - v0));
                if (lane == 0) { *(LAS int*)(lds + L_RE + 8 * rl) = e0; *(LAS int*)(lds + L_RE + 8 * rl + 4) = e1; *(LAS float*)(lds + L_RWT + 8 * rl) = wt0; *(LAS float*)(lds + L_RWT + 8 * rl + 4) = 1.0f - wt0; }
            }
        }
        __syncthreads();
        for (int en = tid; en < 2 * nrows; en += NTHR) {
            const int e = *(LAS int*)(lds + L_RE + 4 * en); int r = 0;
            for (int j = 0; j < en; ++j) r += (*(LAS int*)(lds + L_RE + 4 * j) == e);
            *(LAS int*)(lds + L_RRK + 4 * en) = r;
            __hip_atomic_fetch_add((LAS int*)(lds + L_CNT + 4 * e), 1, __ATOMIC_RELAXED, __HIP_MEMORY_SCOPE_WORKGROUP);
        }
        __syncthreads();
        if (tid < 8) wgcnt[bx * 8 + tid] = *(LAS int*)(lds + L_CNT + 4 * tid);
        __syncthreads();
    }
    SEAM(11);

    if (IN(12)) for (int rep_ = 0; rep_ < NREP(12); ++rep_) {
        const int tid = fresh_tid(), lane = tid & 63;
        LAS int* sb = (LAS int*)(lds + L_SB);
        if (tid < 32) sb[tid] = 0;
        __syncthreads();
        for (int i = tid; i < G * 2; i += NTHR) { const int w = i >> 1, h4 = (i & 1) * 4; const u32x4 c = *(const u32x4*)(wgcnt + w * 8 + h4); const unsigned cv[4] = {c.x, c.y, c.z, c.w};
#pragma unroll
            for (int q = 0; q < 4; ++q) { __hip_atomic_fetch_add(sb + 16 + h4 + q, (int)cv[q], __ATOMIC_RELAXED, __HIP_MEMORY_SCOPE_WORKGROUP); if (w < bx) __hip_atomic_fetch_add(sb + 8 + h4 + q, (int)cv[q], __ATOMIC_RELAXED, __HIP_MEMORY_SCOPE_WORKGROUP); } }
        __syncthreads();
        if (tid == 0) { int base = 0; for (int e = 0; e < 8; ++e) { sb[e] = base; base += (sb[16 + e] + 255) & ~255; } sb[24] = base; }
        __syncthreads();
        const int rbase = bx * RPW;
        const int nrows = (M - rbase) < RPW ? (M - rbase) : RPW;
        unsigned char* HS8 = (unsigned char*)HS;
        for (int en = tid; en < 2 * nrows; en += NTHR) { const int e = *(LAS int*)(lds + L_RE + 4 * en); const int slot = sb[e] + sb[8 + e] + *(LAS int*)(lds + L_RRK + 4 * en);
            *(LAS int*)(lds + L_SLOT + 4 * en) = slot; slot_tok[slot] = 2 * (rbase + (en >> 1)) + (en & 1); slot_w[slot] = *(LAS float*)(lds + L_RWT + 4 * en); }
        __syncthreads();
        for (int en0 = wave; en0 < 2 * nrows; en0 += 4 * NWAVES) {
            u32x4 t[4];
#pragma unroll
            for (int u = 0; u < 4; ++u) { const int en = en0 + 8 * u; if (en < 2 * nrows) t[u] = *(const u32x4*)(XN8 + (size_t)(rbase + (en >> 1)) * D + 16 * lane); }
#pragma unroll
            for (int u = 0; u < 4; ++u) { const int en = en0 + 8 * u; if (en < 2 * nrows) *(u32x4*)(HS8 + (size_t)(*(LAS int*)(lds + L_SLOT + 4 * en)) * D + 16 * lane) = t[u]; } }
        if (bx == 0) {
            for (int e = 0; e < 8; ++e) { const int b0 = sb[e] + sb[16 + e], b1 = sb[e] + ((sb[16 + e] + 255) & ~255); for (int i = b0 + tid; i < b1; i += NTHR) { slot_tok[i] = -1; slot_w[i] = 0.f; } }
            const int nt_all = sb[24] >> 8;
            for (int j = tid; j < nt_all; j += NTHR) { int e = 0; for (int q = 1; q < 8; ++q) if ((j << 8) >= sb[q]) e = q; tilemeta[8 + j] = e; }
            if (tid == 0) { tilemeta[0] = nt_all; tilemeta[1] = nt_all; }
        }
        __syncthreads();
    }
    SEAM(12);

    if (IN(13) || IN(14)) {
        const int tid = fresh_tid();
        for (int j = tid; j < 288; j += NTHR) *(LAS int*)(lds + LDS_TILE_OFF + 4 * j) = (j < MAXTILES + 8) ? tilemeta[j] : 0;
        __syncthreads();
    }
    const LAS int* tmeta = (const LAS int*)(lds + LDS_TILE_OFF);
    if (IN(13)) for (int rep_ = 0; rep_ < NREP(13); ++rep_) {
        const int nall = __builtin_amdgcn_readfirstlane(tmeta[0]);
        pg8::Gemm g{HS, Wegu_t, D, D, D}; pg8::MoeOrder S; S.T.init(nall, NFE_T, G, bx); S.tpe = NFE_T; S.tile_e = tmeta + 8;
        pg8::EpiSwiGLU8 E{(unsigned char*)H2, DFE};
        pg8::gemm_phase<pg8::EpiSwiGLU8, pg8::MoeOrder, true>(lds, g, S, E);
#if PROBE_KLOOP
        { pg8::EpiNull8 E2{(float*)(ws + WS_RSS)}; pg8::gemm_phase<pg8::EpiNull8, pg8::MoeOrder, true>(lds, g, S, E2); }
#endif
    }
    SEAM(13);
    if (IN(14)) {
        const int nall = __builtin_amdgcn_readfirstlane(tmeta[0]);
        pg8::Gemm g{H2, Wed_t, DFE, DFE, DFE}; pg8::MoeOrder S; S.T.init(nall, D / 256, G, bx); S.tpe = D / 256; S.tile_e = tmeta + 8;
        pg8::EpiMoeDown E{X, (bf16_t*)(ws + WS_Y0), slot_tok, slot_w};
        pg8::gemm_phase<pg8::EpiMoeDown, pg8::MoeOrder, true>(lds, g, S, E);
    }
    SEAM(14);

    if (IN(15)) {
        const int lane = fresh_tid() & 63;
        const bf16_t* Y0 = (const bf16_t*)(ws + WS_Y0);
        for (int m = gw; m < M; m += NGW) {
            float* xrow = X + (size_t)m * D; f32x4 v[4];
#pragma unroll
            for (int j = 0; j < 2; ++j) { v[2 * j] = *(const f32x4*)(xrow + 512 * j + 8 * lane); v[2 * j + 1] = *(const f32x4*)(xrow + 512 * j + 8 * lane + 4);
                float f[8]; unpack8(*(const u32x4*)(Y0 + (size_t)m * D + 512 * j + 8 * lane), f);
#pragma unroll
                for (int q = 0; q < 4; ++q) { v[2 * j][q] += f[q]; v[2 * j + 1][q] += f[4 + q]; } }
            float s2 = 0.f;
#pragma unroll
            for (int j = 0; j < 4; ++j) s2 += (v[j][0] * v[j][0] + v[j][1] * v[j][1]) + (v[j][2] * v[j][2] + v[j][3] * v[j][3]);
            const float r = 1.0f / sqrtf(wave_sum(s2) * (1.0f / D) + RMS_EPS);
#pragma unroll
            for (int j = 0; j < 2; ++j) { const f32x4 g0 = *(const f32x4*)(p.in[I_FINAL] + 512 * j + 8 * lane), g1 = *(const f32x4*)(p.in[I_FINAL] + 512 * j + 8 * lane + 4);
                *(f32x4*)(xrow + 512 * j + 8 * lane) = v[2 * j] * r * g0; *(f32x4*)(xrow + 512 * j + 8 * lane + 4) = v[2 * j + 1] * r * g1; }
        }
    }
#undef IN
#undef SEAM
}

extern "C" void kernel_launch(void* const* d_in, const int* in_sizes, int n_in, void* d_out, int out_size, void* d_ws, size_t ws_size, hipStream_t stream) {
    static int grid = 0;
    if (grid == 0) {
        if (n_in != 24 || in_sizes[0] != M * D || out_size != M * D || ws_size < WS_END) { fprintf(stderr, "kernel_launch: unexpected shapes (n_in %d, in0 %d, out %d, ws %zu < %zu)\n", n_in, n_in > 0 ? in_sizes[0] : -1, out_size, ws_size, (size_t)WS_END); grid = -1; return; }
        int dev = 0, cus = 0, per_cu = 0;
        if (hipGetDevice(&dev) != hipSuccess || hipDeviceGetAttribute(&cus, hipDeviceAttributeMultiprocessorCount, dev) != hipSuccess) { grid = -1; return; }
        if (hipFuncSetAttribute((const void*)fwd_kernel, hipFuncAttributeMaxDynamicSharedMemorySize, LDS_BYTES) != hipSuccess) { fprintf(stderr, "kernel_launch: hipFuncSetAttribute failed\n"); grid = -1; return; }
        if (hipOccupancyMaxActiveBlocksPerMultiprocessor(&per_cu, (const void*)fwd_kernel, NTHR, LDS_BYTES) != hipSuccess || per_cu < 1) fprintf(stderr, "kernel_launch: occupancy query reports %d\n", per_cu);
        (void)hipGetLastError();
        grid = cus < 256 ? cus : 256;
    }
    if (grid < 0) return;
    (void)hipMemsetAsync((char*)d_ws + WS_CTL, 0, CTL_ZERO_BYTES, stream);
    Params a{};
    for (int i = 0; i < 24; ++i) a.in[i] = (const float*)d_in[i];
    a.out = (float*)d_out; a.ws = (unsigned char*)d_ws;
    constexpr int NPH = 16;
    if (MK_N_LAUNCHES == 1) { a.ph_lo = 0; a.ph_hi = NPH; hipLaunchKernelGGL(fwd_kernel, dim3(grid), dim3(NTHR), LDS_BYTES, stream, a); }
    else for (int li = 0; li < NPH; ++li) { a.ph_lo = li; a.ph_hi = li + 1; hipLaunchKernelGGL(fwd_kernel, dim3(grid), dim3(NTHR), LDS_BYTES, stream, a); }
}
```

```cpp
#include <hip/hip_runtime.h>
#include <cstdio>
#include <cstdint>

#ifndef MK_N_LAUNCHES
#define MK_N_LAUNCHES 1
#endif

#ifndef PROBE_KLOOP
#define PROBE_KLOOP 0
#endif
#ifndef PROBE_FOLD
#define PROBE_FOLD 3
#endif
#ifndef REPMASK
#define REPMASK 0u
#endif
#define NREP(k) ((((REPMASK) >> (k)) & 1u) ? 2 : 1)
#define LAS __attribute__((address_space(3)))
#define GAS __attribute__((address_space(1)))
typedef unsigned short bf16_t;
typedef short bf16x8 __attribute__((ext_vector_type(8)));
typedef short s16x4 __attribute__((ext_vector_type(4)));
typedef float f32x2 __attribute__((ext_vector_type(2)));
typedef float f32x4 __attribute__((ext_vector_type(4)));
typedef float f32x16 __attribute__((ext_vector_type(16)));
typedef unsigned u32x2 __attribute__((ext_vector_type(2)));
typedef unsigned u32x4 __attribute__((ext_vector_type(4)));
typedef __bf16 hbf16x2 __attribute__((ext_vector_type(2)));
typedef int i32x4 __attribute__((ext_vector_type(4)));
typedef int i32x8 __attribute__((ext_vector_type(8)));

constexpr int D = 1024, BATCH = 2, SEQ = 16384, M = BATCH * SEQ;
constexpr int MIXN = 2048;
constexpr int DFF = 2816, NFF_T = DFF / 128;
constexpr int QKVN = 1280, NQH = 16, NKVH = 2, HD = 64, CHUNK = 64, KVSPAN = 192;
constexpr int NEXP = 8, DFE = 3584, NFE_T = DFE / 128;
constexpr float RMS_EPS = 1e-6f;
constexpr int MAXSLOT = 67328;
constexpr int MAXTILES = MAXSLOT / 256;
constexpr int NWAVES = 8, NTHR = 512;

constexpr size_t MiB = 1u << 20;
constexpr size_t WS_CTL = 0, CTL_ZERO_BYTES = 1 * MiB;
constexpr size_t WS_BIAS = 1 * MiB;
constexpr size_t WS_WGCNT = WS_BIAS + 16 * 256 * 4;
constexpr size_t WS_TILE = WS_WGCNT + 1024 * 16 * 4;
constexpr size_t WS_TOKE = WS_TILE + 4096;
constexpr size_t WS_TOKW = WS_TOKE + 2 * (size_t)M * 4;
constexpr size_t WS_TOKR = WS_TOKW + 2 * (size_t)M * 4;
constexpr size_t WS_SLOTT = WS_TOKR + 2 * (size_t)M * 4;
constexpr size_t WS_SLOTW = WS_SLOTT + (size_t)MAXSLOT * 4;
static_assert(WS_SLOTW + (size_t)MAXSLOT * 4 <= 4 * MiB, "route region");
constexpr size_t WS_WIN = 4 * MiB;
constexpr size_t WS_WOUT = WS_WIN + (size_t)MIXN * D * 2;
constexpr size_t WS_WGU = WS_WOUT + (size_t)D * D * 2;
constexpr size_t WS_WD = WS_WGU + (size_t)2 * DFF * D * 2;
constexpr size_t WS_WQKV = WS_WD + (size_t)D * DFF * 2;
constexpr size_t WS_WO = WS_WQKV + (size_t)QKVN * D * 2;
static_assert(WS_WO + (size_t)D * D * 2 <= 31 * MiB, "dense weights");
constexpr size_t WS_WEGU = 31 * MiB;
constexpr size_t WS_WED = WS_WEGU + (size_t)NEXP * 2 * DFE * D;
static_assert(WS_WED + (size_t)NEXP * D * DFE == 115 * MiB, "expert weights");
constexpr size_t WS_XN = 115 * MiB;
constexpr size_t WS_Y0 = WS_XN;
constexpr size_t WS_R = 179 * MiB;
constexpr size_t WS_PROJ = WS_R, WS_MIXED = WS_R + (size_t)M * MIXN * 2;
constexpr size_t WS_H = WS_R;
constexpr size_t WS_QKV = WS_R, WS_AO = WS_R + (size_t)M * QKVN * 2;
constexpr size_t WS_HS = WS_R, WS_H2 = WS_R + 66 * MiB;
static_assert((size_t)MAXSLOT * D <= 66 * MiB, "HS");
constexpr size_t WS_END = WS_H2 + (size_t)MAXSLOT * DFE;
static_assert(WS_END <= 543497280ull, "workspace");
static_assert(WS_MIXED + (size_t)M * D * 2 <= 543497280ull && WS_H + (size_t)M * DFF * 2 <= 543497280ull, "workspace");

constexpr int CW_BAR = 4096;
constexpr size_t WS_RSS = 480 * MiB;
static_assert(WS_RSS >= WS_END && WS_RSS + 2 * (size_t)M * 4 * 4 <= 543497280ull, "rss");

constexpr int RING_BYTES = 131072;
constexpr int LDS_TILE_OFF = RING_BYTES;
constexpr int LDS_MISC_OFF = RING_BYTES + 2048;
constexpr int LDS_XTAB_OFF = RING_BYTES + 4096;
constexpr int LDS_BYTES = 147456;

__device__ __forceinline__ unsigned pk2(float lo, float hi) { f32x2 v = {lo, hi}; hbf16x2 b = __builtin_convertvector(v, hbf16x2); return __builtin_bit_cast(unsigned, b); }
__device__ __forceinline__ float bf_lo(unsigned w) { return __uint_as_float(w << 16); }
__device__ __forceinline__ float bf_hi(unsigned w) { return __uint_as_float(w & 0xffff0000u); }
__device__ __forceinline__ void unpack8(const u32x4 w, float (&f)[8]) { f[0] = bf_lo(w.x); f[1] = bf_hi(w.x); f[2] = bf_lo(w.y); f[3] = bf_hi(w.y); f[4] = bf_lo(w.z); f[5] = bf_hi(w.z); f[6] = bf_lo(w.w); f[7] = bf_hi(w.w); }
__device__ __forceinline__ u32x4 pack8(const float (&f)[8]) { u32x4 w; w.x = pk2(f[0], f[1]); w.y = pk2(f[2], f[3]); w.z = pk2(f[4], f[5]); w.w = pk2(f[6], f[7]); return w; }
__device__ __forceinline__ float wave_sum(float v) {
#pragma unroll
    for (int o = 1; o < 64; o <<= 1) v += __shfl_xor(v, o);
    return v;
}
__device__ __forceinline__ int fresh_tid() { int t = threadIdx.x; asm volatile("" : "+v"(t)); return t; }
#define LDS_WAIT() asm volatile("s_waitcnt lgkmcnt(0)" ::: "memory")
#define VM_WAIT() asm volatile("s_waitcnt vmcnt(0)" ::: "memory")

namespace pg8 {
constexpr int BM = 256, BK = 64, HALF = 128, HTB = HALF * BK * 2, STAGE_BYTES = 8 * HTB, NXCD = 8, WGM = 8;
__host__ __device__ __forceinline__ int lds_byte(int r, int c) { const int st = (r >> 4) * 2 + (c >> 5), rr = r & 15, cc = c & 31, ob = rr * 64 + cc * 2; return st * 1024 + (ob ^ (((ob >> 9) & 1) << 5)); }
__host__ __device__ __forceinline__ void stage_rc(int b, int& R, int& C) { const int st = b / 1024, sb = b % 1024, swz = sb ^ (((sb >> 9) & 1) << 5); R = (st >> 1) * 16 + swz / 64; C = (st & 1) * 32 + (swz % 64) / 2; }
__host__ __device__ __forceinline__ int perm32(int rho) { const int n = rho >> 4, i = rho & 15; return 8 * (i >> 2) + 4 * n + (i & 3); }

struct Unit { int pm, pn, rm, cn; };
struct Gemm { const void* A; const void* Bt; int lda, ldb, K; };

struct TileOrder {
    int nM, nN, nwg, G, c;
    __device__ __forceinline__ void init(int nM_, int nN_, int G_, int c_) { nM = nM_; nN = nN_; nwg = nM * nN; G = G_; c = c_; }
    __device__ __forceinline__ bool next(int i, int& m, int& n) const {
        const int L = i * G + c; if (L >= nwg) return false;
        int wgid = L; { const int q = nwg / NXCD, r = nwg % NXCD, xcd = wgid % NXCD, off = wgid / NXCD; wgid = (xcd < r ? xcd * (q + 1) : r * (q + 1) + (xcd - r) * q) + off; }
        const int nig = WGM * nN, gid = wgid / nig, fm = gid * WGM, gsz = (nM - fm) < WGM ? (nM - fm) : WGM;
        m = fm + ((wgid % nig) % gsz); n = (wgid % nig) / gsz; return true;
    }
};
struct DenseOrder {
    TileOrder T;
    __device__ __forceinline__ void init(int Mr, int N, int G, int c) { T.init(Mr / BM, N / BM, G, c); }
    __device__ __forceinline__ bool next(int i, Unit& u) const { int m, n; if (!T.next(i, m, n)) return false; u.pm = m; u.pn = n; u.rm = m; u.cn = n; return true; }
    __device__ __forceinline__ void a_ready(const Unit&) const {}
    __device__ __forceinline__ void done(const Unit&) const {}
};
struct MoeOrder {
    TileOrder T; int tpe; const LAS int* tile_e;
    __device__ __forceinline__ bool next(int i, Unit& u) const { int m, n; if (!T.next(i, m, n)) return false;
        const int e = __builtin_amdgcn_readfirstlane(tile_e[m]);
        u.pm = m; u.pn = e * tpe + n; u.rm = m; u.cn = n; return true; }
    __device__ __forceinline__ void a_ready(const Unit&) const {}
    __device__ __forceinline__ void done(const Unit&) const {}
};

__device__ __forceinline__ float rms_scale(const float* rss, int row) { if (!rss) return 1.0f; const f32x4 a = *(const f32x4*)(rss + (size_t)row * 4);
    return 1.0f / sqrtf(((a[0] + a[1]) + (a[2] + a[3])) * (1.0f / D) + RMS_EPS); }
struct EpiBf16 {
    static constexpr bool PERM = true;
    bf16_t* O; int ldc; const float* bias; const float* rss;
    __device__ __forceinline__ void operator()(const f32x4 (&acc)[2][2][4][2], const Unit& u, int wr, int wc, int fr, int fq) const {
        const int row0 = u.rm * BM + wr * 64 + fr, col0 = u.cn * BM + wc * 32 + 8 * fq;
        f32x4 bv[2][2];
#pragma unroll
        for (int bj = 0; bj < 2; ++bj)
#pragma unroll
            for (int n = 0; n < 2; ++n) bv[bj][n] = bias ? *(const f32x4*)(bias + col0 + bj * HALF + 4 * n) : (f32x4){0.f, 0.f, 0.f, 0.f};
        float rs[2][4];
#pragma unroll
        for (int ai = 0; ai < 2; ++ai)
#pragma unroll
            for (int m = 0; m < 4; ++m) rs[ai][m] = rms_scale(rss, row0 + ai * HALF + m * 16);
#pragma unroll
        for (int ai = 0; ai < 2; ++ai)
#pragma unroll
            for (int m = 0; m < 4; ++m) { const int row = row0 + ai * HALF + m * 16; bf16_t* rowp = O + (size_t)row * ldc + col0; const float r = rs[ai][m];
#pragma unroll
                for (int bj = 0; bj < 2; ++bj) { const f32x4 v0 = acc[ai][bj][m][0] * r + bv[bj][0], v1 = acc[ai][bj][m][1] * r + bv[bj][1];
                    u32x4 w; w.x = pk2(v0[0], v0[1]); w.y = pk2(v0[2], v0[3]); w.z = pk2(v1[0], v1[1]); w.w = pk2(v1[2], v1[3]);
                    *(u32x4*)(rowp + bj * HALF) = w; } }
    }
};
__device__ __forceinline__ float silu_mul(float g, float u) { return g * u * __builtin_amdgcn_rcpf(1.0f + __builtin_amdgcn_exp2f(-1.44269504089f * g)); }
struct EpiSwiGLU {
    static constexpr bool PERM = true;
    bf16_t* O; int ldc; const float* rss;
    __device__ __forceinline__ void operator()(const f32x4 (&acc)[2][2][4][2], const Unit& u, int wr, int wc, int fr, int fq) const {
        const int row0 = u.rm * BM + wr * 64 + fr, col0 = u.cn * HALF + wc * 32 + 8 * fq;
        float rs[2][4];
#pragma unroll
        for (int ai = 0; ai < 2; ++ai)
#pragma unroll
            for (int m = 0; m < 4; ++m) rs[ai][m] = rms_scale(rss, row0 + ai * HALF + m * 16);
#pragma unroll
        for (int ai = 0; ai < 2; ++ai)
#pragma unroll
            for (int m = 0; m < 4; ++m) { const int row = row0 + ai * HALF + m * 16; bf16_t* rowp = O + (size_t)row * ldc + col0; const float r = rs[ai][m];
                const f32x4 g0 = acc[ai][0][m][0] * r, g1 = acc[ai][0][m][1] * r, u0 = acc[ai][1][m][0] * r, u1 = acc[ai][1][m][1] * r;
                u32x4 w; w.x = pk2(silu_mul(g0[0], u0[0]), silu_mul(g0[1], u0[1])); w.y = pk2(silu_mul(g0[2], u0[2]), silu_mul(g0[3], u0[3]));
                w.z = pk2(silu_mul(g1[0], u1[0]), silu_mul(g1[1], u1[1])); w.w = pk2(silu_mul(g1[2], u1[2]), silu_mul(g1[3], u1[3]));
                *(u32x4*)rowp = w; }
    }
};
struct EpiResid {
    static constexpr bool PERM = true;
    const float* base; float* out; const float* bias; bf16_t* xb; float* rss; LAS unsigned char* xlds;
    __device__ __forceinline__ void operator()(const f32x4 (&acc)[2][2][4][2], const Unit& u, int wr, int wc, int fr, int fq) const {
        const int row0 = u.rm * BM + wr * 64 + fr, col0 = u.cn * BM + wc * 32 + 8 * fq;
        f32x4 bv[2][2];
#pragma unroll
        for (int bj = 0; bj < 2; ++bj)
#pragma unroll
            for (int n = 0; n < 2; ++n) bv[bj][n] = bias ? *(const f32x4*)(bias + col0 + bj * HALF + 4 * n) : (f32x4){0.f, 0.f, 0.f, 0.f};
#pragma unroll
        for (int ai = 0; ai < 2; ++ai)
#pragma unroll
            for (int m = 0; m < 4; ++m) { const int row = row0 + ai * HALF + m * 16; const size_t off = (size_t)row * D + col0;
                f32x4 bs[2][2];
#pragma unroll
                for (int bj = 0; bj < 2; ++bj)
#pragma unroll
                    for (int n = 0; n < 2; ++n) bs[bj][n] = *(const f32x4*)(base + off + bj * HALF + 4 * n);
                float ss = 0.f;
#pragma unroll
                for (int bj = 0; bj < 2; ++bj) {
#pragma unroll
                    for (int n = 0; n < 2; ++n) { bs[bj][n] = bs[bj][n] + acc[ai][bj][m][n] + bv[bj][n]; *(f32x4*)(out + off + bj * HALF + 4 * n) = bs[bj][n];
                        ss += (bs[bj][n][0] * bs[bj][n][0] + bs[bj][n][1] * bs[bj][n][1]) + (bs[bj][n][2] * bs[bj][n][2] + bs[bj][n][3] * bs[bj][n][3]); }
                    if (xb) { u32x4 w; w.x = pk2(bs[bj][0][0], bs[bj][0][1]); w.y = pk2(bs[bj][0][2], bs[bj][0][3]); w.z = pk2(bs[bj][1][0], bs[bj][1][1]); w.w = pk2(bs[bj][1][2], bs[bj][1][3]);
                        *(u32x4*)(xb + off + bj * HALF) = w; } }
                if (xb) { ss += __shfl_xor(ss, 16); ss += __shfl_xor(ss, 32); if (fq == 0) *(LAS float*)(xlds + 16 * (wr * 64 + ai * HALF + m * 16 + fr) + 4 * wc) = ss; }
                asm volatile("" ::: "memory"); }
        if (xb) { asm volatile("s_waitcnt lgkmcnt(0)" ::: "memory"); __builtin_amdgcn_s_barrier(); asm volatile("" ::: "memory");
            const int t = wr * 256 + wc * 64 + fq * 16 + fr;
            if (t < 256) { const f32x4 a = *(const LAS f32x4*)(xlds + 16 * t); rss[(size_t)(u.rm * BM + t) * 4 + u.cn] = (a[0] + a[1]) + (a[2] + a[3]); } }
    }
};
__device__ __forceinline__ unsigned pk4_fp8(float a, float b, float c, float d) {
    int w = __builtin_amdgcn_cvt_pk_fp8_f32(__builtin_amdgcn_fmed3f(a, -448.f, 448.f), __builtin_amdgcn_fmed3f(b, -448.f, 448.f), 0, false);
    w = __builtin_amdgcn_cvt_pk_fp8_f32(__builtin_amdgcn_fmed3f(c, -448.f, 448.f), __builtin_amdgcn_fmed3f(d, -448.f, 448.f), w, true);
    return (unsigned)w;
}
constexpr int E8M0_ONE = 0x7f7f7f7f, E8M0_2M6 = 0x79797979;
struct EpiSwiGLU8 {
    static constexpr bool PERM = true; static constexpr int SCALE_A = E8M0_ONE, SCALE_B = E8M0_2M6;
    unsigned char* O; int ldc;
    __device__ __forceinline__ void operator()(const f32x4 (&acc)[2][2][4][2], const Unit& u, int wr, int wc, int fr, int fq) const {
        const int row0 = u.rm * BM + wr * 64 + fr, col0 = u.cn * HALF + wc * 32 + 8 * fq;
#pragma unroll
        for (int ai = 0; ai < 2; ++ai)
#pragma unroll
            for (int m = 0; m < 4; ++m) { unsigned char* rowp = O + (size_t)(row0 + ai * HALF + m * 16) * ldc + col0;
                const f32x4 g0 = acc[ai][0][m][0], g1 = acc[ai][0][m][1], u0 = acc[ai][1][m][0], u1 = acc[ai][1][m][1];
                u32x2 w; w.x = pk4_fp8(silu_mul(g0[0], u0[0]), silu_mul(g0[1], u0[1]), silu_mul(g0[2], u0[2]), silu_mul(g0[3], u0[3]));
                w.y = pk4_fp8(silu_mul(g1[0], u1[0]), silu_mul(g1[1], u1[1]), silu_mul(g1[2], u1[2]), silu_mul(g1[3], u1[3]));
                *(u32x2*)rowp = w; }
    }
};
struct EpiNull8 {
    static constexpr bool PERM = true; static constexpr int SCALE_A = E8M0_ONE, SCALE_B = E8M0_2M6;
    float* sink;
    __device__ __forceinline__ void operator()(const f32x4 (&acc)[2][2][4][2], const Unit& u, int wr, int wc, int fr, int fq) const {
        float s = 0.f;
#pragma unroll
        for (int ai = 0; ai < 2; ++ai)
#pragma unroll
            for (int bj = 0; bj < 2; ++bj)
#pragma unroll
                for (int m = 0; m < 4; ++m)
#pragma unroll
                    for (int n = 0; n < 2; ++n) s += (acc[ai][bj][m][n][0] + acc[ai][bj][m][n][1]) + (acc[ai][bj][m][n][2] + acc[ai][bj][m][n][3]);
        if (s == 12345.678f) sink[0] = s;
    }
};
struct EpiMoeDown {
    static constexpr bool PERM = true; static constexpr int SCALE_A = E8M0_ONE, SCALE_B = E8M0_2M6;
    float* X; bf16_t* Y0; const int* slot_tok; const float* slot_w;
    __device__ __forceinline__ void operator()(const f32x4 (&acc)[2][2][4][2], const Unit& u, int wr, int wc, int fr, int fq) const {
        const int row0 = u.rm * BM + wr * 64 + fr, col0 = u.cn * BM + wc * 32 + 8 * fq;
#pragma unroll
        for (int ai = 0; ai < 2; ++ai)
#pragma unroll
            for (int m = 0; m < 4; ++m) { const int slot = row0 + ai * HALF + m * 16; const int meta = slot_tok[slot]; const float w = slot_w[slot];
                if (meta >= 0) { const size_t off = (size_t)(meta >> 1) * D + col0;
                    if (meta & 1) {
                        f32x4 bs[2][2];
#pragma unroll
                        for (int bj = 0; bj < 2; ++bj)
#pragma unroll
                            for (int n = 0; n < 2; ++n) bs[bj][n] = *(const f32x4*)(X + off + bj * HALF + 4 * n);
#pragma unroll
                        for (int bj = 0; bj < 2; ++bj)
#pragma unroll
                            for (int n = 0; n < 2; ++n) *(f32x4*)(X + off + bj * HALF + 4 * n) = bs[bj][n] + acc[ai][bj][m][n] * w;
                    } else {
#pragma unroll
                        for (int bj = 0; bj < 2; ++bj) { const f32x4 v0 = acc[ai][bj][m][0] * w, v1 = acc[ai][bj][m][1] * w;
                            u32x4 o; o.x = pk2(v0[0], v0[1]); o.y = pk2(v0[2], v0[3]); o.z = pk2(v1[0], v1[1]); o.w = pk2(v1[2], v1[3]);
                            *(u32x4*)(Y0 + off + bj * HALF) = o; }
                    } }
                asm volatile("" ::: "memory"); }
    }
};

template <int OFF> __device__ __forceinline__ void glds_s(const char* sbase, unsigned voff, unsigned lds_base) {
    unsigned keep;
    asm volatile("s_mov_b32 %0, m0\n\ts_add_u32 m0, %3, %4\n\ts_nop 0\n\tglobal_load_lds_dwordx4 %1, %2\n\ts_mov_b32 m0, %0" : "=&s"(keep) : "v"(voff), "s"(sbase), "s"(lds_base), "i"(OFF) : "memory", "scc");
}
template <class Epi, class Sched, bool FP8 = false, bool ALIGN_EPI = true, bool SP2 = true>
__device__ __forceinline__ void gemm_phase(LAS unsigned char* lds, const Gemm g, const Sched& S, const Epi& E) {
    const int tid = threadIdx.x, wid = __builtin_amdgcn_readfirstlane(tid >> 6), lane = tid & 63, wr = wid >> 2, wc = wid & 3, fr = lane & 15, fq = lane >> 4;
    const int nt = g.K / (BK * 2);
    unsigned voffA[2], voffB[2];
#pragma unroll
    for (int i = 0; i < 2; ++i) { int R, C; stage_rc(tid * 16 + i * 8192, R, C); const int Rb = Epi::PERM ? ((R & ~31) + perm32(R & 31)) : R;
        voffA[i] = (unsigned)(R * g.lda + C * 2); voffB[i] = (unsigned)(Rb * g.ldb + C * 2); }
    const size_t kstep = (size_t)(BK * 2);
    const size_t hstepA = (size_t)HALF * g.lda, hstepB = (size_t)HALF * g.ldb;
    const size_t tstepA = 2 * hstepA, tstepB = 2 * hstepB;
    const unsigned lds_base = (unsigned)(size_t)lds + (unsigned)wid * 1024u;
    const int aoff = lds_byte(wr * 64 + fr, fq * 8), boff = lds_byte(wc * 32 + fr, fq * 8);
#define PG8_SA(b, h) (((b) * 2 + (h)) * HTB)
#define PG8_SB(b, h) ((4 + (b) * 2 + (h)) * HTB)
#define PG8_STAGE(bufoff, gbase, voff) do { glds_s<(bufoff)>((const char*)(gbase), (voff)[0], lds_base); glds_s<(bufoff) + 8192>((const char*)(gbase), (voff)[1], lds_base); } while (0)
#define PG8_LDA(dst, b, h) do { _Pragma("unroll") for (int m = 0; m < 4; ++m) _Pragma("unroll") for (int k = 0; k < 2; ++k) dst[m][k] = *(const LAS bf16x8*)(lds + PG8_SA(b, h) + aoff + m * 2048 + k * 1024); } while (0)
#define PG8_LDB(dst, b, h) do { _Pragma("unroll") for (int n = 0; n < 2; ++n) _Pragma("unroll") for (int k = 0; k < 2; ++k) dst[n][k] = *(const LAS bf16x8*)(lds + PG8_SB(b, h) + boff + n * 2048 + k * 1024); } while (0)
#define PG8_MMA(ai, bj, At, Bt) do { __builtin_amdgcn_s_setprio(1); _Pragma("unroll") for (int m = 0; m < 4; ++m) _Pragma("unroll") for (int n = 0; n < 2; ++n) { \
        if constexpr (FP8) { const i32x4 b_lo = __builtin_bit_cast(i32x4, Bt[n][0]), b_hi = __builtin_bit_cast(i32x4, Bt[n][1]), a_lo = __builtin_bit_cast(i32x4, At[m][0]), a_hi = __builtin_bit_cast(i32x4, At[m][1]); \
            acc[ai][bj][m][n] = __builtin_amdgcn_mfma_scale_f32_16x16x128_f8f6f4(__builtin_shufflevector(b_lo, b_hi, 0, 1, 2, 3, 4, 5, 6, 7), __builtin_shufflevector(a_lo, a_hi, 0, 1, 2, 3, 4, 5, 6, 7), acc[ai][bj][m][n], 0, 0, 0, Epi::SCALE_B, 0, Epi::SCALE_A); } \
        else { _Pragma("unroll") for (int k = 0; k < 2; ++k) acc[ai][bj][m][n] = __builtin_amdgcn_mfma_f32_16x16x32_bf16(Bt[n][k], At[m][k], acc[ai][bj][m][n], 0, 0, 0); } } \
        __builtin_amdgcn_s_setprio(0); } while (0)
#define PG8_WAIT_V(n) asm volatile("s_waitcnt vmcnt(" #n ")" ::: "memory")
#define PG8_WAIT_L(n) asm volatile("s_waitcnt lgkmcnt(" #n ")" ::: "memory")
#define PG8_BAR __builtin_amdgcn_s_barrier()
#define PG8_SCHED __builtin_amdgcn_sched_barrier(0)
    Unit cur, nxt; int ui = 0;
    if (!S.next(0, cur)) return;
    f32x4 acc[2][2][4][2];
#pragma unroll
    for (int a = 0; a < 2; ++a)
#pragma unroll
        for (int b = 0; b < 2; ++b)
#pragma unroll
            for (int m = 0; m < 4; ++m)
#pragma unroll
                for (int n = 0; n < 2; ++n) acc[a][b][m][n] = (f32x4){0.f, 0.f, 0.f, 0.f};
    bf16x8 At[4][2], B0[2][2], B1[2][2];
    const char* cA = (const char*)g.A + (size_t)cur.pm * tstepA; const char* cB = (const char*)g.Bt + (size_t)cur.pn * tstepB;
    S.a_ready(cur);
    if constexpr (SP2) {
        PG8_STAGE(PG8_SB(0, 0), cB, voffB); PG8_STAGE(PG8_SB(0, 1), cB + hstepB, voffB); PG8_STAGE(PG8_SA(0, 0), cA, voffA); PG8_STAGE(PG8_SA(0, 1), cA + hstepA, voffA);
        if (wr == 1) PG8_BAR;
        PG8_WAIT_V(2); PG8_BAR;
        PG8_STAGE(PG8_SB(1, 0), cB + kstep, voffB); PG8_STAGE(PG8_SA(1, 0), cA + kstep, voffA); PG8_STAGE(PG8_SB(1, 1), cB + hstepB + kstep, voffB);
        PG8_WAIT_V(6); PG8_BAR;
    } else {
        PG8_STAGE(PG8_SB(0, 0), cB, voffB); PG8_STAGE(PG8_SA(0, 0), cA, voffA); PG8_STAGE(PG8_SB(0, 1), cB + hstepB, voffB); PG8_STAGE(PG8_SA(0, 1), cA + hstepA, voffA);
        if (wr == 1) PG8_BAR;
        PG8_WAIT_V(4); PG8_BAR;
        PG8_STAGE(PG8_SB(1, 0), cB + kstep, voffB); PG8_STAGE(PG8_SA(1, 0), cA + kstep, voffA); PG8_STAGE(PG8_SB(1, 1), cB + hstepB + kstep, voffB);
        PG8_WAIT_V(6); PG8_BAR;
    }
    for (;;) {
        const bool has_next = S.next(ui + 1, nxt);
        const char* nA = has_next ? (const char*)g.A + (size_t)nxt.pm * tstepA : cA; const char* nB = has_next ? (const char*)g.Bt + (size_t)nxt.pn * tstepB : cB;
#pragma clang loop unroll(disable)
        for (int t = 0; t < nt; t += 2) {
            const bool last = (t == nt - 2);
            const char* a1 = cA + (size_t)(t + 1) * kstep;
            const char* a2 = last ? nA : cA + (size_t)(t + 2) * kstep; const char* b2 = last ? nB : cB + (size_t)(t + 2) * kstep;
            const char* a3 = a2 + kstep; const char* b3 = b2 + kstep;
            if (last && has_next) S.a_ready(nxt);
            if constexpr (SP2) {
            PG8_LDB(B0, 0, 0); PG8_LDB(B1, 0, 1); PG8_SCHED; PG8_LDA(At, 0, 0); PG8_STAGE(PG8_SA(1, 1), a1 + hstepA, voffA);
            PG8_WAIT_V(8); PG8_WAIT_L(0); PG8_BAR; PG8_MMA(0, 0, At, B0); PG8_MMA(0, 1, At, B1); PG8_BAR; PG8_SCHED;
            PG8_LDA(At, 0, 1); PG8_STAGE(PG8_SB(0, 0), b2, voffB); PG8_STAGE(PG8_SB(0, 1), b2 + hstepB, voffB); PG8_STAGE(PG8_SA(0, 0), a2, voffA);
            PG8_WAIT_V(8); PG8_WAIT_L(0); PG8_BAR; PG8_MMA(1, 0, At, B0); PG8_MMA(1, 1, At, B1); PG8_BAR; PG8_SCHED;
            PG8_LDB(B0, 1, 0); PG8_LDB(B1, 1, 1); PG8_SCHED; PG8_LDA(At, 1, 0); PG8_STAGE(PG8_SA(0, 1), a2 + hstepA, voffA);
            PG8_WAIT_V(8); PG8_WAIT_L(0); PG8_BAR; PG8_MMA(0, 0, At, B0); PG8_MMA(0, 1, At, B1); PG8_BAR; PG8_SCHED;
            PG8_LDA(At, 1, 1); PG8_STAGE(PG8_SB(1, 0), b3, voffB); PG8_STAGE(PG8_SB(1, 1), b3 + hstepB, voffB); PG8_STAGE(PG8_SA(1, 0), a3, voffA);
            PG8_WAIT_V(8); PG8_WAIT_L(0); PG8_BAR; PG8_MMA(1, 0, At, B0); PG8_MMA(1, 1, At, B1); PG8_BAR; PG8_SCHED;
            } else {
            PG8_LDB(B0, 0, 0); PG8_SCHED; PG8_LDA(At, 0, 0); PG8_STAGE(PG8_SA(1, 1), a1 + hstepA, voffA);
            PG8_WAIT_L(8); PG8_BAR; PG8_WAIT_L(0); PG8_MMA(0, 0, At, B0); PG8_BAR; PG8_SCHED;
            PG8_LDB(B1, 0, 1); PG8_STAGE(PG8_SB(0, 0), b2, voffB);
            PG8_BAR; PG8_WAIT_L(0); PG8_MMA(0, 1, At, B1); PG8_BAR;
            PG8_LDA(At, 0, 1); PG8_STAGE(PG8_SA(0, 0), a2, voffA);
            PG8_BAR; PG8_WAIT_L(0); PG8_MMA(1, 0, At, B0); PG8_BAR; PG8_SCHED;
            PG8_STAGE(PG8_SB(0, 1), b2 + hstepB, voffB);
            PG8_WAIT_V(6); PG8_BAR; PG8_MMA(1, 1, At, B1); PG8_BAR;
            PG8_LDB(B0, 1, 0); PG8_SCHED; PG8_LDA(At, 1, 0); PG8_STAGE(PG8_SA(0, 1), a2 + hstepA, voffA);
            PG8_WAIT_L(8); PG8_BAR; PG8_WAIT_L(0); PG8_MMA(0, 0, At, B0); PG8_BAR; PG8_SCHED;
            PG8_LDB(B1, 1, 1); PG8_STAGE(PG8_SB(1, 0), b3, voffB);
            PG8_BAR; PG8_WAIT_L(0); PG8_MMA(0, 1, At, B1); PG8_BAR;
            PG8_LDA(At, 1, 1); PG8_STAGE(PG8_SA(1, 0), a3, voffA);
            PG8_BAR; PG8_WAIT_L(0); PG8_MMA(1, 0, At, B0); PG8_BAR; PG8_SCHED;
            PG8_STAGE(PG8_SB(1, 1), b3 + hstepB, voffB);
            PG8_WAIT_V(6); PG8_BAR; PG8_MMA(1, 1, At, B1); PG8_BAR;
            }
        }
        if constexpr (ALIGN_EPI) { if (wr == 0) PG8_BAR; }
        { int l2 = threadIdx.x; asm volatile("" : "+v"(l2)); l2 &= 63; E(acc, cur, wr, wc, l2 & 15, l2 >> 4); }
        S.done(cur);
        if (!has_next) break;
#pragma unroll
        for (int a = 0; a < 2; ++a)
#pragma unroll
            for (int b = 0; b < 2; ++b)
#pragma unroll
                for (int m = 0; m < 4; ++m)
#pragma unroll
                    for (int n = 0; n < 2; ++n) acc[a][b][m][n] = (f32x4){0.f, 0.f, 0.f, 0.f};
        cur = nxt; cA = nA; cB = nB; ++ui;
        if constexpr (ALIGN_EPI) { if (wr == 1) PG8_BAR; }
    }
    PG8_WAIT_V(0);
    if constexpr (!ALIGN_EPI) { if (wr == 0) PG8_BAR; }
    PG8_BAR;
#undef PG8_SA
#undef PG8_SB
#undef PG8_STAGE
#undef PG8_LDA
#undef PG8_LDB
#undef PG8_MMA
#undef PG8_WAIT_V
#undef PG8_WAIT_L
#undef PG8_BAR
#undef PG8_SCHED
}
}

#define XB_TMO      128
#define XB_XCNT(j)  (256  + 64 * (j))
#define XB_XSUB(j)  (1280 + 64 * (j))
#define XB_XGEN(j)  (2304 + 64 * (j))
#define XB_TOP      3328
#define XB_TOPGEN   3392
#define XCD_BAR_WORDS 3456
#define XB_SPIN_CAP (1u << 18)
__device__ __forceinline__ unsigned xb_ld(unsigned* p)              { return __hip_atomic_load(p, __ATOMIC_RELAXED, __HIP_MEMORY_SCOPE_AGENT); }
__device__ __forceinline__ unsigned xb_add(unsigned* p, unsigned v) { return __hip_atomic_fetch_add(p, v, __ATOMIC_RELAXED, __HIP_MEMORY_SCOPE_AGENT); }
__device__ __forceinline__ unsigned xb_xcc_id() { return (unsigned)__builtin_amdgcn_s_getreg((3 << 11) | 20) & 0xFu; }
#define XB_SPIN(cond, bar) do { unsigned _sp = 0; while (cond) { __builtin_amdgcn_s_sleep(1); \
    if ((++_sp & 255u) == 0u) { if (xb_ld(&(bar)[XB_TMO])) break; if (_sp > XB_SPIN_CAP) { atomicAdd(&(bar)[XB_TMO], 1u); break; } } } } while (0)
struct XcdBarrier { unsigned* bar; unsigned x; volatile LAS unsigned* st; };
__device__ __forceinline__ XcdBarrier xcd_barrier_post(unsigned* bar, volatile LAS unsigned* st) {
    XcdBarrier b; b.bar = bar; b.x = xb_xcc_id(); b.st = st;
    if (threadIdx.x == 0) (void)xb_add(&bar[XB_XCNT(b.x)], 1u);
    return b;
}
__device__ __forceinline__ void xcd_barrier_complete(unsigned* bar, unsigned x, unsigned& nloc, unsigned& nx) {
    const unsigned G = gridDim.x * gridDim.y * gridDim.z;
    unsigned sum, cnt, mine, sp = 0u;
    for (;;) {
        sum = 0u; cnt = 0u; mine = 0u;
#pragma unroll
        for (unsigned j = 0; j < 16; ++j) { const unsigned c = xb_ld(&bar[XB_XCNT(j)]); sum += c; cnt += (c > 0u) ? 1u : 0u; mine = (j == x) ? c : mine; }
        if (sum == G) break;
        __builtin_amdgcn_s_sleep(1);
        if ((++sp & 255u) == 0u) { if (xb_ld(&bar[XB_TMO])) break; if (sp > XB_SPIN_CAP) { atomicAdd(&bar[XB_TMO], 1u); break; } }
    }
    nloc = mine > 0u ? mine : 1u; nx = cnt > 0u ? cnt : 1u;
}
__device__ __forceinline__ void xcd_barrier(const XcdBarrier& b) {
    asm volatile("s_waitcnt vmcnt(0)" ::: "memory");
    __syncthreads();
    if (threadIdx.x == 0) {
        unsigned* bar = b.bar;
        __builtin_amdgcn_s_waitcnt(0);
        unsigned nloc = b.st[0], nx = b.st[1];
        if (nloc == 0u) { xcd_barrier_complete(bar, b.x, nloc, nx); b.st[0] = nloc; b.st[1] = nx; }
        const unsigned old = xb_add(&bar[XB_XSUB(b.x)], 1u);
        const unsigned gen = old / nloc;
        if (old + 1u == (gen + 1u) * nloc) {
            __builtin_amdgcn_fence(__ATOMIC_RELEASE, "agent");
            asm volatile("s_waitcnt vmcnt(0)" ::: "memory");
            const unsigned og = xb_add(&bar[XB_TOP], 1u);
            const unsigned tg = og / nx;
            if (og + 1u == (tg + 1u) * nx) xb_add(&bar[XB_TOPGEN], 1u);
            else XB_SPIN(xb_ld(&bar[XB_TOPGEN]) == tg, bar);
            __builtin_amdgcn_fence(__ATOMIC_ACQUIRE, "agent");
            xb_add(&bar[XB_XGEN(b.x)], 1u);
            asm volatile("s_waitcnt vmcnt(0)" ::: "memory");
        } else {
            XB_SPIN(xb_ld(&bar[XB_XGEN(b.x)]) == gen, bar);
            __builtin_amdgcn_fence(__ATOMIC_ACQUIRE, "agent");
            asm volatile("s_waitcnt vmcnt(0)" ::: "memory");
        }
    }
    __syncthreads();
}

struct Params { const float* in[24]; float* out; unsigned char* ws; int ph_lo, ph_hi; };
enum { I_X = 0, I_RELB, I_EVNM, I_WIN, I_POOLW, I_POOLS, I_CONVW, I_WOUT, I_EVNF, I_FG, I_FU, I_FD, I_ODNM, I_WQKV, I_BQKV, I_SINK, I_WO, I_BO, I_ODNF, I_ROUTER, I_EG, I_EU, I_ED, I_FINAL };

__device__ __forceinline__ void p0_tile(const float* __restrict__ src, int N, int k0, int n0, bf16_t* __restrict__ dst, int ldd, LAS unsigned char* scr, int lane, const float* __restrict__ gain = nullptr) {
    const int n4 = (lane & 15) * 4, kp = lane >> 4;
    f32x4 a[8], b[8];
#pragma unroll
    for (int i = 0; i < 8; ++i) { const float* p = src + (size_t)(k0 + 8 * i + 2 * kp) * N + n0 + n4; a[i] = *(const f32x4*)p; b[i] = *(const f32x4*)(p + N);
        if (gain) { a[i] = a[i] * gain[k0 + 8 * i + 2 * kp]; b[i] = b[i] * gain[k0 + 8 * i + 2 * kp + 1]; } }
#pragma unroll
    for (int i = 0; i < 8; ++i) { const int k = 8 * i + 2 * kp;
#pragma unroll
        for (int q = 0; q < 4; ++q) *(LAS unsigned*)(scr + (n4 + q) * 136 + k * 2) = pk2(a[i][q], b[i][q]); }
    LDS_WAIT();
    const int c = lane & 7, nr = lane >> 3;
#pragma unroll
    for (int j = 0; j < 8; ++j) { const int n = 8 * j + nr; const u32x2 lo = *(const LAS u32x2*)(scr + n * 136 + 16 * c), hi = *(const LAS u32x2*)(scr + n * 136 + 16 * c + 8);
        u32x4 o; o.x = lo.x; o.y = lo.y; o.z = hi.x; o.w = hi.y; *(u32x4*)(dst + (size_t)n * ldd + 8 * c) = o; }
    LDS_WAIT();
}
__device__ __forceinline__ void p0_tile8_load(const float* __restrict__ src, int N, int k0, int n0, int lane, f32x4 (&a)[4][4]) {
    const int n4 = (lane & 7) * 4, kq = lane >> 3;
#pragma unroll
    for (int i = 0; i < 4; ++i)
#pragma unroll
        for (int j = 0; j < 4; ++j) a[i][j] = *(const f32x4*)(src + (size_t)(k0 + 32 * i + 4 * kq + j) * N + n0 + n4);
}
__device__ __forceinline__ void p0_tile8_store(const f32x4 (&a)[4][4], unsigned char* __restrict__ dst, int ldd, float scale, LAS unsigned char* scr, int lane) {
    const int n4 = (lane & 7) * 4, kq = lane >> 3;
#pragma unroll
    for (int i = 0; i < 4; ++i)
#pragma unroll
        for (int q = 0; q < 4; ++q) *(LAS unsigned*)(scr + (n4 + q) * 144 + 32 * i + 4 * kq) = pg8::pk4_fp8(a[i][0][q] * scale, a[i][1][q] * scale, a[i][2][q] * scale, a[i][3][q] * scale);
    LDS_WAIT();
    const int c = lane & 7, nr = lane >> 3;
#pragma unroll
    for (int j = 0; j < 4; ++j) { const int n = 8 * j + nr; *(u32x4*)(dst + (size_t)n * ldd + 16 * c) = *(const LAS u32x4*)(scr + n * 144 + 16 * c); }
    LDS_WAIT();
}
struct P0Tile8 { const float* src; unsigned char* dst; int N, k0, n0, ldd; };
__device__ __forceinline__ P0Tile8 p0_tile8_desc(int it, const float* eg, const float* eu, const float* ed, unsigned char* Wegu8, unsigned char* Wed8) {
    constexpr int T_EG = 8 * 112, T_ED = 28 * 32, per_e = 2 * T_EG + T_ED;
    const int e = it / per_e; int q = it % per_e; P0Tile8 t;
    if (q < 2 * T_EG) { const int up = q >= T_EG; if (up) q -= T_EG; const int kb = q / 112, nb = q % 112, n0 = 32 * nb;
        t.src = (up ? eu : eg) + (size_t)e * D * DFE; t.N = DFE; t.k0 = 128 * kb; t.n0 = n0; t.dst = Wegu8 + ((size_t)e * 2 * DFE + (n0 / 128) * 256 + (n0 % 128) + (up ? 128 : 0)) * D + 128 * kb; t.ldd = D; }
    else { q -= 2 * T_EG; const int kb = q / 32, nb = q % 32;
        t.src = ed + (size_t)e * DFE * D; t.N = D; t.k0 = 128 * kb; t.n0 = 32 * nb; t.dst = Wed8 + ((size_t)e * D + 32 * nb) * DFE + 128 * kb; t.ldd = DFE; }
    return t;
}
__device__ __forceinline__ void norm_row_bf16(const float* __restrict__ xrow, const float* __restrict__ gain, bf16_t* __restrict__ orow, int lane, float (&y)[16]) {
    f32x4 v[4];
#pragma unroll
    for (int j = 0; j < 2; ++j) { v[2 * j] = *(const f32x4*)(xrow + 512 * j + 8 * lane); v[2 * j + 1] = *(const f32x4*)(xrow + 512 * j + 8 * lane + 4); }
    float s = 0.f;
#pragma unroll
    for (int j = 0; j < 4; ++j) s += (v[j][0] * v[j][0] + v[j][1] * v[j][1]) + (v[j][2] * v[j][2] + v[j][3] * v[j][3]);
    const float r = 1.0f / sqrtf(wave_sum(s) * (1.0f / D) + RMS_EPS);
#pragma unroll
    for (int j = 0; j < 2; ++j) { const f32x4 g0 = *(const f32x4*)(gain + 512 * j + 8 * lane), g1 = *(const f32x4*)(gain + 512 * j + 8 * lane + 4);
#pragma unroll
        for (int q = 0; q < 4; ++q) { y[8 * j + q] = v[2 * j][q] * r * g0[q]; y[8 * j + 4 + q] = v[2 * j + 1][q] * r * g1[q]; }
        u32x4 w; w.x = pk2(y[8 * j], y[8 * j + 1]); w.y = pk2(y[8 * j + 2], y[8 * j + 3]); w.z = pk2(y[8 * j + 4], y[8 * j + 5]); w.w = pk2(y[8 * j + 6], y[8 * j + 7]);
        *(u32x4*)(orow + 512 * j + 8 * lane) = w; }
}

__device__ __forceinline__ int t5_bucket(int rel) {
    const int n = rel < 0 ? -rel : rel; const int ret = rel > 0 ? 16 : 0;
    int v;
    if (n < 8) v = n; else if (n < 12) v = 8; else if (n < 16) v = 9; else if (n < 23) v = 10; else if (n < 32) v = 11; else if (n < 46) v = 12; else if (n < 64) v = 13; else if (n < 91) v = 14; else v = 15;
    return ret + v;
}

constexpr int AT_KS_STR = 144, AT_VT_STR = 392;
constexpr int AT_L_K = 0, AT_L_VT = 192 * AT_KS_STR, AT_L_BT = AT_L_VT + 64 * AT_VT_STR, AT_L_OST = AT_L_BT + NQH * 256 * 4;
static_assert(AT_L_OST + NWAVES * 32 * 144 <= RING_BYTES, "attention LDS");
__device__ __forceinline__ void attn_qblock(LAS unsigned char* lds, const bf16x8 (&qf)[4], bf16_t* __restrict__ orow0, int head, int qb, int kb_min, float sink, int wave, int lane) {
    const int r32 = lane & 31, hh = lane >> 5;
    const LAS float* bt = (const LAS float*)(lds + AT_L_BT + head * 1024);
    f32x16 st[6];
#pragma unroll
    for (int kb = 0; kb < 6; ++kb) {
#pragma unroll
        for (int e = 0; e < 16; ++e) st[kb][e] = 0.f;
#pragma unroll
        for (int ks = 0; ks < 4; ++ks) { const bf16x8 kf = *(const LAS bf16x8*)(lds + AT_L_K + (kb * 32 + r32) * AT_KS_STR + 32 * ks + 16 * hh);
            st[kb] = __builtin_amdgcn_mfma_f32_32x32x16_bf16(kf, qf[ks], st[kb], 0, 0, 0); } }
    const float sinkl = sink * 1.44269504089f;
    float mx = sinkl;
#pragma unroll
    for (int kb = 0; kb < 6; ++kb) {
        if (kb < kb_min) {
#pragma unroll
            for (int e = 0; e < 16; ++e) st[kb][e] = -1e30f;
        } else {
#pragma unroll
            for (int e = 0; e < 16; e += 2) { const int j = kb * 32 + (e & 3) + 8 * (e >> 2) + 4 * hh; const int idx = j - (qb * 32 + r32) + 63;
                const f32x2 bb = {bt[idx], bt[idx + 1]}; const f32x2 qk = {st[kb][e], st[kb][e + 1]}; const f32x2 sc = qk * (0.125f * 1.44269504089f) + bb;
                st[kb][e] = sc.x; st[kb][e + 1] = sc.y; mx = __builtin_fmaxf(mx, __builtin_fmaxf(sc.x, sc.y)); } } }
    mx = fmaxf(mx, __shfl_xor(mx, 32));
    f32x2 sum2 = {0.f, 0.f};
#pragma unroll
    for (int kb = 0; kb < 6; ++kb)
#pragma unroll
        for (int e = 0; e < 16; e += 2) { const f32x2 d = (f32x2){st[kb][e], st[kb][e + 1]} - mx; f32x2 pe; pe.x = __builtin_amdgcn_exp2f(d.x); pe.y = __builtin_amdgcn_exp2f(d.y); st[kb][e] = pe.x; st[kb][e + 1] = pe.y; sum2 += pe; }
    float sum = sum2.x + sum2.y;
    sum += __shfl_xor(sum, 32);
    const float inv = 1.0f / (sum + __builtin_amdgcn_exp2f(sinkl - mx));
    f32x16 ot[2];
#pragma unroll
    for (int db = 0; db < 2; ++db)
#pragma unroll
        for (int e = 0; e < 16; ++e) ot[db][e] = 0.f;
#pragma unroll
    for (int kb = 0; kb < 6; ++kb)
#pragma unroll
        for (int s = 0; s < 2; ++s) {
            u32x4 pw; pw.x = pk2(st[kb][8 * s], st[kb][8 * s + 1]); pw.y = pk2(st[kb][8 * s + 2], st[kb][8 * s + 3]); pw.z = pk2(st[kb][8 * s + 4], st[kb][8 * s + 5]); pw.w = pk2(st[kb][8 * s + 6], st[kb][8 * s + 7]);
            const bf16x8 pf = __builtin_bit_cast(bf16x8, pw);
#pragma unroll
            for (int db = 0; db < 2; ++db) { const LAS unsigned char* vp = lds + AT_L_VT + (db * 32 + r32) * AT_VT_STR + 2 * (kb * 32 + 16 * s + 4 * hh);
                const u32x2 v0 = *(const LAS u32x2*)vp, v1 = *(const LAS u32x2*)(vp + 16);
                u32x4 vw; vw.x = v0.x; vw.y = v0.y; vw.z = v1.x; vw.w = v1.y;
                ot[db] = __builtin_amdgcn_mfma_f32_32x32x16_bf16(__builtin_bit_cast(bf16x8, vw), pf, ot[db], 0, 0, 0); } }
    LAS unsigned char* ost = lds + AT_L_OST + wave * (32 * 144);
#pragma unroll
    for (int db = 0; db < 2; ++db)
#pragma unroll
        for (int g4 = 0; g4 < 4; ++g4) { u32x2 w; w.x = pk2(ot[db][4 * g4] * inv, ot[db][4 * g4 + 1] * inv); w.y = pk2(ot[db][4 * g4 + 2] * inv, ot[db][4 * g4 + 3] * inv);
            *(LAS u32x2*)(ost + r32 * 144 + 2 * (db * 32 + 8 * g4 + 4 * hh)) = w; }
    LDS_WAIT();
#pragma unroll
    for (int i = 0; i < 4; ++i) { const int q = 8 * i + (lane >> 3), c = lane & 7; const u32x4 w = *(const LAS u32x4*)(ost + q * 144 + 16 * c);
        *(u32x4*)(orow0 + (size_t)q * D + 8 * c) = w; }
    LDS_WAIT();
}

__global__ void __launch_bounds__(NTHR, 2) fwd_kernel(Params p) {
    extern __shared__ __attribute__((aligned(16))) unsigned char lds_raw[];
    LAS unsigned char* lds = (LAS unsigned char*)lds_raw;
    volatile LAS unsigned* MISC = (volatile LAS unsigned*)(lds + LDS_MISC_OFF);
    const int tid = threadIdx.x, lane = tid & 63, wave = __builtin_amdgcn_readfirstlane(tid >> 6);
    const int G = gridDim.x, bx = blockIdx.x;
    const int vcu = (G % 8 == 0) ? (bx % 8) * (G / 8) + bx / 8 : bx;
    const int gw = vcu * NWAVES + wave, NGW = G * NWAVES;
    unsigned char* ws = p.ws;
    unsigned* ctl = (unsigned*)(ws + WS_CTL);
    if (tid < 64) MISC[tid] = 0u;
    __syncthreads();
    XcdBarrier bar; bar.bar = ctl + CW_BAR; bar.x = 0; bar.st = nullptr;
    if (MK_N_LAUNCHES == 1) bar = xcd_barrier_post(ctl + CW_BAR, MISC + 8);
    const int lo = p.ph_lo, hi = p.ph_hi;
#define IN(k) (lo <= (k) && (k) < hi)
#define SEAM(k) do { if (MK_N_LAUNCHES == 1 && IN((k) + 1)) xcd_barrier(bar); } while (0)

    bf16_t* Win_t = (bf16_t*)(ws + WS_WIN); bf16_t* Wout_t = (bf16_t*)(ws + WS_WOUT); bf16_t* Wgu_t = (bf16_t*)(ws + WS_WGU); bf16_t* Wd_t = (bf16_t*)(ws + WS_WD);
    bf16_t* Wqkv_t = (bf16_t*)(ws + WS_WQKV); bf16_t* Wo_t = (bf16_t*)(ws + WS_WO); bf16_t* Wegu_t = (bf16_t*)(ws + WS_WEGU); bf16_t* Wed_t = (bf16_t*)(ws + WS_WED);
    bf16_t* XN = (bf16_t*)(ws + WS_XN); bf16_t* PROJ = (bf16_t*)(ws + WS_PROJ); bf16_t* MIXED = (bf16_t*)(ws + WS_MIXED); bf16_t* Hb = (bf16_t*)(ws + WS_H);
    bf16_t* QKV = (bf16_t*)(ws + WS_QKV); bf16_t* AO = (bf16_t*)(ws + WS_AO); bf16_t* HS = (bf16_t*)(ws + WS_HS); bf16_t* H2 = (bf16_t*)(ws + WS_H2);
    float* bias_tab = (float*)(ws + WS_BIAS); int* wgcnt = (int*)(ws + WS_WGCNT); int* tilemeta = (int*)(ws + WS_TILE);
    int* tok_e = (int*)(ws + WS_TOKE); float* tok_w = (float*)(ws + WS_TOKW); int* tok_r = (int*)(ws + WS_TOKR); int* slot_tok = (int*)(ws + WS_SLOTT); float* slot_w = (float*)(ws + WS_SLOTW);
    float* rss = (float*)(ws + WS_RSS);
    float* X = p.out;

    if (IN(0)) for (int rep_ = 0; rep_ < NREP(0); ++rep_) {
        const int tid = fresh_tid(), lane = tid & 63;
        LAS unsigned char* scr = lds + wave * 8704;
        constexpr int T_WIN = 16 * 32, T_WOUT = 8 * 16, T_FG = 16 * 44, T_FD = 44 * 16, T_QKV = 16 * 20, T_WO = 16 * 16;
        constexpr int T_EG = 8 * 112, T_ED = 28 * 32;
        constexpr int NT8 = NEXP * (2 * T_EG + T_ED);
        constexpr int NT = T_WIN + T_WOUT + 2 * T_FG + T_FD + T_QKV + T_WO;
        unsigned char* Wegu8 = (unsigned char*)Wegu_t; unsigned char* Wed8 = (unsigned char*)Wed_t;
        {
            f32x4 ta[4][4], tb[4][4];
            int it = gw;
            P0Tile8 da{}, db{};
            if (it < NT8) { da = p0_tile8_desc(it, p.in[I_EG], p.in[I_EU], p.in[I_ED], Wegu8, Wed8); p0_tile8_load(da.src, da.N, da.k0, da.n0, lane, ta); }
            while (it < NT8) {
                const int itb = it + NGW;
                if (itb < NT8) { db = p0_tile8_desc(itb, p.in[I_EG], p.in[I_EU], p.in[I_ED], Wegu8, Wed8); p0_tile8_load(db.src, db.N, db.k0, db.n0, lane, tb); }
                p0_tile8_store(ta, da.dst, da.ldd, 64.f, scr, lane);
                if (itb >= NT8) break;
                const int ita = itb + NGW;
                if (ita < NT8) { da = p0_tile8_desc(ita, p.in[I_EG], p.in[I_EU], p.in[I_ED], Wegu8, Wed8); p0_tile8_load(da.src, da.N, da.k0, da.n0, lane, ta); }
                p0_tile8_store(tb, db.dst, db.ldd, 64.f, scr, lane);
                it = ita;
            }
        }
        for (int it = gw; it < NT; it += NGW) {
            int r = it;
            if (r < T_WIN) { const int kb = r / 32, nb = r % 32; p0_tile(p.in[I_WIN], MIXN, 64 * kb, 64 * nb, Win_t + (size_t)(64 * nb) * D + 64 * kb, D, scr, lane); continue; } r -= T_WIN;
            if (r < T_WOUT) { const int kb = 8 + r / 16, nb = r % 16; p0_tile(p.in[I_WOUT], D, 64 * kb, 64 * nb, Wout_t + (size_t)(64 * nb) * D + 64 * kb, D, scr, lane); continue; } r -= T_WOUT;
            if (r < 2 * T_FG) { const int up = r >= T_FG; const int q = up ? r - T_FG : r; const int kb = q / 44, nb = q % 44, n0 = 64 * nb;
                p0_tile(p.in[up ? I_FU : I_FG], DFF, 64 * kb, n0, Wgu_t + (size_t)((n0 / 128) * 256 + (n0 % 128) + (up ? 128 : 0)) * D + 64 * kb, D, scr, lane, p.in[I_EVNF]); continue; } r -= 2 * T_FG;
            if (r < T_FD) { const int kb = r / 16, nb = r % 16; p0_tile(p.in[I_FD], D, 64 * kb, 64 * nb, Wd_t + (size_t)(64 * nb) * DFF + 64 * kb, DFF, scr, lane); continue; } r -= T_FD;
            if (r < T_QKV) { const int kb = r / 20, nb = r % 20; p0_tile(p.in[I_WQKV], QKVN, 64 * kb, 64 * nb, Wqkv_t + (size_t)(64 * nb) * D + 64 * kb, D, scr, lane, p.in[I_ODNM]); continue; } r -= T_QKV;
            { const int kb = r / 16, nb = r % 16; p0_tile(p.in[I_WO], D, 64 * kb, 64 * nb, Wo_t + (size_t)(64 * nb) * D + 64 * kb, D, scr, lane); }
        }
        for (int it = gw; it < 4 * 32 * 16; it += NGW) {
            const int g = it >> 9, cb = (it >> 4) & 31, nb = it & 15; const int n = 64 * nb + lane, c0 = 4 * cb;
            const float* wo = p.in[I_WOUT] + (size_t)(g * 128) * D + n; const float* ps = p.in[I_POOLS] + g * 128; const float* pw = p.in[I_POOLW] + (size_t)(g * 128 + c0) * 128;
            float acc[4] = {0.f, 0.f, 0.f, 0.f};
            for (int d0 = 0; d0 < 128; d0 += 16) {
                float w[16];
#pragma unroll
                for (int j = 0; j < 16; ++j) w[j] = wo[(size_t)(d0 + j) * D];
#pragma unroll
                for (int j = 0; j < 16; ++j) { const float ww = w[j] * ps[d0 + j];
#pragma unroll
                    for (int cc = 0; cc < 4; ++cc) acc[cc] += pw[cc * 128 + d0 + j] * ww; } }
            u32x2 o; o.x = pk2(acc[0], acc[1]); o.y = pk2(acc[2], acc[3]);
            *(u32x2*)(Wout_t + (size_t)n * D + g * 128 + c0) = o;
        }
#pragma unroll 2
        for (int m = gw; m < M; m += NGW) { float y[16]; norm_row_bf16(p.in[I_X] + (size_t)m * D, p.in[I_EVNM], XN + (size_t)m * D, lane, y); }
        for (int i = bx * NTHR + tid; i < NQH * 256; i += G * NTHR) { const int h = i >> 8, idx = i & 255; bias_tab[i] = idx < 255 ? p.in[I_RELB][t5_bucket(idx - 191) * NQH + h] : 0.f; }
    }
    SEAM(0);

    if (IN(1)) for (int rep_ = 0; rep_ < NREP(1); ++rep_) { pg8::Gemm g{XN, Win_t, 2 * D, 2 * D, 2 * D}; pg8::DenseOrder S; S.init(M, MIXN, G, bx); pg8::EpiBf16 E{PROJ, MIXN, nullptr, nullptr};
        pg8::gemm_phase<pg8::EpiBf16, pg8::DenseOrder>(lds, g, S, E); }
    SEAM(1);

    if (IN(2)) for (int rep_ = 0; rep_ < NREP(2); ++rep_) {
        const int tid = fresh_tid(), lane = tid & 63;
        for (int unit = gw; unit < (M / 32) * 2; unit += NGW) {
            const int rb = unit >> 1, half = unit & 1, r0 = rb * 32, bs = r0 & ~(SEQ - 1);
            if (half == 0) {
                const int w = 2 << (lane >> 4); const bf16_t* P = PROJ + 8 * lane;
                float s[8];
#pragma unroll
                for (int q = 0; q < 8; ++q) s[q] = 0.f;
                for (int j = 1; j <= 16; ++j) if (j <= w && r0 - j >= bs) { float f[8]; unpack8(*(const u32x4*)(P + (size_t)(r0 - j) * MIXN), f);
#pragma unroll
                    for (int q = 0; q < 8; ++q) s[q] += f[q]; }
#pragma unroll 4
                for (int r = r0; r < r0 + 32; ++r) {
                    float cur[8], old[8]; unpack8(*(const u32x4*)(P + (size_t)r * MIXN), cur);
                    const bool has_old = (r - w >= bs);
                    if (has_old) unpack8(*(const u32x4*)(P + (size_t)(r - w) * MIXN), old);
                    const int pos = r - bs + 1; const float inv = 1.0f / (float)(pos < w ? pos : w);
                    float o[8];
#pragma unroll
                    for (int q = 0; q < 8; ++q) { s[q] += cur[q]; if (has_old) s[q] -= old[q]; o[q] = s[q] * inv - cur[q]; }
                    *(u32x4*)(MIXED + (size_t)r * D + 8 * lane) = pack8(o);
                }
            } else {
                const bf16_t* P = PROJ + 8 * lane;
                float w0[8], w1[8], w2[8], z1[8], z2[8];
                { const float* cw = p.in[I_CONVW] + 8 * lane;
#pragma unroll
                  for (int q = 0; q < 8; ++q) { w0[q] = cw[q]; w1[q] = cw[512 + q]; w2[q] = cw[1024 + q]; z1[q] = 0.f; z2[q] = 0.f; } }
                if (r0 - 1 >= bs) { float a[8], b[8]; unpack8(*(const u32x4*)(P + (size_t)(r0 - 1) * MIXN + 1024), a); unpack8(*(const u32x4*)(P + (size_t)(r0 - 1) * MIXN + 1536), b);
#pragma unroll
                    for (int q = 0; q < 8; ++q) z1[q] = a[q] * b[q]; }
                if (r0 - 2 >= bs) { float a[8], b[8]; unpack8(*(const u32x4*)(P + (size_t)(r0 - 2) * MIXN + 1024), a); unpack8(*(const u32x4*)(P + (size_t)(r0 - 2) * MIXN + 1536), b);
#pragma unroll
                    for (int q = 0; q < 8; ++q) z2[q] = a[q] * b[q]; }
#pragma unroll 4
                for (int r = r0; r < r0 + 32; ++r) {
                    float gp[8], a[8], b[8], o[8];
                    unpack8(*(const u32x4*)(P + (size_t)r * MIXN + 512), gp); unpack8(*(const u32x4*)(P + (size_t)r * MIXN + 1024), a); unpack8(*(const u32x4*)(P + (size_t)r * MIXN + 1536), b);
#pragma unroll
                    for (int q = 0; q < 8; ++q) { const float zc = a[q] * b[q]; o[q] = gp[q] * (w0[q] * z2[q] + w1[q] * z1[q] + w2[q] * zc); z2[q] = z1[q]; z1[q] = zc; }
                    *(u32x4*)(MIXED + (size_t)r * D + 512 + 8 * lane) = pack8(o);
                }
            }
        }
    }
    SEAM(2);

    if (IN(3)) for (int rep_ = 0; rep_ < NREP(3); ++rep_) { pg8::Gemm g{MIXED, Wout_t, 2 * D, 2 * D, 2 * D}; pg8::DenseOrder S; S.init(M, D, G, bx); pg8::EpiResid E{p.in[I_X], X, nullptr, XN, rss, lds + LDS_XTAB_OFF};
        pg8::gemm_phase<pg8::EpiResid, pg8::DenseOrder>(lds, g, S, E); }
    SEAM(3);


    if (IN(5)) for (int rep_ = 0; rep_ < NREP(5); ++rep_) { pg8::Gemm g{XN, Wgu_t, 2 * D, 2 * D, 2 * D}; pg8::DenseOrder S; S.init(M, 2 * DFF, G, bx); pg8::EpiSwiGLU E{Hb, DFF, rss};
        pg8::gemm_phase<pg8::EpiSwiGLU, pg8::DenseOrder>(lds, g, S, E); }
    SEAM(5);

    if (IN(6)) for (int rep_ = 0; rep_ < NREP(6); ++rep_) { pg8::Gemm g{Hb, Wd_t, 2 * DFF, 2 * DFF, 2 * DFF}; pg8::DenseOrder S; S.init(M, D, G, bx); pg8::EpiResid E{X, X, nullptr, XN, rss + (size_t)M * 4, lds + LDS_XTAB_OFF};
        pg8::gemm_phase<pg8::EpiResid, pg8::DenseOrder>(lds, g, S, E); }
    SEAM(6);


    if (IN(8)) for (int rep_ = 0; rep_ < NREP(8); ++rep_) { pg8::Gemm g{XN, Wqkv_t, 2 * D, 2 * D, 2 * D}; pg8::DenseOrder S; S.init(M, QKVN, G, bx); pg8::EpiBf16 E{QKV, QKVN, p.in[I_BQKV], rss + (size_t)M * 4};
        pg8::gemm_phase<pg8::EpiBf16, pg8::DenseOrder>(lds, g, S, E); }
    SEAM(8);

    if (IN(9)) for (int rep_ = 0; rep_ < NREP(9); ++rep_) {
        const int tid = fresh_tid(), lane = tid & 63;
        for (int i = tid; i < NQH * 256; i += NTHR) *(LAS float*)(lds + AT_L_BT + 4 * i) = bias_tab[i] * 1.44269504089f;
        const int r32 = lane & 31, hh = lane >> 5;
        constexpr int NUNIT = BATCH * (SEQ / CHUNK) * NKVH;
        u32x4 kr[3], vr[3]; bf16x8 qfA[4], qfB[4];
#define AT_KV_LOAD(unit_) do { const int tid_ = fresh_tid(); const int kvh_ = (unit_) & 1, n_ = ((unit_) >> 1) & 255, t0_ = ((unit_) >> 9) * SEQ + n_ * CHUNK; _Pragma("unroll") for (int i = 0; i < 3; ++i) { const int pc = tid_ + i * NTHR, j = pc >> 3, c = pc & 7; \
            kr[i] = (u32x4){0u, 0u, 0u, 0u}; vr[i] = (u32x4){0u, 0u, 0u, 0u}; \
            if (n_ * CHUNK - 128 + j >= 0) { const bf16_t* src = QKV + (size_t)(t0_ - 128 + j) * QKVN + 1024 + kvh_ * HD + 8 * c; kr[i] = *(const u32x4*)src; vr[i] = *(const u32x4*)(src + 128); } } } while (0)
#define AT_Q_LOAD(qf_, unit_, qb_) do { const int l_ = fresh_tid() & 63; const int r32 = l_ & 31, hh = l_ >> 5; const int kvh_ = (unit_) & 1, n_ = ((unit_) >> 1) & 255, t0_ = ((unit_) >> 9) * SEQ + n_ * CHUNK; \
            const bf16_t* qp = QKV + (size_t)(t0_ + (qb_) * 32 + r32) * QKVN + (kvh_ * 8 + wave) * HD + 8 * hh; _Pragma("unroll") for (int ks = 0; ks < 4; ++ks) qf_[ks] = *(const bf16x8*)(qp + 16 * ks); } while (0)
        int unit = vcu;
        if (unit < NUNIT) { AT_KV_LOAD(unit); }
        for (; unit < NUNIT; unit += G) {
            const int kvh = unit & 1, n = (unit >> 1) & 255, b = unit >> 9;
            const int t0 = b * SEQ + n * CHUNK;
            const bool has_next = unit + G < NUNIT;
            __syncthreads();
            const int tid_s = fresh_tid();
#pragma unroll
            for (int i = 0; i < 3; ++i) { const int pc = tid_s + i * NTHR, j = pc >> 3, c = pc & 7;
                *(LAS u32x4*)(lds + AT_L_K + j * AT_KS_STR + 16 * c) = kr[i];
                const unsigned vw[4] = {vr[i].x, vr[i].y, vr[i].z, vr[i].w};
#pragma unroll
                for (int q = 0; q < 4; ++q) { *(LAS unsigned short*)(lds + AT_L_VT + (8 * c + 2 * q) * AT_VT_STR + 2 * j) = (unsigned short)(vw[q] & 0xffffu);
                                              *(LAS unsigned short*)(lds + AT_L_VT + (8 * c + 2 * q + 1) * AT_VT_STR + 2 * j) = (unsigned short)(vw[q] >> 16); } }
            AT_Q_LOAD(qfA, unit, 0); AT_Q_LOAD(qfB, unit, 1);
            __syncthreads();
            const int head = kvh * 8 + wave;
            const float sink = p.in[I_SINK][head];
            const int kb_min = n == 0 ? 4 : (n == 1 ? 2 : 0);
            attn_qblock(lds, qfA, AO + (size_t)t0 * D + head * HD, head, 0, kb_min, sink, wave, fresh_tid() & 63);
            if (has_next) AT_KV_LOAD(unit + G);
            attn_qblock(lds, qfB, AO + (size_t)(t0 + 32) * D + head * HD, head, 1, kb_min, sink, wave, fresh_tid() & 63);
        }
#undef AT_KV_LOAD
#undef AT_Q_LOAD
        __syncthreads();
    }
    SEAM(9);

    if (IN(10)) for (int rep_ = 0; rep_ < NREP(10); ++rep_) { pg8::Gemm g{AO, Wo_t, 2 * D, 2 * D, 2 * D}; pg8::DenseOrder S; S.init(M, D, G, bx); pg8::EpiResid E{X, X, p.in[I_BO], nullptr, nullptr, nullptr};
        pg8::gemm_phase<pg8::EpiResid, pg8::DenseOrder>(lds, g, S, E); }
    SEAM(10);

    const int RPW = (M + G - 1) / G;
    constexpr int L_RW = 0, L_RE = 32768, L_RWT = L_RE + 1024 * 4, L_RRK = L_RWT + 1024 * 4, L_CNT = L_RRK + 1024 * 4, L_SB = L_CNT + 64, L_SLOT = L_SB + 256;
    unsigned char* XN8 = (unsigned char*)XN;
    if (IN(11)) for (int rep_ = 0; rep_ < NREP(11); ++rep_) {
        const int tid = fresh_tid(), lane = tid & 63;
        for (int i = tid; i < D * NEXP; i += NTHR) { const int c = i >> 3, e = i & 7; *(LAS float*)(lds + L_RW + 4 * (e * D + c)) = p.in[I_ROUTER][i] * p.in[I_ODNF][c]; }
        if (tid < 8) *(LAS int*)(lds + L_CNT + 4 * tid) = 0;
        __syncthreads();
        const int rbase = bx * RPW;
        const int nrows = (M - rbase) < RPW ? (M - rbase) : RPW;
        f32x4 gn[4];
#pragma unroll
        for (int j = 0; j < 4; ++j) gn[j] = *(const f32x4*)(p.in[I_ODNF] + 256 * j + 4 * lane);
        for (int rl0 = wave; rl0 < nrows; rl0 += 4 * NWAVES) {
            f32x4 v[4][4];
#pragma unroll
            for (int u = 0; u < 4; ++u) { const int rl = rl0 + 8 * u; const int m = rbase + (rl < nrows ? rl : rl0);
#pragma unroll
                for (int j = 0; j < 4; ++j) v[u][j] = *(const f32x4*)(X + (size_t)m * D + 256 * j + 4 * lane); }
#pragma unroll
            for (int u = 0; u < 4; ++u) { const int rl = rl0 + 8 * u; if (rl >= nrows) continue; const int m = rbase + rl;
                float s2 = 0.f;
#pragma unroll
                for (int j = 0; j < 4; ++j) s2 += (v[u][j][0] * v[u][j][0] + v[u][j][1] * v[u][j][1]) + (v[u][j][2] * v[u][j][2] + v[u][j][3] * v[u][j][3]);
                const float r = 1.0f / sqrtf(wave_sum(s2) * (1.0f / D) + RMS_EPS);
                float lg[8];
#pragma unroll
                for (int e = 0; e < 8; ++e) { float a = 0.f;
#pragma unroll
                    for (int j = 0; j < 4; ++j) { const f32x4 w = *(const LAS f32x4*)(lds + L_RW + 4096 * e + 1024 * j + 16 * lane); a += (v[u][j][0] * w[0] + v[u][j][1] * w[1]) + (v[u][j][2] * w[2] + v[u][j][3] * w[3]); }
                    lg[e] = a; }
#pragma unroll
                for (int e = 0; e < 8; ++e) lg[e] = wave_sum(lg[e]) * r;
#pragma unroll
                for (int j = 0; j < 4; ++j) { const f32x4 y = v[u][j] * r * gn[j]; *(unsigned*)(XN8 + (size_t)m * D + 256 * j + 4 * lane) = pg8::pk4_fp8(y[0], y[1], y[2], y[3]); }
                int e0 = 0; float v0 = lg[0];
#pragma unroll
                for (int e = 1; e < 8; ++e) if (lg[e] > v0) { v0 = lg[e]; e0 = e; }
                int e1 = -1; float v1 = -3.0e38f;
#pragma unroll
                for (int e = 0; e < 8; ++e) if (e != e0 && lg[e] > v1) { v1 = lg[e]; e1 = e; }
                const float wt0 = 1.0f / (1.0f + __expf(v1 - v0));
                if (lane == 0) { *(LAS int*)(lds + L_RE + 8 * rl) = e0; *(LAS int*)(lds + L_RE + 8 * rl + 4) = e1; *(LAS float*)(lds + L_RWT + 8 * rl) = wt0; *(LAS float*)(lds + L_RWT + 8 * rl + 4) = 1.0f - wt0; }
            }
        }
        __syncthreads();
        for (int en = tid; en < 2 * nrows; en += NTHR) {
            const int e = *(LAS int*)(lds + L_RE + 4 * en); int r = 0;
            for (int j = 0; j < en; ++j) r += (*(LAS int*)(lds + L_RE + 4 * j) == e);
            *(LAS int*)(lds + L_RRK + 4 * en) = r;
            __hip_atomic_fetch_add((LAS int*)(lds + L_CNT + 4 * e), 1, __ATOMIC_RELAXED, __HIP_MEMORY_SCOPE_WORKGROUP);
        }
        __syncthreads();
        if (tid < 8) wgcnt[bx * 8 + tid] = *(LAS int*)(lds + L_CNT + 4 * tid);
        __syncthreads();
    }
    SEAM(11);

    if (IN(12)) for (int rep_ = 0; rep_ < NREP(12); ++rep_) {
        const int tid = fresh_tid(), lane = tid & 63;
        LAS int* sb = (LAS int*)(lds + L_SB);
        if (tid < 32) sb[tid] = 0;
        __syncthreads();
        for (int i = tid; i < G * 2; i += NTHR) { const int w = i >> 1, h4 = (i & 1) * 4; const u32x4 c = *(const u32x4*)(wgcnt + w * 8 + h4); const unsigned cv[4] = {c.x, c.y, c.z, c.w};
#pragma unroll
            for (int q = 0; q < 4; ++q) { __hip_atomic_fetch_add(sb + 16 + h4 + q, (int)cv[q], __ATOMIC_RELAXED, __HIP_MEMORY_SCOPE_WORKGROUP); if (w < bx) __hip_atomic_fetch_add(sb + 8 + h4 + q, (int)cv[q], __ATOMIC_RELAXED, __HIP_MEMORY_SCOPE_WORKGROUP); } }
        __syncthreads();
        if (tid == 0) { int base = 0; for (int e = 0; e < 8; ++e) { sb[e] = base; base += (sb[16 + e] + 255) & ~255; } sb[24] = base; }
        __syncthreads();
        const int rbase = bx * RPW;
        const int nrows = (M - rbase) < RPW ? (M - rbase) : RPW;
        unsigned char* HS8 = (unsigned char*)HS;
        for (int en = tid; en < 2 * nrows; en += NTHR) { const int e = *(LAS int*)(lds + L_RE + 4 * en); const int slot = sb[e] + sb[8 + e] + *(LAS int*)(lds + L_RRK + 4 * en);
            *(LAS int*)(lds + L_SLOT + 4 * en) = slot; slot_tok[slot] = 2 * (rbase + (en >> 1)) + (en & 1); slot_w[slot] = *(LAS float*)(lds + L_RWT + 4 * en); }
        __syncthreads();
        for (int en0 = wave; en0 < 2 * nrows; en0 += 4 * NWAVES) {
            u32x4 t[4];
#pragma unroll
            for (int u = 0; u < 4; ++u) { const int en = en0 + 8 * u; if (en < 2 * nrows) t[u] = *(const u32x4*)(XN8 + (size_t)(rbase + (en >> 1)) * D + 16 * lane); }
#pragma unroll
            for (int u = 0; u < 4; ++u) { const int en = en0 + 8 * u; if (en < 2 * nrows) *(u32x4*)(HS8 + (size_t)(*(LAS int*)(lds + L_SLOT + 4 * en)) * D + 16 * lane) = t[u]; } }
        if (bx == 0) {
            for (int e = 0; e < 8; ++e) { const int b0 = sb[e] + sb[16 + e], b1 = sb[e] + ((sb[16 + e] + 255) & ~255); for (int i = b0 + tid; i < b1; i += NTHR) { slot_tok[i] = -1; slot_w[i] = 0.f; } }
            const int nt_all = sb[24] >> 8;
            for (int j = tid; j < nt_all; j += NTHR) { int e = 0; for (int q = 1; q < 8; ++q) if ((j << 8) >= sb[q]) e = q; tilemeta[8 + j] = e; }
            if (tid == 0) { tilemeta[0] = nt_all; tilemeta[1] = nt_all; }
        }
        __syncthreads();
    }
    SEAM(12);

    if (IN(13) || IN(14)) {
        const int tid = fresh_tid();
        for (int j = tid; j < 288; j += NTHR) *(LAS int*)(lds + LDS_TILE_OFF + 4 * j) = (j < MAXTILES + 8) ? tilemeta[j] : 0;
        __syncthreads();
    }
    const LAS int* tmeta = (const LAS int*)(lds + LDS_TILE_OFF);
    if (IN(13)) for (int rep_ = 0; rep_ < NREP(13); ++rep_) {
        const int nall = __builtin_amdgcn_readfirstlane(tmeta[0]);
        pg8::Gemm g{HS, Wegu_t, D, D, D}; pg8::MoeOrder S; S.T.init(nall, NFE_T, G, bx); S.tpe = NFE_T; S.tile_e = tmeta + 8;
        pg8::EpiSwiGLU8 E{(unsigned char*)H2, DFE};
        pg8::gemm_phase<pg8::EpiSwiGLU8, pg8::MoeOrder, true>(lds, g, S, E);
#if PROBE_KLOOP
        { pg8::EpiNull8 E2{(float*)(ws + WS_RSS)}; pg8::gemm_phase<pg8::EpiNull8, pg8::MoeOrder, true>(lds, g, S, E2); }
#endif
    }
    SEAM(13);
    if (IN(14)) {
        const int nall = __builtin_amdgcn_readfirstlane(tmeta[0]);
        pg8::Gemm g{H2, Wed_t, DFE, DFE, DFE}; pg8::MoeOrder S; S.T.init(nall, D / 256, G, bx); S.tpe = D / 256; S.tile_e = tmeta + 8;
        pg8::EpiMoeDown E{X, (bf16_t*)(ws + WS_Y0), slot_tok, slot_w};
        pg8::gemm_phase<pg8::EpiMoeDown, pg8::MoeOrder, true>(lds, g, S, E);
    }
    SEAM(14);

    if (IN(15)) {
        const int lane = fresh_tid() & 63;
        const bf16_t* Y0 = (const bf16_t*)(ws + WS_Y0);
        for (int m = gw; m < M; m += NGW) {
            float* xrow = X + (size_t)m * D; f32x4 v[4];
#pragma unroll
            for (int j = 0; j < 2; ++j) { v[2 * j] = *(const f32x4*)(xrow + 512 * j + 8 * lane); v[2 * j + 1] = *(const f32x4*)(xrow + 512 * j + 8 * lane + 4);
                float f[8]; unpack8(*(const u32x4*)(Y0 + (size_t)m * D + 512 * j + 8 * lane), f);
#pragma unroll
                for (int q = 0; q < 4; ++q) { v[2 * j][q] += f[q]; v[2 * j + 1][q] += f[4 + q]; } }
            float s2 = 0.f;
#pragma unroll
            for (int j = 0; j < 4; ++j) s2 += (v[j][0] * v[j][0] + v[j][1] * v[j][1]) + (v[j][2] * v[j][2] + v[j][3] * v[j][3]);
            const float r = 1.0f / sqrtf(wave_sum(s2) * (1.0f / D) + RMS_EPS);
#pragma unroll
            for (int j = 0; j < 2; ++j) { const f32x4 g0 = *(const f32x4*)(p.in[I_FINAL] + 512 * j + 8 * lane), g1 = *(const f32x4*)(p.in[I_FINAL] + 512 * j + 8 * lane + 4);
                *(f32x4*)(xrow + 512 * j + 8 * lane) = v[2 * j] * r * g0; *(f32x4*)(xrow + 512 * j + 8 * lane + 4) = v[2 * j + 1] * r * g1; }
        }
    }
#undef IN
#undef SEAM
}

extern "C" void kernel_launch(void* const* d_in, const int* in_sizes, int n_in, void* d_out, int out_size, void* d_ws, size_t ws_size, hipStream_t stream) {
    static int grid = 0;
    if (grid == 0) {
        if (n_in != 24 || in_sizes[0] != M * D || out_size != M * D || ws_size < WS_END) { fprintf(stderr, "kernel_launch: unexpected shapes (n_in %d, in0 %d, out %d, ws %zu < %zu)\n", n_in, n_in > 0 ? in_sizes[0] : -1, out_size, ws_size, (size_t)WS_END); grid = -1; return; }
        int dev = 0, cus = 0, per_cu = 0;
        if (hipGetDevice(&dev) != hipSuccess || hipDeviceGetAttribute(&cus, hipDeviceAttributeMultiprocessorCount, dev) != hipSuccess) { grid = -1; return; }
        if (hipFuncSetAttribute((const void*)fwd_kernel, hipFuncAttributeMaxDynamicSharedMemorySize, LDS_BYTES) != hipSuccess) { fprintf(stderr, "kernel_launch: hipFuncSetAttribute failed\n"); grid = -1; return; }
        if (hipOccupancyMaxActiveBlocksPerMultiprocessor(&per_cu, (const void*)fwd_kernel, NTHR, LDS_BYTES) != hipSuccess || per_cu < 1) fprintf(stderr, "kernel_launch: occupancy query reports %d\n", per_cu);
        (void)hipGetLastError();
        grid = cus < 256 ? cus : 256;
    }
    if (grid < 0) return;
    (void)hipMemsetAsync((char*)d_ws + WS_CTL, 0, CTL_ZERO_BYTES, stream);
    Params a{};
    for (int i = 0; i < 24; ++i) a.in[i] = (const float*)d_in[i];
    a.out = (float*)d_out; a.ws = (unsigned char*)d_ws;
    constexpr int NPH = 16;
    if (MK_N_LAUNCHES == 1) { a.ph_lo = 0; a.ph_hi = NPH; hipLaunchKernelGGL(fwd_kernel, dim3(grid), dim3(NTHR), LDS_BYTES, stream, a); }
    else for (int li = 0; li < NPH; ++li) { a.ph_lo = li; a.ph_hi = li + 1; hipLaunchKernelGGL(fwd_kernel, dim3(grid), dim3(NTHR), LDS_BYTES, stream, a); }
}
```

```cpp
#include <hip/hip_runtime.h>
#include <cstdio>
#include <cstdint>

#ifndef MK_N_LAUNCHES
#define MK_N_LAUNCHES 1
#endif

#ifndef PROBE_PH
#define PROBE_PH -1
#endif
#ifndef PROBE_MODE
#define PROBE_MODE 3
#endif
#ifndef PROBE_KDBG
#define PROBE_KDBG -1
#endif
#ifndef MOE_GU_FP6
#define MOE_GU_FP6 0
#endif
#ifndef PROBE_K8
#define PROBE_K8 -1
#define PROBE_K8_FMT 0
#endif
#ifndef EPIWAIT
#define EPIWAIT 0
#endif
#ifndef REPMASK
#define REPMASK 0u
#endif
#define NREP(k) ((((REPMASK) >> (k)) & 1u) ? 2 : 1)
#define LAS __attribute__((address_space(3)))
#define GAS __attribute__((address_space(1)))
typedef unsigned short bf16_t;
typedef short bf16x8 __attribute__((ext_vector_type(8)));
typedef short s16x4 __attribute__((ext_vector_type(4)));
typedef float f32x2 __attribute__((ext_vector_type(2)));
typedef float f32x4 __attribute__((ext_vector_type(4)));
typedef float f32x16 __attribute__((ext_vector_type(16)));
typedef unsigned u32x2 __attribute__((ext_vector_type(2)));
typedef unsigned u32x4 __attribute__((ext_vector_type(4)));
typedef __bf16 hbf16x2 __attribute__((ext_vector_type(2)));
typedef int i32x4 __attribute__((ext_vector_type(4)));
typedef int i32x8 __attribute__((ext_vector_type(8)));
typedef int i32x6 __attribute__((ext_vector_type(6)));
typedef __bf16 hbf16x32 __attribute__((ext_vector_type(32)));

constexpr int D = 1024, BATCH = 2, SEQ = 16384, M = BATCH * SEQ;
constexpr int MIXN = 2048;
constexpr int DFF = 2816, NFF_T = DFF / 128;
constexpr int QKVN = 1280, NQH = 16, NKVH = 2, HD = 64, CHUNK = 64, KVSPAN = 192;
constexpr int NEXP = 8, DFE = 3584, NFE_T = DFE / 128;
constexpr float RMS_EPS = 1e-6f;
constexpr int MAXSLOT = 67328;
constexpr int MAXTILES = MAXSLOT / 256;
constexpr int NWAVES = 8, NTHR = 512;

constexpr size_t MiB = 1u << 20;
constexpr size_t WS_CTL = 0, CTL_ZERO_BYTES = 1 * MiB;
constexpr size_t WS_BIAS = 1 * MiB;
constexpr size_t WS_WGCNT = WS_BIAS + 16 * 256 * 4;
constexpr size_t WS_TILE = WS_WGCNT + 1024 * 16 * 4;
constexpr size_t WS_SLOTT = WS_TILE + 4096;
constexpr size_t WS_SLOTW = WS_SLOTT + (size_t)MAXSLOT * 4;
constexpr size_t WS_TSLOT = WS_SLOTW + (size_t)MAXSLOT * 4;
static_assert(WS_TSLOT + 2 * (size_t)M * 4 <= 4 * MiB, "route region");
constexpr size_t WS_WIN = 4 * MiB;
constexpr size_t WS_WOUT = WS_WIN + (size_t)MIXN * D * 2;
constexpr size_t WS_WGU = WS_WOUT + (size_t)D * D * 2;
constexpr size_t WS_WD = WS_WGU + (size_t)2 * DFF * D * 2;
constexpr size_t WS_WQKV = WS_WD + (size_t)D * DFF * 2;
constexpr size_t WS_WO = WS_WQKV + (size_t)QKVN * D * 2;
static_assert(WS_WO + (size_t)D * D * 2 <= 31 * MiB, "dense weights");
constexpr size_t WS_WEGU = 31 * MiB;
constexpr size_t WS_WED = WS_WEGU + (size_t)NEXP * 2 * DFE * D;
static_assert(WS_WED + (size_t)NEXP * D * DFE == 115 * MiB, "expert weights");
constexpr size_t WS_XN = 115 * MiB;
constexpr size_t WS_Y0 = 23 * MiB;
static_assert(WS_Y0 + (size_t)M * D * 2 <= WS_WED, "Y0 must not touch the down weights");
constexpr size_t WS_R = 179 * MiB;
constexpr size_t WS_PROJ = WS_R, WS_MIXED = WS_R + (size_t)M * MIXN * 2;
constexpr size_t WS_H = WS_R;
constexpr size_t WS_QKV = WS_R, WS_AO = WS_R + (size_t)M * QKVN * 2;
constexpr size_t WS_Y1 = WS_R;
constexpr size_t WS_HS = WS_R, WS_H2 = WS_R + 66 * MiB;
static_assert((size_t)MAXSLOT * D <= 66 * MiB, "HS");
constexpr size_t WS_END = WS_H2 + (size_t)MAXSLOT * DFE;
constexpr size_t WS_SLAB = 482 * MiB;
static_assert(WS_SLAB >= WS_END && WS_SLAB + 256 * 65536 * 2 <= 543497280ull, "slabs");
static_assert(WS_END <= 543497280ull, "workspace");
static_assert(WS_MIXED + (size_t)M * D * 2 <= 543497280ull && WS_H + (size_t)M * DFF * 2 <= 543497280ull, "workspace");

constexpr int CW_BAR = 4096;
constexpr size_t WS_RSS = 480 * MiB;
static_assert(WS_RSS >= WS_END && WS_RSS + 3 * (size_t)M * 4 * 4 <= 543497280ull, "rss");

constexpr int RING_BYTES = 131072;
constexpr int LDS_TILE_OFF = RING_BYTES;
constexpr int LDS_MISC_OFF = RING_BYTES + 2048;
constexpr int LDS_XTAB_OFF = RING_BYTES + 4096;
constexpr int LDS_BYTES = 147456;

__device__ __forceinline__ unsigned pk2(float lo, float hi) { f32x2 v = {lo, hi}; hbf16x2 b = __builtin_convertvector(v, hbf16x2); return __builtin_bit_cast(unsigned, b); }
__device__ __forceinline__ float bf_lo(unsigned w) { return __uint_as_float(w << 16); }
__device__ __forceinline__ float bf_hi(unsigned w) { return __uint_as_float(w & 0xffff0000u); }
__device__ __forceinline__ void unpack8(const u32x4 w, float (&f)[8]) { f[0] = bf_lo(w.x); f[1] = bf_hi(w.x); f[2] = bf_lo(w.y); f[3] = bf_hi(w.y); f[4] = bf_lo(w.z); f[5] = bf_hi(w.z); f[6] = bf_lo(w.w); f[7] = bf_hi(w.w); }
__device__ __forceinline__ u32x4 pack8(const float (&f)[8]) { u32x4 w; w.x = pk2(f[0], f[1]); w.y = pk2(f[2], f[3]); w.z = pk2(f[4], f[5]); w.w = pk2(f[6], f[7]); return w; }
constexpr float F6_ACT = 1.75f, F6_W = 1.44269504089f * 64.0f / 1.75f, F6_DOWN = -0.48045301392f;
__device__ __forceinline__ i32x6 pk32_fp6(const unsigned (&w)[16]) {
    u32x4 a = {w[0], w[1], w[2], w[3]}, b = {w[4], w[5], w[6], w[7]}, c = {w[8], w[9], w[10], w[11]}, d = {w[12], w[13], w[14], w[15]};
    typedef unsigned u32x16 __attribute__((ext_vector_type(16)));
    const u32x16 all = __builtin_shufflevector(__builtin_shufflevector(a, b, 0, 1, 2, 3, 4, 5, 6, 7), __builtin_shufflevector(c, d, 0, 1, 2, 3, 4, 5, 6, 7), 0, 1, 2, 3, 4, 5, 6, 7, 8, 9, 10, 11, 12, 13, 14, 15);
    return __builtin_amdgcn_cvt_scalef32_pk32_fp6_bf16(__builtin_bit_cast(hbf16x32, all), 1.0f);
}
__device__ __forceinline__ float wave_sum(float v) {
#pragma unroll
    for (int o = 1; o < 64; o <<= 1) v += __shfl_xor(v, o);
    return v;
}
__device__ __forceinline__ int fresh_tid() { int t = threadIdx.x; asm volatile("" : "+v"(t)); return t; }
#define LDS_WAIT() asm volatile("s_waitcnt lgkmcnt(0)" ::: "memory")
#define VM_WAIT() asm volatile("s_waitcnt vmcnt(0)" ::: "memory")

namespace pg8 {
constexpr int BM = 256, BK = 64, HALF = 128, HTB = HALF * BK * 2, STAGE_BYTES = 8 * HTB, NXCD = 8, WGM = 8;
__host__ __device__ __forceinline__ int lds_byte(int r, int c) { const int st = (r >> 4) * 2 + (c >> 5), rr = r & 15, cc = c & 31, ob = rr * 64 + cc * 2; return st * 1024 + (ob ^ (((ob >> 9) & 1) << 5)); }
__host__ __device__ __forceinline__ void stage_rc(int b, int& R, int& C) { const int st = b / 1024, sb = b % 1024, swz = sb ^ (((sb >> 9) & 1) << 5); R = (st >> 1) * 16 + swz / 64; C = (st & 1) * 32 + (swz % 64) / 2; }
__host__ __device__ __forceinline__ int perm32(int rho) { const int n = rho >> 4, i = rho & 15; return 8 * (i >> 2) + 4 * n + (i & 3); }

struct Unit { int pm, pn, rm, cn; };
struct Gemm { const void* A; const void* Bt; int lda, ldb, K; };

struct TileOrder {
    int nM, nN, nwg, G, c;
    __device__ __forceinline__ void init(int nM_, int nN_, int G_, int c_) { nM = nM_; nN = nN_; nwg = nM * nN; G = G_; c = c_; }
    __device__ __forceinline__ bool next(int i, int& m, int& n) const {
        const int L = i * G + c; if (L >= nwg) return false;
        int wgid = L; { const int q = nwg / NXCD, r = nwg % NXCD, xcd = wgid % NXCD, off = wgid / NXCD; wgid = (xcd < r ? xcd * (q + 1) : r * (q + 1) + (xcd - r) * q) + off; }
        const int nig = WGM * nN, gid = wgid / nig, fm = gid * WGM, gsz = (nM - fm) < WGM ? (nM - fm) : WGM;
        m = fm + ((wgid % nig) % gsz); n = (wgid % nig) / gsz; return true;
    }
};
struct DenseOrder {
    TileOrder T;
    __device__ __forceinline__ void init(int Mr, int N, int G, int c) { T.init(Mr / BM, N / BM, G, c); }
    __device__ __forceinline__ bool next(int i, Unit& u) const { int m, n; if (!T.next(i, m, n)) return false; u.pm = m; u.pn = n; u.rm = m; u.cn = n; return true; }
    __device__ __forceinline__ void a_ready(const Unit&) const {}
    __device__ __forceinline__ void done(const Unit&) const {}
};
struct MoeOrder {
    TileOrder T; int tpe; const LAS int* tile_e;
    __device__ __forceinline__ bool next(int i, Unit& u) const { int m, n; if (!T.next(i, m, n)) return false;
        const int e = __builtin_amdgcn_readfirstlane(tile_e[m]);
        u.pm = m; u.pn = e * tpe + n; u.rm = m; u.cn = n; return true; }
    __device__ __forceinline__ void a_ready(const Unit&) const {}
    __device__ __forceinline__ void done(const Unit&) const {}
};

__device__ __forceinline__ float rms_scale(const float* rss, int row) { if (!rss) return 1.0f; const f32x4 a = *(const f32x4*)(rss + (size_t)row * 4);
    return 1.0f / sqrtf(((a[0] + a[1]) + (a[2] + a[3])) * (1.0f / D) + RMS_EPS); }
struct EpiBf16 {
    static constexpr bool PERM = true; static constexpr int NST = 16;
    bf16_t* O; int ldc; const float* bias; const float* rss;
    __device__ __forceinline__ void operator()(const f32x4 (&acc)[2][2][4][2], const Unit& u, int wr, int wc, int fr, int fq) const {
        const int row0 = u.rm * BM + wr * 64 + fr, col0 = u.cn * BM + wc * 32 + 8 * fq;
        f32x4 bv[2][2];
#pragma unroll
        for (int bj = 0; bj < 2; ++bj)
#pragma unroll
            for (int n = 0; n < 2; ++n) bv[bj][n] = bias ? *(const f32x4*)(bias + col0 + bj * HALF + 4 * n) : (f32x4){0.f, 0.f, 0.f, 0.f};
        float rs[2][4];
#pragma unroll
        for (int ai = 0; ai < 2; ++ai)
#pragma unroll
            for (int m = 0; m < 4; ++m) rs[ai][m] = rms_scale(rss, row0 + ai * HALF + m * 16);
#pragma unroll
        for (int ai = 0; ai < 2; ++ai)
#pragma unroll
            for (int m = 0; m < 4; ++m) { const int row = row0 + ai * HALF + m * 16; bf16_t* rowp = O + (size_t)row * ldc + col0; const float r = rs[ai][m];
#pragma unroll
                for (int bj = 0; bj < 2; ++bj) { const f32x4 v0 = acc[ai][bj][m][0] * r + bv[bj][0], v1 = acc[ai][bj][m][1] * r + bv[bj][1];
                    u32x4 w; w.x = pk2(v0[0], v0[1]); w.y = pk2(v0[2], v0[3]); w.z = pk2(v1[0], v1[1]); w.w = pk2(v1[2], v1[3]);
                    *(u32x4*)(rowp + bj * HALF) = w; } }
    }
};
__device__ __forceinline__ float silu_mul(float g2, float u) { return g2 * u * __builtin_amdgcn_rcpf(1.0f + __builtin_amdgcn_exp2f(g2)); }
struct EpiSwiGLU {
    static constexpr bool PERM = true; static constexpr int NST = 8;
    bf16_t* O; int ldc; const float* rss;
    __device__ __forceinline__ void operator()(const f32x4 (&acc)[2][2][4][2], const Unit& u, int wr, int wc, int fr, int fq) const {
        const int row0 = u.rm * BM + wr * 64 + fr, col0 = u.cn * HALF + wc * 32 + 8 * fq;
        float rs[2][4];
#pragma unroll
        for (int ai = 0; ai < 2; ++ai)
#pragma unroll
            for (int m = 0; m < 4; ++m) rs[ai][m] = rms_scale(rss, row0 + ai * HALF + m * 16);
#pragma unroll
        for (int ai = 0; ai < 2; ++ai)
#pragma unroll
            for (int m = 0; m < 4; ++m) { const int row = row0 + ai * HALF + m * 16; bf16_t* rowp = O + (size_t)row * ldc + col0; const float r = rs[ai][m];
                const f32x4 g0 = acc[ai][0][m][0] * r, g1 = acc[ai][0][m][1] * r, u0 = acc[ai][1][m][0] * r, u1 = acc[ai][1][m][1] * r;
                u32x4 w; w.x = pk2(silu_mul(g0[0], u0[0]), silu_mul(g0[1], u0[1])); w.y = pk2(silu_mul(g0[2], u0[2]), silu_mul(g0[3], u0[3]));
                w.z = pk2(silu_mul(g1[0], u1[0]), silu_mul(g1[1], u1[1])); w.w = pk2(silu_mul(g1[2], u1[2]), silu_mul(g1[3], u1[3]));
                *(u32x4*)rowp = w; }
    }
};
template <bool BASE_F32> struct EpiResid {
    static constexpr bool PERM = true; static constexpr int NST = 16;
    const void* base; bf16_t* xb; const float* bias; float* rss; LAS unsigned char* xlds;
    __device__ __forceinline__ void operator()(const f32x4 (&acc)[2][2][4][2], const Unit& u, int wr, int wc, int fr, int fq) const {
        const int row0 = u.rm * BM + wr * 64 + fr, col0 = u.cn * BM + wc * 32 + 8 * fq;
        f32x4 bv[2][2];
#pragma unroll
        for (int bj = 0; bj < 2; ++bj)
#pragma unroll
            for (int n = 0; n < 2; ++n) bv[bj][n] = bias ? *(const f32x4*)(bias + col0 + bj * HALF + 4 * n) : (f32x4){0.f, 0.f, 0.f, 0.f};
#pragma unroll
        for (int ai = 0; ai < 2; ++ai) {
            f32x4 bs[4][2][2];
#pragma unroll
            for (int m = 0; m < 4; ++m) { const size_t off = (size_t)(row0 + ai * HALF + m * 16) * D + col0;
#pragma unroll
                for (int bj = 0; bj < 2; ++bj) {
                    if constexpr (BASE_F32) { bs[m][bj][0] = *(const f32x4*)((const float*)base + off + bj * HALF); bs[m][bj][1] = *(const f32x4*)((const float*)base + off + bj * HALF + 4); }
                    else { const u32x4 w = *(const u32x4*)((const bf16_t*)base + off + bj * HALF); bs[m][bj][0] = (f32x4){bf_lo(w.x), bf_hi(w.x), bf_lo(w.y), bf_hi(w.y)}; bs[m][bj][1] = (f32x4){bf_lo(w.z), bf_hi(w.z), bf_lo(w.w), bf_hi(w.w)}; } } }
#pragma unroll
            for (int m = 0; m < 4; ++m) { const int row = row0 + ai * HALF + m * 16; const size_t off = (size_t)row * D + col0;
                float ss = 0.f;
#pragma unroll
                for (int bj = 0; bj < 2; ++bj) {
#pragma unroll
                    for (int n = 0; n < 2; ++n) { const f32x4 v = bs[m][bj][n] + acc[ai][bj][m][n] + bv[bj][n]; bs[m][bj][n] = v; ss += (v[0] * v[0] + v[1] * v[1]) + (v[2] * v[2] + v[3] * v[3]); }
                    u32x4 w; w.x = pk2(bs[m][bj][0][0], bs[m][bj][0][1]); w.y = pk2(bs[m][bj][0][2], bs[m][bj][0][3]); w.z = pk2(bs[m][bj][1][0], bs[m][bj][1][1]); w.w = pk2(bs[m][bj][1][2], bs[m][bj][1][3]);
                    *(u32x4*)(xb + off + bj * HALF) = w; }
                if (rss) { ss += __shfl_xor(ss, 16); ss += __shfl_xor(ss, 32); if (fq == 0) *(LAS float*)(xlds + 16 * (wr * 64 + ai * HALF + m * 16 + fr) + 4 * wc) = ss; } }
            asm volatile("" ::: "memory"); }
        if (rss) { asm volatile("s_waitcnt lgkmcnt(0)" ::: "memory"); __builtin_amdgcn_s_barrier(); asm volatile("" ::: "memory");
            const int t = wr * 256 + wc * 64 + fq * 16 + fr;
            if (t < 256) { const f32x4 a = *(const LAS f32x4*)(xlds + 16 * t); rss[(size_t)(u.rm * BM + t) * 4 + u.cn] = (a[0] + a[1]) + (a[2] + a[3]); } }
    }
};
__device__ __forceinline__ unsigned pk4_fp8(float a, float b, float c, float d) {
    int w = __builtin_amdgcn_cvt_pk_fp8_f32(__builtin_amdgcn_fmed3f(a, -448.f, 448.f), __builtin_amdgcn_fmed3f(b, -448.f, 448.f), 0, false);
    w = __builtin_amdgcn_cvt_pk_fp8_f32(__builtin_amdgcn_fmed3f(c, -448.f, 448.f), __builtin_amdgcn_fmed3f(d, -448.f, 448.f), w, true);
    return (unsigned)w;
}
__device__ __forceinline__ unsigned pk4_fp8_raw(float a, float b, float c, float d) {
    int w = __builtin_amdgcn_cvt_pk_fp8_f32(a, b, 0, false); w = __builtin_amdgcn_cvt_pk_fp8_f32(c, d, w, true); return (unsigned)w;
}
constexpr int E8M0_ONE = 0x7f7f7f7f, E8M0_2M6 = 0x79797979;
struct EpiSwiGLU8 {
    static constexpr bool PERM = true; static constexpr int SCALE_A = E8M0_ONE, SCALE_B = E8M0_2M6, FMT = MOE_GU_FP6 ? 2 : 0, NST = 8;
    unsigned char* O; int ldc;
    __device__ __forceinline__ void operator()(const f32x4 (&acc)[2][2][4][2], const Unit& u, int wr, int wc, int fr, int fq) const {
        const int row0 = u.rm * BM + wr * 64 + fr, col0 = u.cn * HALF + wc * 32 + 8 * fq;
#pragma unroll
        for (int ai = 0; ai < 2; ++ai)
#pragma unroll
            for (int m = 0; m < 4; ++m) { unsigned char* rowp = O + (size_t)(row0 + ai * HALF + m * 16) * ldc + col0;
                const f32x4 g0 = acc[ai][0][m][0], g1 = acc[ai][0][m][1], u0 = acc[ai][1][m][0], u1 = acc[ai][1][m][1];
                u32x2 w; w.x = pk4_fp8_raw(silu_mul(g0[0], u0[0]), silu_mul(g0[1], u0[1]), silu_mul(g0[2], u0[2]), silu_mul(g0[3], u0[3]));
                w.y = pk4_fp8_raw(silu_mul(g1[0], u1[0]), silu_mul(g1[1], u1[1]), silu_mul(g1[2], u1[2]), silu_mul(g1[3], u1[3]));
                *(u32x2*)rowp = w; }
    }
};
template <int FMT_> struct EpiNull8 {
    static constexpr bool PERM = true; static constexpr int SCALE_A = E8M0_ONE, SCALE_B = E8M0_2M6, FMT = FMT_, NST = 0;
    float* sink;
    __device__ __forceinline__ void operator()(const f32x4 (&acc)[2][2][4][2], const Unit& u, int wr, int wc, int fr, int fq) const {
        float s = 0.f;
#pragma unroll
        for (int ai = 0; ai < 2; ++ai)
#pragma unroll
            for (int bj = 0; bj < 2; ++bj)
#pragma unroll
                for (int m = 0; m < 4; ++m)
#pragma unroll
                    for (int n = 0; n < 2; ++n) s += (acc[ai][bj][m][n][0] + acc[ai][bj][m][n][1]) + (acc[ai][bj][m][n][2] + acc[ai][bj][m][n][3]);
        if (s == 12345.678f) sink[0] = s;
    }
};
struct EpiNull16 {
    static constexpr bool PERM = true; static constexpr int NST = 0;
    float* sink;
    __device__ __forceinline__ void operator()(const f32x4 (&acc)[2][2][4][2], const Unit& u, int wr, int wc, int fr, int fq) const {
        float s = 0.f;
#pragma unroll
        for (int ai = 0; ai < 2; ++ai)
#pragma unroll
            for (int bj = 0; bj < 2; ++bj)
#pragma unroll
                for (int m = 0; m < 4; ++m)
#pragma unroll
                    for (int n = 0; n < 2; ++n) s += (acc[ai][bj][m][n][0] + acc[ai][bj][m][n][1]) + (acc[ai][bj][m][n][2] + acc[ai][bj][m][n][3]);
        if (s == 12345.678f) sink[0] = s;
    }
};
constexpr long DY1 = ((long)WS_Y1 - (long)WS_Y0) / 2;
struct SingleOrder {
    int has, pm, pn, rm, cn;
    __device__ __forceinline__ bool next(int i, Unit& u) const { if (i != 0 || !has) return false; u.pm = pm; u.pn = pn; u.rm = rm; u.cn = cn; return true; }
    __device__ __forceinline__ void a_ready(const Unit&) const {}
    __device__ __forceinline__ void done(const Unit&) const {}
};
struct EpiSlab {
    static constexpr bool PERM = true; static constexpr int SCALE_A = E8M0_ONE, SCALE_B = E8M0_2M6, FMT = 0, NST = 0;
    bf16_t* slab; const u32x2* slot_rec;
    __device__ __forceinline__ void operator()(const f32x4 (&acc)[2][2][4][2], const Unit& u, int wr, int wc, int fr, int fq) const {
        const int r0 = wr * 64 + fr, c0 = wc * 32 + 8 * fq;
#pragma unroll
        for (int ai = 0; ai < 2; ++ai)
#pragma unroll
            for (int m = 0; m < 4; ++m) { const int rl = r0 + ai * HALF + m * 16; const u32x2 rec = slot_rec[u.rm * BM + rl];
                if ((int)rec.x >= 0) { const float ww = __uint_as_float(rec.y);
#pragma unroll
                    for (int bj = 0; bj < 2; ++bj) { const f32x4 v0 = acc[ai][bj][m][0] * ww, v1 = acc[ai][bj][m][1] * ww;
                        u32x4 o; o.x = pk2(v0[0], v0[1]); o.y = pk2(v0[2], v0[3]); o.z = pk2(v1[0], v1[1]); o.w = pk2(v1[2], v1[3]);
                        *(u32x4*)(slab + rl * 256 + c0 + bj * HALF) = o; } } }
    }
};
struct EpiMoeDown {
    static constexpr bool PERM = true; static constexpr int SCALE_A = E8M0_ONE, SCALE_B = E8M0_2M6, FMT = 0, NST = 8;
    bf16_t* Y0; const u32x2* slot_rec;
    __device__ __forceinline__ void operator()(const f32x4 (&acc)[2][2][4][2], const Unit& u, int wr, int wc, int fr, int fq) const {
        const int row0 = u.rm * BM + wr * 64 + fr, col0 = u.cn * BM + wc * 32 + 8 * fq;
        int meta[2][4]; float w[2][4];
#pragma unroll
        for (int ai = 0; ai < 2; ++ai)
#pragma unroll
            for (int m = 0; m < 4; ++m) { const u32x2 rec = slot_rec[row0 + ai * HALF + m * 16]; meta[ai][m] = (int)rec.x; w[ai][m] = __uint_as_float(rec.y); }
#pragma unroll
        for (int ai = 0; ai < 2; ++ai)
#pragma unroll
            for (int m = 0; m < 4; ++m) { const int mt = meta[ai][m]; const float ww = w[ai][m];
                if (mt >= 0) { const unsigned off = ((mt & 1) ? (unsigned)DY1 : 0u) + (unsigned)(mt >> 1) * D + col0; bf16_t* dst = Y0 + off;
#pragma unroll
                    for (int bj = 0; bj < 2; ++bj) { const f32x4 v0 = acc[ai][bj][m][0] * ww, v1 = acc[ai][bj][m][1] * ww;
                        u32x4 o; o.x = pk2(v0[0], v0[1]); o.y = pk2(v0[2], v0[3]); o.z = pk2(v1[0], v1[1]); o.w = pk2(v1[2], v1[3]);
                        *(u32x4*)(dst + bj * HALF) = o; } } }
    }
};

template <int OFF0> __device__ __forceinline__ void glds_pair(const char* sbase, unsigned voff0, unsigned voff1, unsigned lds_base) {
    asm volatile("s_add_u32 m0, %3, %4\n\ts_nop 0\n\tglobal_load_lds_dwordx4 %0, %2\n\ts_add_u32 m0, %3, %5\n\ts_nop 0\n\tglobal_load_lds_dwordx4 %1, %2"
                 :: "v"(voff0), "v"(voff1), "s"(sbase), "s"(lds_base), "i"(OFF0), "i"(OFF0 + 8192) : "memory", "scc");
}
template <class Epi, class Sched, bool FP8 = false, bool ALIGN_EPI = true, bool SP2 = true, int DBG = 0>
__device__ __forceinline__ void gemm_phase(LAS unsigned char* lds, const Gemm g, const Sched& S, const Epi& E) {
    int tid_o = threadIdx.x; asm volatile("" : "+v"(tid_o));
    const int tid = tid_o, wid = __builtin_amdgcn_readfirstlane(tid >> 6), lane = tid & 63, wr = wid >> 2, wc = wid & 3, fr = lane & 15, fq = lane >> 4;
    const int nt = g.K / (BK * 2);
    unsigned voffA[2], voffB[2];
#pragma unroll
    for (int i = 0; i < 2; ++i) { int R, C; stage_rc(tid * 16 + i * 8192, R, C); const int Rb = Epi::PERM ? ((R & ~31) + perm32(R & 31)) : R;
        voffA[i] = (unsigned)(R * g.lda + C * 2); voffB[i] = (unsigned)(Rb * g.ldb + C * 2); }
    const size_t kstep = (size_t)(BK * 2);
    const size_t hstepA = (size_t)HALF * g.lda, hstepB = (size_t)HALF * g.ldb;
    const size_t tstepA = 2 * hstepA, tstepB = 2 * hstepB;
    const unsigned lds_base = (unsigned)(size_t)lds + (unsigned)wid * 1024u;
    const int aoff = lds_byte(wr * 64 + fr, fq * 8), boff = lds_byte(wc * 32 + fr, fq * 8);
#define PG8_SA(b, h) (((b) * 2 + (h)) * HTB)
#define PG8_SB(b, h) ((4 + (b) * 2 + (h)) * HTB)
#define PG8_STAGE(bufoff, gbase, voff) do { if constexpr (!(DBG & 1)) glds_pair<(bufoff)>((const char*)(gbase), (voff)[0], (voff)[1], lds_base); } while (0)
#define PG8_LDA(dst, b, h) do { if constexpr (!(DBG & 2)) _Pragma("unroll") for (int m = 0; m < 4; ++m) _Pragma("unroll") for (int k = 0; k < 2; ++k) dst[m][k] = *(const LAS bf16x8*)(lds + PG8_SA(b, h) + aoff + m * 2048 + k * 1024); } while (0)
#define PG8_LDB(dst, b, h) do { if constexpr (!(DBG & 2)) _Pragma("unroll") for (int n = 0; n < 2; ++n) _Pragma("unroll") for (int k = 0; k < 2; ++k) dst[n][k] = *(const LAS bf16x8*)(lds + PG8_SB(b, h) + boff + n * 2048 + k * 1024); } while (0)
#define PG8_MMA(ai, bj, At, Bt) do { if constexpr (!(DBG & 8)) __builtin_amdgcn_s_setprio((DBG & 16) ? 3 : 1); if constexpr (!(DBG & 4)) _Pragma("unroll") for (int m = 0; m < 4; ++m) _Pragma("unroll") for (int n = 0; n < 2; ++n) { \
        if constexpr (FP8) { if constexpr (Epi::FMT == 8) { _Pragma("unroll") for (int k = 0; k < 2; ++k) acc[ai][bj][m][n] = __builtin_bit_cast(f32x4, __builtin_amdgcn_mfma_i32_16x16x64_i8(__builtin_bit_cast(i32x4, Bt[n][k]), __builtin_bit_cast(i32x4, At[m][k]), __builtin_bit_cast(i32x4, acc[ai][bj][m][n]), 0, 0, 0)); } \
            else { const i32x4 b_lo = __builtin_bit_cast(i32x4, Bt[n][0]), b_hi = __builtin_bit_cast(i32x4, Bt[n][1]), a_lo = __builtin_bit_cast(i32x4, At[m][0]), a_hi = __builtin_bit_cast(i32x4, At[m][1]); \
            acc[ai][bj][m][n] = __builtin_amdgcn_mfma_scale_f32_16x16x128_f8f6f4(__builtin_shufflevector(b_lo, b_hi, 0, 1, 2, 3, 4, 5, 6, 7), __builtin_shufflevector(a_lo, a_hi, 0, 1, 2, 3, 4, 5, 6, 7), acc[ai][bj][m][n], Epi::FMT, Epi::FMT, 0, Epi::SCALE_B, 0, Epi::SCALE_A); } } \
        else { _Pragma("unroll") for (int k = 0; k < 2; ++k) acc[ai][bj][m][n] = __builtin_amdgcn_mfma_f32_16x16x32_bf16(Bt[n][k], At[m][k], acc[ai][bj][m][n], 0, 0, 0); } } \
        if constexpr (!(DBG & 8)) __builtin_amdgcn_s_setprio(0); } while (0)
#define PG8_WAIT_V(n) asm volatile("s_waitcnt vmcnt(" #n ")" ::: "memory")
#define PG8_WAIT_L(n) asm volatile("s_waitcnt lgkmcnt(" #n ")" ::: "memory")
#define PG8_BAR __builtin_amdgcn_s_barrier()
#define PG8_SCHED __builtin_amdgcn_sched_barrier(0)
    Unit cur, nxt; int ui = 0;
    if (!S.next(0, cur)) return;
    f32x4 acc[2][2][4][2];
#pragma unroll
    for (int a = 0; a < 2; ++a)
#pragma unroll
        for (int b = 0; b < 2; ++b)
#pragma unroll
            for (int m = 0; m < 4; ++m)
#pragma unroll
                for (int n = 0; n < 2; ++n) acc[a][b][m][n] = (f32x4){0.f, 0.f, 0.f, 0.f};
    bf16x8 At[4][2], B0[2][2], B1[2][2];
    const char* cA = (const char*)g.A + (size_t)cur.pm * tstepA; const char* cB = (const char*)g.Bt + (size_t)cur.pn * tstepB;
    S.a_ready(cur);
    if constexpr (SP2) {
        PG8_STAGE(PG8_SB(0, 0), cB, voffB); PG8_STAGE(PG8_SB(0, 1), cB + hstepB, voffB); PG8_STAGE(PG8_SA(0, 0), cA, voffA); PG8_STAGE(PG8_SA(0, 1), cA + hstepA, voffA);
        if (wr == 1) PG8_BAR;
        PG8_WAIT_V(2); PG8_BAR;
        PG8_STAGE(PG8_SB(1, 0), cB + kstep, voffB); PG8_STAGE(PG8_SA(1, 0), cA + kstep, voffA); PG8_STAGE(PG8_SB(1, 1), cB + hstepB + kstep, voffB);
        PG8_WAIT_V(6); PG8_BAR;
    } else {
        PG8_STAGE(PG8_SB(0, 0), cB, voffB); PG8_STAGE(PG8_SA(0, 0), cA, voffA); PG8_STAGE(PG8_SB(0, 1), cB + hstepB, voffB); PG8_STAGE(PG8_SA(0, 1), cA + hstepA, voffA);
        if (wr == 1) PG8_BAR;
        PG8_WAIT_V(4); PG8_BAR;
        PG8_STAGE(PG8_SB(1, 0), cB + kstep, voffB); PG8_STAGE(PG8_SA(1, 0), cA + kstep, voffA); PG8_STAGE(PG8_SB(1, 1), cB + hstepB + kstep, voffB);
        PG8_WAIT_V(6); PG8_BAR;
    }
    for (;;) {
        const bool has_next = S.next(ui + 1, nxt);
        const char* nA = has_next ? (const char*)g.A + (size_t)nxt.pm * tstepA : cA; const char* nB = has_next ? (const char*)g.Bt + (size_t)nxt.pn * tstepB : cB;
#pragma clang loop unroll(disable)
        for (int t = 0; t < nt; t += 2) {
            const bool last = (t == nt - 2);
            const char* a1 = cA + (size_t)(t + 1) * kstep;
            const char* a2 = last ? nA : cA + (size_t)(t + 2) * kstep; const char* b2 = last ? nB : cB + (size_t)(t + 2) * kstep;
            const char* a3 = a2 + kstep; const char* b3 = b2 + kstep;
            if (last && has_next) S.a_ready(nxt);
            if constexpr (SP2) {
            const bool post_epi = EPIWAIT && (t == 0) && (ui > 0);
            PG8_LDB(B0, 0, 0); PG8_LDB(B1, 0, 1); PG8_SCHED; PG8_LDA(At, 0, 0); PG8_STAGE(PG8_SA(1, 1), a1 + hstepA, voffA);
            if (post_epi) asm volatile("s_waitcnt vmcnt(%0)" :: "n"(8 + Epi::NST) : "memory"); else PG8_WAIT_V(8);
            PG8_WAIT_L(0); PG8_BAR; PG8_MMA(0, 0, At, B0); PG8_MMA(0, 1, At, B1); PG8_BAR; PG8_SCHED;
            PG8_LDA(At, 0, 1); PG8_STAGE(PG8_SB(0, 0), b2, voffB); PG8_STAGE(PG8_SB(0, 1), b2 + hstepB, voffB); PG8_STAGE(PG8_SA(0, 0), a2, voffA);
            if (post_epi) asm volatile("s_waitcnt vmcnt(%0)" :: "n"(8 + Epi::NST) : "memory"); else PG8_WAIT_V(8);
            PG8_WAIT_L(0); PG8_BAR; PG8_MMA(1, 0, At, B0); PG8_MMA(1, 1, At, B1); PG8_BAR; PG8_SCHED;
            PG8_LDB(B0, 1, 0); PG8_LDB(B1, 1, 1); PG8_SCHED; PG8_LDA(At, 1, 0); PG8_STAGE(PG8_SA(0, 1), a2 + hstepA, voffA);
            PG8_WAIT_V(8); PG8_WAIT_L(0); PG8_BAR; PG8_MMA(0, 0, At, B0); PG8_MMA(0, 1, At, B1); PG8_BAR; PG8_SCHED;
            PG8_LDA(At, 1, 1); PG8_STAGE(PG8_SB(1, 0), b3, voffB); PG8_STAGE(PG8_SB(1, 1), b3 + hstepB, voffB); PG8_STAGE(PG8_SA(1, 0), a3, voffA);
            PG8_WAIT_V(8); PG8_WAIT_L(0); PG8_BAR; PG8_MMA(1, 0, At, B0); PG8_MMA(1, 1, At, B1); PG8_BAR; PG8_SCHED;
            } else {
            PG8_LDB(B0, 0, 0); PG8_SCHED; PG8_LDA(At, 0, 0); PG8_STAGE(PG8_SA(1, 1), a1 + hstepA, voffA);
            PG8_WAIT_L(8); PG8_BAR; PG8_WAIT_L(0); PG8_MMA(0, 0, At, B0); PG8_BAR; PG8_SCHED;
            PG8_LDB(B1, 0, 1); PG8_STAGE(PG8_SB(0, 0), b2, voffB);
            PG8_BAR; PG8_WAIT_L(0); PG8_MMA(0, 1, At, B1); PG8_BAR;
            PG8_LDA(At, 0, 1); PG8_STAGE(PG8_SA(0, 0), a2, voffA);
            PG8_BAR; PG8_WAIT_L(0); PG8_MMA(1, 0, At, B0); PG8_BAR; PG8_SCHED;
            PG8_STAGE(PG8_SB(0, 1), b2 + hstepB, voffB);
            PG8_WAIT_V(6); PG8_BAR; PG8_MMA(1, 1, At, B1); PG8_BAR;
            PG8_LDB(B0, 1, 0); PG8_SCHED; PG8_LDA(At, 1, 0); PG8_STAGE(PG8_SA(0, 1), a2 + hstepA, voffA);
            PG8_WAIT_L(8); PG8_BAR; PG8_WAIT_L(0); PG8_MMA(0, 0, At, B0); PG8_BAR; PG8_SCHED;
            PG8_LDB(B1, 1, 1); PG8_STAGE(PG8_SB(1, 0), b3, voffB);
            PG8_BAR; PG8_WAIT_L(0); PG8_MMA(0, 1, At, B1); PG8_BAR;
            PG8_LDA(At, 1, 1); PG8_STAGE(PG8_SA(1, 0), a3, voffA);
            PG8_BAR; PG8_WAIT_L(0); PG8_MMA(1, 0, At, B0); PG8_BAR; PG8_SCHED;
            PG8_STAGE(PG8_SB(1, 1), b3 + hstepB, voffB);
            PG8_WAIT_V(6); PG8_BAR; PG8_MMA(1, 1, At, B1); PG8_BAR;
            }
        }
        if constexpr (ALIGN_EPI) { if (wr == 0) PG8_BAR; }
        { int l2 = threadIdx.x; asm volatile("" : "+v"(l2)); l2 &= 63; E(acc, cur, wr, wc, l2 & 15, l2 >> 4); }
        S.done(cur);
        if (!has_next) break;
#pragma unroll
        for (int a = 0; a < 2; ++a)
#pragma unroll
            for (int b = 0; b < 2; ++b)
#pragma unroll
                for (int m = 0; m < 4; ++m)
#pragma unroll
                    for (int n = 0; n < 2; ++n) acc[a][b][m][n] = (f32x4){0.f, 0.f, 0.f, 0.f};
        cur = nxt; cA = nA; cB = nB; ++ui;
        if constexpr (ALIGN_EPI) { if (wr == 1) PG8_BAR; }
    }
    PG8_WAIT_V(0);
    if constexpr (!ALIGN_EPI) { if (wr == 0) PG8_BAR; }
    PG8_BAR;
#undef PG8_SA
#undef PG8_SB
#undef PG8_STAGE
#undef PG8_LDA
#undef PG8_LDB
#undef PG8_MMA
#undef PG8_WAIT_V
#undef PG8_WAIT_L
#undef PG8_BAR
#undef PG8_SCHED
}
}

#define XB_TMO      128
#define XB_XCNT(j)  (256  + 64 * (j))
#define XB_XSUB(j)  (1280 + 64 * (j))
#define XB_XGEN(j)  (2304 + 64 * (j))
#define XB_TOP      3328
#define XB_TOPGEN   3392
#define XCD_BAR_WORDS 3456
#define XB_SPIN_CAP (1u << 18)
__device__ __forceinline__ unsigned xb_ld(unsigned* p)              { return __hip_atomic_load(p, __ATOMIC_RELAXED, __HIP_MEMORY_SCOPE_AGENT); }
__device__ __forceinline__ unsigned xb_add(unsigned* p, unsigned v) { return __hip_atomic_fetch_add(p, v, __ATOMIC_RELAXED, __HIP_MEMORY_SCOPE_AGENT); }
__device__ __forceinline__ unsigned xb_xcc_id() { return (unsigned)__builtin_amdgcn_s_getreg((3 << 11) | 20) & 0xFu; }
#define XB_SPIN(cond, bar) do { unsigned _sp = 0; while (cond) { __builtin_amdgcn_s_sleep(1); \
    if ((++_sp & 255u) == 0u) { if (xb_ld(&(bar)[XB_TMO])) break; if (_sp > XB_SPIN_CAP) { atomicAdd(&(bar)[XB_TMO], 1u); break; } } } } while (0)
struct XcdBarrier { unsigned* bar; unsigned x; volatile LAS unsigned* st; };
__device__ __forceinline__ XcdBarrier xcd_barrier_post(unsigned* bar, volatile LAS unsigned* st) {
    XcdBarrier b; b.bar = bar; b.x = xb_xcc_id(); b.st = st;
    if (threadIdx.x == 0) (void)xb_add(&bar[XB_XCNT(b.x)], 1u);
    return b;
}
__device__ __forceinline__ void xcd_barrier_complete(unsigned* bar, unsigned x, unsigned& nloc, unsigned& nx) {
    const unsigned G = gridDim.x * gridDim.y * gridDim.z;
    unsigned sum, cnt, mine, sp = 0u;
    for (;;) {
        sum = 0u; cnt = 0u; mine = 0u;
#pragma unroll
        for (unsigned j = 0; j < 16; ++j) { const unsigned c = xb_ld(&bar[XB_XCNT(j)]); sum += c; cnt += (c > 0u) ? 1u : 0u; mine = (j == x) ? c : mine; }
        if (sum == G) break;
        __builtin_amdgcn_s_sleep(1);
        if ((++sp & 255u) == 0u) { if (xb_ld(&bar[XB_TMO])) break; if (sp > XB_SPIN_CAP) { atomicAdd(&bar[XB_TMO], 1u); break; } }
    }
    nloc = mine > 0u ? mine : 1u; nx = cnt > 0u ? cnt : 1u;
}
__device__ __forceinline__ void xcd_barrier(const XcdBarrier& b) {
    asm volatile("s_waitcnt vmcnt(0)" ::: "memory");
    __syncthreads();
    if (threadIdx.x == 0) {
        unsigned* bar = b.bar;
        __builtin_amdgcn_s_waitcnt(0);
        unsigned nloc = b.st[0], nx = b.st[1];
        if (nloc == 0u) { xcd_barrier_complete(bar, b.x, nloc, nx); b.st[0] = nloc; b.st[1] = nx; }
        const unsigned old = xb_add(&bar[XB_XSUB(b.x)], 1u);
        const unsigned gen = old / nloc;
        if (old + 1u == (gen + 1u) * nloc) {
            __builtin_amdgcn_fence(__ATOMIC_RELEASE, "agent");
            asm volatile("s_waitcnt vmcnt(0)" ::: "memory");
            const unsigned og = xb_add(&bar[XB_TOP], 1u);
            const unsigned tg = og / nx;
            if (og + 1u == (tg + 1u) * nx) xb_add(&bar[XB_TOPGEN], 1u);
            else XB_SPIN(xb_ld(&bar[XB_TOPGEN]) == tg, bar);
            __builtin_amdgcn_fence(__ATOMIC_ACQUIRE, "agent");
            xb_add(&bar[XB_XGEN(b.x)], 1u);
            asm volatile("s_waitcnt vmcnt(0)" ::: "memory");
        } else {
            XB_SPIN(xb_ld(&bar[XB_XGEN(b.x)]) == gen, bar);
            __builtin_amdgcn_fence(__ATOMIC_ACQUIRE, "agent");
            asm volatile("s_waitcnt vmcnt(0)" ::: "memory");
        }
    }
    __syncthreads();
}

struct Params { const float* in[24]; float* out; unsigned char* ws; int ph_lo, ph_hi; };
enum { I_X = 0, I_RELB, I_EVNM, I_WIN, I_POOLW, I_POOLS, I_CONVW, I_WOUT, I_EVNF, I_FG, I_FU, I_FD, I_ODNM, I_WQKV, I_BQKV, I_SINK, I_WO, I_BO, I_ODNF, I_ROUTER, I_EG, I_EU, I_ED, I_FINAL };

__device__ __forceinline__ void p0_tile(const float* __restrict__ src, int N, int k0, int n0, bf16_t* __restrict__ dst, int ldd, LAS unsigned char* scr, int lane, const float* __restrict__ gain = nullptr, float scale = 1.0f) {
    const int n4 = (lane & 15) * 4, kp = lane >> 4;
    f32x4 a[8], b[8];
#pragma unroll
    for (int i = 0; i < 8; ++i) { const float* p = src + (size_t)(k0 + 8 * i + 2 * kp) * N + n0 + n4; a[i] = __builtin_nontemporal_load((const f32x4*)p); b[i] = __builtin_nontemporal_load((const f32x4*)(p + N));
        if (gain) { a[i] = a[i] * (gain[k0 + 8 * i + 2 * kp] * scale); b[i] = b[i] * (gain[k0 + 8 * i + 2 * kp + 1] * scale); } else if (scale != 1.0f) { a[i] = a[i] * scale; b[i] = b[i] * scale; } }
#pragma unroll
    for (int i = 0; i < 8; ++i) { const int k = 8 * i + 2 * kp;
#pragma unroll
        for (int q = 0; q < 4; ++q) *(LAS unsigned*)(scr + (n4 + q) * 136 + k * 2) = pk2(a[i][q], b[i][q]); }
    LDS_WAIT();
    const int c = lane & 7, nr = lane >> 3;
#pragma unroll
    for (int j = 0; j < 8; ++j) { const int n = 8 * j + nr; const u32x2 lo = *(const LAS u32x2*)(scr + n * 136 + 16 * c), hi = *(const LAS u32x2*)(scr + n * 136 + 16 * c + 8);
        u32x4 o; o.x = lo.x; o.y = lo.y; o.z = hi.x; o.w = hi.y; *(u32x4*)(dst + (size_t)n * ldd + 8 * c) = o; }
    LDS_WAIT();
}
struct P0WTile { const float* src; unsigned char* dst; int N, ldd, n0, up; float scale; };
__device__ __forceinline__ P0WTile p0w_desc(int t, const float* eg, const float* eu, const float* ed, unsigned char* Wegu8, unsigned char* Wed8) {
    const int e = MOE_GU_FP6 ? t / 112 : t / 336; int q = MOE_GU_FP6 ? 224 + t % 112 : t % 336; P0WTile d;
    if (q < 224) { const int up = q >= 112; if (up) q -= 112; const int kb = q / 14, nb = q % 14;
        d.src = (up ? eu : eg) + (size_t)e * D * DFE + (size_t)(128 * kb) * DFE + 256 * nb; d.N = DFE; d.n0 = 256 * nb; d.up = up; d.dst = Wegu8 + (size_t)e * 2 * DFE * D + 128 * kb; d.ldd = D; d.scale = up ? 64.f : -64.f * 1.44269504089f; }
    else { q -= 224; const int kb = q / 4, nb = q % 4;
        d.src = ed + (size_t)e * DFE * D + (size_t)(128 * kb) * D + 256 * nb; d.N = D; d.n0 = 256 * nb; d.up = -1; d.dst = Wed8 + (size_t)e * D * DFE + 128 * kb; d.ldd = DFE; d.scale = MOE_GU_FP6 ? 64.f * F6_DOWN : -64.f * 0.69314718056f; }
    return d;
}
__device__ __forceinline__ void p0w_load(const P0WTile& d, int wave, int lane, f32x4 (&a)[16]) {
#pragma unroll
    for (int r = 0; r < 16; ++r) a[r] = __builtin_nontemporal_load((const f32x4*)(d.src + (size_t)(16 * wave + r) * d.N + 4 * lane));
}
__device__ __forceinline__ void p0w_to_lds(const f32x4 (&a)[16], LAS unsigned char* buf, int wave, int lane, float scale) {
#pragma unroll
    for (int i = 0; i < 4; ++i)
#pragma unroll
        for (int q = 0; q < 4; ++q) { const int n = 4 * lane + q, c = 4 * wave + i;
            *(LAS unsigned*)(buf + n * 128 + 4 * (c ^ (4 * ((n >> 2) & 7)))) = pg8::pk4_fp8(a[4 * i][q] * scale, a[4 * i + 1][q] * scale, a[4 * i + 2][q] * scale, a[4 * i + 3][q] * scale); }
}
__device__ __forceinline__ void p0w_store(const P0WTile& d, const LAS unsigned char* buf, int wave, int lane) {
    const int pc = lane & 7;
#pragma unroll
    for (int j = 0; j < 4; ++j) { const int n = 32 * wave + 8 * j + (lane >> 3); const u32x4 v = *(const LAS u32x4*)(buf + n * 128 + 16 * (pc ^ ((n >> 2) & 7)));
        const int ng = d.n0 + n; const int row = d.up >= 0 ? (ng >> 7) * 256 + (ng & 127) + 128 * d.up : ng;
        __builtin_nontemporal_store(v, (u32x4*)(d.dst + (size_t)row * d.ldd + 16 * pc)); }
}
struct P0W6 { const float* src; unsigned char* dst; int n0, up; float scale; };
__device__ __forceinline__ P0W6 p0w6_desc(int t, const float* eg, const float* eu, unsigned char* Wegu8) {
    const int e = t / 224; int q = t % 224; const int up = q >= 112; if (up) q -= 112; const int kb = q / 28, nb = q % 28; P0W6 d;
    d.src = (up ? eu : eg) + (size_t)e * D * DFE + (size_t)(256 * kb) * DFE + 128 * nb; d.n0 = 128 * nb; d.up = up; d.dst = Wegu8 + (size_t)e * 2 * DFE * D + 256 * kb; d.scale = up ? F6_W : -F6_W;
    return d;
}
__device__ __forceinline__ void p0w6_load(const P0W6& d, int wave, int lane, f32x2 (&a)[32]) {
#pragma unroll
    for (int r = 0; r < 32; ++r) a[r] = __builtin_nontemporal_load((const f32x2*)(d.src + (size_t)(32 * wave + r) * DFE + 2 * lane));
}
__device__ __forceinline__ void p0w6_to_lds(const f32x2 (&a)[32], LAS unsigned char* buf, int wave, int lane, float scale) {
    const int off = (wave >> 2) * 128 + 16 * (wave & 3);
#pragma unroll
    for (int h = 0; h < 2; ++h) { unsigned w[16];
#pragma unroll
        for (int i = 0; i < 16; ++i) w[i] = pk2(a[2 * i][h] * scale, a[2 * i + 1][h] * scale);
        const i32x6 P = pk32_fp6(w);
        LAS unsigned char* rowp = buf + (2 * lane + h) * 272 + off;
        *(LAS u32x4*)rowp = (u32x4){(unsigned)P[0], (unsigned)P[1], (unsigned)P[2], (unsigned)P[3]};
        *(LAS u32x4*)(rowp + 64) = (u32x4){(unsigned)P[4], (unsigned)P[5], 0u, 0u}; }
}
__device__ __forceinline__ void p0w6_store(const P0W6& d, const LAS unsigned char* buf, int tid) {
    const int row = tid >> 2, seg = tid & 3; const int ng = d.n0 + row; const int drow = (ng >> 7) * 256 + (ng & 127) + 128 * d.up;
#pragma unroll
    for (int j = 0; j < 4; ++j) __builtin_nontemporal_store(*(const LAS u32x4*)(buf + row * 272 + seg * 64 + 16 * j), (u32x4*)(d.dst + (size_t)drow * D + seg * 64 + 16 * j));
}
__device__ __forceinline__ void norm_row_bf16(const float* __restrict__ xrow, const float* __restrict__ gain, bf16_t* __restrict__ orow, int lane, float (&y)[16]) {
    f32x4 v[4];
#pragma unroll
    for (int j = 0; j < 2; ++j) { v[2 * j] = __builtin_nontemporal_load((const f32x4*)(xrow + 512 * j + 8 * lane)); v[2 * j + 1] = __builtin_nontemporal_load((const f32x4*)(xrow + 512 * j + 8 * lane + 4)); }
    float s = 0.f;
#pragma unroll
    for (int j = 0; j < 4; ++j) s += (v[j][0] * v[j][0] + v[j][1] * v[j][1]) + (v[j][2] * v[j][2] + v[j][3] * v[j][3]);
    const float r = 1.0f / sqrtf(wave_sum(s) * (1.0f / D) + RMS_EPS);
#pragma unroll
    for (int j = 0; j < 2; ++j) { const f32x4 g0 = *(const f32x4*)(gain + 512 * j + 8 * lane), g1 = *(const f32x4*)(gain + 512 * j + 8 * lane + 4);
#pragma unroll
        for (int q = 0; q < 4; ++q) { y[8 * j + q] = v[2 * j][q] * r * g0[q]; y[8 * j + 4 + q] = v[2 * j + 1][q] * r * g1[q]; }
        u32x4 w; w.x = pk2(y[8 * j], y[8 * j + 1]); w.y = pk2(y[8 * j + 2], y[8 * j + 3]); w.z = pk2(y[8 * j + 4], y[8 * j + 5]); w.w = pk2(y[8 * j + 6], y[8 * j + 7]);
        *(u32x4*)(orow + 512 * j + 8 * lane) = w; }
}

__device__ __forceinline__ int t5_bucket(int rel) {
    const int n = rel < 0 ? -rel : rel; const int ret = rel > 0 ? 16 : 0;
    int v;
    if (n < 8) v = n; else if (n < 12) v = 8; else if (n < 16) v = 9; else if (n < 23) v = 10; else if (n < 32) v = 11; else if (n < 46) v = 12; else if (n < 64) v = 13; else if (n < 91) v = 14; else v = 15;
    return ret + v;
}

constexpr int AT_KS_STR = 144, AT_VT_STR = 392;
constexpr int AT_L_K = 0, AT_L_VT = 192 * AT_KS_STR, AT_L_BT = AT_L_VT + 64 * AT_VT_STR, AT_L_OST = AT_L_BT + NQH * 256 * 4;
static_assert(AT_L_OST + NWAVES * 32 * 144 <= RING_BYTES, "attention LDS");
__device__ __forceinline__ void attn_qblock(LAS unsigned char* lds, const bf16x8 (&qf)[4], bf16_t* __restrict__ orow0, int head, int qb, int kb_min, float sink, int wave, int lane) {
    const int r32 = lane & 31, hh = lane >> 5;
    const LAS float* bt = (const LAS float*)(lds + AT_L_BT + head * 1024);
    f32x16 st[6];
#pragma unroll
    for (int kb = 0; kb < 6; ++kb) {
#pragma unroll
        for (int e = 0; e < 16; ++e) st[kb][e] = 0.f;
#pragma unroll
        for (int ks = 0; ks < 4; ++ks) { const bf16x8 kf = *(const LAS bf16x8*)(lds + AT_L_K + (kb * 32 + r32) * AT_KS_STR + 32 * ks + 16 * hh);
            st[kb] = __builtin_amdgcn_mfma_f32_32x32x16_bf16(kf, qf[ks], st[kb], 0, 0, 0); } }
    const float sinkl = sink * 1.44269504089f;
    float mx = sinkl;
#pragma unroll
    for (int kb = 0; kb < 6; ++kb) {
        if (kb < kb_min) {
#pragma unroll
            for (int e = 0; e < 16; ++e) st[kb][e] = -1e30f;
        } else {
#pragma unroll
            for (int e = 0; e < 16; e += 2) { const int j = kb * 32 + (e & 3) + 8 * (e >> 2) + 4 * hh; const int idx = j - (qb * 32 + r32) + 63;
                const f32x2 bb = {bt[idx], bt[idx + 1]}; const f32x2 qk = {st[kb][e], st[kb][e + 1]}; const f32x2 sc = qk * (0.125f * 1.44269504089f) + bb;
                st[kb][e] = sc.x; st[kb][e + 1] = sc.y; mx = __builtin_fmaxf(mx, __builtin_fmaxf(sc.x, sc.y)); } } }
    mx = fmaxf(mx, __shfl_xor(mx, 32));
    f32x2 sum2 = {0.f, 0.f};
#pragma unroll
    for (int kb = 0; kb < 6; ++kb)
#pragma unroll
        for (int e = 0; e < 16; e += 2) { const f32x2 d = (f32x2){st[kb][e], st[kb][e + 1]} - mx; f32x2 pe; pe.x = __builtin_amdgcn_exp2f(d.x); pe.y = __builtin_amdgcn_exp2f(d.y); st[kb][e] = pe.x; st[kb][e + 1] = pe.y; sum2 += pe; }
    float sum = sum2.x + sum2.y;
    sum += __shfl_xor(sum, 32);
    const float inv = 1.0f / (sum + __builtin_amdgcn_exp2f(sinkl - mx));
    f32x16 ot[2];
#pragma unroll
    for (int db = 0; db < 2; ++db)
#pragma unroll
        for (int e = 0; e < 16; ++e) ot[db][e] = 0.f;
#pragma unroll
    for (int kb = 0; kb < 6; ++kb)
#pragma unroll
        for (int s = 0; s < 2; ++s) {
            u32x4 pw; pw.x = pk2(st[kb][8 * s], st[kb][8 * s + 1]); pw.y = pk2(st[kb][8 * s + 2], st[kb][8 * s + 3]); pw.z = pk2(st[kb][8 * s + 4], st[kb][8 * s + 5]); pw.w = pk2(st[kb][8 * s + 6], st[kb][8 * s + 7]);
            const bf16x8 pf = __builtin_bit_cast(bf16x8, pw);
#pragma unroll
            for (int db = 0; db < 2; ++db) { const LAS unsigned char* vp = lds + AT_L_VT + (db * 32 + r32) * AT_VT_STR + 2 * (kb * 32 + 16 * s + 4 * hh);
                const u32x2 v0 = *(const LAS u32x2*)vp, v1 = *(const LAS u32x2*)(vp + 16);
                u32x4 vw; vw.x = v0.x; vw.y = v0.y; vw.z = v1.x; vw.w = v1.y;
                ot[db] = __builtin_amdgcn_mfma_f32_32x32x16_bf16(__builtin_bit_cast(bf16x8, vw), pf, ot[db], 0, 0, 0); } }
    LAS unsigned char* ost = lds + AT_L_OST + wave * (32 * 144);
#pragma unroll
    for (int db = 0; db < 2; ++db)
#pragma unroll
        for (int g4 = 0; g4 < 4; ++g4) { u32x2 w; w.x = pk2(ot[db][4 * g4] * inv, ot[db][4 * g4 + 1] * inv); w.y = pk2(ot[db][4 * g4 + 2] * inv, ot[db][4 * g4 + 3] * inv);
            *(LAS u32x2*)(ost + r32 * 144 + 2 * (db * 32 + 8 * g4 + 4 * hh)) = w; }
    LDS_WAIT();
#pragma unroll
    for (int i = 0; i < 4; ++i) { const int q = 8 * i + (lane >> 3), c = lane & 7; const u32x4 w = *(const LAS u32x4*)(ost + q * 144 + 16 * c);
        *(u32x4*)(orow0 + (size_t)q * D + 8 * c) = w; }
    LDS_WAIT();
}

__global__ void __launch_bounds__(NTHR, 2) fwd_kernel(Params p) {
    extern __shared__ __attribute__((aligned(16))) unsigned char lds_raw[];
    LAS unsigned char* lds = (LAS unsigned char*)lds_raw;
    volatile LAS unsigned* MISC = (volatile LAS unsigned*)(lds + LDS_MISC_OFF);
    const int tid = threadIdx.x, lane = tid & 63, wave = __builtin_amdgcn_readfirstlane(tid >> 6);
    const int G = gridDim.x, bx = blockIdx.x;
    const int vcu = (G % 8 == 0) ? (bx % 8) * (G / 8) + bx / 8 : bx;
    const int gw = vcu * NWAVES + wave, NGW = G * NWAVES;
    unsigned char* ws = p.ws;
    unsigned* ctl = (unsigned*)(ws + WS_CTL);
    if (tid < 64) MISC[tid] = 0u;
    __syncthreads();
    XcdBarrier bar; bar.bar = ctl + CW_BAR; bar.x = 0; bar.st = nullptr;
    if (MK_N_LAUNCHES == 1) bar = xcd_barrier_post(ctl + CW_BAR, MISC + 8);
    const int lo = p.ph_lo, hi = p.ph_hi;
#define IN(k) (lo <= (k) && (k) < hi)
    unsigned long long prb_c0 = 0, prb_r0 = 0, prb_c1 = 0, prb_r1 = 0;
#define PRB_BEGIN(k) do { if (PROBE_PH == (k)) { prb_c0 = __builtin_amdgcn_s_memtime(); prb_r0 = __builtin_amdgcn_s_memrealtime(); } } while (0)
#define PRB_END2(k) do { if (PROBE_PH == (k) && PROBE_MODE == 3) { prb_c1 = __builtin_amdgcn_s_memtime(); prb_r1 = __builtin_amdgcn_s_memrealtime(); } } while (0)
#define PRB_END(k) do { if (PROBE_PH == (k) && PROBE_MODE != 3) { prb_c1 = __builtin_amdgcn_s_memtime(); prb_r1 = __builtin_amdgcn_s_memrealtime(); } } while (0)
#define SEAM(k) do { if (MK_N_LAUNCHES == 1 && IN((k) + 1)) xcd_barrier(bar); } while (0)

    bf16_t* Win_t = (bf16_t*)(ws + WS_WIN); bf16_t* Wout_t = (bf16_t*)(ws + WS_WOUT); bf16_t* Wgu_t = (bf16_t*)(ws + WS_WGU); bf16_t* Wd_t = (bf16_t*)(ws + WS_WD);
    bf16_t* Wqkv_t = (bf16_t*)(ws + WS_WQKV); bf16_t* Wo_t = (bf16_t*)(ws + WS_WO); bf16_t* Wegu_t = (bf16_t*)(ws + WS_WEGU); bf16_t* Wed_t = (bf16_t*)(ws + WS_WED);
    bf16_t* XN = (bf16_t*)(ws + WS_XN); bf16_t* PROJ = (bf16_t*)(ws + WS_PROJ); bf16_t* MIXED = (bf16_t*)(ws + WS_MIXED); bf16_t* Hb = (bf16_t*)(ws + WS_H);
    bf16_t* QKV = (bf16_t*)(ws + WS_QKV); bf16_t* AO = (bf16_t*)(ws + WS_AO); bf16_t* HS = (bf16_t*)(ws + WS_HS); bf16_t* H2 = (bf16_t*)(ws + WS_H2);
    float* bias_tab = (float*)(ws + WS_BIAS); int* wgcnt = (int*)(ws + WS_WGCNT); int* tilemeta = (int*)(ws + WS_TILE);
    u32x2* slot_rec = (u32x2*)(ws + WS_SLOTT);
    float* rss = (float*)(ws + WS_RSS);
    float* X = p.out;

    PRB_BEGIN(0);
    if (IN(0)) for (int rep_ = 0; rep_ < NREP(0); ++rep_) {
        const int tid = fresh_tid(), lane = tid & 63;
        LAS unsigned char* scr = lds + wave * 8704;
        constexpr int T_WIN = 16 * 32, T_WOUT = 8 * 16, T_FG = 16 * 44, T_FD = 44 * 16, T_QKV = 16 * 20, T_WO = 16 * 16;
        constexpr int NT = T_WIN + T_WOUT + 2 * T_FG + T_FD + T_QKV + T_WO;
        unsigned char* Wegu8 = (unsigned char*)Wegu_t; unsigned char* Wed8 = (unsigned char*)Wed_t;
        PRB_BEGIN(100);
        {
            constexpr int NTW = MOE_GU_FP6 ? NEXP * 112 : NEXP * 336;
            f32x4 ta[16], tb[16], tc[16]; P0WTile da{}, db{}, dc{};
            int t = bx; int pb = 0;
#define P0W_LOAD(dd, rr, ti) do { if ((ti) < NTW) { dd = p0w_desc((ti), p.in[I_EG], p.in[I_EU], p.in[I_ED], Wegu8, Wed8); p0w_load(dd, wave, lane, rr); } } while (0)
#define P0W_DRAIN(dd, rr) do { p0w_to_lds(rr, lds + pb * 32768, wave, lane, dd.scale); __syncthreads(); p0w_store(dd, lds + pb * 32768, wave, lane); pb ^= 1; } while (0)
            P0W_LOAD(da, ta, t); P0W_LOAD(db, tb, t + G);
            while (t < NTW) {
                P0W_LOAD(dc, tc, t + 2 * G); P0W_DRAIN(da, ta); if (t + G >= NTW) break;
                P0W_LOAD(da, ta, t + 3 * G); P0W_DRAIN(db, tb); if (t + 2 * G >= NTW) break;
                P0W_LOAD(db, tb, t + 4 * G); P0W_DRAIN(dc, tc);
                t += 3 * G;
            }
#undef P0W_LOAD
#undef P0W_DRAIN
            __syncthreads();
        }
#if MOE_GU_FP6
        {
            constexpr int NT6 = NEXP * 224;
            f32x2 ta[32], tb[32], tc[32]; P0W6 da{}, db{}, dc{};
            int t = bx; int pb = 0;
#define P0W6_LOAD(dd, rr, ti) do { if ((ti) < NT6) { dd = p0w6_desc((ti), p.in[I_EG], p.in[I_EU], Wegu8); p0w6_load(dd, wave, lane, rr); } } while (0)
#define P0W6_DRAIN(dd, rr) do { p0w6_to_lds(rr, lds + pb * 34816, wave, lane, dd.scale); __syncthreads(); p0w6_store(dd, lds + pb * 34816, tid); pb ^= 1; } while (0)
            P0W6_LOAD(da, ta, t); P0W6_LOAD(db, tb, t + G);
            while (t < NT6) {
                P0W6_LOAD(dc, tc, t + 2 * G); P0W6_DRAIN(da, ta); if (t + G >= NT6) break;
                P0W6_LOAD(da, ta, t + 3 * G); P0W6_DRAIN(db, tb); if (t + 2 * G >= NT6) break;
                P0W6_LOAD(db, tb, t + 4 * G); P0W6_DRAIN(dc, tc);
                t += 3 * G;
            }
#undef P0W6_LOAD
#undef P0W6_DRAIN
            __syncthreads();
        }
#endif
        PRB_END(100); PRB_BEGIN(101);
        for (int it = (gw + NGW / 2) % NGW; it < NT; it += NGW) {
            int r = it;
            if (r < T_WIN) { const int kb = r / 32, nb = r % 32; p0_tile(p.in[I_WIN], MIXN, 64 * kb, 64 * nb, Win_t + (size_t)(64 * nb) * D + 64 * kb, D, scr, lane, p.in[I_EVNM]); continue; } r -= T_WIN;
            if (r < T_WOUT) { const int kb = 8 + r / 16, nb = r % 16; p0_tile(p.in[I_WOUT], D, 64 * kb, 64 * nb, Wout_t + (size_t)(64 * nb) * D + 64 * kb, D, scr, lane); continue; } r -= T_WOUT;
            if (r < 2 * T_FG) { const int up = r >= T_FG; const int q = up ? r - T_FG : r; const int kb = q / 44, nb = q % 44, n0 = 64 * nb;
                p0_tile(p.in[up ? I_FU : I_FG], DFF, 64 * kb, n0, Wgu_t + (size_t)((n0 / 128) * 256 + (n0 % 128) + (up ? 128 : 0)) * D + 64 * kb, D, scr, lane, p.in[I_EVNF], up ? 1.0f : -1.44269504089f); continue; } r -= 2 * T_FG;
            if (r < T_FD) { const int kb = r / 16, nb = r % 16; p0_tile(p.in[I_FD], D, 64 * kb, 64 * nb, Wd_t + (size_t)(64 * nb) * DFF + 64 * kb, DFF, scr, lane, nullptr, -0.69314718056f); continue; } r -= T_FD;
            if (r < T_QKV) { const int kb = r / 20, nb = r % 20; p0_tile(p.in[I_WQKV], QKVN, 64 * kb, 64 * nb, Wqkv_t + (size_t)(64 * nb) * D + 64 * kb, D, scr, lane, p.in[I_ODNM]); continue; } r -= T_QKV;
            { const int kb = r / 16, nb = r % 16; p0_tile(p.in[I_WO], D, 64 * kb, 64 * nb, Wo_t + (size_t)(64 * nb) * D + 64 * kb, D, scr, lane); }
        }
        PRB_END(101); PRB_BEGIN(102);
        for (int it = gw; it < 4 * 32 * 16; it += NGW) {
            const int g = it >> 9, cb = (it >> 4) & 31, nb = it & 15; const int n = 64 * nb + lane, c0 = 4 * cb;
            const float* wo = p.in[I_WOUT] + (size_t)(g * 128) * D + n; const float* ps = p.in[I_POOLS] + g * 128; const float* pw = p.in[I_POOLW] + (size_t)(g * 128 + c0) * 128;
            float acc[4] = {0.f, 0.f, 0.f, 0.f};
            for (int d0 = 0; d0 < 128; d0 += 64) {
                float w[64];
#pragma unroll
                for (int j = 0; j < 64; ++j) w[j] = wo[(size_t)(d0 + j) * D];
#pragma unroll
                for (int j = 0; j < 64; ++j) { const float ww = w[j] * ps[d0 + j];
#pragma unroll
                    for (int cc = 0; cc < 4; ++cc) acc[cc] += pw[cc * 128 + d0 + j] * ww; } }
            u32x2 o; o.x = pk2(acc[0], acc[1]); o.y = pk2(acc[2], acc[3]);
            *(u32x2*)(Wout_t + (size_t)n * D + g * 128 + c0) = o;
        }
        PRB_END(102); PRB_BEGIN(103);
        for (int m = gw; m < M; m += NGW) {
            const float* xrow = p.in[I_X] + (size_t)m * D; f32x4 v[4];
#pragma unroll
            for (int j = 0; j < 2; ++j) { v[2 * j] = __builtin_nontemporal_load((const f32x4*)(xrow + 512 * j + 8 * lane)); v[2 * j + 1] = __builtin_nontemporal_load((const f32x4*)(xrow + 512 * j + 8 * lane + 4)); }
            float s2 = 0.f;
#pragma unroll
            for (int j = 0; j < 4; ++j) s2 += (v[j][0] * v[j][0] + v[j][1] * v[j][1]) + (v[j][2] * v[j][2] + v[j][3] * v[j][3]);
            s2 = wave_sum(s2);
#pragma unroll
            for (int j = 0; j < 2; ++j) { u32x4 w; w.x = pk2(v[2 * j][0], v[2 * j][1]); w.y = pk2(v[2 * j][2], v[2 * j][3]); w.z = pk2(v[2 * j + 1][0], v[2 * j + 1][1]); w.w = pk2(v[2 * j + 1][2], v[2 * j + 1][3]);
                *(u32x4*)(XN + (size_t)m * D + 512 * j + 8 * lane) = w; }
            if (lane == 0) *(f32x4*)(rss + (size_t)m * 4) = (f32x4){s2, 0.f, 0.f, 0.f};
        }
        PRB_END(103);
        for (int i = bx * NTHR + tid; i < NQH * 256; i += G * NTHR) { const int h = i >> 8, idx = i & 255; bias_tab[i] = idx < 255 ? p.in[I_RELB][t5_bucket(idx - 191) * NQH + h] : 0.f; }
    }
    PRB_END(0);
    SEAM(0);
    PRB_END2(0);
    PRB_BEGIN(1);

    if (IN(1)) for (int rep_ = 0; rep_ < NREP(1); ++rep_) { pg8::Gemm g{XN, Win_t, 2 * D, 2 * D, 2 * D}; pg8::DenseOrder S; S.init(M, MIXN, G, bx); pg8::EpiBf16 E{PROJ, MIXN, nullptr, rss};
        pg8::gemm_phase<pg8::EpiBf16, pg8::DenseOrder>(lds, g, S, E); }
    PRB_END(1);
    SEAM(1);
    PRB_END2(1);
    PRB_BEGIN(2);

    if (IN(2)) for (int rep_ = 0; rep_ < NREP(2); ++rep_) {
        const int tid = fresh_tid(), lane = tid & 63;
        for (int unit = gw; unit < (M / 32) * 2; unit += NGW) {
            const int rb = unit >> 1, half = unit & 1, r0 = rb * 32, bs = r0 & ~(SEQ - 1);
            if (half == 0) {
                const int w = 2 << (lane >> 4); const bf16_t* P = PROJ + 8 * lane;
                float s[8];
#pragma unroll
                for (int q = 0; q < 8; ++q) s[q] = 0.f;
                for (int j = 1; j <= 16; ++j) if (j <= w && r0 - j >= bs) { float f[8]; unpack8(*(const u32x4*)(P + (size_t)(r0 - j) * MIXN), f);
#pragma unroll
                    for (int q = 0; q < 8; ++q) s[q] += f[q]; }
#pragma unroll 8
                for (int r = r0; r < r0 + 32; ++r) {
                    float cur[8], old[8]; unpack8(*(const u32x4*)(P + (size_t)r * MIXN), cur);
                    const bool has_old = (r - w >= bs);
                    if (has_old) unpack8(*(const u32x4*)(P + (size_t)(r - w) * MIXN), old);
                    const int pos = r - bs + 1; const float inv = 1.0f / (float)(pos < w ? pos : w);
                    float o[8];
#pragma unroll
                    for (int q = 0; q < 8; ++q) { s[q] += cur[q]; if (has_old) s[q] -= old[q]; o[q] = s[q] * inv - cur[q]; }
                    *(u32x4*)(MIXED + (size_t)r * D + 8 * lane) = pack8(o);
                }
            } else {
                const bf16_t* P = PROJ + 8 * lane;
                float w0[8], w1[8], w2[8], z1[8], z2[8];
                { const float* cw = p.in[I_CONVW] + 8 * lane;
#pragma unroll
                  for (int q = 0; q < 8; ++q) { w0[q] = cw[q]; w1[q] = cw[512 + q]; w2[q] = cw[1024 + q]; z1[q] = 0.f; z2[q] = 0.f; } }
                if (r0 - 1 >= bs) { float a[8], b[8]; unpack8(*(const u32x4*)(P + (size_t)(r0 - 1) * MIXN + 1024), a); unpack8(*(const u32x4*)(P + (size_t)(r0 - 1) * MIXN + 1536), b);
#pragma unroll
                    for (int q = 0; q < 8; ++q) z1[q] = a[q] * b[q]; }
                if (r0 - 2 >= bs) { float a[8], b[8]; unpack8(*(const u32x4*)(P + (size_t)(r0 - 2) * MIXN + 1024), a); unpack8(*(const u32x4*)(P + (size_t)(r0 - 2) * MIXN + 1536), b);
#pragma unroll
                    for (int q = 0; q < 8; ++q) z2[q] = a[q] * b[q]; }
#pragma unroll 8
                for (int r = r0; r < r0 + 32; ++r) {
                    float gp[8], a[8], b[8], o[8];
                    unpack8(*(const u32x4*)(P + (size_t)r * MIXN + 512), gp); unpack8(*(const u32x4*)(P + (size_t)r * MIXN + 1024), a); unpack8(*(const u32x4*)(P + (size_t)r * MIXN + 1536), b);
#pragma unroll
                    for (int q = 0; q < 8; ++q) { const float zc = a[q] * b[q]; o[q] = gp[q] * (w0[q] * z2[q] + w1[q] * z1[q] + w2[q] * zc); z2[q] = z1[q]; z1[q] = zc; }
                    *(u32x4*)(MIXED + (size_t)r * D + 512 + 8 * lane) = pack8(o);
                }
            }
        }
    }
    PRB_END(2);
    SEAM(2);
    PRB_END2(2);
    PRB_BEGIN(3);

    if (IN(3)) for (int rep_ = 0; rep_ < NREP(3); ++rep_) { pg8::Gemm g{MIXED, Wout_t, 2 * D, 2 * D, 2 * D}; pg8::DenseOrder S; S.init(M, D, G, bx); pg8::EpiResid<false> E{XN, XN, nullptr, rss + (size_t)M * 4, lds + LDS_XTAB_OFF};
        pg8::gemm_phase<pg8::EpiResid<false>, pg8::DenseOrder>(lds, g, S, E); }
    PRB_END(3);
    SEAM(3);
    PRB_END2(3);
    PRB_BEGIN(5);


    if (IN(5)) for (int rep_ = 0; rep_ < NREP(5); ++rep_) { pg8::Gemm g{XN, Wgu_t, 2 * D, 2 * D, 2 * D}; pg8::DenseOrder S; S.init(M, 2 * DFF, G, bx); pg8::EpiSwiGLU E{Hb, DFF, rss + (size_t)M * 4};
        pg8::gemm_phase<pg8::EpiSwiGLU, pg8::DenseOrder>(lds, g, S, E);
#if PROBE_KDBG >= 0
        __syncthreads(); PRB_BEGIN(105);
        { pg8::EpiNull16 E2{(float*)(ws + WS_RSS)}; pg8::gemm_phase<pg8::EpiNull16, pg8::DenseOrder, false, true, true, PROBE_KDBG>(lds, g, S, E2); }
        PRB_END(105);
#endif
    }
    PRB_END(5);
    SEAM(5);
    PRB_END2(5);
    PRB_BEGIN(6);

    if (IN(6)) for (int rep_ = 0; rep_ < NREP(6); ++rep_) { pg8::Gemm g{Hb, Wd_t, 2 * DFF, 2 * DFF, 2 * DFF}; pg8::DenseOrder S; S.init(M, D, G, bx); pg8::EpiResid<false> E{XN, XN, nullptr, rss + (size_t)M * 8, lds + LDS_XTAB_OFF};
        pg8::gemm_phase<pg8::EpiResid<false>, pg8::DenseOrder>(lds, g, S, E); }
    PRB_END(6);
    SEAM(6);
    PRB_END2(6);
    PRB_BEGIN(8);


    if (IN(8)) for (int rep_ = 0; rep_ < NREP(8); ++rep_) { pg8::Gemm g{XN, Wqkv_t, 2 * D, 2 * D, 2 * D}; pg8::DenseOrder S; S.init(M, QKVN, G, bx); pg8::EpiBf16 E{QKV, QKVN, p.in[I_BQKV], rss + (size_t)M * 8};
        pg8::gemm_phase<pg8::EpiBf16, pg8::DenseOrder>(lds, g, S, E); }
    PRB_END(8);
    SEAM(8);
    PRB_END2(8);
    PRB_BEGIN(9);

    if (IN(9)) for (int rep_ = 0; rep_ < NREP(9); ++rep_) {
        const int tid = fresh_tid(), lane = tid & 63;
        for (int i = tid; i < NQH * 256; i += NTHR) *(LAS float*)(lds + AT_L_BT + 4 * i) = bias_tab[i] * 1.44269504089f;
        const int r32 = lane & 31, hh = lane >> 5;
        constexpr int NUNIT = BATCH * (SEQ / CHUNK) * NKVH;
        u32x4 kr[3], vr[3]; bf16x8 qfA[4], qfB[4];
#define AT_KV_LOAD(unit_) do { const int tid_ = fresh_tid(); const int kvh_ = (unit_) & 1, n_ = ((unit_) >> 1) & 255, t0_ = ((unit_) >> 9) * SEQ + n_ * CHUNK; _Pragma("unroll") for (int i = 0; i < 3; ++i) { const int pc = tid_ + i * NTHR, j = pc >> 3, c = pc & 7; \
            kr[i] = (u32x4){0u, 0u, 0u, 0u}; vr[i] = (u32x4){0u, 0u, 0u, 0u}; \
            if (n_ * CHUNK - 128 + j >= 0) { const bf16_t* src = QKV + (size_t)(t0_ - 128 + j) * QKVN + 1024 + kvh_ * HD + 8 * c; kr[i] = *(const u32x4*)src; vr[i] = *(const u32x4*)(src + 128); } } } while (0)
#define AT_Q_LOAD(qf_, unit_, qb_) do { const int l_ = fresh_tid() & 63; const int r32 = l_ & 31, hh = l_ >> 5; const int kvh_ = (unit_) & 1, n_ = ((unit_) >> 1) & 255, t0_ = ((unit_) >> 9) * SEQ + n_ * CHUNK; \
            const bf16_t* qp = QKV + (size_t)(t0_ + (qb_) * 32 + r32) * QKVN + (kvh_ * 8 + wave) * HD + 8 * hh; _Pragma("unroll") for (int ks = 0; ks < 4; ++ks) qf_[ks] = *(const bf16x8*)(qp + 16 * ks); } while (0)
        int unit = vcu;
        if (unit < NUNIT) { AT_KV_LOAD(unit); AT_Q_LOAD(qfA, unit, 0); }
        for (; unit < NUNIT; unit += G) {
            const int kvh = unit & 1, n = (unit >> 1) & 255, b = unit >> 9;
            const int t0 = b * SEQ + n * CHUNK;
            const bool has_next = unit + G < NUNIT;
            __syncthreads();
            const int tid_s = fresh_tid();
#pragma unroll
            for (int i = 0; i < 3; ++i) { const int pc = tid_s + i * NTHR, j = pc >> 3, c = pc & 7;
                *(LAS u32x4*)(lds + AT_L_K + j * AT_KS_STR + 16 * c) = kr[i];
                const unsigned vw[4] = {vr[i].x, vr[i].y, vr[i].z, vr[i].w};
                const bool odd = (j & 1) != 0;
                const unsigned m0 = odd ? vw[2] : vw[0], m1 = odd ? vw[3] : vw[1];
                const unsigned o0 = __shfl_xor(odd ? vw[0] : vw[2], 8), o1 = __shfl_xor(odd ? vw[1] : vw[3], 8);
                const unsigned e0 = odd ? o0 : m0, e1 = odd ? o1 : m1, d0 = odd ? m0 : o0, d1 = odd ? m1 : o1;
                LAS unsigned char* vb = lds + AT_L_VT + (8 * c + (odd ? 4 : 0)) * AT_VT_STR + 2 * (j & ~1);
                *(LAS unsigned*)(vb + 0 * AT_VT_STR) = (e0 & 0xffffu) | (d0 << 16);
                *(LAS unsigned*)(vb + 1 * AT_VT_STR) = (e0 >> 16) | (d0 & 0xffff0000u);
                *(LAS unsigned*)(vb + 2 * AT_VT_STR) = (e1 & 0xffffu) | (d1 << 16);
                *(LAS unsigned*)(vb + 3 * AT_VT_STR) = (e1 >> 16) | (d1 & 0xffff0000u); }
            AT_Q_LOAD(qfB, unit, 1);
            __syncthreads();
            const int head = kvh * 8 + wave;
            const float sink = p.in[I_SINK][head];
            const int kb_min = n == 0 ? 4 : (n == 1 ? 2 : 0);
            attn_qblock(lds, qfA, AO + (size_t)t0 * D + head * HD, head, 0, kb_min, sink, wave, fresh_tid() & 63);
            if (has_next) { AT_KV_LOAD(unit + G); AT_Q_LOAD(qfA, unit + G, 0); }
            attn_qblock(lds, qfB, AO + (size_t)(t0 + 32) * D + head * HD, head, 1, kb_min, sink, wave, fresh_tid() & 63);
        }
#undef AT_KV_LOAD
#undef AT_Q_LOAD
        __syncthreads();
    }
    PRB_END(9);
    SEAM(9);
    PRB_END2(9);
    PRB_BEGIN(10);

    if (IN(10)) for (int rep_ = 0; rep_ < NREP(10); ++rep_) { pg8::Gemm g{AO, Wo_t, 2 * D, 2 * D, 2 * D}; pg8::DenseOrder S; S.init(M, D, G, bx); pg8::EpiResid<false> E{XN, XN, p.in[I_BO], nullptr, nullptr};
        pg8::gemm_phase<pg8::EpiResid<false>, pg8::DenseOrder>(lds, g, S, E); }
    PRB_END(10);
    SEAM(10);
    PRB_END2(10);
    PRB_BEGIN(11);

    const int RPW = (M + G - 1) / G;
    constexpr int L_RW = 0, L_RE = 32768, L_RWT = L_RE + 1024 * 4, L_RRK = L_RWT + 1024 * 4, L_CNT = L_RRK + 1024 * 4, L_SB = L_CNT + 64, L_SLOT = L_SB + 256;
    unsigned char* XN8 = (unsigned char*)p.out;
    if (IN(11)) for (int rep_ = 0; rep_ < NREP(11); ++rep_) {
        const int tid = fresh_tid(), lane = tid & 63;
        if (tid < 8) *(LAS int*)(lds + L_CNT + 4 * tid) = 0;
        const int rbase = bx * RPW;
        const int nrows = (M - rbase) < RPW ? (M - rbase) : RPW;
        f32x4 gn[4], wA[4][4], wB[4][4];
#pragma unroll
        for (int j = 0; j < 4; ++j) { gn[j] = *(const f32x4*)(p.in[I_ODNF] + 16 * lane + 4 * j);
#pragma unroll
            for (int q = 0; q < 4; ++q) { const float* wr = p.in[I_ROUTER] + (size_t)(16 * lane + 4 * j + q) * NEXP; wA[j][q] = *(const f32x4*)wr * gn[j][q]; wB[j][q] = *(const f32x4*)(wr + 4) * gn[j][q]; } }
        const bool h5 = (lane & 32) != 0, h4 = (lane & 16) != 0, h3 = (lane & 8) != 0;
        for (int rl0 = wave; rl0 < nrows; rl0 += 4 * NWAVES) {
            u32x4 pv[4][2];
#pragma unroll
            for (int u = 0; u < 4; ++u) { const int rl = rl0 + 8 * u; const int m = rbase + (rl < nrows ? rl : rl0);
#pragma unroll
                for (int hq = 0; hq < 2; ++hq) pv[u][hq] = __builtin_nontemporal_load((const u32x4*)(XN + (size_t)m * D + 16 * lane + 8 * hq)); }
#pragma unroll
            for (int u = 0; u < 4; ++u) { const int rl = rl0 + 8 * u; if (rl >= nrows) continue; const int m = rbase + rl;
                f32x4 x[4];
#pragma unroll
                for (int hq = 0; hq < 2; ++hq) { x[2 * hq] = (f32x4){bf_lo(pv[u][hq].x), bf_hi(pv[u][hq].x), bf_lo(pv[u][hq].y), bf_hi(pv[u][hq].y)}; x[2 * hq + 1] = (f32x4){bf_lo(pv[u][hq].z), bf_hi(pv[u][hq].z), bf_lo(pv[u][hq].w), bf_hi(pv[u][hq].w)}; }
                float s2 = 0.f; f32x4 la = {0.f, 0.f, 0.f, 0.f}, lb = {0.f, 0.f, 0.f, 0.f};
#pragma unroll
                for (int j = 0; j < 4; ++j) { s2 += (x[j][0] * x[j][0] + x[j][1] * x[j][1]) + (x[j][2] * x[j][2] + x[j][3] * x[j][3]);
#pragma unroll
                    for (int q = 0; q < 4; ++q) { la += wA[j][q] * x[j][q]; lb += wB[j][q] * x[j][q]; } }
                const float r = 1.0f / sqrtf(wave_sum(s2) * (1.0f / D) + RMS_EPS);
#if MOE_GU_FP6
                { unsigned own[8], w[16];
#pragma unroll
                  for (int j = 0; j < 4; ++j) { const f32x4 y = x[j] * (r * F6_ACT) * gn[j]; own[2 * j] = pk2(y[0], y[1]); own[2 * j + 1] = pk2(y[2], y[3]); }
                  const bool oddl = (lane & 1) != 0;
#pragma unroll
                  for (int i = 0; i < 8; ++i) { const unsigned pt = __shfl_xor(own[i], 1); w[i] = oddl ? pt : own[i]; w[8 + i] = oddl ? own[i] : pt; }
                  const i32x6 P = pk32_fp6(w);
                  const int pg = lane >> 1; unsigned char* gp = XN8 + (size_t)m * D + 128 * (pg >> 2) + 16 * (pg & 3) + (oddl ? 64 : 0);
                  *(u32x4*)gp = oddl ? (u32x4){(unsigned)P[4], (unsigned)P[5], 0u, 0u} : (u32x4){(unsigned)P[0], (unsigned)P[1], (unsigned)P[2], (unsigned)P[3]}; }
#else
                { u32x4 o;
                  { const f32x4 y = x[0] * r * gn[0]; o.x = pg8::pk4_fp8(y[0], y[1], y[2], y[3]); } { const f32x4 y = x[1] * r * gn[1]; o.y = pg8::pk4_fp8(y[0], y[1], y[2], y[3]); }
                  { const f32x4 y = x[2] * r * gn[2]; o.z = pg8::pk4_fp8(y[0], y[1], y[2], y[3]); } { const f32x4 y = x[3] * r * gn[3]; o.w = pg8::pk4_fp8(y[0], y[1], y[2], y[3]); }
                  *(u32x4*)(XN8 + (size_t)m * D + 16 * lane) = o; }
#endif
                float t4[4], s4[4];
#pragma unroll
                for (int i = 0; i < 4; ++i) { t4[i] = h5 ? lb[i] : la[i]; s4[i] = h5 ? la[i] : lb[i]; }
#pragma unroll
                for (int i = 0; i < 4; ++i) t4[i] += __shfl_xor(s4[i], 32);
                float t2[2], s2b[2];
#pragma unroll
                for (int i = 0; i < 2; ++i) { t2[i] = h4 ? t4[i + 2] : t4[i]; s2b[i] = h4 ? t4[i] : t4[i + 2]; }
#pragma unroll
                for (int i = 0; i < 2; ++i) t2[i] += __shfl_xor(s2b[i], 16);
                float t1 = h3 ? t2[1] : t2[0]; const float s1 = h3 ? t2[0] : t2[1];
                t1 += __shfl_xor(s1, 8); t1 += __shfl_xor(t1, 4); t1 += __shfl_xor(t1, 2); t1 += __shfl_xor(t1, 1);
                float lg[8];
#pragma unroll
                for (int e = 0; e < 8; ++e) lg[e] = __int_as_float(__builtin_amdgcn_readlane(__float_as_int(t1), 8 * e)) * r;
                int e0 = 0; float v0 = lg[0];
#pragma unroll
                for (int e = 1; e < 8; ++e) if (lg[e] > v0) { v0 = lg[e]; e0 = e; }
                int e1 = -1; float v1 = -3.0e38f;
#pragma unroll
                for (int e = 0; e < 8; ++e) if (e != e0 && lg[e] > v1) { v1 = lg[e]; e1 = e; }
                const float wt0 = 1.0f / (1.0f + __expf(v1 - v0));
                if (lane == 0) { *(LAS int*)(lds + L_RE + 8 * rl) = e0; *(LAS int*)(lds + L_RE + 8 * rl + 4) = e1; *(LAS float*)(lds + L_RWT + 8 * rl) = wt0; *(LAS float*)(lds + L_RWT + 8 * rl + 4) = 1.0f - wt0; }
            }
        }
        __syncthreads();
        { LAS int* wcnt = (LAS int*)(lds + L_SLOT);
          const int nent = 2 * nrows, nchunk = (nent + 63) >> 6;
          int rloc[2] = {0, 0}, emine[2] = {-1, -1};
#pragma unroll
          for (int cc = 0; cc < 2; ++cc) { const int chunk = wave + 8 * cc; if (chunk < nchunk) { const int en = chunk * 64 + lane; const int e = en < nent ? *(LAS int*)(lds + L_RE + 4 * en) : -1; emine[cc] = e;
#pragma unroll
              for (int ex = 0; ex < 8; ++ex) { const unsigned long long mk = __ballot(e == ex); if (e == ex) rloc[cc] = __popcll(mk & ((1ull << lane) - 1ull)); if (lane == 0) wcnt[chunk * 8 + ex] = __popcll(mk); } } }
          __syncthreads();
#pragma unroll
          for (int cc = 0; cc < 2; ++cc) { const int chunk = wave + 8 * cc; const int en = chunk * 64 + lane; if (chunk < nchunk && en < nent) { const int e = emine[cc]; int r = rloc[cc]; for (int c2 = 0; c2 < chunk; ++c2) r += wcnt[c2 * 8 + e]; *(LAS int*)(lds + L_RRK + 4 * en) = r; } }
          if (tid < 8) { int c = 0; for (int c2 = 0; c2 < nchunk; ++c2) c += wcnt[c2 * 8 + tid]; *(LAS int*)(lds + L_CNT + 4 * tid) = c; }
        }
        __syncthreads();
        if (tid < 8) wgcnt[bx * 8 + tid] = *(LAS int*)(lds + L_CNT + 4 * tid);
        __syncthreads();
    }
    PRB_END(11);
    SEAM(11);
    PRB_END2(11);
    PRB_BEGIN(12);

    if (IN(12)) for (int rep_ = 0; rep_ < NREP(12); ++rep_) {
        const int tid = fresh_tid(), lane = tid & 63;
        LAS int* sb = (LAS int*)(lds + L_SB);
        if (tid < 32) sb[tid] = 0;
        __syncthreads();
        for (int i = tid; i < G * 2; i += NTHR) { const int w = i >> 1, h4 = (i & 1) * 4; const u32x4 c = *(const u32x4*)(wgcnt + w * 8 + h4); const unsigned cv[4] = {c.x, c.y, c.z, c.w};
#pragma unroll
            for (int q = 0; q < 4; ++q) { __hip_atomic_fetch_add(sb + 16 + h4 + q, (int)cv[q], __ATOMIC_RELAXED, __HIP_MEMORY_SCOPE_WORKGROUP); if (w < bx) __hip_atomic_fetch_add(sb + 8 + h4 + q, (int)cv[q], __ATOMIC_RELAXED, __HIP_MEMORY_SCOPE_WORKGROUP); } }
        __syncthreads();
        if (tid == 0) { int base = 0; for (int e = 0; e < 8; ++e) { sb[e] = base; base += (sb[16 + e] + 255) & ~255; } sb[24] = base; }
        __syncthreads();
        const int rbase = bx * RPW;
        const int nrows = (M - rbase) < RPW ? (M - rbase) : RPW;
        unsigned char* HS8 = (unsigned char*)HS; int* tslot = (int*)(p.ws + WS_TSLOT);
        for (int en = tid; en < 2 * nrows; en += NTHR) { const int e = *(LAS int*)(lds + L_RE + 4 * en); const int slot = sb[e] + sb[8 + e] + *(LAS int*)(lds + L_RRK + 4 * en);
            *(LAS int*)(lds + L_SLOT + 4 * en) = slot; tslot[(en & 1) * M + rbase + (en >> 1)] = slot; u32x2 rec; rec.x = (unsigned)(2 * (rbase + (en >> 1)) + (en & 1)); rec.y = *(LAS unsigned*)(lds + L_RWT + 4 * en); slot_rec[slot] = rec; }
        __syncthreads();
        for (int en0 = wave; en0 < 2 * nrows; en0 += 4 * NWAVES) {
            u32x4 t[4];
#pragma unroll
            for (int u = 0; u < 4; ++u) { const int en = en0 + 8 * u; if (en < 2 * nrows) t[u] = *(const u32x4*)(XN8 + (size_t)(rbase + (en >> 1)) * D + 16 * lane); }
#pragma unroll
            for (int u = 0; u < 4; ++u) { const int en = en0 + 8 * u; if (en < 2 * nrows) *(u32x4*)(HS8 + (size_t)(*(LAS int*)(lds + L_SLOT + 4 * en)) * D + 16 * lane) = t[u]; } }
        if (bx == 0) {
            for (int e = 0; e < 8; ++e) { const int b0 = sb[e] + sb[16 + e], b1 = sb[e] + ((sb[16 + e] + 255) & ~255); for (int i = b0 + tid; i < b1; i += NTHR) { u32x2 rec; rec.x = 0xffffffffu; rec.y = 0u; slot_rec[i] = rec; } }
            const int nt_all = sb[24] >> 8;
            for (int j = tid; j < nt_all; j += NTHR) { int e = 0; for (int q = 1; q < 8; ++q) if ((j << 8) >= sb[q]) e = q; tilemeta[8 + j] = e; }
            if (tid == 0) { tilemeta[0] = nt_all; tilemeta[1] = nt_all; }
        }
        __syncthreads();
    }
    PRB_END(12);
    SEAM(12);
    PRB_END2(12);
    PRB_BEGIN(13);

    if (IN(13) || IN(14)) {
        const int tid = fresh_tid();
        for (int j = tid; j < 288; j += NTHR) *(LAS int*)(lds + LDS_TILE_OFF + 4 * j) = (j < MAXTILES + 8) ? tilemeta[j] : 0;
        __syncthreads();
    }
    const LAS int* tmeta = (const LAS int*)(lds + LDS_TILE_OFF);
    if (IN(13)) for (int rep_ = 0; rep_ < NREP(13); ++rep_) {
        const int nall = __builtin_amdgcn_readfirstlane(tmeta[0]);
        pg8::Gemm g{HS, Wegu_t, D, D, D}; pg8::MoeOrder S; S.T.init(nall, NFE_T, G, bx); S.tpe = NFE_T; S.tile_e = tmeta + 8;
        pg8::EpiSwiGLU8 E{(unsigned char*)H2, DFE};
        pg8::gemm_phase<pg8::EpiSwiGLU8, pg8::MoeOrder, true>(lds, g, S, E);
#if PROBE_K8 >= 0
        __syncthreads(); PRB_BEGIN(113);
        { pg8::EpiNull8<PROBE_K8_FMT> E2{(float*)(ws + WS_RSS)}; pg8::gemm_phase<pg8::EpiNull8<PROBE_K8_FMT>, pg8::MoeOrder, true, true, true, PROBE_K8>(lds, g, S, E2); }
        PRB_END(113);
#endif
    }
    PRB_END(13);
    SEAM(13);
    PRB_END2(13);
    PRB_BEGIN(14);
    const int TAILMODE = (G == 256);
    if (IN(14)) {
        const int nall = __builtin_amdgcn_readfirstlane(tmeta[0]);
        const int nfull = (TAILMODE && nall > 256) ? 256 : nall;
        { pg8::Gemm g{H2, Wed_t, DFE, DFE, DFE}; pg8::MoeOrder S; S.T.init(nfull, D / 256, G, bx); S.tpe = D / 256; S.tile_e = tmeta + 8;
          pg8::EpiMoeDown E{(bf16_t*)(p.ws + WS_Y0), (const u32x2*)(p.ws + WS_SLOTT)};
          pg8::gemm_phase<pg8::EpiMoeDown, pg8::MoeOrder, true>(lds, g, S, E); }
        const int nall2 = __builtin_amdgcn_readfirstlane(tmeta[0]);
        const int nfull2 = (TAILMODE && nall2 > 256) ? 256 : nall2;
        if (nall2 > nfull2) {
            const int R = 4 * (nall2 - nfull2); const int NSL = (256 / R) < 14 ? (256 / R) : 14;
            const int c = bx, uidx = c / NSL, sl = c - uidx * NSL;
            const int p0 = 14 * sl / NSL, p1 = 14 * (sl + 1) / NSL;
            pg8::SingleOrder S; S.has = (uidx < R) && (p1 > p0); S.pm = nfull2 + (uidx >> 2); S.rm = S.pm; S.cn = uidx & 3;
            S.pn = __builtin_amdgcn_readfirstlane(tmeta[8 + (S.has ? S.pm : 0)]) * (D / 256) + S.cn;
            pg8::Gemm g{(const unsigned char*)H2 + 256 * p0, (const unsigned char*)Wed_t + 256 * p0, DFE, DFE, 256 * (p1 - p0)};
            pg8::EpiSlab E{(bf16_t*)(p.ws + WS_SLAB) + (size_t)c * 65536, (const u32x2*)(p.ws + WS_SLOTT)};
            pg8::gemm_phase<pg8::EpiSlab, pg8::SingleOrder, true>(lds, g, S, E);
        }
    }
    PRB_END(14);
    SEAM(14);
    PRB_END2(14);
    PRB_BEGIN(15);

    if (IN(15)) {
        const int lane = fresh_tid() & 63;
        const bf16_t* Y0 = (const bf16_t*)(ws + WS_Y0); const bf16_t* Y1 = (const bf16_t*)(ws + WS_Y1); const int* tslot = (const int*)(p.ws + WS_TSLOT); const bf16_t* slabs = (const bf16_t*)(p.ws + WS_SLAB);
        const int nall = tilemeta[0];
        const int nfull = (TAILMODE && nall > 256) ? 256 : nall;
        const int R = 4 * (nall - nfull); const int NSL = R > 0 ? ((256 / R) < 14 ? (256 / R) : 14) : 1;
        for (int m0 = gw; m0 < M; m0 += 2 * NGW) {
            u32x4 xr[2][2], yr[2][2][2]; int slot2[2][2];
#pragma unroll
            for (int rr = 0; rr < 2; ++rr) { const int m = (m0 + rr * NGW < M) ? m0 + rr * NGW : m0;
#pragma unroll
                for (int j = 0; j < 2; ++j) xr[rr][j] = __builtin_nontemporal_load((const u32x4*)(XN + (size_t)m * D + 512 * j + 8 * lane));
#pragma unroll
                for (int k = 0; k < 2; ++k) { slot2[rr][k] = tslot[k * M + m];
#pragma unroll
                    for (int j = 0; j < 2; ++j) yr[rr][k][j] = __builtin_nontemporal_load((const u32x4*)((k ? Y1 : Y0) + (size_t)m * D + 512 * j + 8 * lane)); } }
#pragma unroll
            for (int rr = 0; rr < 2; ++rr) { const int m = m0 + rr * NGW; if (m >= M) continue;
                float* xrow = X + (size_t)m * D; f32x4 v[4];
#pragma unroll
                for (int j = 0; j < 2; ++j) { float fx[8]; unpack8(xr[rr][j], fx); v[2 * j] = (f32x4){fx[0], fx[1], fx[2], fx[3]}; v[2 * j + 1] = (f32x4){fx[4], fx[5], fx[6], fx[7]}; }
#pragma unroll
                for (int k = 0; k < 2; ++k) {
                    const int slot = __builtin_amdgcn_readfirstlane(slot2[rr][k]); const int tile = slot >> 8;
                    if (tile < nfull) {
#pragma unroll
                        for (int j = 0; j < 2; ++j) { float f[8]; unpack8(yr[rr][k][j], f);
#pragma unroll
                            for (int q = 0; q < 4; ++q) { v[2 * j][q] += f[q]; v[2 * j + 1][q] += f[4 + q]; } }
                    } else {
#pragma unroll
                        for (int j = 0; j < 2; ++j) { const int col = 512 * j + 8 * lane; const int uidx = (tile - nfull) * 4 + (col >> 8);
                            const bf16_t* sp = slabs + ((size_t)uidx * NSL) * 65536 + (size_t)(slot & 255) * 256 + (col & 255);
#pragma unroll
                            for (int sb = 0; sb < 14; sb += 7) {
                                u32x4 sv[7];
#pragma unroll
                                for (int i = 0; i < 7; ++i) { const int sl = sb + i; sv[i] = (u32x4){0u, 0u, 0u, 0u}; if (sl < NSL && 14 * (sl + 1) / NSL > 14 * sl / NSL) sv[i] = *(const u32x4*)(sp + (size_t)sl * 65536); }
#pragma unroll
                                for (int i = 0; i < 7; ++i) { float f[8]; unpack8(sv[i], f);
#pragma unroll
                                    for (int q = 0; q < 4; ++q) { v[2 * j][q] += f[q]; v[2 * j + 1][q] += f[4 + q]; } } } }
                    }
                }
                float s2 = 0.f;
#pragma unroll
                for (int j = 0; j < 4; ++j) s2 += (v[j][0] * v[j][0] + v[j][1] * v[j][1]) + (v[j][2] * v[j][2] + v[j][3] * v[j][3]);
                const float r = 1.0f / sqrtf(wave_sum(s2) * (1.0f / D) + RMS_EPS);
#pragma unroll
                for (int j = 0; j < 2; ++j) { const f32x4 g0 = *(const f32x4*)(p.in[I_FINAL] + 512 * j + 8 * lane), g1 = *(const f32x4*)(p.in[I_FINAL] + 512 * j + 8 * lane + 4);
                    __builtin_nontemporal_store(v[2 * j] * r * g0, (f32x4*)(xrow + 512 * j + 8 * lane)); __builtin_nontemporal_store(v[2 * j + 1] * r * g1, (f32x4*)(xrow + 512 * j + 8 * lane + 4)); }
            }
        }
    }
    PRB_END(15);
    if (PROBE_PH >= 0 && bx == 0) {
        const unsigned long long dr = prb_r1 - prb_r0, dc = prb_c1 - prb_c0;
        const unsigned long long spin = (PROBE_MODE == 1) ? (dr ? dc * 10000ull / dr : 0ull) : 8ull * dr;
        const unsigned long long t0 = __builtin_amdgcn_s_memrealtime();
        while (__builtin_amdgcn_s_memrealtime() - t0 < spin) __builtin_amdgcn_s_sleep(8);
    }
#undef IN
#undef SEAM
}

extern "C" void kernel_launch(void* const* d_in, const int* in_sizes, int n_in, void* d_out, int out_size, void* d_ws, size_t ws_size, hipStream_t stream) {
    static int grid = 0;
    if (grid == 0) {
        if (n_in != 24 || in_sizes[0] != M * D || out_size != M * D || ws_size < WS_END) { fprintf(stderr, "kernel_launch: unexpected shapes (n_in %d, in0 %d, out %d, ws %zu < %zu)\n", n_in, n_in > 0 ? in_sizes[0] : -1, out_size, ws_size, (size_t)WS_END); grid = -1; return; }
        int dev = 0, cus = 0, per_cu = 0;
        if (hipGetDevice(&dev) != hipSuccess || hipDeviceGetAttribute(&cus, hipDeviceAttributeMultiprocessorCount, dev) != hipSuccess) { grid = -1; return; }
        if (hipFuncSetAttribute((const void*)fwd_kernel, hipFuncAttributeMaxDynamicSharedMemorySize, LDS_BYTES) != hipSuccess) { fprintf(stderr, "kernel_launch: hipFuncSetAttribute failed\n"); grid = -1; return; }
        if (hipOccupancyMaxActiveBlocksPerMultiprocessor(&per_cu, (const void*)fwd_kernel, NTHR, LDS_BYTES) != hipSuccess || per_cu < 1) fprintf(stderr, "kernel_launch: occupancy query reports %d\n", per_cu);
        (void)hipGetLastError();
        grid = cus < 256 ? cus : 256;
    }
    if (grid < 0) return;
    (void)hipMemsetAsync((char*)d_ws + WS_CTL, 0, CTL_ZERO_BYTES, stream);
    Params a{};
    for (int i = 0; i < 24; ++i) a.in[i] = (const float*)d_in[i];
    a.out = (float*)d_out; a.ws = (unsigned char*)d_ws;
    constexpr int NPH = 16;
    if (MK_N_LAUNCHES == 1) { a.ph_lo = 0; a.ph_hi = NPH; hipLaunchKernelGGL(fwd_kernel, dim3(grid), dim3(NTHR), LDS_BYTES, stream, a); }
    else for (int li = 0; li < NPH; ++li) { a.ph_lo = li; a.ph_hi = li + 1; hipLaunchKernelGGL(fwd_kernel, dim3(grid), dim3(NTHR), LDS_BYTES, stream, a); }
}
```

```cpp
#include <hip/hip_runtime.h>
#include <cstdio>
#include <cstdint>

#ifndef MK_N_LAUNCHES
#define MK_N_LAUNCHES 1
#endif

#ifndef PROBE_PH
#define PROBE_PH -1
#endif
#ifndef PROBE_MODE
#define PROBE_MODE 3
#endif
#ifndef PROBE_KDBG
#define PROBE_KDBG -1
#endif
#ifndef MOE_GU_FP6
#define MOE_GU_FP6 0
#endif
#ifndef PROBE_K8
#define PROBE_K8 -1
#define PROBE_K8_FMT 0
#endif
#ifndef EPIWAIT
#define EPIWAIT 0
#endif
#ifndef REPMASK
#define REPMASK 0u
#endif
#define NREP(k) ((((REPMASK) >> (k)) & 1u) ? 2 : 1)
#define LAS __attribute__((address_space(3)))
#define GAS __attribute__((address_space(1)))
typedef unsigned short bf16_t;
typedef short bf16x8 __attribute__((ext_vector_type(8)));
typedef short s16x4 __attribute__((ext_vector_type(4)));
typedef float f32x2 __attribute__((ext_vector_type(2)));
typedef float f32x4 __attribute__((ext_vector_type(4)));
typedef float f32x16 __attribute__((ext_vector_type(16)));
typedef unsigned u32x2 __attribute__((ext_vector_type(2)));
typedef unsigned u32x4 __attribute__((ext_vector_type(4)));
typedef __bf16 hbf16x2 __attribute__((ext_vector_type(2)));
typedef int i32x4 __attribute__((ext_vector_type(4)));
typedef int i32x8 __attribute__((ext_vector_type(8)));
typedef int i32x6 __attribute__((ext_vector_type(6)));
typedef __bf16 hbf16x32 __attribute__((ext_vector_type(32)));

constexpr int D = 1024, BATCH = 2, SEQ = 16384, M = BATCH * SEQ;
constexpr int MIXN = 2048;
constexpr int DFF = 2816, NFF_T = DFF / 128;
constexpr int QKVN = 1280, NQH = 16, NKVH = 2, HD = 64, CHUNK = 64, KVSPAN = 192;
constexpr int NEXP = 8, DFE = 3584, NFE_T = DFE / 128;
constexpr float RMS_EPS = 1e-6f;
constexpr int MAXSLOT = 67328;
constexpr int MAXTILES = MAXSLOT / 256;
constexpr int NWAVES = 8, NTHR = 512;

constexpr size_t MiB = 1u << 20;
constexpr size_t WS_CTL = 0, CTL_ZERO_BYTES = 1 * MiB;
constexpr size_t WS_BIAS = 1 * MiB;
constexpr size_t WS_WGCNT = WS_BIAS + 16 * 256 * 4;
constexpr size_t WS_TILE = WS_WGCNT + 1024 * 16 * 4;
constexpr size_t WS_SLOTT = WS_TILE + 4096;
constexpr size_t WS_SLOTW = WS_SLOTT + (size_t)MAXSLOT * 4;
constexpr size_t WS_TSLOT = WS_SLOTW + (size_t)MAXSLOT * 4;
static_assert(WS_TSLOT + 2 * (size_t)M * 4 <= 4 * MiB, "route region");
constexpr size_t WS_WIN = 4 * MiB;
constexpr size_t WS_WOUT = WS_WIN + (size_t)MIXN * D * 2;
constexpr size_t WS_WGU = WS_WOUT + (size_t)D * D * 2;
constexpr size_t WS_WD = WS_WGU + (size_t)2 * DFF * D * 2;
constexpr size_t WS_WQKV = WS_WD + (size_t)D * DFF * 2;
constexpr size_t WS_WO = WS_WQKV + (size_t)QKVN * D * 2;
static_assert(WS_WO + (size_t)D * D * 2 <= 31 * MiB, "dense weights");
constexpr size_t WS_WEGU = 31 * MiB;
constexpr size_t WS_WED = WS_WEGU + (size_t)NEXP * 2 * DFE * D;
static_assert(WS_WED + (size_t)NEXP * D * DFE == 115 * MiB, "expert weights");
constexpr size_t WS_XN = 115 * MiB;
constexpr size_t WS_Y0 = 23 * MiB;
static_assert(WS_Y0 + (size_t)M * D * 2 <= WS_WED, "Y0 must not touch the down weights");
constexpr size_t WS_R = 179 * MiB;
constexpr size_t WS_PROJ = WS_R, WS_MIXED = WS_R + (size_t)M * MIXN * 2;
constexpr size_t WS_H = WS_R;
constexpr size_t WS_QKV = WS_R, WS_AO = WS_R + (size_t)M * QKVN * 2;
constexpr size_t WS_Y1 = WS_R;
constexpr size_t WS_HS = WS_R, WS_H2 = WS_R + 66 * MiB;
static_assert((size_t)MAXSLOT * D <= 66 * MiB, "HS");
constexpr size_t WS_END = WS_H2 + (size_t)MAXSLOT * DFE;
constexpr size_t WS_SLAB = 482 * MiB;
static_assert(WS_SLAB >= WS_END && WS_SLAB + 256 * 65536 * 2 <= 543497280ull, "slabs");
constexpr size_t WS_TOP = WS_SLAB + 256 * 65536 * 2;
static_assert(WS_END <= 543497280ull, "workspace");
static_assert(WS_MIXED + (size_t)M * D * 2 <= 543497280ull && WS_H + (size_t)M * DFF * 2 <= 543497280ull, "workspace");

constexpr int CW_BAR = 4096;
constexpr size_t WS_RSS = 480 * MiB;
static_assert(WS_RSS >= WS_END && WS_RSS + 3 * (size_t)M * 4 * 4 <= 543497280ull, "rss");

constexpr int RING_BYTES = 131072;
constexpr int LDS_TILE_OFF = RING_BYTES;
constexpr int LDS_MISC_OFF = RING_BYTES + 2048;
constexpr int LDS_UTAB_OFF = RING_BYTES + 3072;
constexpr int LDS_XTAB_OFF = RING_BYTES + 4096;
constexpr int LDS_BYTES = 147456;

__device__ __forceinline__ unsigned pk2(float lo, float hi) { f32x2 v = {lo, hi}; hbf16x2 b = __builtin_convertvector(v, hbf16x2); return __builtin_bit_cast(unsigned, b); }
__device__ __forceinline__ float bf_lo(unsigned w) { return __uint_as_float(w << 16); }
__device__ __forceinline__ float bf_hi(unsigned w) { return __uint_as_float(w & 0xffff0000u); }
__device__ __forceinline__ void unpack8(const u32x4 w, float (&f)[8]) { f[0] = bf_lo(w.x); f[1] = bf_hi(w.x); f[2] = bf_lo(w.y); f[3] = bf_hi(w.y); f[4] = bf_lo(w.z); f[5] = bf_hi(w.z); f[6] = bf_lo(w.w); f[7] = bf_hi(w.w); }
__device__ __forceinline__ u32x4 pack8(const float (&f)[8]) { u32x4 w; w.x = pk2(f[0], f[1]); w.y = pk2(f[2], f[3]); w.z = pk2(f[4], f[5]); w.w = pk2(f[6], f[7]); return w; }
constexpr float F6_ACT = 1.75f, F6_W = 1.44269504089f * 64.0f / 1.75f, F6_DOWN = -0.48045301392f;
__device__ __forceinline__ i32x6 pk32_fp6(const unsigned (&w)[16]) {
    u32x4 a = {w[0], w[1], w[2], w[3]}, b = {w[4], w[5], w[6], w[7]}, c = {w[8], w[9], w[10], w[11]}, d = {w[12], w[13], w[14], w[15]};
    typedef unsigned u32x16 __attribute__((ext_vector_type(16)));
    const u32x16 all = __builtin_shufflevector(__builtin_shufflevector(a, b, 0, 1, 2, 3, 4, 5, 6, 7), __builtin_shufflevector(c, d, 0, 1, 2, 3, 4, 5, 6, 7), 0, 1, 2, 3, 4, 5, 6, 7, 8, 9, 10, 11, 12, 13, 14, 15);
    return __builtin_amdgcn_cvt_scalef32_pk32_fp6_bf16(__builtin_bit_cast(hbf16x32, all), 1.0f);
}
__device__ __forceinline__ float wave_sum(float v) {
#pragma unroll
    for (int o = 1; o < 64; o <<= 1) v += __shfl_xor(v, o);
    return v;
}
__device__ __forceinline__ int fresh_tid() { int t = threadIdx.x; asm volatile("" : "+v"(t)); return t; }
#define LDS_WAIT() asm volatile("s_waitcnt lgkmcnt(0)" ::: "memory")
#define VM_WAIT() asm volatile("s_waitcnt vmcnt(0)" ::: "memory")

namespace pg8 {
constexpr int BM = 256, BK = 64, HALF = 128, HTB = HALF * BK * 2, STAGE_BYTES = 8 * HTB, NXCD = 8, WGM = 8;
__host__ __device__ __forceinline__ int lds_byte(int r, int c) { const int st = (r >> 4) * 2 + (c >> 5), rr = r & 15, cc = c & 31, ob = rr * 64 + cc * 2; return st * 1024 + (ob ^ (((ob >> 9) & 1) << 5)); }
__host__ __device__ __forceinline__ void stage_rc(int b, int& R, int& C) { const int st = b / 1024, sb = b % 1024, swz = sb ^ (((sb >> 9) & 1) << 5); R = (st >> 1) * 16 + swz / 64; C = (st & 1) * 32 + (swz % 64) / 2; }
__host__ __device__ __forceinline__ int perm32(int rho) { const int n = rho >> 4, i = rho & 15; return 8 * (i >> 2) + 4 * n + (i & 3); }

struct Unit { int pm, pn, rm, cn; };
struct Gemm { const void* A; const void* Bt; int lda, ldb, K; };

struct TileOrder {
    int nM, nN, nwg, G, c;
    __device__ __forceinline__ void init(int nM_, int nN_, int G_, int c_) { nM = nM_; nN = nN_; nwg = nM * nN; G = G_; c = c_; }
    __device__ __forceinline__ bool next(int i, int& m, int& n) const {
        const int L = i * G + c; if (L >= nwg) return false;
        int wgid = L; { const int q = nwg / NXCD, r = nwg % NXCD, xcd = wgid % NXCD, off = wgid / NXCD; wgid = (xcd < r ? xcd * (q + 1) : r * (q + 1) + (xcd - r) * q) + off; }
        const int nig = WGM * nN, gid = wgid / nig, fm = gid * WGM, gsz = (nM - fm) < WGM ? (nM - fm) : WGM;
        m = fm + ((wgid % nig) % gsz); n = (wgid % nig) / gsz; return true;
    }
};
struct DenseOrder {
    TileOrder T; LAS int* tab;
    __device__ __forceinline__ void init(int Mr, int N, int G, int c, LAS int* tab_) { T.init(Mr / BM, N / BM, G, c); tab = tab_; prepare(); }
    __device__ __forceinline__ void prepare() const { const int t = threadIdx.x; if (t < 64) { int m, n; tab[t] = T.next(t, m, n) ? (m | (n << 16)) : -1; } __syncthreads(); }
    __device__ __forceinline__ bool next(int i, Unit& u) const { if (i >= 64) return false; const int v = __builtin_amdgcn_readfirstlane(tab[i]); if (v < 0) return false; u.pm = v & 0xffff; u.pn = v >> 16; u.rm = u.pm; u.cn = u.pn; return true; }
    __device__ __forceinline__ void a_ready(const Unit&) const {}
    __device__ __forceinline__ void done(const Unit&) const {}
};
struct MoeOrder {
    TileOrder T; int tpe; const LAS int* tile_e; LAS int* tab;
    __device__ __forceinline__ void prepare() const { const int t = threadIdx.x; if (t < 64) { int m, n; tab[t] = T.next(t, m, n) ? (m | ((tile_e[m] * tpe + n) << 16)) : -1; } __syncthreads(); }
    __device__ __forceinline__ bool next(int i, Unit& u) const { if (i >= 64) return false; const int v = __builtin_amdgcn_readfirstlane(tab[i]); if (v < 0) return false;
        u.pm = v & 0xffff; u.pn = v >> 16; u.rm = u.pm; u.cn = u.pn % tpe; return true; }
    __device__ __forceinline__ void a_ready(const Unit&) const {}
    __device__ __forceinline__ void done(const Unit&) const {}
};

__device__ __forceinline__ float rms_scale(const float* rss, int row) { if (!rss) return 1.0f; const f32x4 a = *(const f32x4*)(rss + (size_t)row * 4);
    return 1.0f / sqrtf(((a[0] + a[1]) + (a[2] + a[3])) * (1.0f / D) + RMS_EPS); }
struct EpiBf16 {
    static constexpr bool PERM = true; static constexpr int NST = 16;
    bf16_t* O; int ldc; const float* bias; const float* rss;
    __device__ __forceinline__ void operator()(const f32x4 (&acc)[2][2][4][2], const Unit& u, int wr, int wc, int fr, int fq) const {
        const int row0 = u.rm * BM + wr * 64 + fr, col0 = u.cn * BM + wc * 32 + 8 * fq;
        f32x4 bv[2][2];
#pragma unroll
        for (int bj = 0; bj < 2; ++bj)
#pragma unroll
            for (int n = 0; n < 2; ++n) bv[bj][n] = bias ? *(const f32x4*)(bias + col0 + bj * HALF + 4 * n) : (f32x4){0.f, 0.f, 0.f, 0.f};
        float rs[2][4];
#pragma unroll
        for (int ai = 0; ai < 2; ++ai)
#pragma unroll
            for (int m = 0; m < 4; ++m) rs[ai][m] = rms_scale(rss, row0 + ai * HALF + m * 16);
#pragma unroll
        for (int ai = 0; ai < 2; ++ai)
#pragma unroll
            for (int m = 0; m < 4; ++m) { const int row = row0 + ai * HALF + m * 16; bf16_t* rowp = O + (size_t)row * ldc + col0; const float r = rs[ai][m];
#pragma unroll
                for (int bj = 0; bj < 2; ++bj) { const f32x4 v0 = acc[ai][bj][m][0] * r + bv[bj][0], v1 = acc[ai][bj][m][1] * r + bv[bj][1];
                    u32x4 w; w.x = pk2(v0[0], v0[1]); w.y = pk2(v0[2], v0[3]); w.z = pk2(v1[0], v1[1]); w.w = pk2(v1[2], v1[3]);
                    *(u32x4*)(rowp + bj * HALF) = w; } }
    }
};
__device__ __forceinline__ float silu_mul(float g2, float u) { return g2 * u * __builtin_amdgcn_rcpf(1.0f + __builtin_amdgcn_exp2f(g2)); }
struct EpiSwiGLU {
    static constexpr bool PERM = true; static constexpr int NST = 8;
    bf16_t* O; int ldc; const float* rss;
    __device__ __forceinline__ void operator()(const f32x4 (&acc)[2][2][4][2], const Unit& u, int wr, int wc, int fr, int fq) const {
        const int row0 = u.rm * BM + wr * 64 + fr, col0 = u.cn * HALF + wc * 32 + 8 * fq;
        float rs[2][4];
#pragma unroll
        for (int ai = 0; ai < 2; ++ai)
#pragma unroll
            for (int m = 0; m < 4; ++m) rs[ai][m] = rms_scale(rss, row0 + ai * HALF + m * 16);
#pragma unroll
        for (int ai = 0; ai < 2; ++ai)
#pragma unroll
            for (int m = 0; m < 4; ++m) { const int row = row0 + ai * HALF + m * 16; bf16_t* rowp = O + (size_t)row * ldc + col0; const float r = rs[ai][m];
                const f32x4 g0 = acc[ai][0][m][0] * r, g1 = acc[ai][0][m][1] * r, u0 = acc[ai][1][m][0] * r, u1 = acc[ai][1][m][1] * r;
                u32x4 w; w.x = pk2(silu_mul(g0[0], u0[0]), silu_mul(g0[1], u0[1])); w.y = pk2(silu_mul(g0[2], u0[2]), silu_mul(g0[3], u0[3]));
                w.z = pk2(silu_mul(g1[0], u1[0]), silu_mul(g1[1], u1[1])); w.w = pk2(silu_mul(g1[2], u1[2]), silu_mul(g1[3], u1[3]));
                *(u32x4*)rowp = w; }
    }
};
template <bool BASE_F32> struct EpiResid {
    static constexpr bool PERM = true; static constexpr int NST = 16;
    const void* base; bf16_t* xb; const float* bias; float* rss; LAS unsigned char* xlds;
    __device__ __forceinline__ void operator()(const f32x4 (&acc)[2][2][4][2], const Unit& u, int wr, int wc, int fr, int fq) const {
        const int row0 = u.rm * BM + wr * 64 + fr, col0 = u.cn * BM + wc * 32 + 8 * fq;
        f32x4 bv[2][2];
#pragma unroll
        for (int bj = 0; bj < 2; ++bj)
#pragma unroll
            for (int n = 0; n < 2; ++n) bv[bj][n] = bias ? *(const f32x4*)(bias + col0 + bj * HALF + 4 * n) : (f32x4){0.f, 0.f, 0.f, 0.f};
#pragma unroll
        for (int ai = 0; ai < 2; ++ai) {
            f32x4 bs[4][2][2];
#pragma unroll
            for (int m = 0; m < 4; ++m) { const size_t off = (size_t)(row0 + ai * HALF + m * 16) * D + col0;
#pragma unroll
                for (int bj = 0; bj < 2; ++bj) {
                    if constexpr (BASE_F32) { bs[m][bj][0] = *(const f32x4*)((const float*)base + off + bj * HALF); bs[m][bj][1] = *(const f32x4*)((const float*)base + off + bj * HALF + 4); }
                    else { const u32x4 w = *(const u32x4*)((const bf16_t*)base + off + bj * HALF); bs[m][bj][0] = (f32x4){bf_lo(w.x), bf_hi(w.x), bf_lo(w.y), bf_hi(w.y)}; bs[m][bj][1] = (f32x4){bf_lo(w.z), bf_hi(w.z), bf_lo(w.w), bf_hi(w.w)}; } } }
#pragma unroll
            for (int m = 0; m < 4; ++m) { const int row = row0 + ai * HALF + m * 16; const size_t off = (size_t)row * D + col0;
                float ss = 0.f;
#pragma unroll
                for (int bj = 0; bj < 2; ++bj) {
#pragma unroll
                    for (int n = 0; n < 2; ++n) { const f32x4 v = bs[m][bj][n] + acc[ai][bj][m][n] + bv[bj][n]; bs[m][bj][n] = v; ss += (v[0] * v[0] + v[1] * v[1]) + (v[2] * v[2] + v[3] * v[3]); }
                    u32x4 w; w.x = pk2(bs[m][bj][0][0], bs[m][bj][0][1]); w.y = pk2(bs[m][bj][0][2], bs[m][bj][0][3]); w.z = pk2(bs[m][bj][1][0], bs[m][bj][1][1]); w.w = pk2(bs[m][bj][1][2], bs[m][bj][1][3]);
                    *(u32x4*)(xb + off + bj * HALF) = w; }
                if (rss) { ss += __shfl_xor(ss, 16); ss += __shfl_xor(ss, 32); if (fq == 0) *(LAS float*)(xlds + 16 * (wr * 64 + ai * HALF + m * 16 + fr) + 4 * wc) = ss; } }
            asm volatile("" ::: "memory"); }
        if (rss) { asm volatile("s_waitcnt lgkmcnt(0)" ::: "memory"); __builtin_amdgcn_s_barrier(); asm volatile("" ::: "memory");
            const int t = wr * 256 + wc * 64 + fq * 16 + fr;
            if (t < 256) { const f32x4 a = *(const LAS f32x4*)(xlds + 16 * t); rss[(size_t)(u.rm * BM + t) * 4 + u.cn] = (a[0] + a[1]) + (a[2] + a[3]); } }
    }
};
__device__ __forceinline__ unsigned pk4_fp8(float a, float b, float c, float d) {
    int w = __builtin_amdgcn_cvt_pk_fp8_f32(__builtin_amdgcn_fmed3f(a, -448.f, 448.f), __builtin_amdgcn_fmed3f(b, -448.f, 448.f), 0, false);
    w = __builtin_amdgcn_cvt_pk_fp8_f32(__builtin_amdgcn_fmed3f(c, -448.f, 448.f), __builtin_amdgcn_fmed3f(d, -448.f, 448.f), w, true);
    return (unsigned)w;
}
__device__ __forceinline__ unsigned pk4_fp8_raw(float a, float b, float c, float d) {
    int w = __builtin_amdgcn_cvt_pk_fp8_f32(a, b, 0, false); w = __builtin_amdgcn_cvt_pk_fp8_f32(c, d, w, true); return (unsigned)w;
}
constexpr int E8M0_ONE = 0x7f7f7f7f, E8M0_2M6 = 0x79797979;
struct EpiSwiGLU8 {
    static constexpr bool PERM = true; static constexpr int SCALE_A = E8M0_ONE, SCALE_B = E8M0_2M6, FMT = MOE_GU_FP6 ? 2 : 0, NST = 8;
    unsigned char* O; int ldc;
    __device__ __forceinline__ void operator()(const f32x4 (&acc)[2][2][4][2], const Unit& u, int wr, int wc, int fr, int fq) const {
        const int row0 = u.rm * BM + wr * 64 + fr, col0 = u.cn * HALF + wc * 32 + 8 * fq;
#pragma unroll
        for (int ai = 0; ai < 2; ++ai)
#pragma unroll
            for (int m = 0; m < 4; ++m) { unsigned char* rowp = O + (size_t)(row0 + ai * HALF + m * 16) * ldc + col0;
                const f32x4 g0 = acc[ai][0][m][0], g1 = acc[ai][0][m][1], u0 = acc[ai][1][m][0], u1 = acc[ai][1][m][1];
                u32x2 w; w.x = pk4_fp8_raw(silu_mul(g0[0], u0[0]), silu_mul(g0[1], u0[1]), silu_mul(g0[2], u0[2]), silu_mul(g0[3], u0[3]));
                w.y = pk4_fp8_raw(silu_mul(g1[0], u1[0]), silu_mul(g1[1], u1[1]), silu_mul(g1[2], u1[2]), silu_mul(g1[3], u1[3]));
                *(u32x2*)rowp = w; }
    }
};
template <int FMT_> struct EpiNull8 {
    static constexpr bool PERM = true; static constexpr int SCALE_A = E8M0_ONE, SCALE_B = E8M0_2M6, FMT = FMT_, NST = 0;
    float* sink;
    __device__ __forceinline__ void operator()(const f32x4 (&acc)[2][2][4][2], const Unit& u, int wr, int wc, int fr, int fq) const {
        float s = 0.f;
#pragma unroll
        for (int ai = 0; ai < 2; ++ai)
#pragma unroll
            for (int bj = 0; bj < 2; ++bj)
#pragma unroll
                for (int m = 0; m < 4; ++m)
#pragma unroll
                    for (int n = 0; n < 2; ++n) s += (acc[ai][bj][m][n][0] + acc[ai][bj][m][n][1]) + (acc[ai][bj][m][n][2] + acc[ai][bj][m][n][3]);
        if (s == 12345.678f) sink[0] = s;
    }
};
struct EpiNull16 {
    static constexpr bool PERM = true; static constexpr int NST = 0;
    float* sink;
    __device__ __forceinline__ void operator()(const f32x4 (&acc)[2][2][4][2], const Unit& u, int wr, int wc, int fr, int fq) const {
        float s = 0.f;
#pragma unroll
        for (int ai = 0; ai < 2; ++ai)
#pragma unroll
            for (int bj = 0; bj < 2; ++bj)
#pragma unroll
                for (int m = 0; m < 4; ++m)
#pragma unroll
                    for (int n = 0; n < 2; ++n) s += (acc[ai][bj][m][n][0] + acc[ai][bj][m][n][1]) + (acc[ai][bj][m][n][2] + acc[ai][bj][m][n][3]);
        if (s == 12345.678f) sink[0] = s;
    }
};
constexpr long DY1 = ((long)WS_Y1 - (long)WS_Y0) / 2;
struct SingleOrder {
    int has, pm, pn, rm, cn;
    __device__ __forceinline__ bool next(int i, Unit& u) const { if (i != 0 || !has) return false; u.pm = pm; u.pn = pn; u.rm = rm; u.cn = cn; return true; }
    __device__ __forceinline__ void a_ready(const Unit&) const {}
    __device__ __forceinline__ void done(const Unit&) const {}
};
struct EpiSlab {
    static constexpr bool PERM = true; static constexpr int SCALE_A = E8M0_ONE, SCALE_B = E8M0_2M6, FMT = 0, NST = 0;
    bf16_t* slab; const u32x2* slot_rec;
    __device__ __forceinline__ void operator()(const f32x4 (&acc)[2][2][4][2], const Unit& u, int wr, int wc, int fr, int fq) const {
        const int r0 = wr * 64 + fr, c0 = wc * 32 + 8 * fq;
#pragma unroll
        for (int ai = 0; ai < 2; ++ai)
#pragma unroll
            for (int m = 0; m < 4; ++m) { const int rl = r0 + ai * HALF + m * 16; const u32x2 rec = slot_rec[u.rm * BM + rl];
                if ((int)rec.x >= 0) { const float ww = __uint_as_float(rec.y);
#pragma unroll
                    for (int bj = 0; bj < 2; ++bj) { const f32x4 v0 = acc[ai][bj][m][0] * ww, v1 = acc[ai][bj][m][1] * ww;
                        u32x4 o; o.x = pk2(v0[0], v0[1]); o.y = pk2(v0[2], v0[3]); o.z = pk2(v1[0], v1[1]); o.w = pk2(v1[2], v1[3]);
                        *(u32x4*)(slab + rl * 256 + c0 + bj * HALF) = o; } } }
    }
};
struct EpiMoeDown {
    static constexpr bool PERM = true; static constexpr int SCALE_A = E8M0_ONE, SCALE_B = E8M0_2M6, FMT = 0, NST = 8;
    bf16_t* Y0; const u32x2* slot_rec;
    __device__ __forceinline__ void operator()(const f32x4 (&acc)[2][2][4][2], const Unit& u, int wr, int wc, int fr, int fq) const {
        const int row0 = u.rm * BM + wr * 64 + fr, col0 = u.cn * BM + wc * 32 + 8 * fq;
        int meta[2][4]; float w[2][4];
#pragma unroll
        for (int ai = 0; ai < 2; ++ai)
#pragma unroll
            for (int m = 0; m < 4; ++m) { const u32x2 rec = slot_rec[row0 + ai * HALF + m * 16]; meta[ai][m] = (int)rec.x; w[ai][m] = __uint_as_float(rec.y); }
#pragma unroll
        for (int ai = 0; ai < 2; ++ai)
#pragma unroll
            for (int m = 0; m < 4; ++m) { const int mt = meta[ai][m]; const float ww = w[ai][m];
                if (mt >= 0) { const unsigned off = ((mt & 1) ? (unsigned)DY1 : 0u) + (unsigned)(mt >> 1) * D + col0; bf16_t* dst = Y0 + off;
#pragma unroll
                    for (int bj = 0; bj < 2; ++bj) { const f32x4 v0 = acc[ai][bj][m][0] * ww, v1 = acc[ai][bj][m][1] * ww;
                        u32x4 o; o.x = pk2(v0[0], v0[1]); o.y = pk2(v0[2], v0[3]); o.z = pk2(v1[0], v1[1]); o.w = pk2(v1[2], v1[3]);
                        *(u32x4*)(dst + bj * HALF) = o; } } }
    }
};

template <int OFF0> __device__ __forceinline__ void glds_pair(const char* sbase, unsigned voff0, unsigned voff1, unsigned lds_base) {
    asm volatile("s_add_u32 m0, %3, %4\n\ts_nop 0\n\tglobal_load_lds_dwordx4 %0, %2\n\ts_add_u32 m0, %3, %5\n\ts_nop 0\n\tglobal_load_lds_dwordx4 %1, %2"
                 :: "v"(voff0), "v"(voff1), "s"(sbase), "s"(lds_base), "i"(OFF0), "i"(OFF0 + 8192) : "memory", "scc");
}
template <class Epi, class Sched, bool FP8 = false, bool ALIGN_EPI = true, bool SP2 = true, int DBG = 0>
__device__ __forceinline__ void gemm_phase(LAS unsigned char* lds, const Gemm g, const Sched& S, const Epi& E) {
    int tid_o = threadIdx.x; asm volatile("" : "+v"(tid_o));
    const int tid = tid_o, wid = __builtin_amdgcn_readfirstlane(tid >> 6), lane = tid & 63, wr = wid >> 2, wc = wid & 3, fr = lane & 15, fq = lane >> 4;
    const int nt = g.K / (BK * 2);
    unsigned voffA[2], voffB[2];
#pragma unroll
    for (int i = 0; i < 2; ++i) { int R, C; stage_rc(tid * 16 + i * 8192, R, C); const int Rb = Epi::PERM ? ((R & ~31) + perm32(R & 31)) : R;
        voffA[i] = (unsigned)(R * g.lda + C * 2); voffB[i] = (unsigned)(Rb * g.ldb + C * 2); }
    const size_t kstep = (size_t)(BK * 2);
    const size_t hstepA = (size_t)HALF * g.lda, hstepB = (size_t)HALF * g.ldb;
    const size_t tstepA = 2 * hstepA, tstepB = 2 * hstepB;
    const unsigned lds_base = (unsigned)(size_t)lds + (unsigned)wid * 1024u;
    const int aoff = lds_byte(wr * 64 + fr, fq * 8), boff = lds_byte(wc * 32 + fr, fq * 8);
#define PG8_SA(b, h) (((b) * 2 + (h)) * HTB)
#define PG8_SB(b, h) ((4 + (b) * 2 + (h)) * HTB)
#define PG8_STAGE(bufoff, gbase, voff) do { if constexpr (!(DBG & 1)) glds_pair<(bufoff)>((const char*)(gbase), (voff)[0], (voff)[1], lds_base); } while (0)
#define PG8_LDA(dst, b, h) do { if constexpr (!(DBG & 2)) _Pragma("unroll") for (int m = 0; m < 4; ++m) _Pragma("unroll") for (int k = 0; k < 2; ++k) dst[m][k] = *(const LAS bf16x8*)(lds + PG8_SA(b, h) + aoff + m * 2048 + k * 1024); } while (0)
#define PG8_LDB(dst, b, h) do { if constexpr (!(DBG & 2)) _Pragma("unroll") for (int n = 0; n < 2; ++n) _Pragma("unroll") for (int k = 0; k < 2; ++k) dst[n][k] = *(const LAS bf16x8*)(lds + PG8_SB(b, h) + boff + n * 2048 + k * 1024); } while (0)
#define PG8_MMA(ai, bj, At, Bt) do { if constexpr (!(DBG & 8)) __builtin_amdgcn_s_setprio((DBG & 16) ? 3 : 1); if constexpr (!(DBG & 4)) _Pragma("unroll") for (int m = 0; m < 4; ++m) _Pragma("unroll") for (int n = 0; n < 2; ++n) { \
        if constexpr (FP8) { if constexpr (Epi::FMT == 8) { _Pragma("unroll") for (int k = 0; k < 2; ++k) acc[ai][bj][m][n] = __builtin_bit_cast(f32x4, __builtin_amdgcn_mfma_i32_16x16x64_i8(__builtin_bit_cast(i32x4, Bt[n][k]), __builtin_bit_cast(i32x4, At[m][k]), __builtin_bit_cast(i32x4, acc[ai][bj][m][n]), 0, 0, 0)); } \
            else { const i32x4 b_lo = __builtin_bit_cast(i32x4, Bt[n][0]), b_hi = __builtin_bit_cast(i32x4, Bt[n][1]), a_lo = __builtin_bit_cast(i32x4, At[m][0]), a_hi = __builtin_bit_cast(i32x4, At[m][1]); \
            acc[ai][bj][m][n] = __builtin_amdgcn_mfma_scale_f32_16x16x128_f8f6f4(__builtin_shufflevector(b_lo, b_hi, 0, 1, 2, 3, 4, 5, 6, 7), __builtin_shufflevector(a_lo, a_hi, 0, 1, 2, 3, 4, 5, 6, 7), acc[ai][bj][m][n], Epi::FMT, Epi::FMT, 0, Epi::SCALE_B, 0, Epi::SCALE_A); } } \
        else { _Pragma("unroll") for (int k = 0; k < 2; ++k) acc[ai][bj][m][n] = __builtin_amdgcn_mfma_f32_16x16x32_bf16(Bt[n][k], At[m][k], acc[ai][bj][m][n], 0, 0, 0); } } \
        if constexpr (!(DBG & 8)) __builtin_amdgcn_s_setprio(0); } while (0)
#define PG8_WAIT_V(n) asm volatile("s_waitcnt vmcnt(" #n ")" ::: "memory")
#define PG8_WAIT_L(n) asm volatile("s_waitcnt lgkmcnt(" #n ")" ::: "memory")
#define PG8_BAR __builtin_amdgcn_s_barrier()
#define PG8_SCHED __builtin_amdgcn_sched_barrier(0)
    Unit cur, nxt; int ui = 0;
    if (!S.next(0, cur)) return;
    f32x4 acc[2][2][4][2];
#pragma unroll
    for (int a = 0; a < 2; ++a)
#pragma unroll
        for (int b = 0; b < 2; ++b)
#pragma unroll
            for (int m = 0; m < 4; ++m)
#pragma unroll
                for (int n = 0; n < 2; ++n) acc[a][b][m][n] = (f32x4){0.f, 0.f, 0.f, 0.f};
    bf16x8 At[4][2], B0[2][2], B1[2][2];
    const char* cA = (const char*)g.A + (size_t)cur.pm * tstepA; const char* cB = (const char*)g.Bt + (size_t)cur.pn * tstepB;
    S.a_ready(cur);
    if constexpr (SP2) {
        PG8_STAGE(PG8_SB(0, 0), cB, voffB); PG8_STAGE(PG8_SB(0, 1), cB + hstepB, voffB); PG8_STAGE(PG8_SA(0, 0), cA, voffA); PG8_STAGE(PG8_SA(0, 1), cA + hstepA, voffA);
        if (wr == 1) PG8_BAR;
        PG8_WAIT_V(2); PG8_BAR;
        PG8_STAGE(PG8_SB(1, 0), cB + kstep, voffB); PG8_STAGE(PG8_SA(1, 0), cA + kstep, voffA); PG8_STAGE(PG8_SB(1, 1), cB + hstepB + kstep, voffB);
        PG8_WAIT_V(6); PG8_BAR;
    } else {
        PG8_STAGE(PG8_SB(0, 0), cB, voffB); PG8_STAGE(PG8_SA(0, 0), cA, voffA); PG8_STAGE(PG8_SB(0, 1), cB + hstepB, voffB); PG8_STAGE(PG8_SA(0, 1), cA + hstepA, voffA);
        if (wr == 1) PG8_BAR;
        PG8_WAIT_V(4); PG8_BAR;
        PG8_STAGE(PG8_SB(1, 0), cB + kstep, voffB); PG8_STAGE(PG8_SA(1, 0), cA + kstep, voffA); PG8_STAGE(PG8_SB(1, 1), cB + hstepB + kstep, voffB);
        PG8_WAIT_V(6); PG8_BAR;
    }
    for (;;) {
        const bool has_next = S.next(ui + 1, nxt);
        const char* nA = has_next ? (const char*)g.A + (size_t)nxt.pm * tstepA : cA; const char* nB = has_next ? (const char*)g.Bt + (size_t)nxt.pn * tstepB : cB;
#pragma clang loop unroll(disable)
        for (int t = 0; t < nt; t += 2) {
            const bool last = (t == nt - 2);
            const char* a1 = cA + (size_t)(t + 1) * kstep;
            const char* a2 = last ? nA : cA + (size_t)(t + 2) * kstep; const char* b2 = last ? nB : cB + (size_t)(t + 2) * kstep;
            const char* a3 = a2 + kstep; const char* b3 = b2 + kstep;
            if (last && has_next) S.a_ready(nxt);
            if constexpr (SP2) {
            const bool post_epi = EPIWAIT && (t == 0) && (ui > 0);
            PG8_LDB(B0, 0, 0); PG8_LDB(B1, 0, 1); PG8_SCHED; PG8_LDA(At, 0, 0); PG8_STAGE(PG8_SA(1, 1), a1 + hstepA, voffA);
            if (post_epi) asm volatile("s_waitcnt vmcnt(%0)" :: "n"(8 + Epi::NST) : "memory"); else PG8_WAIT_V(8);
            PG8_WAIT_L(0); PG8_BAR; PG8_MMA(0, 0, At, B0); PG8_MMA(0, 1, At, B1); PG8_BAR; PG8_SCHED;
            PG8_LDA(At, 0, 1); PG8_STAGE(PG8_SB(0, 0), b2, voffB); PG8_STAGE(PG8_SB(0, 1), b2 + hstepB, voffB); PG8_STAGE(PG8_SA(0, 0), a2, voffA);
            if (post_epi) asm volatile("s_waitcnt vmcnt(%0)" :: "n"(8 + Epi::NST) : "memory"); else PG8_WAIT_V(8);
            PG8_WAIT_L(0); PG8_BAR; PG8_MMA(1, 0, At, B0); PG8_MMA(1, 1, At, B1); PG8_BAR; PG8_SCHED;
            PG8_LDB(B0, 1, 0); PG8_LDB(B1, 1, 1); PG8_SCHED; PG8_LDA(At, 1, 0); PG8_STAGE(PG8_SA(0, 1), a2 + hstepA, voffA);
            PG8_WAIT_V(8); PG8_WAIT_L(0); PG8_BAR; PG8_MMA(0, 0, At, B0); PG8_MMA(0, 1, At, B1); PG8_BAR; PG8_SCHED;
            PG8_LDA(At, 1, 1); PG8_STAGE(PG8_SB(1, 0), b3, voffB); PG8_STAGE(PG8_SB(1, 1), b3 + hstepB, voffB); PG8_STAGE(PG8_SA(1, 0), a3, voffA);
            PG8_WAIT_V(8); PG8_WAIT_L(0); PG8_BAR; PG8_MMA(1, 0, At, B0); PG8_MMA(1, 1, At, B1); PG8_BAR; PG8_SCHED;
            } else {
            PG8_LDB(B0, 0, 0); PG8_SCHED; PG8_LDA(At, 0, 0); PG8_STAGE(PG8_SA(1, 1), a1 + hstepA, voffA);
            PG8_WAIT_L(8); PG8_BAR; PG8_WAIT_L(0); PG8_MMA(0, 0, At, B0); PG8_BAR; PG8_SCHED;
            PG8_LDB(B1, 0, 1); PG8_STAGE(PG8_SB(0, 0), b2, voffB);
            PG8_BAR; PG8_WAIT_L(0); PG8_MMA(0, 1, At, B1); PG8_BAR;
            PG8_LDA(At, 0, 1); PG8_STAGE(PG8_SA(0, 0), a2, voffA);
            PG8_BAR; PG8_WAIT_L(0); PG8_MMA(1, 0, At, B0); PG8_BAR; PG8_SCHED;
            PG8_STAGE(PG8_SB(0, 1), b2 + hstepB, voffB);
            PG8_WAIT_V(6); PG8_BAR; PG8_MMA(1, 1, At, B1); PG8_BAR;
            PG8_LDB(B0, 1, 0); PG8_SCHED; PG8_LDA(At, 1, 0); PG8_STAGE(PG8_SA(0, 1), a2 + hstepA, voffA);
            PG8_WAIT_L(8); PG8_BAR; PG8_WAIT_L(0); PG8_MMA(0, 0, At, B0); PG8_BAR; PG8_SCHED;
            PG8_LDB(B1, 1, 1); PG8_STAGE(PG8_SB(1, 0), b3, voffB);
            PG8_BAR; PG8_WAIT_L(0); PG8_MMA(0, 1, At, B1); PG8_BAR;
            PG8_LDA(At, 1, 1); PG8_STAGE(PG8_SA(1, 0), a3, voffA);
            PG8_BAR; PG8_WAIT_L(0); PG8_MMA(1, 0, At, B0); PG8_BAR; PG8_SCHED;
            PG8_STAGE(PG8_SB(1, 1), b3 + hstepB, voffB);
            PG8_WAIT_V(6); PG8_BAR; PG8_MMA(1, 1, At, B1); PG8_BAR;
            }
        }
        if constexpr (ALIGN_EPI) { if (wr == 0) PG8_BAR; }
        { int l2 = threadIdx.x; asm volatile("" : "+v"(l2)); l2 &= 63; E(acc, cur, wr, wc, l2 & 15, l2 >> 4); }
        S.done(cur);
        if (!has_next) break;
#pragma unroll
        for (int a = 0; a < 2; ++a)
#pragma unroll
            for (int b = 0; b < 2; ++b)
#pragma unroll
                for (int m = 0; m < 4; ++m)
#pragma unroll
                    for (int n = 0; n < 2; ++n) acc[a][b][m][n] = (f32x4){0.f, 0.f, 0.f, 0.f};
        cur = nxt; cA = nA; cB = nB; ++ui;
        if constexpr (ALIGN_EPI) { if (wr == 1) PG8_BAR; }
    }
    PG8_WAIT_V(0);
    if constexpr (!ALIGN_EPI) { if (wr == 0) PG8_BAR; }
    PG8_BAR;
#undef PG8_SA
#undef PG8_SB
#undef PG8_STAGE
#undef PG8_LDA
#undef PG8_LDB
#undef PG8_MMA
#undef PG8_WAIT_V
#undef PG8_WAIT_L
#undef PG8_BAR
#undef PG8_SCHED
}
}

#define XB_TMO      128
#define XB_XCNT(j)  (256  + 64 * (j))
#define XB_XSUB(j)  (1280 + 64 * (j))
#define XB_XGEN(j)  (2304 + 64 * (j))
#define XB_TOP      3328
#define XB_TOPGEN   3392
#define XCD_BAR_WORDS 3456
#define XB_SPIN_CAP (1u << 18)
__device__ __forceinline__ unsigned xb_ld(unsigned* p)              { return __hip_atomic_load(p, __ATOMIC_RELAXED, __HIP_MEMORY_SCOPE_AGENT); }
__device__ __forceinline__ unsigned xb_add(unsigned* p, unsigned v) { return __hip_atomic_fetch_add(p, v, __ATOMIC_RELAXED, __HIP_MEMORY_SCOPE_AGENT); }
__device__ __forceinline__ unsigned xb_xcc_id() { return (unsigned)__builtin_amdgcn_s_getreg((3 << 11) | 20) & 0xFu; }
#define XB_SPIN(cond, bar) do { unsigned _sp = 0; while (cond) { __builtin_amdgcn_s_sleep(1); \
    if ((++_sp & 255u) == 0u) { if (xb_ld(&(bar)[XB_TMO])) break; if (_sp > XB_SPIN_CAP) { atomicAdd(&(bar)[XB_TMO], 1u); break; } } } } while (0)
struct XcdBarrier { unsigned* bar; unsigned x; volatile LAS unsigned* st; };
__device__ __forceinline__ XcdBarrier xcd_barrier_post(unsigned* bar, volatile LAS unsigned* st) {
    XcdBarrier b; b.bar = bar; b.x = xb_xcc_id(); b.st = st;
    if (threadIdx.x == 0) (void)xb_add(&bar[XB_XCNT(b.x)], 1u);
    return b;
}
__device__ __forceinline__ void xcd_barrier_complete(unsigned* bar, unsigned x, unsigned& nloc, unsigned& nx) {
    const unsigned G = gridDim.x * gridDim.y * gridDim.z;
    unsigned sum, cnt, mine, sp = 0u;
    for (;;) {
        sum = 0u; cnt = 0u; mine = 0u;
#pragma unroll
        for (unsigned j = 0; j < 16; ++j) { const unsigned c = xb_ld(&bar[XB_XCNT(j)]); sum += c; cnt += (c > 0u) ? 1u : 0u; mine = (j == x) ? c : mine; }
        if (sum == G) break;
        __builtin_amdgcn_s_sleep(1);
        if ((++sp & 255u) == 0u) { if (xb_ld(&bar[XB_TMO])) break; if (sp > XB_SPIN_CAP) { atomicAdd(&bar[XB_TMO], 1u); break; } }
    }
    nloc = mine > 0u ? mine : 1u; nx = cnt > 0u ? cnt : 1u;
}
__device__ __forceinline__ void xcd_barrier(const XcdBarrier& b) {
    asm volatile("s_waitcnt vmcnt(0)" ::: "memory");
    __syncthreads();
    if (threadIdx.x == 0) {
        unsigned* bar = b.bar;
        __builtin_amdgcn_s_waitcnt(0);
        unsigned nloc = b.st[0], nx = b.st[1];
        if (nloc == 0u) { xcd_barrier_complete(bar, b.x, nloc, nx); b.st[0] = nloc; b.st[1] = nx; }
        const unsigned old = xb_add(&bar[XB_XSUB(b.x)], 1u);
        const unsigned gen = old / nloc;
        if (old + 1u == (gen + 1u) * nloc) {
            __builtin_amdgcn_fence(__ATOMIC_RELEASE, "agent");
            asm volatile("s_waitcnt vmcnt(0)" ::: "memory");
            const unsigned og = xb_add(&bar[XB_TOP], 1u);
            const unsigned tg = og / nx;
            if (og + 1u == (tg + 1u) * nx) xb_add(&bar[XB_TOPGEN], 1u);
            else XB_SPIN(xb_ld(&bar[XB_TOPGEN]) == tg, bar);
            __builtin_amdgcn_fence(__ATOMIC_ACQUIRE, "agent");
            xb_add(&bar[XB_XGEN(b.x)], 1u);
            asm volatile("s_waitcnt vmcnt(0)" ::: "memory");
        } else {
            XB_SPIN(xb_ld(&bar[XB_XGEN(b.x)]) == gen, bar);
            __builtin_amdgcn_fence(__ATOMIC_ACQUIRE, "agent");
            asm volatile("s_waitcnt vmcnt(0)" ::: "memory");
        }
    }
    __syncthreads();
}

struct Params { const float* in[24]; float* out; unsigned char* ws; int ph_lo, ph_hi; };
enum { I_X = 0, I_RELB, I_EVNM, I_WIN, I_POOLW, I_POOLS, I_CONVW, I_WOUT, I_EVNF, I_FG, I_FU, I_FD, I_ODNM, I_WQKV, I_BQKV, I_SINK, I_WO, I_BO, I_ODNF, I_ROUTER, I_EG, I_EU, I_ED, I_FINAL };

__device__ __forceinline__ void p0_tile(const float* __restrict__ src, int N, int k0, int n0, bf16_t* __restrict__ dst, int ldd, LAS unsigned char* scr, int lane, const float* __restrict__ gain = nullptr, float scale = 1.0f) {
    const int n4 = (lane & 15) * 4, kp = lane >> 4;
    f32x4 a[8], b[8];
#pragma unroll
    for (int i = 0; i < 8; ++i) { const float* p = src + (size_t)(k0 + 8 * i + 2 * kp) * N + n0 + n4; a[i] = __builtin_nontemporal_load((const f32x4*)p); b[i] = __builtin_nontemporal_load((const f32x4*)(p + N));
        if (gain) { a[i] = a[i] * (gain[k0 + 8 * i + 2 * kp] * scale); b[i] = b[i] * (gain[k0 + 8 * i + 2 * kp + 1] * scale); } else if (scale != 1.0f) { a[i] = a[i] * scale; b[i] = b[i] * scale; } }
#pragma unroll
    for (int i = 0; i < 8; ++i) { const int k = 8 * i + 2 * kp;
#pragma unroll
        for (int q = 0; q < 4; ++q) *(LAS unsigned*)(scr + (n4 + q) * 136 + k * 2) = pk2(a[i][q], b[i][q]); }
    LDS_WAIT();
    const int c = lane & 7, nr = lane >> 3;
#pragma unroll
    for (int j = 0; j < 8; ++j) { const int n = 8 * j + nr; const u32x2 lo = *(const LAS u32x2*)(scr + n * 136 + 16 * c), hi = *(const LAS u32x2*)(scr + n * 136 + 16 * c + 8);
        u32x4 o; o.x = lo.x; o.y = lo.y; o.z = hi.x; o.w = hi.y; *(u32x4*)(dst + (size_t)n * ldd + 8 * c) = o; }
    LDS_WAIT();
}
struct P0WTile { const float* src; unsigned char* dst; int N, ldd, n0, up; float scale; };
__device__ __forceinline__ P0WTile p0w_desc(int t, const float* eg, const float* eu, const float* ed, unsigned char* Wegu8, unsigned char* Wed8) {
    const int e = MOE_GU_FP6 ? t / 112 : t / 336; int q = MOE_GU_FP6 ? 224 + t % 112 : t % 336; P0WTile d;
    if (q < 224) { const int up = q >= 112; if (up) q -= 112; const int kb = q / 14, nb = q % 14;
        d.src = (up ? eu : eg) + (size_t)e * D * DFE + (size_t)(128 * kb) * DFE + 256 * nb; d.N = DFE; d.n0 = 256 * nb; d.up = up; d.dst = Wegu8 + (size_t)e * 2 * DFE * D + 128 * kb; d.ldd = D; d.scale = up ? 64.f : -64.f * 1.44269504089f; }
    else { q -= 224; const int kb = q / 4, nb = q % 4;
        d.src = ed + (size_t)e * DFE * D + (size_t)(128 * kb) * D + 256 * nb; d.N = D; d.n0 = 256 * nb; d.up = -1; d.dst = Wed8 + (size_t)e * D * DFE + 128 * kb; d.ldd = DFE; d.scale = MOE_GU_FP6 ? 64.f * F6_DOWN : -64.f * 0.69314718056f; }
    return d;
}
__device__ __forceinline__ void p0w_load(const P0WTile& d, int wave, int lane, f32x4 (&a)[16]) {
#pragma unroll
    for (int r = 0; r < 16; ++r) a[r] = __builtin_nontemporal_load((const f32x4*)(d.src + (size_t)(16 * wave + r) * d.N + 4 * lane));
}
__device__ __forceinline__ void p0w_to_lds(const f32x4 (&a)[16], LAS unsigned char* buf, int wave, int lane, float scale) {
#pragma unroll
    for (int i = 0; i < 4; ++i)
#pragma unroll
        for (int q = 0; q < 4; ++q) { const int n = 4 * lane + q, c = 4 * wave + i;
            *(LAS unsigned*)(buf + n * 128 + 4 * (c ^ (4 * ((n >> 2) & 7)))) = pg8::pk4_fp8(a[4 * i][q] * scale, a[4 * i + 1][q] * scale, a[4 * i + 2][q] * scale, a[4 * i + 3][q] * scale); }
}
__device__ __forceinline__ void p0w_store(const P0WTile& d, const LAS unsigned char* buf, int wave, int lane) {
    const int pc = lane & 7;
#pragma unroll
    for (int j = 0; j < 4; ++j) { const int n = 32 * wave + 8 * j + (lane >> 3); const u32x4 v = *(const LAS u32x4*)(buf + n * 128 + 16 * (pc ^ ((n >> 2) & 7)));
        const int ng = d.n0 + n; const int row = d.up >= 0 ? (ng >> 7) * 256 + (ng & 127) + 128 * d.up : ng;
        __builtin_nontemporal_store(v, (u32x4*)(d.dst + (size_t)row * d.ldd + 16 * pc)); }
}
struct P0W6 { const float* src; unsigned char* dst; int n0, up; float scale; };
__device__ __forceinline__ P0W6 p0w6_desc(int t, const float* eg, const float* eu, unsigned char* Wegu8) {
    const int e = t / 224; int q = t % 224; const int up = q >= 112; if (up) q -= 112; const int kb = q / 28, nb = q % 28; P0W6 d;
    d.src = (up ? eu : eg) + (size_t)e * D * DFE + (size_t)(256 * kb) * DFE + 128 * nb; d.n0 = 128 * nb; d.up = up; d.dst = Wegu8 + (size_t)e * 2 * DFE * D + 256 * kb; d.scale = up ? F6_W : -F6_W;
    return d;
}
__device__ __forceinline__ void p0w6_load(const P0W6& d, int wave, int lane, f32x2 (&a)[32]) {
#pragma unroll
    for (int r = 0; r < 32; ++r) a[r] = __builtin_nontemporal_load((const f32x2*)(d.src + (size_t)(32 * wave + r) * DFE + 2 * lane));
}
__device__ __forceinline__ void p0w6_to_lds(const f32x2 (&a)[32], LAS unsigned char* buf, int wave, int lane, float scale) {
    const int off = (wave >> 2) * 128 + 16 * (wave & 3);
#pragma unroll
    for (int h = 0; h < 2; ++h) { unsigned w[16];
#pragma unroll
        for (int i = 0; i < 16; ++i) w[i] = pk2(a[2 * i][h] * scale, a[2 * i + 1][h] * scale);
        const i32x6 P = pk32_fp6(w);
        LAS unsigned char* rowp = buf + (2 * lane + h) * 272 + off;
        *(LAS u32x4*)rowp = (u32x4){(unsigned)P[0], (unsigned)P[1], (unsigned)P[2], (unsigned)P[3]};
        *(LAS u32x4*)(rowp + 64) = (u32x4){(unsigned)P[4], (unsigned)P[5], 0u, 0u}; }
}
__device__ __forceinline__ void p0w6_store(const P0W6& d, const LAS unsigned char* buf, int tid) {
    const int row = tid >> 2, seg = tid & 3; const int ng = d.n0 + row; const int drow = (ng >> 7) * 256 + (ng & 127) + 128 * d.up;
#pragma unroll
    for (int j = 0; j < 4; ++j) __builtin_nontemporal_store(*(const LAS u32x4*)(buf + row * 272 + seg * 64 + 16 * j), (u32x4*)(d.dst + (size_t)drow * D + seg * 64 + 16 * j));
}
__device__ __forceinline__ void norm_row_bf16(const float* __restrict__ xrow, const float* __restrict__ gain, bf16_t* __restrict__ orow, int lane, float (&y)[16]) {
    f32x4 v[4];
#pragma unroll
    for (int j = 0; j < 2; ++j) { v[2 * j] = __builtin_nontemporal_load((const f32x4*)(xrow + 512 * j + 8 * lane)); v[2 * j + 1] = __builtin_nontemporal_load((const f32x4*)(xrow + 512 * j + 8 * lane + 4)); }
    float s = 0.f;
#pragma unroll
    for (int j = 0; j < 4; ++j) s += (v[j][0] * v[j][0] + v[j][1] * v[j][1]) + (v[j][2] * v[j][2] + v[j][3] * v[j][3]);
    const float r = 1.0f / sqrtf(wave_sum(s) * (1.0f / D) + RMS_EPS);
#pragma unroll
    for (int j = 0; j < 2; ++j) { const f32x4 g0 = *(const f32x4*)(gain + 512 * j + 8 * lane), g1 = *(const f32x4*)(gain + 512 * j + 8 * lane + 4);
#pragma unroll
        for (int q = 0; q < 4; ++q) { y[8 * j + q] = v[2 * j][q] * r * g0[q]; y[8 * j + 4 + q] = v[2 * j + 1][q] * r * g1[q]; }
        u32x4 w; w.x = pk2(y[8 * j], y[8 * j + 1]); w.y = pk2(y[8 * j + 2], y[8 * j + 3]); w.z = pk2(y[8 * j + 4], y[8 * j + 5]); w.w = pk2(y[8 * j + 6], y[8 * j + 7]);
        *(u32x4*)(orow + 512 * j + 8 * lane) = w; }
}

__device__ __forceinline__ int t5_bucket(int rel) {
    const int n = rel < 0 ? -rel : rel; const int ret = rel > 0 ? 16 : 0;
    int v;
    if (n < 8) v = n; else if (n < 12) v = 8; else if (n < 16) v = 9; else if (n < 23) v = 10; else if (n < 32) v = 11; else if (n < 46) v = 12; else if (n < 64) v = 13; else if (n < 91) v = 14; else v = 15;
    return ret + v;
}

constexpr int AT_KS_STR = 144, AT_VT_STR = 392;
constexpr int AT_L_K = 0, AT_L_VT = 192 * AT_KS_STR, AT_L_BT = AT_L_VT + 64 * AT_VT_STR, AT_L_OST = AT_L_BT + NQH * 256 * 4;
static_assert(AT_L_OST + NWAVES * 32 * 144 <= RING_BYTES, "attention LDS");
__device__ __forceinline__ void attn_qblock(LAS unsigned char* lds, const bf16x8 (&qf)[4], bf16_t* __restrict__ orow0, int head, int qb, int kb_min, float sink, int wave, int lane) {
    const int r32 = lane & 31, hh = lane >> 5;
    const LAS float* bt = (const LAS float*)(lds + AT_L_BT + head * 1024);
    f32x16 st[6];
#pragma unroll
    for (int kb = 0; kb < 6; ++kb) {
#pragma unroll
        for (int e = 0; e < 16; ++e) st[kb][e] = 0.f;
#pragma unroll
        for (int ks = 0; ks < 4; ++ks) { const bf16x8 kf = *(const LAS bf16x8*)(lds + AT_L_K + (kb * 32 + r32) * AT_KS_STR + 32 * ks + 16 * hh);
            st[kb] = __builtin_amdgcn_mfma_f32_32x32x16_bf16(kf, qf[ks], st[kb], 0, 0, 0); } }
    const float sinkl = sink * 1.44269504089f;
    float mx = sinkl;
#pragma unroll
    for (int kb = 0; kb < 6; ++kb) {
        if (kb < kb_min) {
#pragma unroll
            for (int e = 0; e < 16; ++e) st[kb][e] = -1e30f;
        } else {
#pragma unroll
            for (int e = 0; e < 16; e += 2) { const int j = kb * 32 + (e & 3) + 8 * (e >> 2) + 4 * hh; const int idx = j - (qb * 32 + r32) + 63;
                const f32x2 bb = {bt[idx], bt[idx + 1]}; const f32x2 qk = {st[kb][e], st[kb][e + 1]}; const f32x2 sc = qk * (0.125f * 1.44269504089f) + bb;
                st[kb][e] = sc.x; st[kb][e + 1] = sc.y; mx = __builtin_fmaxf(mx, __builtin_fmaxf(sc.x, sc.y)); } } }
    mx = fmaxf(mx, __shfl_xor(mx, 32));
    f32x2 sum2 = {0.f, 0.f};
#pragma unroll
    for (int kb = 0; kb < 6; ++kb)
#pragma unroll
        for (int e = 0; e < 16; e += 2) { const f32x2 d = (f32x2){st[kb][e], st[kb][e + 1]} - mx; f32x2 pe; pe.x = __builtin_amdgcn_exp2f(d.x); pe.y = __builtin_amdgcn_exp2f(d.y); st[kb][e] = pe.x; st[kb][e + 1] = pe.y; sum2 += pe; }
    float sum = sum2.x + sum2.y;
    sum += __shfl_xor(sum, 32);
    const float inv = 1.0f / (sum + __builtin_amdgcn_exp2f(sinkl - mx));
    f32x16 ot[2];
#pragma unroll
    for (int db = 0; db < 2; ++db)
#pragma unroll
        for (int e = 0; e < 16; ++e) ot[db][e] = 0.f;
#pragma unroll
    for (int kb = 0; kb < 6; ++kb)
#pragma unroll
        for (int s = 0; s < 2; ++s) {
            u32x4 pw; pw.x = pk2(st[kb][8 * s], st[kb][8 * s + 1]); pw.y = pk2(st[kb][8 * s + 2], st[kb][8 * s + 3]); pw.z = pk2(st[kb][8 * s + 4], st[kb][8 * s + 5]); pw.w = pk2(st[kb][8 * s + 6], st[kb][8 * s + 7]);
            const bf16x8 pf = __builtin_bit_cast(bf16x8, pw);
#pragma unroll
            for (int db = 0; db < 2; ++db) { const LAS unsigned char* vp = lds + AT_L_VT + (db * 32 + r32) * AT_VT_STR + 2 * (kb * 32 + 16 * s + 4 * hh);
                const u32x2 v0 = *(const LAS u32x2*)vp, v1 = *(const LAS u32x2*)(vp + 16);
                u32x4 vw; vw.x = v0.x; vw.y = v0.y; vw.z = v1.x; vw.w = v1.y;
                ot[db] = __builtin_amdgcn_mfma_f32_32x32x16_bf16(__builtin_bit_cast(bf16x8, vw), pf, ot[db], 0, 0, 0); } }
    LAS unsigned char* ost = lds + AT_L_OST + wave * (32 * 144);
#pragma unroll
    for (int db = 0; db < 2; ++db)
#pragma unroll
        for (int g4 = 0; g4 < 4; ++g4) { u32x2 w; w.x = pk2(ot[db][4 * g4] * inv, ot[db][4 * g4 + 1] * inv); w.y = pk2(ot[db][4 * g4 + 2] * inv, ot[db][4 * g4 + 3] * inv);
            *(LAS u32x2*)(ost + r32 * 144 + 2 * (db * 32 + 8 * g4 + 4 * hh)) = w; }
    LDS_WAIT();
#pragma unroll
    for (int i = 0; i < 4; ++i) { const int q = 8 * i + (lane >> 3), c = lane & 7; const u32x4 w = *(const LAS u32x4*)(ost + q * 144 + 16 * c);
        *(u32x4*)(orow0 + (size_t)q * D + 8 * c) = w; }
    LDS_WAIT();
}

__global__ void __launch_bounds__(NTHR, 2) fwd_kernel(Params p) {
    extern __shared__ __attribute__((aligned(16))) unsigned char lds_raw[];
    LAS unsigned char* lds = (LAS unsigned char*)lds_raw;
    volatile LAS unsigned* MISC = (volatile LAS unsigned*)(lds + LDS_MISC_OFF);
    const int tid = threadIdx.x, lane = tid & 63, wave = __builtin_amdgcn_readfirstlane(tid >> 6);
    const int G = gridDim.x, bx = blockIdx.x;
    const int vcu = (G % 8 == 0) ? (bx % 8) * (G / 8) + bx / 8 : bx;
    const int gw = vcu * NWAVES + wave, NGW = G * NWAVES;
    unsigned char* ws = p.ws;
    unsigned* ctl = (unsigned*)(ws + WS_CTL);
    if (tid < 64) MISC[tid] = 0u;
    __syncthreads();
    XcdBarrier bar; bar.bar = ctl + CW_BAR; bar.x = 0; bar.st = nullptr;
    if (MK_N_LAUNCHES == 1) bar = xcd_barrier_post(ctl + CW_BAR, MISC + 8);
    const int lo = p.ph_lo, hi = p.ph_hi;
#define IN(k) (lo <= (k) && (k) < hi)
    unsigned long long prb_c0 = 0, prb_r0 = 0, prb_c1 = 0, prb_r1 = 0;
#define PRB_BEGIN(k) do { if (PROBE_PH == (k)) { prb_c0 = __builtin_amdgcn_s_memtime(); prb_r0 = __builtin_amdgcn_s_memrealtime(); } } while (0)
#define PRB_END2(k) do { if (PROBE_PH == (k) && PROBE_MODE == 3) { prb_c1 = __builtin_amdgcn_s_memtime(); prb_r1 = __builtin_amdgcn_s_memrealtime(); } } while (0)
#define PRB_END(k) do { if (PROBE_PH == (k) && PROBE_MODE != 3) { prb_c1 = __builtin_amdgcn_s_memtime(); prb_r1 = __builtin_amdgcn_s_memrealtime(); } } while (0)
#define SEAM(k) do { if (MK_N_LAUNCHES == 1 && IN((k) + 1)) xcd_barrier(bar); } while (0)

    bf16_t* Win_t = (bf16_t*)(ws + WS_WIN); bf16_t* Wout_t = (bf16_t*)(ws + WS_WOUT); bf16_t* Wgu_t = (bf16_t*)(ws + WS_WGU); bf16_t* Wd_t = (bf16_t*)(ws + WS_WD);
    bf16_t* Wqkv_t = (bf16_t*)(ws + WS_WQKV); bf16_t* Wo_t = (bf16_t*)(ws + WS_WO); bf16_t* Wegu_t = (bf16_t*)(ws + WS_WEGU); bf16_t* Wed_t = (bf16_t*)(ws + WS_WED);
    bf16_t* XN = (bf16_t*)(ws + WS_XN); bf16_t* PROJ = (bf16_t*)(ws + WS_PROJ); bf16_t* MIXED = (bf16_t*)(ws + WS_MIXED); bf16_t* Hb = (bf16_t*)(ws + WS_H);
    bf16_t* QKV = (bf16_t*)(ws + WS_QKV); bf16_t* AO = (bf16_t*)(ws + WS_AO); bf16_t* HS = (bf16_t*)(ws + WS_HS); bf16_t* H2 = (bf16_t*)(ws + WS_H2);
    float* bias_tab = (float*)(ws + WS_BIAS); int* wgcnt = (int*)(ws + WS_WGCNT); int* tilemeta = (int*)(ws + WS_TILE);
    u32x2* slot_rec = (u32x2*)(ws + WS_SLOTT);
    float* rss = (float*)(ws + WS_RSS);
    float* X = p.out;

    PRB_BEGIN(0);
    if (IN(0)) for (int rep_ = 0; rep_ < NREP(0); ++rep_) {
        const int tid = fresh_tid(), lane = tid & 63;
        LAS unsigned char* scr = lds + wave * 8704;
        constexpr int T_WIN = 16 * 32, T_WOUT = 8 * 16, T_FG = 16 * 44, T_FD = 44 * 16, T_QKV = 16 * 20, T_WO = 16 * 16;
        constexpr int NT = T_WIN + T_WOUT + 2 * T_FG + T_FD + T_QKV + T_WO;
        unsigned char* Wegu8 = (unsigned char*)Wegu_t; unsigned char* Wed8 = (unsigned char*)Wed_t;
        PRB_BEGIN(100);
        {
            constexpr int NTW = MOE_GU_FP6 ? NEXP * 112 : NEXP * 336;
            f32x4 ta[16], tb[16], tc[16]; P0WTile da{}, db{}, dc{};
            int t = bx; int pb = 0;
#define P0W_LOAD(dd, rr, ti) do { if ((ti) < NTW) { dd = p0w_desc((ti), p.in[I_EG], p.in[I_EU], p.in[I_ED], Wegu8, Wed8); p0w_load(dd, wave, lane, rr); } } while (0)
#define P0W_DRAIN(dd, rr) do { p0w_to_lds(rr, lds + pb * 32768, wave, lane, dd.scale); __syncthreads(); p0w_store(dd, lds + pb * 32768, wave, lane); pb ^= 1; } while (0)
            P0W_LOAD(da, ta, t); P0W_LOAD(db, tb, t + G);
            while (t < NTW) {
                P0W_LOAD(dc, tc, t + 2 * G); P0W_DRAIN(da, ta); if (t + G >= NTW) break;
                P0W_LOAD(da, ta, t + 3 * G); P0W_DRAIN(db, tb); if (t + 2 * G >= NTW) break;
                P0W_LOAD(db, tb, t + 4 * G); P0W_DRAIN(dc, tc);
                t += 3 * G;
            }
#undef P0W_LOAD
#undef P0W_DRAIN
            __syncthreads();
        }
#if MOE_GU_FP6
        {
            constexpr int NT6 = NEXP * 224;
            f32x2 ta[32], tb[32], tc[32]; P0W6 da{}, db{}, dc{};
            int t = bx; int pb = 0;
#define P0W6_LOAD(dd, rr, ti) do { if ((ti) < NT6) { dd = p0w6_desc((ti), p.in[I_EG], p.in[I_EU], Wegu8); p0w6_load(dd, wave, lane, rr); } } while (0)
#define P0W6_DRAIN(dd, rr) do { p0w6_to_lds(rr, lds + pb * 34816, wave, lane, dd.scale); __syncthreads(); p0w6_store(dd, lds + pb * 34816, tid); pb ^= 1; } while (0)
            P0W6_LOAD(da, ta, t); P0W6_LOAD(db, tb, t + G);
            while (t < NT6) {
                P0W6_LOAD(dc, tc, t + 2 * G); P0W6_DRAIN(da, ta); if (t + G >= NT6) break;
                P0W6_LOAD(da, ta, t + 3 * G); P0W6_DRAIN(db, tb); if (t + 2 * G >= NT6) break;
                P0W6_LOAD(db, tb, t + 4 * G); P0W6_DRAIN(dc, tc);
                t += 3 * G;
            }
#undef P0W6_LOAD
#undef P0W6_DRAIN
            __syncthreads();
        }
#endif
        PRB_END(100); PRB_BEGIN(101);
        for (int it = (gw + NGW / 2) % NGW; it < NT; it += NGW) {
            int r = it;
            if (r < T_WIN) { const int kb = r / 32, nb = r % 32; p0_tile(p.in[I_WIN], MIXN, 64 * kb, 64 * nb, Win_t + (size_t)(64 * nb) * D + 64 * kb, D, scr, lane, p.in[I_EVNM]); continue; } r -= T_WIN;
            if (r < T_WOUT) { const int kb = 8 + r / 16, nb = r % 16; p0_tile(p.in[I_WOUT], D, 64 * kb, 64 * nb, Wout_t + (size_t)(64 * nb) * D + 64 * kb, D, scr, lane); continue; } r -= T_WOUT;
            if (r < 2 * T_FG) { const int up = r >= T_FG; const int q = up ? r - T_FG : r; const int kb = q / 44, nb = q % 44, n0 = 64 * nb;
                p0_tile(p.in[up ? I_FU : I_FG], DFF, 64 * kb, n0, Wgu_t + (size_t)((n0 / 128) * 256 + (n0 % 128) + (up ? 128 : 0)) * D + 64 * kb, D, scr, lane, p.in[I_EVNF], up ? 1.0f : -1.44269504089f); continue; } r -= 2 * T_FG;
            if (r < T_FD) { const int kb = r / 16, nb = r % 16; p0_tile(p.in[I_FD], D, 64 * kb, 64 * nb, Wd_t + (size_t)(64 * nb) * DFF + 64 * kb, DFF, scr, lane, nullptr, -0.69314718056f); continue; } r -= T_FD;
            if (r < T_QKV) { const int kb = r / 20, nb = r % 20; p0_tile(p.in[I_WQKV], QKVN, 64 * kb, 64 * nb, Wqkv_t + (size_t)(64 * nb) * D + 64 * kb, D, scr, lane, p.in[I_ODNM]); continue; } r -= T_QKV;
            { const int kb = r / 16, nb = r % 16; p0_tile(p.in[I_WO], D, 64 * kb, 64 * nb, Wo_t + (size_t)(64 * nb) * D + 64 * kb, D, scr, lane); }
        }
        PRB_END(101); PRB_BEGIN(102);
        for (int it = gw; it < 4 * 32 * 16; it += NGW) {
            const int g = it >> 9, cb = (it >> 4) & 31, nb = it & 15; const int n = 64 * nb + lane, c0 = 4 * cb;
            const float* wo = p.in[I_WOUT] + (size_t)(g * 128) * D + n; const float* ps = p.in[I_POOLS] + g * 128; const float* pw = p.in[I_POOLW] + (size_t)(g * 128 + c0) * 128;
            float acc[4] = {0.f, 0.f, 0.f, 0.f};
            for (int d0 = 0; d0 < 128; d0 += 64) {
                float w[64];
#pragma unroll
                for (int j = 0; j < 64; ++j) w[j] = wo[(size_t)(d0 + j) * D];
#pragma unroll
                for (int j = 0; j < 64; ++j) { const float ww = w[j] * ps[d0 + j];
#pragma unroll
                    for (int cc = 0; cc < 4; ++cc) acc[cc] += pw[cc * 128 + d0 + j] * ww; } }
            u32x2 o; o.x = pk2(acc[0], acc[1]); o.y = pk2(acc[2], acc[3]);
            *(u32x2*)(Wout_t + (size_t)n * D + g * 128 + c0) = o;
        }
        PRB_END(102); PRB_BEGIN(103);
        for (int m = gw; m < M; m += NGW) {
            const float* xrow = p.in[I_X] + (size_t)m * D; f32x4 v[4];
#pragma unroll
            for (int j = 0; j < 2; ++j) { v[2 * j] = __builtin_nontemporal_load((const f32x4*)(xrow + 512 * j + 8 * lane)); v[2 * j + 1] = __builtin_nontemporal_load((const f32x4*)(xrow + 512 * j + 8 * lane + 4)); }
            float s2 = 0.f;
#pragma unroll
            for (int j = 0; j < 4; ++j) s2 += (v[j][0] * v[j][0] + v[j][1] * v[j][1]) + (v[j][2] * v[j][2] + v[j][3] * v[j][3]);
            s2 = wave_sum(s2);
#pragma unroll
            for (int j = 0; j < 2; ++j) { u32x4 w; w.x = pk2(v[2 * j][0], v[2 * j][1]); w.y = pk2(v[2 * j][2], v[2 * j][3]); w.z = pk2(v[2 * j + 1][0], v[2 * j + 1][1]); w.w = pk2(v[2 * j + 1][2], v[2 * j + 1][3]);
                *(u32x4*)(XN + (size_t)m * D + 512 * j + 8 * lane) = w; }
            if (lane == 0) *(f32x4*)(rss + (size_t)m * 4) = (f32x4){s2, 0.f, 0.f, 0.f};
        }
        PRB_END(103);
        for (int i = bx * NTHR + tid; i < NQH * 256; i += G * NTHR) { const int h = i >> 8, idx = i & 255; bias_tab[i] = idx < 255 ? p.in[I_RELB][t5_bucket(idx - 191) * NQH + h] : 0.f; }
    }
    PRB_END(0);
    SEAM(0);
    PRB_END2(0);
    PRB_BEGIN(1);

    if (IN(1)) for (int rep_ = 0; rep_ < NREP(1); ++rep_) { pg8::Gemm g{XN, Win_t, 2 * D, 2 * D, 2 * D}; pg8::DenseOrder S; S.init(M, MIXN, G, bx, (LAS int*)(lds + LDS_UTAB_OFF)); pg8::EpiBf16 E{PROJ, MIXN, nullptr, rss};
        pg8::gemm_phase<pg8::EpiBf16, pg8::DenseOrder>(lds, g, S, E); }
    PRB_END(1);
    SEAM(1);
    PRB_END2(1);
    PRB_BEGIN(2);

    if (IN(2)) for (int rep_ = 0; rep_ < NREP(2); ++rep_) {
        const int tid = fresh_tid(), lane = tid & 63;
        for (int unit = gw; unit < (M / 32) * 2; unit += NGW) {
            const int rb = unit >> 1, half = unit & 1, r0 = rb * 32, bs = r0 & ~(SEQ - 1);
            if (half == 0) {
                const int w = 2 << (lane >> 4); const bf16_t* P = PROJ + 8 * lane;
                float s[8];
#pragma unroll
                for (int q = 0; q < 8; ++q) s[q] = 0.f;
                for (int j = 1; j <= 16; ++j) if (j <= w && r0 - j >= bs) { float f[8]; unpack8(*(const u32x4*)(P + (size_t)(r0 - j) * MIXN), f);
#pragma unroll
                    for (int q = 0; q < 8; ++q) s[q] += f[q]; }
#pragma unroll 8
                for (int r = r0; r < r0 + 32; ++r) {
                    float cur[8], old[8]; unpack8(*(const u32x4*)(P + (size_t)r * MIXN), cur);
                    const bool has_old = (r - w >= bs);
                    if (has_old) unpack8(*(const u32x4*)(P + (size_t)(r - w) * MIXN), old);
                    const int pos = r - bs + 1; const float inv = 1.0f / (float)(pos < w ? pos : w);
                    float o[8];
#pragma unroll
                    for (int q = 0; q < 8; ++q) { s[q] += cur[q]; if (has_old) s[q] -= old[q]; o[q] = s[q] * inv - cur[q]; }
                    *(u32x4*)(MIXED + (size_t)r * D + 8 * lane) = pack8(o);
                }
            } else {
                const bf16_t* P = PROJ + 8 * lane;
                float w0[8], w1[8], w2[8], z1[8], z2[8];
                { const float* cw = p.in[I_CONVW] + 8 * lane;
#pragma unroll
                  for (int q = 0; q < 8; ++q) { w0[q] = cw[q]; w1[q] = cw[512 + q]; w2[q] = cw[1024 + q]; z1[q] = 0.f; z2[q] = 0.f; } }
                if (r0 - 1 >= bs) { float a[8], b[8]; unpack8(*(const u32x4*)(P + (size_t)(r0 - 1) * MIXN + 1024), a); unpack8(*(const u32x4*)(P + (size_t)(r0 - 1) * MIXN + 1536), b);
#pragma unroll
                    for (int q = 0; q < 8; ++q) z1[q] = a[q] * b[q]; }
                if (r0 - 2 >= bs) { float a[8], b[8]; unpack8(*(const u32x4*)(P + (size_t)(r0 - 2) * MIXN + 1024), a); unpack8(*(const u32x4*)(P + (size_t)(r0 - 2) * MIXN + 1536), b);
#pragma unroll
                    for (int q = 0; q < 8; ++q) z2[q] = a[q] * b[q]; }
#pragma unroll 8
                for (int r = r0; r < r0 + 32; ++r) {
                    float gp[8], a[8], b[8], o[8];
                    unpack8(*(const u32x4*)(P + (size_t)r * MIXN + 512), gp); unpack8(*(const u32x4*)(P + (size_t)r * MIXN + 1024), a); unpack8(*(const u32x4*)(P + (size_t)r * MIXN + 1536), b);
#pragma unroll
                    for (int q = 0; q < 8; ++q) { const float zc = a[q] * b[q]; o[q] = gp[q] * (w0[q] * z2[q] + w1[q] * z1[q] + w2[q] * zc); z2[q] = z1[q]; z1[q] = zc; }
                    *(u32x4*)(MIXED + (size_t)r * D + 512 + 8 * lane) = pack8(o);
                }
            }
        }
    }
    PRB_END(2);
    SEAM(2);
    PRB_END2(2);
    PRB_BEGIN(3);

    if (IN(3)) for (int rep_ = 0; rep_ < NREP(3); ++rep_) { pg8::Gemm g{MIXED, Wout_t, 2 * D, 2 * D, 2 * D}; pg8::DenseOrder S; S.init(M, D, G, bx, (LAS int*)(lds + LDS_UTAB_OFF)); pg8::EpiResid<false> E{XN, XN, nullptr, rss + (size_t)M * 4, lds + LDS_XTAB_OFF};
        pg8::gemm_phase<pg8::EpiResid<false>, pg8::DenseOrder>(lds, g, S, E); }
    PRB_END(3);
    SEAM(3);
    PRB_END2(3);
    PRB_BEGIN(5);


    if (IN(5)) for (int rep_ = 0; rep_ < NREP(5); ++rep_) { pg8::Gemm g{XN, Wgu_t, 2 * D, 2 * D, 2 * D}; pg8::DenseOrder S; S.init(M, 2 * DFF, G, bx, (LAS int*)(lds + LDS_UTAB_OFF)); pg8::EpiSwiGLU E{Hb, DFF, rss + (size_t)M * 4};
        pg8::gemm_phase<pg8::EpiSwiGLU, pg8::DenseOrder>(lds, g, S, E);
#if PROBE_KDBG >= 0
        __syncthreads(); PRB_BEGIN(105);
        { pg8::EpiNull16 E2{(float*)(ws + WS_RSS)}; pg8::gemm_phase<pg8::EpiNull16, pg8::DenseOrder, false, true, true, PROBE_KDBG>(lds, g, S, E2); }
        PRB_END(105);
#endif
    }
    PRB_END(5);
    SEAM(5);
    PRB_END2(5);
    PRB_BEGIN(6);

    if (IN(6)) for (int rep_ = 0; rep_ < NREP(6); ++rep_) { pg8::Gemm g{Hb, Wd_t, 2 * DFF, 2 * DFF, 2 * DFF}; pg8::DenseOrder S; S.init(M, D, G, bx, (LAS int*)(lds + LDS_UTAB_OFF)); pg8::EpiResid<false> E{XN, XN, nullptr, rss + (size_t)M * 8, lds + LDS_XTAB_OFF};
        pg8::gemm_phase<pg8::EpiResid<false>, pg8::DenseOrder>(lds, g, S, E); }
    PRB_END(6);
    SEAM(6);
    PRB_END2(6);
    PRB_BEGIN(8);


    if (IN(8)) for (int rep_ = 0; rep_ < NREP(8); ++rep_) { pg8::Gemm g{XN, Wqkv_t, 2 * D, 2 * D, 2 * D}; pg8::DenseOrder S; S.init(M, QKVN, G, bx, (LAS int*)(lds + LDS_UTAB_OFF)); pg8::EpiBf16 E{QKV, QKVN, p.in[I_BQKV], rss + (size_t)M * 8};
        pg8::gemm_phase<pg8::EpiBf16, pg8::DenseOrder>(lds, g, S, E); }
    PRB_END(8);
    SEAM(8);
    PRB_END2(8);
    PRB_BEGIN(9);

    if (IN(9)) for (int rep_ = 0; rep_ < NREP(9); ++rep_) {
        const int tid = fresh_tid(), lane = tid & 63;
        for (int i = tid; i < NQH * 256; i += NTHR) *(LAS float*)(lds + AT_L_BT + 4 * i) = bias_tab[i] * 1.44269504089f;
        const int r32 = lane & 31, hh = lane >> 5;
        constexpr int NUNIT = BATCH * (SEQ / CHUNK) * NKVH;
        u32x4 kr[3], vr[3]; bf16x8 qfA[4], qfB[4];
#define AT_KV_LOAD(unit_) do { const int tid_ = fresh_tid(); const int kvh_ = (unit_) & 1, n_ = ((unit_) >> 1) & 255, t0_ = ((unit_) >> 9) * SEQ + n_ * CHUNK; _Pragma("unroll") for (int i = 0; i < 3; ++i) { const int pc = tid_ + i * NTHR, j = pc >> 3, c = pc & 7; \
            kr[i] = (u32x4){0u, 0u, 0u, 0u}; vr[i] = (u32x4){0u, 0u, 0u, 0u}; \
            if (n_ * CHUNK - 128 + j >= 0) { const bf16_t* src = QKV + (size_t)(t0_ - 128 + j) * QKVN + 1024 + kvh_ * HD + 8 * c; kr[i] = *(const u32x4*)src; vr[i] = *(const u32x4*)(src + 128); } } } while (0)
#define AT_Q_LOAD(qf_, unit_, qb_) do { const int l_ = fresh_tid() & 63; const int r32 = l_ & 31, hh = l_ >> 5; const int kvh_ = (unit_) & 1, n_ = ((unit_) >> 1) & 255, t0_ = ((unit_) >> 9) * SEQ + n_ * CHUNK; \
            const bf16_t* qp = QKV + (size_t)(t0_ + (qb_) * 32 + r32) * QKVN + (kvh_ * 8 + wave) * HD + 8 * hh; _Pragma("unroll") for (int ks = 0; ks < 4; ++ks) qf_[ks] = *(const bf16x8*)(qp + 16 * ks); } while (0)
        int unit = vcu;
        if (unit < NUNIT) { AT_KV_LOAD(unit); AT_Q_LOAD(qfA, unit, 0); }
        for (; unit < NUNIT; unit += G) {
            const int kvh = unit & 1, n = (unit >> 1) & 255, b = unit >> 9;
            const int t0 = b * SEQ + n * CHUNK;
            const bool has_next = unit + G < NUNIT;
            __syncthreads();
            const int tid_s = fresh_tid();
#pragma unroll
            for (int i = 0; i < 3; ++i) { const int pc = tid_s + i * NTHR, j = pc >> 3, c = pc & 7;
                *(LAS u32x4*)(lds + AT_L_K + j * AT_KS_STR + 16 * c) = kr[i];
                const unsigned vw[4] = {vr[i].x, vr[i].y, vr[i].z, vr[i].w};
                const bool odd = (j & 1) != 0;
                const unsigned m0 = odd ? vw[2] : vw[0], m1 = odd ? vw[3] : vw[1];
                const unsigned o0 = __shfl_xor(odd ? vw[0] : vw[2], 8), o1 = __shfl_xor(odd ? vw[1] : vw[3], 8);
                const unsigned e0 = odd ? o0 : m0, e1 = odd ? o1 : m1, d0 = odd ? m0 : o0, d1 = odd ? m1 : o1;
                LAS unsigned char* vb = lds + AT_L_VT + (8 * c + (odd ? 4 : 0)) * AT_VT_STR + 2 * (j & ~1);
                *(LAS unsigned*)(vb + 0 * AT_VT_STR) = (e0 & 0xffffu) | (d0 << 16);
                *(LAS unsigned*)(vb + 1 * AT_VT_STR) = (e0 >> 16) | (d0 & 0xffff0000u);
                *(LAS unsigned*)(vb + 2 * AT_VT_STR) = (e1 & 0xffffu) | (d1 << 16);
                *(LAS unsigned*)(vb + 3 * AT_VT_STR) = (e1 >> 16) | (d1 & 0xffff0000u); }
            AT_Q_LOAD(qfB, unit, 1);
            __syncthreads();
            const int head = kvh * 8 + wave;
            const float sink = p.in[I_SINK][head];
            const int kb_min = n == 0 ? 4 : (n == 1 ? 2 : 0);
            attn_qblock(lds, qfA, AO + (size_t)t0 * D + head * HD, head, 0, kb_min, sink, wave, fresh_tid() & 63);
            if (has_next) { AT_KV_LOAD(unit + G); AT_Q_LOAD(qfA, unit + G, 0); }
            attn_qblock(lds, qfB, AO + (size_t)(t0 + 32) * D + head * HD, head, 1, kb_min, sink, wave, fresh_tid() & 63);
        }
#undef AT_KV_LOAD
#undef AT_Q_LOAD
        __syncthreads();
    }
    PRB_END(9);
    SEAM(9);
    PRB_END2(9);
    PRB_BEGIN(10);

    if (IN(10)) for (int rep_ = 0; rep_ < NREP(10); ++rep_) { pg8::Gemm g{AO, Wo_t, 2 * D, 2 * D, 2 * D}; pg8::DenseOrder S; S.init(M, D, G, bx, (LAS int*)(lds + LDS_UTAB_OFF)); pg8::EpiResid<false> E{XN, XN, p.in[I_BO], nullptr, nullptr};
        pg8::gemm_phase<pg8::EpiResid<false>, pg8::DenseOrder>(lds, g, S, E); }
    PRB_END(10);
    SEAM(10);
    PRB_END2(10);
    PRB_BEGIN(11);

    const int RPW = (M + G - 1) / G;
    constexpr int L_RW = 0, L_RE = 32768, L_RWT = L_RE + 1024 * 4, L_RRK = L_RWT + 1024 * 4, L_CNT = L_RRK + 1024 * 4, L_SB = L_CNT + 64, L_SLOT = L_SB + 256;
    unsigned char* XN8 = (unsigned char*)p.out;
    if (IN(11)) for (int rep_ = 0; rep_ < NREP(11); ++rep_) {
        const int tid = fresh_tid(), lane = tid & 63;
        if (tid < 8) *(LAS int*)(lds + L_CNT + 4 * tid) = 0;
        const int rbase = bx * RPW;
        const int nrows = (M - rbase) < RPW ? (M - rbase) : RPW;
        f32x4 gn[4], wA[4][4], wB[4][4];
#pragma unroll
        for (int j = 0; j < 4; ++j) { gn[j] = *(const f32x4*)(p.in[I_ODNF] + 16 * lane + 4 * j);
#pragma unroll
            for (int q = 0; q < 4; ++q) { const float* wr = p.in[I_ROUTER] + (size_t)(16 * lane + 4 * j + q) * NEXP; wA[j][q] = *(const f32x4*)wr * gn[j][q]; wB[j][q] = *(const f32x4*)(wr + 4) * gn[j][q]; } }
        const bool h5 = (lane & 32) != 0, h4 = (lane & 16) != 0, h3 = (lane & 8) != 0;
        for (int rl0 = wave; rl0 < nrows; rl0 += 4 * NWAVES) {
            u32x4 pv[4][2];
#pragma unroll
            for (int u = 0; u < 4; ++u) { const int rl = rl0 + 8 * u; const int m = rbase + (rl < nrows ? rl : rl0);
#pragma unroll
                for (int hq = 0; hq < 2; ++hq) pv[u][hq] = __builtin_nontemporal_load((const u32x4*)(XN + (size_t)m * D + 16 * lane + 8 * hq)); }
#pragma unroll
            for (int u = 0; u < 4; ++u) { const int rl = rl0 + 8 * u; if (rl >= nrows) continue; const int m = rbase + rl;
                f32x4 x[4];
#pragma unroll
                for (int hq = 0; hq < 2; ++hq) { x[2 * hq] = (f32x4){bf_lo(pv[u][hq].x), bf_hi(pv[u][hq].x), bf_lo(pv[u][hq].y), bf_hi(pv[u][hq].y)}; x[2 * hq + 1] = (f32x4){bf_lo(pv[u][hq].z), bf_hi(pv[u][hq].z), bf_lo(pv[u][hq].w), bf_hi(pv[u][hq].w)}; }
                float s2 = 0.f; f32x4 la = {0.f, 0.f, 0.f, 0.f}, lb = {0.f, 0.f, 0.f, 0.f};
#pragma unroll
                for (int j = 0; j < 4; ++j) { s2 += (x[j][0] * x[j][0] + x[j][1] * x[j][1]) + (x[j][2] * x[j][2] + x[j][3] * x[j][3]);
#pragma unroll
                    for (int q = 0; q < 4; ++q) { la += wA[j][q] * x[j][q]; lb += wB[j][q] * x[j][q]; } }
                const float r = 1.0f / sqrtf(wave_sum(s2) * (1.0f / D) + RMS_EPS);
#if MOE_GU_FP6
                { unsigned own[8], w[16];
#pragma unroll
                  for (int j = 0; j < 4; ++j) { const f32x4 y = x[j] * (r * F6_ACT) * gn[j]; own[2 * j] = pk2(y[0], y[1]); own[2 * j + 1] = pk2(y[2], y[3]); }
                  const bool oddl = (lane & 1) != 0;
#pragma unroll
                  for (int i = 0; i < 8; ++i) { const unsigned pt = __shfl_xor(own[i], 1); w[i] = oddl ? pt : own[i]; w[8 + i] = oddl ? own[i] : pt; }
                  const i32x6 P = pk32_fp6(w);
                  const int pg = lane >> 1; unsigned char* gp = XN8 + (size_t)m * D + 128 * (pg >> 2) + 16 * (pg & 3) + (oddl ? 64 : 0);
                  *(u32x4*)gp = oddl ? (u32x4){(unsigned)P[4], (unsigned)P[5], 0u, 0u} : (u32x4){(unsigned)P[0], (unsigned)P[1], (unsigned)P[2], (unsigned)P[3]}; }
#else
                { u32x4 o;
                  { const f32x4 y = x[0] * r * gn[0]; o.x = pg8::pk4_fp8(y[0], y[1], y[2], y[3]); } { const f32x4 y = x[1] * r * gn[1]; o.y = pg8::pk4_fp8(y[0], y[1], y[2], y[3]); }
                  { const f32x4 y = x[2] * r * gn[2]; o.z = pg8::pk4_fp8(y[0], y[1], y[2], y[3]); } { const f32x4 y = x[3] * r * gn[3]; o.w = pg8::pk4_fp8(y[0], y[1], y[2], y[3]); }
                  *(u32x4*)(XN8 + (size_t)m * D + 16 * lane) = o; }
#endif
                float t4[4], s4[4];
#pragma unroll
                for (int i = 0; i < 4; ++i) { t4[i] = h5 ? lb[i] : la[i]; s4[i] = h5 ? la[i] : lb[i]; }
#pragma unroll
                for (int i = 0; i < 4; ++i) t4[i] += __shfl_xor(s4[i], 32);
                float t2[2], s2b[2];
#pragma unroll
                for (int i = 0; i < 2; ++i) { t2[i] = h4 ? t4[i + 2] : t4[i]; s2b[i] = h4 ? t4[i] : t4[i + 2]; }
#pragma unroll
                for (int i = 0; i < 2; ++i) t2[i] += __shfl_xor(s2b[i], 16);
                float t1 = h3 ? t2[1] : t2[0]; const float s1 = h3 ? t2[0] : t2[1];
                t1 += __shfl_xor(s1, 8); t1 += __shfl_xor(t1, 4); t1 += __shfl_xor(t1, 2); t1 += __shfl_xor(t1, 1);
                float lg[8];
#pragma unroll
                for (int e = 0; e < 8; ++e) lg[e] = __int_as_float(__builtin_amdgcn_readlane(__float_as_int(t1), 8 * e)) * r;
                int e0 = 0; float v0 = lg[0];
#pragma unroll
                for (int e = 1; e < 8; ++e) if (lg[e] > v0) { v0 = lg[e]; e0 = e; }
                int e1 = -1; float v1 = -3.0e38f;
#pragma unroll
                for (int e = 0; e < 8; ++e) if (e != e0 && lg[e] > v1) { v1 = lg[e]; e1 = e; }
                const float wt0 = 1.0f / (1.0f + __expf(v1 - v0));
                if (lane == 0) { *(LAS int*)(lds + L_RE + 8 * rl) = e0; *(LAS int*)(lds + L_RE + 8 * rl + 4) = e1; *(LAS float*)(lds + L_RWT + 8 * rl) = wt0; *(LAS float*)(lds + L_RWT + 8 * rl + 4) = 1.0f - wt0; }
            }
        }
        __syncthreads();
        { LAS int* wcnt = (LAS int*)(lds + L_SLOT);
          const int nent = 2 * nrows, nchunk = (nent + 63) >> 6;
          int rloc[2] = {0, 0}, emine[2] = {-1, -1};
#pragma unroll
          for (int cc = 0; cc < 2; ++cc) { const int chunk = wave + 8 * cc; if (chunk < nchunk) { const int en = chunk * 64 + lane; const int e = en < nent ? *(LAS int*)(lds + L_RE + 4 * en) : -1; emine[cc] = e;
#pragma unroll
              for (int ex = 0; ex < 8; ++ex) { const unsigned long long mk = __ballot(e == ex); if (e == ex) rloc[cc] = __popcll(mk & ((1ull << lane) - 1ull)); if (lane == 0) wcnt[chunk * 8 + ex] = __popcll(mk); } } }
          __syncthreads();
#pragma unroll
          for (int cc = 0; cc < 2; ++cc) { const int chunk = wave + 8 * cc; const int en = chunk * 64 + lane; if (chunk < nchunk && en < nent) { const int e = emine[cc]; int r = rloc[cc]; for (int c2 = 0; c2 < chunk; ++c2) r += wcnt[c2 * 8 + e]; *(LAS int*)(lds + L_RRK + 4 * en) = r; } }
          if (tid < 8) { int c = 0; for (int c2 = 0; c2 < nchunk; ++c2) c += wcnt[c2 * 8 + tid]; *(LAS int*)(lds + L_CNT + 4 * tid) = c; }
        }
        __syncthreads();
        if (tid < 8) wgcnt[bx * 8 + tid] = *(LAS int*)(lds + L_CNT + 4 * tid);
        __syncthreads();
    }
    PRB_END(11);
    SEAM(11);
    PRB_END2(11);
    PRB_BEGIN(12);

    if (IN(12)) for (int rep_ = 0; rep_ < NREP(12); ++rep_) {
        const int tid = fresh_tid(), lane = tid & 63;
        LAS int* sb = (LAS int*)(lds + L_SB);
        if (tid < 32) sb[tid] = 0;
        __syncthreads();
        for (int i = tid; i < G * 2; i += NTHR) { const int w = i >> 1, h4 = (i & 1) * 4; const u32x4 c = *(const u32x4*)(wgcnt + w * 8 + h4); const unsigned cv[4] = {c.x, c.y, c.z, c.w};
#pragma unroll
            for (int q = 0; q < 4; ++q) { __hip_atomic_fetch_add(sb + 16 + h4 + q, (int)cv[q], __ATOMIC_RELAXED, __HIP_MEMORY_SCOPE_WORKGROUP); if (w < bx) __hip_atomic_fetch_add(sb + 8 + h4 + q, (int)cv[q], __ATOMIC_RELAXED, __HIP_MEMORY_SCOPE_WORKGROUP); } }
        __syncthreads();
        if (tid == 0) { int base = 0; for (int e = 0; e < 8; ++e) { sb[e] = base; base += (sb[16 + e] + 255) & ~255; } sb[24] = base; }
        __syncthreads();
        const int rbase = bx * RPW;
        const int nrows = (M - rbase) < RPW ? (M - rbase) : RPW;
        unsigned char* HS8 = (unsigned char*)HS; int* tslot = (int*)(p.ws + WS_TSLOT);
        for (int en = tid; en < 2 * nrows; en += NTHR) { const int e = *(LAS int*)(lds + L_RE + 4 * en); const int slot = sb[e] + sb[8 + e] + *(LAS int*)(lds + L_RRK + 4 * en);
            *(LAS int*)(lds + L_SLOT + 4 * en) = slot; tslot[(en & 1) * M + rbase + (en >> 1)] = slot; u32x2 rec; rec.x = (unsigned)(2 * (rbase + (en >> 1)) + (en & 1)); rec.y = *(LAS unsigned*)(lds + L_RWT + 4 * en); slot_rec[slot] = rec; }
        __syncthreads();
        for (int en0 = wave; en0 < 2 * nrows; en0 += 4 * NWAVES) {
            u32x4 t[4];
#pragma unroll
            for (int u = 0; u < 4; ++u) { const int en = en0 + 8 * u; if (en < 2 * nrows) t[u] = *(const u32x4*)(XN8 + (size_t)(rbase + (en >> 1)) * D + 16 * lane); }
#pragma unroll
            for (int u = 0; u < 4; ++u) { const int en = en0 + 8 * u; if (en < 2 * nrows) *(u32x4*)(HS8 + (size_t)(*(LAS int*)(lds + L_SLOT + 4 * en)) * D + 16 * lane) = t[u]; } }
        if (bx == 0) {
            for (int e = 0; e < 8; ++e) { const int b0 = sb[e] + sb[16 + e], b1 = sb[e] + ((sb[16 + e] + 255) & ~255); for (int i = b0 + tid; i < b1; i += NTHR) { u32x2 rec; rec.x = 0xffffffffu; rec.y = 0u; slot_rec[i] = rec; } }
            const int nt_all = sb[24] >> 8;
            for (int j = tid; j < nt_all; j += NTHR) { int e = 0; for (int q = 1; q < 8; ++q) if ((j << 8) >= sb[q]) e = q; tilemeta[8 + j] = e; }
            if (tid == 0) { tilemeta[0] = nt_all; tilemeta[1] = nt_all; }
        }
        __syncthreads();
    }
    PRB_END(12);
    SEAM(12);
    PRB_END2(12);
    PRB_BEGIN(13);

    if (IN(13) || IN(14)) {
        const int tid = fresh_tid();
        for (int j = tid; j < 288; j += NTHR) *(LAS int*)(lds + LDS_TILE_OFF + 4 * j) = (j < MAXTILES + 8) ? tilemeta[j] : 0;
        __syncthreads();
    }
    const LAS int* tmeta = (const LAS int*)(lds + LDS_TILE_OFF);
    if (IN(13)) for (int rep_ = 0; rep_ < NREP(13); ++rep_) {
        const int nall = __builtin_amdgcn_readfirstlane(tmeta[0]);
        pg8::Gemm g{HS, Wegu_t, D, D, D}; pg8::MoeOrder S; S.T.init(nall, NFE_T, G, bx); S.tpe = NFE_T; S.tile_e = tmeta + 8; S.tab = (LAS int*)(lds + LDS_UTAB_OFF); S.prepare();
        pg8::EpiSwiGLU8 E{(unsigned char*)H2, DFE};
        pg8::gemm_phase<pg8::EpiSwiGLU8, pg8::MoeOrder, true>(lds, g, S, E);
#if PROBE_K8 >= 0
        __syncthreads(); PRB_BEGIN(113);
        { pg8::EpiNull8<PROBE_K8_FMT> E2{(float*)(ws + WS_RSS)}; pg8::gemm_phase<pg8::EpiNull8<PROBE_K8_FMT>, pg8::MoeOrder, true, true, true, PROBE_K8>(lds, g, S, E2); }
        PRB_END(113);
#endif
    }
    PRB_END(13);
    SEAM(13);
    PRB_END2(13);
    PRB_BEGIN(14);
    const int TAILMODE = (G == 256);
    if (IN(14)) {
        const int nall = __builtin_amdgcn_readfirstlane(tmeta[0]);
        const int nfull = (TAILMODE && nall > 256) ? 256 : nall;
        { pg8::Gemm g{H2, Wed_t, DFE, DFE, DFE}; pg8::MoeOrder S; S.T.init(nfull, D / 256, G, bx); S.tpe = D / 256; S.tile_e = tmeta + 8; S.tab = (LAS int*)(lds + LDS_UTAB_OFF); S.prepare();
          pg8::EpiMoeDown E{(bf16_t*)(p.ws + WS_Y0), (const u32x2*)(p.ws + WS_SLOTT)};
          pg8::gemm_phase<pg8::EpiMoeDown, pg8::MoeOrder, true>(lds, g, S, E); }
        const int nall2 = __builtin_amdgcn_readfirstlane(tmeta[0]);
        const int nfull2 = (TAILMODE && nall2 > 256) ? 256 : nall2;
        if (nall2 > nfull2) {
            const int R = 4 * (nall2 - nfull2); const int NSL = (256 / R) < 14 ? (256 / R) : 14;
            const int c = bx, uidx = c / NSL, sl = c - uidx * NSL;
            const int p0 = 14 * sl / NSL, p1 = 14 * (sl + 1) / NSL;
            pg8::SingleOrder S; S.has = (uidx < R) && (p1 > p0); S.pm = nfull2 + (uidx >> 2); S.rm = S.pm; S.cn = uidx & 3;
            S.pn = __builtin_amdgcn_readfirstlane(tmeta[8 + (S.has ? S.pm : 0)]) * (D / 256) + S.cn;
            pg8::Gemm g{(const unsigned char*)H2 + 256 * p0, (const unsigned char*)Wed_t + 256 * p0, DFE, DFE, 256 * (p1 - p0)};
            pg8::EpiSlab E{(bf16_t*)(p.ws + WS_SLAB) + (size_t)c * 65536, (const u32x2*)(p.ws + WS_SLOTT)};
            pg8::gemm_phase<pg8::EpiSlab, pg8::SingleOrder, true>(lds, g, S, E);
        }
    }
    PRB_END(14);
    SEAM(14);
    PRB_END2(14);
    PRB_BEGIN(15);

    if (IN(15)) {
        const int lane = fresh_tid() & 63;
        const bf16_t* Y0 = (const bf16_t*)(ws + WS_Y0); const bf16_t* Y1 = (const bf16_t*)(ws + WS_Y1); const int* tslot = (const int*)(p.ws + WS_TSLOT); const bf16_t* slabs = (const bf16_t*)(p.ws + WS_SLAB);
        const int nall = tilemeta[0];
        const int nfull = (TAILMODE && nall > 256) ? 256 : nall;
        const int R = 4 * (nall - nfull); const int NSL = R > 0 ? ((256 / R) < 14 ? (256 / R) : 14) : 1;
        for (int m0 = gw; m0 < M; m0 += 2 * NGW) {
            u32x4 xr[2][2], yr[2][2][2]; int slot2[2][2];
#pragma unroll
            for (int rr = 0; rr < 2; ++rr) { const int m = (m0 + rr * NGW < M) ? m0 + rr * NGW : m0;
#pragma unroll
                for (int j = 0; j < 2; ++j) xr[rr][j] = __builtin_nontemporal_load((const u32x4*)(XN + (size_t)m * D + 512 * j + 8 * lane));
#pragma unroll
                for (int k = 0; k < 2; ++k) { slot2[rr][k] = tslot[k * M + m];
#pragma unroll
                    for (int j = 0; j < 2; ++j) yr[rr][k][j] = __builtin_nontemporal_load((const u32x4*)((k ? Y1 : Y0) + (size_t)m * D + 512 * j + 8 * lane)); } }
#pragma unroll
            for (int rr = 0; rr < 2; ++rr) { const int m = m0 + rr * NGW; if (m >= M) continue;
                float* xrow = X + (size_t)m * D; f32x4 v[4];
#pragma unroll
                for (int j = 0; j < 2; ++j) { float fx[8]; unpack8(xr[rr][j], fx); v[2 * j] = (f32x4){fx[0], fx[1], fx[2], fx[3]}; v[2 * j + 1] = (f32x4){fx[4], fx[5], fx[6], fx[7]}; }
#pragma unroll
                for (int k = 0; k < 2; ++k) {
                    const int slot = __builtin_amdgcn_readfirstlane(slot2[rr][k]); const int tile = slot >> 8;
                    if (tile < nfull) {
#pragma unroll
                        for (int j = 0; j < 2; ++j) { float f[8]; unpack8(yr[rr][k][j], f);
#pragma unroll
                            for (int q = 0; q < 4; ++q) { v[2 * j][q] += f[q]; v[2 * j + 1][q] += f[4 + q]; } }
                    } else {
#pragma unroll
                        for (int j = 0; j < 2; ++j) { const int col = 512 * j + 8 * lane; const int uidx = (tile - nfull) * 4 + (col >> 8);
                            const bf16_t* sp = slabs + ((size_t)uidx * NSL) * 65536 + (size_t)(slot & 255) * 256 + (col & 255);
#pragma unroll
                            for (int sb = 0; sb < 14; sb += 7) {
                                u32x4 sv[7];
#pragma unroll
                                for (int i = 0; i < 7; ++i) { const int sl = sb + i; sv[i] = (u32x4){0u, 0u, 0u, 0u}; if (sl < NSL && 14 * (sl + 1) / NSL > 14 * sl / NSL) sv[i] = *(const u32x4*)(sp + (size_t)sl * 65536); }
#pragma unroll
                                for (int i = 0; i < 7; ++i) { float f[8]; unpack8(sv[i], f);
#pragma unroll
                                    for (int q = 0; q < 4; ++q) { v[2 * j][q] += f[q]; v[2 * j + 1][q] += f[4 + q]; } } } }
                    }
                }
                float s2 = 0.f;
#pragma unroll
                for (int j = 0; j < 4; ++j) s2 += (v[j][0] * v[j][0] + v[j][1] * v[j][1]) + (v[j][2] * v[j][2] + v[j][3] * v[j][3]);
                const float r = 1.0f / sqrtf(wave_sum(s2) * (1.0f / D) + RMS_EPS);
#pragma unroll
                for (int j = 0; j < 2; ++j) { const f32x4 g0 = *(const f32x4*)(p.in[I_FINAL] + 512 * j + 8 * lane), g1 = *(const f32x4*)(p.in[I_FINAL] + 512 * j + 8 * lane + 4);
                    __builtin_nontemporal_store(v[2 * j] * r * g0, (f32x4*)(xrow + 512 * j + 8 * lane)); __builtin_nontemporal_store(v[2 * j + 1] * r * g1, (f32x4*)(xrow + 512 * j + 8 * lane + 4)); }
            }
        }
    }
    PRB_END(15);
    if (PROBE_PH >= 0 && bx == 0) {
        const unsigned long long dr = prb_r1 - prb_r0, dc = prb_c1 - prb_c0;
        const unsigned long long spin = (PROBE_MODE == 1) ? (dr ? dc * 10000ull / dr : 0ull) : 8ull * dr;
        const unsigned long long t0 = __builtin_amdgcn_s_memrealtime();
        while (__builtin_amdgcn_s_memrealtime() - t0 < spin) __builtin_amdgcn_s_sleep(8);
    }
#undef IN
#undef SEAM
}

extern "C" void kernel_launch(void* const* d_in, const int* in_sizes, int n_in, void* d_out, int out_size, void* d_ws, size_t ws_size, hipStream_t stream) {
    static int grid = 0;
    if (grid == 0) {
        if (n_in != 24 || in_sizes[0] != M * D || out_size != M * D || ws_size < WS_TOP) { fprintf(stderr, "kernel_launch: unexpected shapes (n_in %d, in0 %d, out %d, ws %zu < %zu)\n", n_in, n_in > 0 ? in_sizes[0] : -1, out_size, ws_size, (size_t)WS_TOP); grid = -1; return; }
        int dev = 0, cus = 0, per_cu = 0;
        if (hipGetDevice(&dev) != hipSuccess || hipDeviceGetAttribute(&cus, hipDeviceAttributeMultiprocessorCount, dev) != hipSuccess) { grid = -1; return; }
        if (hipFuncSetAttribute((const void*)fwd_kernel, hipFuncAttributeMaxDynamicSharedMemorySize, LDS_BYTES) != hipSuccess) { fprintf(stderr, "kernel_launch: hipFuncSetAttribute failed\n"); grid = -1; return; }
        if (hipOccupancyMaxActiveBlocksPerMultiprocessor(&per_cu, (const void*)fwd_kernel, NTHR, LDS_BYTES) != hipSuccess || per_cu < 1) fprintf(stderr, "kernel_launch: occupancy query reports %d\n", per_cu);
        (void)hipGetLastError();
        grid = cus < 256 ? cus : 256;
    }
    if (grid < 0) return;
    (void)hipMemsetAsync((char*)d_ws + WS_CTL, 0, CTL_ZERO_BYTES, stream);
    Params a{};
    for (int i = 0; i < 24; ++i) a.in[i] = (const float*)d_in[i];
    a.out = (float*)d_out; a.ws = (unsigned char*)d_ws;
    constexpr int NPH = 16;
    if (MK_N_LAUNCHES == 1) { a.ph_lo = 0; a.ph_hi = NPH; hipLaunchKernelGGL(fwd_kernel, dim3(grid), dim3(NTHR), LDS_BYTES, stream, a); }
    else for (int li = 0; li < NPH; ++li) { a.ph_lo = li; a.ph_hi = li + 1; hipLaunchKernelGGL(fwd_kernel, dim3(grid), dim3(NTHR), LDS_BYTES, stream, a); }
}
```

```cpp
#include <hip/hip_runtime.h>
#include <cstdio>
#include <cstdint>

#ifndef MK_N_LAUNCHES
#define MK_N_LAUNCHES 1
#endif

#ifndef PROBE_PH
#define PROBE_PH -1
#endif
#ifndef PROBE_MODE
#define PROBE_MODE 3
#endif
#ifndef PROBE_KDBG
#define PROBE_KDBG -1
#endif
#ifndef MOE_GU_FP6
#define MOE_GU_FP6 0
#endif
#ifndef PROBE_K8
#define PROBE_K8 -1
#define PROBE_K8_FMT 0
#endif
#ifndef EPIWAIT
#define EPIWAIT 0
#endif
#ifndef P13_ALIGN
#define P13_ALIGN true
#endif
#ifndef REPMASK
#define REPMASK 0u
#endif
#define NREP(k) ((((REPMASK) >> (k)) & 1u) ? 2 : 1)
#define LAS __attribute__((address_space(3)))
#define GAS __attribute__((address_space(1)))
typedef unsigned short bf16_t;
typedef short bf16x8 __attribute__((ext_vector_type(8)));
typedef short s16x4 __attribute__((ext_vector_type(4)));
typedef float f32x2 __attribute__((ext_vector_type(2)));
typedef float f32x4 __attribute__((ext_vector_type(4)));
typedef float f32x16 __attribute__((ext_vector_type(16)));
typedef unsigned u32x2 __attribute__((ext_vector_type(2)));
typedef unsigned u32x4 __attribute__((ext_vector_type(4)));
typedef __bf16 hbf16x2 __attribute__((ext_vector_type(2)));
typedef int i32x4 __attribute__((ext_vector_type(4)));
typedef int i32x8 __attribute__((ext_vector_type(8)));
typedef int i32x6 __attribute__((ext_vector_type(6)));
typedef __bf16 hbf16x32 __attribute__((ext_vector_type(32)));

constexpr int D = 1024, BATCH = 2, SEQ = 16384, M = BATCH * SEQ;
constexpr int MIXN = 2048;
constexpr int DFF = 2816, NFF_T = DFF / 128;
constexpr int QKVN = 1280, NQH = 16, NKVH = 2, HD = 64, CHUNK = 64, KVSPAN = 192;
constexpr int NEXP = 8, DFE = 3584, NFE_T = DFE / 128;
constexpr float RMS_EPS = 1e-6f;
constexpr int MAXSLOT = 67328;
constexpr int MAXTILES = MAXSLOT / 256;
constexpr int NWAVES = 8, NTHR = 512;

constexpr size_t MiB = 1u << 20;
constexpr size_t WS_CTL = 0, CTL_ZERO_BYTES = 1 * MiB;
constexpr size_t WS_BIAS = 1 * MiB;
constexpr size_t WS_WGCNT = WS_BIAS + 16 * 256 * 4;
constexpr size_t WS_TILE = WS_WGCNT + 1024 * 16 * 4;
constexpr size_t WS_SLOTT = WS_TILE + 4096;
constexpr size_t WS_SLOTW = WS_SLOTT + (size_t)MAXSLOT * 4;
constexpr size_t WS_TSLOT = WS_SLOTW + (size_t)MAXSLOT * 4;
static_assert(WS_TSLOT + 2 * (size_t)M * 4 <= 4 * MiB, "route region");
constexpr size_t WS_WIN = 4 * MiB;
constexpr size_t WS_WOUT = WS_WIN + (size_t)MIXN * D * 2;
constexpr size_t WS_WGU = WS_WOUT + (size_t)D * D * 2;
constexpr size_t WS_WD = WS_WGU + (size_t)2 * DFF * D * 2;
constexpr size_t WS_WQKV = WS_WD + (size_t)D * DFF * 2;
constexpr size_t WS_WO = WS_WQKV + (size_t)QKVN * D * 2;
static_assert(WS_WO + (size_t)D * D * 2 <= 31 * MiB, "dense weights");
constexpr size_t WS_WEGU = 31 * MiB;
constexpr size_t WS_WED = WS_WEGU + (size_t)NEXP * 2 * DFE * D;
static_assert(WS_WED + (size_t)NEXP * D * DFE == 115 * MiB, "expert weights");
constexpr size_t WS_XN = 115 * MiB;
constexpr size_t WS_Y0 = 23 * MiB;
static_assert(WS_Y0 + (size_t)M * D * 2 <= WS_WED, "Y0 must not touch the down weights");
constexpr size_t WS_R = 179 * MiB;
constexpr size_t WS_PROJ = WS_R, WS_MIXED = WS_R + (size_t)M * MIXN * 2;
constexpr size_t WS_H = WS_R;
constexpr size_t WS_QKV = WS_R, WS_AO = WS_R + (size_t)M * QKVN * 2;
constexpr size_t WS_Y1 = WS_R;
constexpr size_t WS_HS = WS_R, WS_H2 = WS_R + 66 * MiB;
static_assert((size_t)MAXSLOT * D <= 66 * MiB, "HS");
constexpr size_t WS_END = WS_H2 + (size_t)MAXSLOT * DFE;
constexpr size_t WS_SLAB = 482 * MiB;
static_assert(WS_SLAB >= WS_END && WS_SLAB + 256 * 65536 * 2 <= 543497280ull, "slabs");
constexpr size_t WS_TOP = WS_SLAB + 256 * 65536 * 2;
static_assert(WS_END <= 543497280ull, "workspace");
static_assert(WS_MIXED + (size_t)M * D * 2 <= 543497280ull && WS_H + (size_t)M * DFF * 2 <= 543497280ull, "workspace");

constexpr int CW_BAR = 4096;
constexpr size_t WS_RSS = 480 * MiB;
static_assert(WS_RSS >= WS_END && WS_RSS + 3 * (size_t)M * 4 * 4 <= 543497280ull, "rss");

constexpr int RING_BYTES = 131072;
constexpr int LDS_TILE_OFF = RING_BYTES;
constexpr int LDS_MISC_OFF = RING_BYTES + 2048;
constexpr int LDS_UTAB_OFF = RING_BYTES + 3072;
constexpr int LDS_XTAB_OFF = RING_BYTES + 4096;
constexpr int LDS_BYTES = 147456;

__device__ __forceinline__ unsigned pk2(float lo, float hi) { f32x2 v = {lo, hi}; hbf16x2 b = __builtin_convertvector(v, hbf16x2); return __builtin_bit_cast(unsigned, b); }
__device__ __forceinline__ float bf_lo(unsigned w) { return __uint_as_float(w << 16); }
__device__ __forceinline__ float bf_hi(unsigned w) { return __uint_as_float(w & 0xffff0000u); }
__device__ __forceinline__ void unpack8(const u32x4 w, float (&f)[8]) { f[0] = bf_lo(w.x); f[1] = bf_hi(w.x); f[2] = bf_lo(w.y); f[3] = bf_hi(w.y); f[4] = bf_lo(w.z); f[5] = bf_hi(w.z); f[6] = bf_lo(w.w); f[7] = bf_hi(w.w); }
__device__ __forceinline__ u32x4 pack8(const float (&f)[8]) { u32x4 w; w.x = pk2(f[0], f[1]); w.y = pk2(f[2], f[3]); w.z = pk2(f[4], f[5]); w.w = pk2(f[6], f[7]); return w; }
constexpr float F6_ACT = 1.75f, F6_W = 1.44269504089f * 64.0f / 1.75f, F6_DOWN = -0.48045301392f;
__device__ __forceinline__ i32x6 pk32_fp6(const unsigned (&w)[16]) {
    u32x4 a = {w[0], w[1], w[2], w[3]}, b = {w[4], w[5], w[6], w[7]}, c = {w[8], w[9], w[10], w[11]}, d = {w[12], w[13], w[14], w[15]};
    typedef unsigned u32x16 __attribute__((ext_vector_type(16)));
    const u32x16 all = __builtin_shufflevector(__builtin_shufflevector(a, b, 0, 1, 2, 3, 4, 5, 6, 7), __builtin_shufflevector(c, d, 0, 1, 2, 3, 4, 5, 6, 7), 0, 1, 2, 3, 4, 5, 6, 7, 8, 9, 10, 11, 12, 13, 14, 15);
    return __builtin_amdgcn_cvt_scalef32_pk32_fp6_bf16(__builtin_bit_cast(hbf16x32, all), 1.0f);
}
__device__ __forceinline__ float wave_sum(float v) {
#pragma unroll
    for (int o = 1; o < 64; o <<= 1) v += __shfl_xor(v, o);
    return v;
}
__device__ __forceinline__ int fresh_tid() { int t = threadIdx.x; asm volatile("" : "+v"(t)); return t; }
#define LDS_WAIT() asm volatile("s_waitcnt lgkmcnt(0)" ::: "memory")
#define VM_WAIT() asm volatile("s_waitcnt vmcnt(0)" ::: "memory")

namespace pg8 {
constexpr int BM = 256, BK = 64, HALF = 128, HTB = HALF * BK * 2, STAGE_BYTES = 8 * HTB, NXCD = 8, WGM = 8;
__host__ __device__ __forceinline__ int lds_byte(int r, int c) { const int st = (r >> 4) * 2 + (c >> 5), rr = r & 15, cc = c & 31, ob = rr * 64 + cc * 2; return st * 1024 + (ob ^ (((ob >> 9) & 1) << 5)); }
__host__ __device__ __forceinline__ void stage_rc(int b, int& R, int& C) { const int st = b / 1024, sb = b % 1024, swz = sb ^ (((sb >> 9) & 1) << 5); R = (st >> 1) * 16 + swz / 64; C = (st & 1) * 32 + (swz % 64) / 2; }
__host__ __device__ __forceinline__ int perm32(int rho) { const int n = rho >> 4, i = rho & 15; return 8 * (i >> 2) + 4 * n + (i & 3); }

struct Unit { int pm, pn, rm, cn; };
struct Gemm { const void* A; const void* Bt; int lda, ldb, K; };

struct TileOrder {
    int nM, nN, nwg, G, c;
    __device__ __forceinline__ void init(int nM_, int nN_, int G_, int c_) { nM = nM_; nN = nN_; nwg = nM * nN; G = G_; c = c_; }
    __device__ __forceinline__ bool next(int i, int& m, int& n) const {
        const int L = i * G + c; if (L >= nwg) return false;
        int wgid = L; { const int q = nwg / NXCD, r = nwg % NXCD, xcd = wgid % NXCD, off = wgid / NXCD; wgid = (xcd < r ? xcd * (q + 1) : r * (q + 1) + (xcd - r) * q) + off; }
        const int nig = WGM * nN, gid = wgid / nig, fm = gid * WGM, gsz = (nM - fm) < WGM ? (nM - fm) : WGM;
        m = fm + ((wgid % nig) % gsz); n = (wgid % nig) / gsz; return true;
    }
};
struct DenseOrder {
    TileOrder T; LAS int* tab;
    __device__ __forceinline__ void init(int Mr, int N, int G, int c, LAS int* tab_) { T.init(Mr / BM, N / BM, G, c); tab = tab_; prepare(); }
    __device__ __forceinline__ void prepare() const { const int t = threadIdx.x; if (t < 64) { int m, n; tab[t] = T.next(t, m, n) ? (m | (n << 16)) : -1; } __syncthreads(); }
    __device__ __forceinline__ bool next(int i, Unit& u) const { if (i >= 64) return false; const int v = __builtin_amdgcn_readfirstlane(tab[i]); if (v < 0) return false; u.pm = v & 0xffff; u.pn = v >> 16; u.rm = u.pm; u.cn = u.pn; return true; }
    __device__ __forceinline__ void a_ready(const Unit&) const {}
    __device__ __forceinline__ void done(const Unit&) const {}
};
struct MoeOrder {
    TileOrder T; int tpe; const LAS int* tile_e; LAS int* tab;
    __device__ __forceinline__ void prepare() const { const int t = threadIdx.x; if (t < 64) { int m, n; tab[t] = T.next(t, m, n) ? (m | ((tile_e[m] * tpe + n) << 16)) : -1; } __syncthreads(); }
    __device__ __forceinline__ bool next(int i, Unit& u) const { if (i >= 64) return false; const int v = __builtin_amdgcn_readfirstlane(tab[i]); if (v < 0) return false;
        u.pm = v & 0xffff; u.pn = v >> 16; u.rm = u.pm; u.cn = u.pn % tpe; return true; }
    __device__ __forceinline__ void a_ready(const Unit&) const {}
    __device__ __forceinline__ void done(const Unit&) const {}
};

__device__ __forceinline__ float rms_scale(const float* rss, int row) { if (!rss) return 1.0f; const f32x4 a = *(const f32x4*)(rss + (size_t)row * 4);
    return 1.0f / sqrtf(((a[0] + a[1]) + (a[2] + a[3])) * (1.0f / D) + RMS_EPS); }
struct EpiBf16 {
    static constexpr bool PERM = true; static constexpr int NST = 16;
    bf16_t* O; int ldc; const float* bias; const float* rss;
    __device__ __forceinline__ void operator()(const f32x4 (&acc)[2][2][4][2], const Unit& u, int wr, int wc, int fr, int fq) const {
        const int row0 = u.rm * BM + wr * 64 + fr, col0 = u.cn * BM + wc * 32 + 8 * fq;
        f32x4 bv[2][2];
#pragma unroll
        for (int bj = 0; bj < 2; ++bj)
#pragma unroll
            for (int n = 0; n < 2; ++n) bv[bj][n] = bias ? *(const f32x4*)(bias + col0 + bj * HALF + 4 * n) : (f32x4){0.f, 0.f, 0.f, 0.f};
        float rs[2][4];
#pragma unroll
        for (int ai = 0; ai < 2; ++ai)
#pragma unroll
            for (int m = 0; m < 4; ++m) rs[ai][m] = rms_scale(rss, row0 + ai * HALF + m * 16);
#pragma unroll
        for (int ai = 0; ai < 2; ++ai)
#pragma unroll
            for (int m = 0; m < 4; ++m) { const int row = row0 + ai * HALF + m * 16; bf16_t* rowp = O + (size_t)row * ldc + col0; const float r = rs[ai][m];
#pragma unroll
                for (int bj = 0; bj < 2; ++bj) { const f32x4 v0 = acc[ai][bj][m][0] * r + bv[bj][0], v1 = acc[ai][bj][m][1] * r + bv[bj][1];
                    u32x4 w; w.x = pk2(v0[0], v0[1]); w.y = pk2(v0[2], v0[3]); w.z = pk2(v1[0], v1[1]); w.w = pk2(v1[2], v1[3]);
                    *(u32x4*)(rowp + bj * HALF) = w; } }
    }
};
__device__ __forceinline__ float silu_mul(float g2, float u) { return g2 * u * __builtin_amdgcn_rcpf(1.0f + __builtin_amdgcn_exp2f(g2)); }
struct EpiSwiGLU {
    static constexpr bool PERM = true; static constexpr int NST = 8;
    bf16_t* O; int ldc; const float* rss;
    __device__ __forceinline__ void operator()(const f32x4 (&acc)[2][2][4][2], const Unit& u, int wr, int wc, int fr, int fq) const {
        const int row0 = u.rm * BM + wr * 64 + fr, col0 = u.cn * HALF + wc * 32 + 8 * fq;
        float rs[2][4];
#pragma unroll
        for (int ai = 0; ai < 2; ++ai)
#pragma unroll
            for (int m = 0; m < 4; ++m) rs[ai][m] = rms_scale(rss, row0 + ai * HALF + m * 16);
#pragma unroll
        for (int ai = 0; ai < 2; ++ai)
#pragma unroll
            for (int m = 0; m < 4; ++m) { const int row = row0 + ai * HALF + m * 16; bf16_t* rowp = O + (size_t)row * ldc + col0; const float r = rs[ai][m];
                const f32x4 g0 = acc[ai][0][m][0] * r, g1 = acc[ai][0][m][1] * r, u0 = acc[ai][1][m][0] * r, u1 = acc[ai][1][m][1] * r;
                u32x4 w; w.x = pk2(silu_mul(g0[0], u0[0]), silu_mul(g0[1], u0[1])); w.y = pk2(silu_mul(g0[2], u0[2]), silu_mul(g0[3], u0[3]));
                w.z = pk2(silu_mul(g1[0], u1[0]), silu_mul(g1[1], u1[1])); w.w = pk2(silu_mul(g1[2], u1[2]), silu_mul(g1[3], u1[3]));
                *(u32x4*)rowp = w; }
    }
};
template <bool BASE_F32> struct EpiResid {
    static constexpr bool PERM = true; static constexpr int NST = 16;
    const void* base; bf16_t* xb; const float* bias; float* rss; LAS unsigned char* xlds;
    __device__ __forceinline__ void operator()(const f32x4 (&acc)[2][2][4][2], const Unit& u, int wr, int wc, int fr, int fq) const {
        const int row0 = u.rm * BM + wr * 64 + fr, col0 = u.cn * BM + wc * 32 + 8 * fq;
        f32x4 bv[2][2];
#pragma unroll
        for (int bj = 0; bj < 2; ++bj)
#pragma unroll
            for (int n = 0; n < 2; ++n) bv[bj][n] = bias ? *(const f32x4*)(bias + col0 + bj * HALF + 4 * n) : (f32x4){0.f, 0.f, 0.f, 0.f};
#pragma unroll
        for (int ai = 0; ai < 2; ++ai) {
            f32x4 bs[4][2][2];
#pragma unroll
            for (int m = 0; m < 4; ++m) { const size_t off = (size_t)(row0 + ai * HALF + m * 16) * D + col0;
#pragma unroll
                for (int bj = 0; bj < 2; ++bj) {
                    if constexpr (BASE_F32) { bs[m][bj][0] = *(const f32x4*)((const float*)base + off + bj * HALF); bs[m][bj][1] = *(const f32x4*)((const float*)base + off + bj * HALF + 4); }
                    else { const u32x4 w = *(const u32x4*)((const bf16_t*)base + off + bj * HALF); bs[m][bj][0] = (f32x4){bf_lo(w.x), bf_hi(w.x), bf_lo(w.y), bf_hi(w.y)}; bs[m][bj][1] = (f32x4){bf_lo(w.z), bf_hi(w.z), bf_lo(w.w), bf_hi(w.w)}; } } }
#pragma unroll
            for (int m = 0; m < 4; ++m) { const int row = row0 + ai * HALF + m * 16; const size_t off = (size_t)row * D + col0;
                float ss = 0.f;
#pragma unroll
                for (int bj = 0; bj < 2; ++bj) {
#pragma unroll
                    for (int n = 0; n < 2; ++n) { const f32x4 v = bs[m][bj][n] + acc[ai][bj][m][n] + bv[bj][n]; bs[m][bj][n] = v; ss += (v[0] * v[0] + v[1] * v[1]) + (v[2] * v[2] + v[3] * v[3]); }
                    u32x4 w; w.x = pk2(bs[m][bj][0][0], bs[m][bj][0][1]); w.y = pk2(bs[m][bj][0][2], bs[m][bj][0][3]); w.z = pk2(bs[m][bj][1][0], bs[m][bj][1][1]); w.w = pk2(bs[m][bj][1][2], bs[m][bj][1][3]);
                    *(u32x4*)(xb + off + bj * HALF) = w; }
                if (rss) { ss += __shfl_xor(ss, 16); ss += __shfl_xor(ss, 32); if (fq == 0) *(LAS float*)(xlds + 16 * (wr * 64 + ai * HALF + m * 16 + fr) + 4 * wc) = ss; } }
            asm volatile("" ::: "memory"); }
        if (rss) { asm volatile("s_waitcnt lgkmcnt(0)" ::: "memory"); __builtin_amdgcn_s_barrier(); asm volatile("" ::: "memory");
            const int t = wr * 256 + wc * 64 + fq * 16 + fr;
            if (t < 256) { const f32x4 a = *(const LAS f32x4*)(xlds + 16 * t); rss[(size_t)(u.rm * BM + t) * 4 + u.cn] = (a[0] + a[1]) + (a[2] + a[3]); } }
    }
};
__device__ __forceinline__ unsigned pk4_fp8(float a, float b, float c, float d) {
    int w = __builtin_amdgcn_cvt_pk_fp8_f32(__builtin_amdgcn_fmed3f(a, -448.f, 448.f), __builtin_amdgcn_fmed3f(b, -448.f, 448.f), 0, false);
    w = __builtin_amdgcn_cvt_pk_fp8_f32(__builtin_amdgcn_fmed3f(c, -448.f, 448.f), __builtin_amdgcn_fmed3f(d, -448.f, 448.f), w, true);
    return (unsigned)w;
}
__device__ __forceinline__ unsigned pk4_fp8_raw(float a, float b, float c, float d) {
    int w = __builtin_amdgcn_cvt_pk_fp8_f32(a, b, 0, false); w = __builtin_amdgcn_cvt_pk_fp8_f32(c, d, w, true); return (unsigned)w;
}
constexpr int E8M0_ONE = 0x7f7f7f7f, E8M0_2M6 = 0x79797979;
struct EpiSwiGLU8 {
    static constexpr bool PERM = true; static constexpr int SCALE_A = E8M0_ONE, SCALE_B = E8M0_2M6, FMT = MOE_GU_FP6 ? 2 : 0, NST = 8;
    unsigned char* O; int ldc;
    __device__ __forceinline__ void operator()(const f32x4 (&acc)[2][2][4][2], const Unit& u, int wr, int wc, int fr, int fq) const {
        const int row0 = u.rm * BM + wr * 64 + fr, col0 = u.cn * HALF + wc * 32 + 8 * fq;
#pragma unroll
        for (int ai = 0; ai < 2; ++ai)
#pragma unroll
            for (int m = 0; m < 4; ++m) { unsigned char* rowp = O + (size_t)(row0 + ai * HALF + m * 16) * ldc + col0;
                const f32x4 g0 = acc[ai][0][m][0], g1 = acc[ai][0][m][1], u0 = acc[ai][1][m][0], u1 = acc[ai][1][m][1];
                u32x2 w; w.x = pk4_fp8_raw(silu_mul(g0[0], u0[0]), silu_mul(g0[1], u0[1]), silu_mul(g0[2], u0[2]), silu_mul(g0[3], u0[3]));
                w.y = pk4_fp8_raw(silu_mul(g1[0], u1[0]), silu_mul(g1[1], u1[1]), silu_mul(g1[2], u1[2]), silu_mul(g1[3], u1[3]));
                *(u32x2*)rowp = w; }
    }
};
template <int FMT_> struct EpiNull8 {
    static constexpr bool PERM = true; static constexpr int SCALE_A = E8M0_ONE, SCALE_B = E8M0_2M6, FMT = FMT_, NST = 0;
    float* sink;
    __device__ __forceinline__ void operator()(const f32x4 (&acc)[2][2][4][2], const Unit& u, int wr, int wc, int fr, int fq) const {
        float s = 0.f;
#pragma unroll
        for (int ai = 0; ai < 2; ++ai)
#pragma unroll
            for (int bj = 0; bj < 2; ++bj)
#pragma unroll
                for (int m = 0; m < 4; ++m)
#pragma unroll
                    for (int n = 0; n < 2; ++n) s += (acc[ai][bj][m][n][0] + acc[ai][bj][m][n][1]) + (acc[ai][bj][m][n][2] + acc[ai][bj][m][n][3]);
        if (s == 12345.678f) sink[0] = s;
    }
};
struct EpiNull16 {
    static constexpr bool PERM = true; static constexpr int NST = 0;
    float* sink;
    __device__ __forceinline__ void operator()(const f32x4 (&acc)[2][2][4][2], const Unit& u, int wr, int wc, int fr, int fq) const {
        float s = 0.f;
#pragma unroll
        for (int ai = 0; ai < 2; ++ai)
#pragma unroll
            for (int bj = 0; bj < 2; ++bj)
#pragma unroll
                for (int m = 0; m < 4; ++m)
#pragma unroll
                    for (int n = 0; n < 2; ++n) s += (acc[ai][bj][m][n][0] + acc[ai][bj][m][n][1]) + (acc[ai][bj][m][n][2] + acc[ai][bj][m][n][3]);
        if (s == 12345.678f) sink[0] = s;
    }
};
constexpr long DY1 = ((long)WS_Y1 - (long)WS_Y0) / 2;
struct SingleOrder {
    int has, pm, pn, rm, cn;
    __device__ __forceinline__ bool next(int i, Unit& u) const { if (i != 0 || !has) return false; u.pm = pm; u.pn = pn; u.rm = rm; u.cn = cn; return true; }
    __device__ __forceinline__ void a_ready(const Unit&) const {}
    __device__ __forceinline__ void done(const Unit&) const {}
};
struct EpiSlab {
    static constexpr bool PERM = true; static constexpr int SCALE_A = E8M0_ONE, SCALE_B = E8M0_2M6, FMT = 0, NST = 0;
    bf16_t* slab; const u32x2* slot_rec;
    __device__ __forceinline__ void operator()(const f32x4 (&acc)[2][2][4][2], const Unit& u, int wr, int wc, int fr, int fq) const {
        const int r0 = wr * 64 + fr, c0 = wc * 32 + 8 * fq;
#pragma unroll
        for (int ai = 0; ai < 2; ++ai)
#pragma unroll
            for (int m = 0; m < 4; ++m) { const int rl = r0 + ai * HALF + m * 16; const u32x2 rec = slot_rec[u.rm * BM + rl];
                if ((int)rec.x >= 0) { const float ww = __uint_as_float(rec.y);
#pragma unroll
                    for (int bj = 0; bj < 2; ++bj) { const f32x4 v0 = acc[ai][bj][m][0] * ww, v1 = acc[ai][bj][m][1] * ww;
                        u32x4 o; o.x = pk2(v0[0], v0[1]); o.y = pk2(v0[2], v0[3]); o.z = pk2(v1[0], v1[1]); o.w = pk2(v1[2], v1[3]);
                        *(u32x4*)(slab + rl * 256 + c0 + bj * HALF) = o; } } }
    }
};
struct EpiMoeDown {
    static constexpr bool PERM = true; static constexpr int SCALE_A = E8M0_ONE, SCALE_B = E8M0_2M6, FMT = 0, NST = 8;
    bf16_t* Y0; const u32x2* slot_rec;
    __device__ __forceinline__ void operator()(const f32x4 (&acc)[2][2][4][2], const Unit& u, int wr, int wc, int fr, int fq) const {
        const int row0 = u.rm * BM + wr * 64 + fr, col0 = u.cn * BM + wc * 32 + 8 * fq;
        int meta[2][4]; float w[2][4];
#pragma unroll
        for (int ai = 0; ai < 2; ++ai)
#pragma unroll
            for (int m = 0; m < 4; ++m) { const u32x2 rec = slot_rec[row0 + ai * HALF + m * 16]; meta[ai][m] = (int)rec.x; w[ai][m] = __uint_as_float(rec.y); }
#pragma unroll
        for (int ai = 0; ai < 2; ++ai)
#pragma unroll
            for (int m = 0; m < 4; ++m) { const int mt = meta[ai][m]; const float ww = w[ai][m];
                if (mt >= 0) { const unsigned off = ((mt & 1) ? (unsigned)DY1 : 0u) + (unsigned)(mt >> 1) * D + col0; bf16_t* dst = Y0 + off;
#pragma unroll
                    for (int bj = 0; bj < 2; ++bj) { const f32x4 v0 = acc[ai][bj][m][0] * ww, v1 = acc[ai][bj][m][1] * ww;
                        u32x4 o; o.x = pk2(v0[0], v0[1]); o.y = pk2(v0[2], v0[3]); o.z = pk2(v1[0], v1[1]); o.w = pk2(v1[2], v1[3]);
                        *(u32x4*)(dst + bj * HALF) = o; } } }
    }
};

template <int OFF0> __device__ __forceinline__ void glds_pair(const char* sbase, unsigned voff0, unsigned voff1, unsigned lds_base) {
    asm volatile("s_add_u32 m0, %3, %4\n\ts_nop 0\n\tglobal_load_lds_dwordx4 %0, %2\n\ts_add_u32 m0, %3, %5\n\ts_nop 0\n\tglobal_load_lds_dwordx4 %1, %2"
                 :: "v"(voff0), "v"(voff1), "s"(sbase), "s"(lds_base), "i"(OFF0), "i"(OFF0 + 8192) : "memory", "scc");
}
template <class Epi, class Sched, bool FP8 = false, bool ALIGN_EPI = true, bool SP2 = true, int DBG = 0>
__device__ __forceinline__ void gemm_phase(LAS unsigned char* lds, const Gemm g, const Sched& S, const Epi& E) {
    int tid_o = threadIdx.x; asm volatile("" : "+v"(tid_o));
    const int tid = tid_o, wid = __builtin_amdgcn_readfirstlane(tid >> 6), lane = tid & 63, wr = wid >> 2, wc = wid & 3, fr = lane & 15, fq = lane >> 4;
    const int nt = g.K / (BK * 2);
    unsigned voffA[2], voffB[2];
#pragma unroll
    for (int i = 0; i < 2; ++i) { int R, C; stage_rc(tid * 16 + i * 8192, R, C); const int Rb = Epi::PERM ? ((R & ~31) + perm32(R & 31)) : R;
        voffA[i] = (unsigned)(R * g.lda + C * 2); voffB[i] = (unsigned)(Rb * g.ldb + C * 2); }
    const size_t kstep = (size_t)(BK * 2);
    const size_t hstepA = (size_t)HALF * g.lda, hstepB = (size_t)HALF * g.ldb;
    const size_t tstepA = 2 * hstepA, tstepB = 2 * hstepB;
    const unsigned lds_base = (unsigned)(size_t)lds + (unsigned)wid * 1024u;
    const int aoff = lds_byte(wr * 64 + fr, fq * 8), boff = lds_byte(wc * 32 + fr, fq * 8);
#define PG8_SA(b, h) (((b) * 2 + (h)) * HTB)
#define PG8_SB(b, h) ((4 + (b) * 2 + (h)) * HTB)
#define PG8_STAGE(bufoff, gbase, voff) do { if constexpr (!(DBG & 1)) glds_pair<(bufoff)>((const char*)(gbase), (voff)[0], (voff)[1], lds_base); } while (0)
#define PG8_LDA(dst, b, h) do { if constexpr (!(DBG & 2)) _Pragma("unroll") for (int m = 0; m < 4; ++m) _Pragma("unroll") for (int k = 0; k < 2; ++k) dst[m][k] = *(const LAS bf16x8*)(lds + PG8_SA(b, h) + aoff + m * 2048 + k * 1024); } while (0)
#define PG8_LDB(dst, b, h) do { if constexpr (!(DBG & 2)) _Pragma("unroll") for (int n = 0; n < 2; ++n) _Pragma("unroll") for (int k = 0; k < 2; ++k) dst[n][k] = *(const LAS bf16x8*)(lds + PG8_SB(b, h) + boff + n * 2048 + k * 1024); } while (0)
#define PG8_MMA(ai, bj, At, Bt) do { if constexpr (!(DBG & 8)) __builtin_amdgcn_s_setprio((DBG & 16) ? 3 : 1); if constexpr (!(DBG & 4)) _Pragma("unroll") for (int m = 0; m < 4; ++m) _Pragma("unroll") for (int n = 0; n < 2; ++n) { \
        if constexpr (FP8) { if constexpr (Epi::FMT == 8) { _Pragma("unroll") for (int k = 0; k < 2; ++k) acc[ai][bj][m][n] = __builtin_bit_cast(f32x4, __builtin_amdgcn_mfma_i32_16x16x64_i8(__builtin_bit_cast(i32x4, Bt[n][k]), __builtin_bit_cast(i32x4, At[m][k]), __builtin_bit_cast(i32x4, acc[ai][bj][m][n]), 0, 0, 0)); } \
            else { const i32x4 b_lo = __builtin_bit_cast(i32x4, Bt[n][0]), b_hi = __builtin_bit_cast(i32x4, Bt[n][1]), a_lo = __builtin_bit_cast(i32x4, At[m][0]), a_hi = __builtin_bit_cast(i32x4, At[m][1]); \
            acc[ai][bj][m][n] = __builtin_amdgcn_mfma_scale_f32_16x16x128_f8f6f4(__builtin_shufflevector(b_lo, b_hi, 0, 1, 2, 3, 4, 5, 6, 7), __builtin_shufflevector(a_lo, a_hi, 0, 1, 2, 3, 4, 5, 6, 7), acc[ai][bj][m][n], Epi::FMT, Epi::FMT, 0, Epi::SCALE_B, 0, Epi::SCALE_A); } } \
        else { _Pragma("unroll") for (int k = 0; k < 2; ++k) acc[ai][bj][m][n] = __builtin_amdgcn_mfma_f32_16x16x32_bf16(Bt[n][k], At[m][k], acc[ai][bj][m][n], 0, 0, 0); } } \
        if constexpr (!(DBG & 8)) __builtin_amdgcn_s_setprio(0); } while (0)
#define PG8_WAIT_V(n) asm volatile("s_waitcnt vmcnt(" #n ")" ::: "memory")
#define PG8_WAIT_L(n) asm volatile("s_waitcnt lgkmcnt(" #n ")" ::: "memory")
#define PG8_BAR __builtin_amdgcn_s_barrier()
#define PG8_SCHED __builtin_amdgcn_sched_barrier(0)
    Unit cur, nxt; int ui = 0;
    if (!S.next(0, cur)) return;
    f32x4 acc[2][2][4][2];
#pragma unroll
    for (int a = 0; a < 2; ++a)
#pragma unroll
        for (int b = 0; b < 2; ++b)
#pragma unroll
            for (int m = 0; m < 4; ++m)
#pragma unroll
                for (int n = 0; n < 2; ++n) acc[a][b][m][n] = (f32x4){0.f, 0.f, 0.f, 0.f};
    bf16x8 At[4][2], B0[2][2], B1[2][2];
    const char* cA = (const char*)g.A + (size_t)cur.pm * tstepA; const char* cB = (const char*)g.Bt + (size_t)cur.pn * tstepB;
    S.a_ready(cur);
    if constexpr (SP2) {
        PG8_STAGE(PG8_SB(0, 0), cB, voffB); PG8_STAGE(PG8_SB(0, 1), cB + hstepB, voffB); PG8_STAGE(PG8_SA(0, 0), cA, voffA); PG8_STAGE(PG8_SA(0, 1), cA + hstepA, voffA);
        if (wr == 1) PG8_BAR;
        PG8_WAIT_V(2); PG8_BAR;
        PG8_STAGE(PG8_SB(1, 0), cB + kstep, voffB); PG8_STAGE(PG8_SA(1, 0), cA + kstep, voffA); PG8_STAGE(PG8_SB(1, 1), cB + hstepB + kstep, voffB);
        PG8_WAIT_V(6); PG8_BAR;
    } else {
        PG8_STAGE(PG8_SB(0, 0), cB, voffB); PG8_STAGE(PG8_SA(0, 0), cA, voffA); PG8_STAGE(PG8_SB(0, 1), cB + hstepB, voffB); PG8_STAGE(PG8_SA(0, 1), cA + hstepA, voffA);
        if (wr == 1) PG8_BAR;
        PG8_WAIT_V(4); PG8_BAR;
        PG8_STAGE(PG8_SB(1, 0), cB + kstep, voffB); PG8_STAGE(PG8_SA(1, 0), cA + kstep, voffA); PG8_STAGE(PG8_SB(1, 1), cB + hstepB + kstep, voffB);
        PG8_WAIT_V(6); PG8_BAR;
    }
    for (;;) {
        const bool has_next = S.next(ui + 1, nxt);
        const char* nA = has_next ? (const char*)g.A + (size_t)nxt.pm * tstepA : cA; const char* nB = has_next ? (const char*)g.Bt + (size_t)nxt.pn * tstepB : cB;
#pragma clang loop unroll(disable)
        for (int t = 0; t < nt; t += 2) {
            const bool last = (t == nt - 2);
            const char* a1 = cA + (size_t)(t + 1) * kstep;
            const char* a2 = last ? nA : cA + (size_t)(t + 2) * kstep; const char* b2 = last ? nB : cB + (size_t)(t + 2) * kstep;
            const char* a3 = a2 + kstep; const char* b3 = b2 + kstep;
            if (last && has_next) S.a_ready(nxt);
            if constexpr (SP2) {
            const bool post_epi = EPIWAIT && (t == 0) && (ui > 0);
            PG8_LDB(B0, 0, 0); PG8_LDB(B1, 0, 1); PG8_SCHED; PG8_LDA(At, 0, 0); PG8_STAGE(PG8_SA(1, 1), a1 + hstepA, voffA);
            if (post_epi) asm volatile("s_waitcnt vmcnt(%0)" :: "n"(8 + Epi::NST) : "memory"); else PG8_WAIT_V(8);
            PG8_WAIT_L(0); PG8_BAR; PG8_MMA(0, 0, At, B0); PG8_MMA(0, 1, At, B1); PG8_BAR; PG8_SCHED;
            PG8_LDA(At, 0, 1); PG8_STAGE(PG8_SB(0, 0), b2, voffB); PG8_STAGE(PG8_SB(0, 1), b2 + hstepB, voffB); PG8_STAGE(PG8_SA(0, 0), a2, voffA);
            if (post_epi) asm volatile("s_waitcnt vmcnt(%0)" :: "n"(8 + Epi::NST) : "memory"); else PG8_WAIT_V(8);
            PG8_WAIT_L(0); PG8_BAR; PG8_MMA(1, 0, At, B0); PG8_MMA(1, 1, At, B1); PG8_BAR; PG8_SCHED;
            PG8_LDB(B0, 1, 0); PG8_LDB(B1, 1, 1); PG8_SCHED; PG8_LDA(At, 1, 0); PG8_STAGE(PG8_SA(0, 1), a2 + hstepA, voffA);
            PG8_WAIT_V(8); PG8_WAIT_L(0); PG8_BAR; PG8_MMA(0, 0, At, B0); PG8_MMA(0, 1, At, B1); PG8_BAR; PG8_SCHED;
            PG8_LDA(At, 1, 1); PG8_STAGE(PG8_SB(1, 0), b3, voffB); PG8_STAGE(PG8_SB(1, 1), b3 + hstepB, voffB); PG8_STAGE(PG8_SA(1, 0), a3, voffA);
            PG8_WAIT_V(8); PG8_WAIT_L(0); PG8_BAR; PG8_MMA(1, 0, At, B0); PG8_MMA(1, 1, At, B1); PG8_BAR; PG8_SCHED;
            } else {
            PG8_LDB(B0, 0, 0); PG8_SCHED; PG8_LDA(At, 0, 0); PG8_STAGE(PG8_SA(1, 1), a1 + hstepA, voffA);
            PG8_WAIT_L(8); PG8_BAR; PG8_WAIT_L(0); PG8_MMA(0, 0, At, B0); PG8_BAR; PG8_SCHED;
            PG8_LDB(B1, 0, 1); PG8_STAGE(PG8_SB(0, 0), b2, voffB);
            PG8_BAR; PG8_WAIT_L(0); PG8_MMA(0, 1, At, B1); PG8_BAR;
            PG8_LDA(At, 0, 1); PG8_STAGE(PG8_SA(0, 0), a2, voffA);
            PG8_BAR; PG8_WAIT_L(0); PG8_MMA(1, 0, At, B0); PG8_BAR; PG8_SCHED;
            PG8_STAGE(PG8_SB(0, 1), b2 + hstepB, voffB);
            PG8_WAIT_V(6); PG8_BAR; PG8_MMA(1, 1, At, B1); PG8_BAR;
            PG8_LDB(B0, 1, 0); PG8_SCHED; PG8_LDA(At, 1, 0); PG8_STAGE(PG8_SA(0, 1), a2 + hstepA, voffA);
            PG8_WAIT_L(8); PG8_BAR; PG8_WAIT_L(0); PG8_MMA(0, 0, At, B0); PG8_BAR; PG8_SCHED;
            PG8_LDB(B1, 1, 1); PG8_STAGE(PG8_SB(1, 0), b3, voffB);
            PG8_BAR; PG8_WAIT_L(0); PG8_MMA(0, 1, At, B1); PG8_BAR;
            PG8_LDA(At, 1, 1); PG8_STAGE(PG8_SA(1, 0), a3, voffA);
            PG8_BAR; PG8_WAIT_L(0); PG8_MMA(1, 0, At, B0); PG8_BAR; PG8_SCHED;
            PG8_STAGE(PG8_SB(1, 1), b3 + hstepB, voffB);
            PG8_WAIT_V(6); PG8_BAR; PG8_MMA(1, 1, At, B1); PG8_BAR;
            }
        }
        if constexpr (ALIGN_EPI) { if (wr == 0) PG8_BAR; }
        { int l2 = threadIdx.x; asm volatile("" : "+v"(l2)); l2 &= 63; E(acc, cur, wr, wc, l2 & 15, l2 >> 4); }
        S.done(cur);
        if (!has_next) break;
#pragma unroll
        for (int a = 0; a < 2; ++a)
#pragma unroll
            for (int b = 0; b < 2; ++b)
#pragma unroll
                for (int m = 0; m < 4; ++m)
#pragma unroll
                    for (int n = 0; n < 2; ++n) acc[a][b][m][n] = (f32x4){0.f, 0.f, 0.f, 0.f};
        cur = nxt; cA = nA; cB = nB; ++ui;
        if constexpr (ALIGN_EPI) { if (wr == 1) PG8_BAR; }
    }
    PG8_WAIT_V(0);
    if constexpr (!ALIGN_EPI) { if (wr == 0) PG8_BAR; }
    PG8_BAR;
#undef PG8_SA
#undef PG8_SB
#undef PG8_STAGE
#undef PG8_LDA
#undef PG8_LDB
#undef PG8_MMA
#undef PG8_WAIT_V
#undef PG8_WAIT_L
#undef PG8_BAR
#undef PG8_SCHED
}
}

#define XB_TMO      128
#define XB_XCNT(j)  (256  + 64 * (j))
#define XB_XSUB(j)  (1280 + 64 * (j))
#define XB_XGEN(j)  (2304 + 64 * (j))
#define XB_TOP      3328
#define XB_TOPGEN   3392
#define XCD_BAR_WORDS 3456
#define XB_SPIN_CAP (1u << 18)
__device__ __forceinline__ unsigned xb_ld(unsigned* p)              { return __hip_atomic_load(p, __ATOMIC_RELAXED, __HIP_MEMORY_SCOPE_AGENT); }
__device__ __forceinline__ unsigned xb_add(unsigned* p, unsigned v) { return __hip_atomic_fetch_add(p, v, __ATOMIC_RELAXED, __HIP_MEMORY_SCOPE_AGENT); }
__device__ __forceinline__ unsigned xb_xcc_id() { return (unsigned)__builtin_amdgcn_s_getreg((3 << 11) | 20) & 0xFu; }
#define XB_SPIN(cond, bar) do { unsigned _sp = 0; while (cond) { __builtin_amdgcn_s_sleep(1); \
    if ((++_sp & 255u) == 0u) { if (xb_ld(&(bar)[XB_TMO])) break; if (_sp > XB_SPIN_CAP) { atomicAdd(&(bar)[XB_TMO], 1u); break; } } } } while (0)
struct XcdBarrier { unsigned* bar; unsigned x; volatile LAS unsigned* st; };
__device__ __forceinline__ XcdBarrier xcd_barrier_post(unsigned* bar, volatile LAS unsigned* st) {
    XcdBarrier b; b.bar = bar; b.x = xb_xcc_id(); b.st = st;
    if (threadIdx.x == 0) (void)xb_add(&bar[XB_XCNT(b.x)], 1u);
    return b;
}
__device__ __forceinline__ void xcd_barrier_complete(unsigned* bar, unsigned x, unsigned& nloc, unsigned& nx) {
    const unsigned G = gridDim.x * gridDim.y * gridDim.z;
    unsigned sum, cnt, mine, sp = 0u;
    for (;;) {
        sum = 0u; cnt = 0u; mine = 0u;
#pragma unroll
        for (unsigned j = 0; j < 16; ++j) { const unsigned c = xb_ld(&bar[XB_XCNT(j)]); sum += c; cnt += (c > 0u) ? 1u : 0u; mine = (j == x) ? c : mine; }
        if (sum == G) break;
        __builtin_amdgcn_s_sleep(1);
        if ((++sp & 255u) == 0u) { if (xb_ld(&bar[XB_TMO])) break; if (sp > XB_SPIN_CAP) { atomicAdd(&bar[XB_TMO], 1u); break; } }
    }
    nloc = mine > 0u ? mine : 1u; nx = cnt > 0u ? cnt : 1u;
}
__device__ __forceinline__ void xcd_barrier(const XcdBarrier& b) {
    asm volatile("s_waitcnt vmcnt(0)" ::: "memory");
    __syncthreads();
    if (threadIdx.x == 0) {
        unsigned* bar = b.bar;
        __builtin_amdgcn_s_waitcnt(0);
        unsigned nloc = b.st[0], nx = b.st[1];
        if (nloc == 0u) { xcd_barrier_complete(bar, b.x, nloc, nx); b.st[0] = nloc; b.st[1] = nx; }
        const unsigned old = xb_add(&bar[XB_XSUB(b.x)], 1u);
        const unsigned gen = old / nloc;
        if (old + 1u == (gen + 1u) * nloc) {
            __builtin_amdgcn_fence(__ATOMIC_RELEASE, "agent");
            asm volatile("s_waitcnt vmcnt(0)" ::: "memory");
            const unsigned og = xb_add(&bar[XB_TOP], 1u);
            const unsigned tg = og / nx;
            if (og + 1u == (tg + 1u) * nx) xb_add(&bar[XB_TOPGEN], 1u);
            else XB_SPIN(xb_ld(&bar[XB_TOPGEN]) == tg, bar);
            __builtin_amdgcn_fence(__ATOMIC_ACQUIRE, "agent");
            xb_add(&bar[XB_XGEN(b.x)], 1u);
            asm volatile("s_waitcnt vmcnt(0)" ::: "memory");
        } else {
            XB_SPIN(xb_ld(&bar[XB_XGEN(b.x)]) == gen, bar);
            __builtin_amdgcn_fence(__ATOMIC_ACQUIRE, "agent");
            asm volatile("s_waitcnt vmcnt(0)" ::: "memory");
        }
    }
    __syncthreads();
}

struct Params { const float* in[24]; float* out; unsigned char* ws; int ph_lo, ph_hi; };
enum { I_X = 0, I_RELB, I_EVNM, I_WIN, I_POOLW, I_POOLS, I_CONVW, I_WOUT, I_EVNF, I_FG, I_FU, I_FD, I_ODNM, I_WQKV, I_BQKV, I_SINK, I_WO, I_BO, I_ODNF, I_ROUTER, I_EG, I_EU, I_ED, I_FINAL };

__device__ __forceinline__ void p0_tile(const float* __restrict__ src, int N, int k0, int n0, bf16_t* __restrict__ dst, int ldd, LAS unsigned char* scr, int lane, const float* __restrict__ gain = nullptr, float scale = 1.0f) {
    const int n4 = (lane & 15) * 4, kp = lane >> 4;
    f32x4 a[8], b[8];
#pragma unroll
    for (int i = 0; i < 8; ++i) { const float* p = src + (size_t)(k0 + 8 * i + 2 * kp) * N + n0 + n4; a[i] = __builtin_nontemporal_load((const f32x4*)p); b[i] = __builtin_nontemporal_load((const f32x4*)(p + N));
        if (gain) { a[i] = a[i] * (gain[k0 + 8 * i + 2 * kp] * scale); b[i] = b[i] * (gain[k0 + 8 * i + 2 * kp + 1] * scale); } else if (scale != 1.0f) { a[i] = a[i] * scale; b[i] = b[i] * scale; } }
#pragma unroll
    for (int i = 0; i < 8; ++i) { const int k = 8 * i + 2 * kp;
#pragma unroll
        for (int q = 0; q < 4; ++q) *(LAS unsigned*)(scr + (n4 + q) * 136 + k * 2) = pk2(a[i][q], b[i][q]); }
    LDS_WAIT();
    const int c = lane & 7, nr = lane >> 3;
#pragma unroll
    for (int j = 0; j < 8; ++j) { const int n = 8 * j + nr; const u32x2 lo = *(const LAS u32x2*)(scr + n * 136 + 16 * c), hi = *(const LAS u32x2*)(scr + n * 136 + 16 * c + 8);
        u32x4 o; o.x = lo.x; o.y = lo.y; o.z = hi.x; o.w = hi.y; *(u32x4*)(dst + (size_t)n * ldd + 8 * c) = o; }
    LDS_WAIT();
}
struct P0WTile { const float* src; unsigned char* dst; int N, ldd, n0, up; float scale; };
__device__ __forceinline__ P0WTile p0w_desc(int t, const float* eg, const float* eu, const float* ed, unsigned char* Wegu8, unsigned char* Wed8) {
    const int e = MOE_GU_FP6 ? t / 112 : t / 336; int q = MOE_GU_FP6 ? 224 + t % 112 : t % 336; P0WTile d;
    if (q < 224) { const int up = q >= 112; if (up) q -= 112; const int kb = q / 14, nb = q % 14;
        d.src = (up ? eu : eg) + (size_t)e * D * DFE + (size_t)(128 * kb) * DFE + 256 * nb; d.N = DFE; d.n0 = 256 * nb; d.up = up; d.dst = Wegu8 + (size_t)e * 2 * DFE * D + 128 * kb; d.ldd = D; d.scale = up ? 64.f : -64.f * 1.44269504089f; }
    else { q -= 224; const int kb = q / 4, nb = q % 4;
        d.src = ed + (size_t)e * DFE * D + (size_t)(128 * kb) * D + 256 * nb; d.N = D; d.n0 = 256 * nb; d.up = -1; d.dst = Wed8 + (size_t)e * D * DFE + 128 * kb; d.ldd = DFE; d.scale = MOE_GU_FP6 ? 64.f * F6_DOWN : -64.f * 0.69314718056f; }
    return d;
}
__device__ __forceinline__ void p0w_load(const P0WTile& d, int wave, int lane, f32x4 (&a)[16]) {
#pragma unroll
    for (int r = 0; r < 16; ++r) a[r] = __builtin_nontemporal_load((const f32x4*)(d.src + (size_t)(16 * wave + r) * d.N + 4 * lane));
}
__device__ __forceinline__ void p0w_to_lds(const f32x4 (&a)[16], LAS unsigned char* buf, int wave, int lane, float scale) {
#pragma unroll
    for (int i = 0; i < 4; ++i)
#pragma unroll
        for (int q = 0; q < 4; ++q) { const int n = 4 * lane + q, c = 4 * wave + i;
            *(LAS unsigned*)(buf + n * 128 + 4 * (c ^ (4 * ((n >> 2) & 7)))) = pg8::pk4_fp8(a[4 * i][q] * scale, a[4 * i + 1][q] * scale, a[4 * i + 2][q] * scale, a[4 * i + 3][q] * scale); }
}
__device__ __forceinline__ void p0w_store(const P0WTile& d, const LAS unsigned char* buf, int wave, int lane) {
    const int pc = lane & 7;
#pragma unroll
    for (int j = 0; j < 4; ++j) { const int n = 32 * wave + 8 * j + (lane >> 3); const u32x4 v = *(const LAS u32x4*)(buf + n * 128 + 16 * (pc ^ ((n >> 2) & 7)));
        const int ng = d.n0 + n; const int row = d.up >= 0 ? (ng >> 7) * 256 + (ng & 127) + 128 * d.up : ng;
        __builtin_nontemporal_store(v, (u32x4*)(d.dst + (size_t)row * d.ldd + 16 * pc)); }
}
struct P0W6 { const float* src; unsigned char* dst; int n0, up; float scale; };
__device__ __forceinline__ P0W6 p0w6_desc(int t, const float* eg, const float* eu, unsigned char* Wegu8) {
    const int e = t / 224; int q = t % 224; const int up = q >= 112; if (up) q -= 112; const int kb = q / 28, nb = q % 28; P0W6 d;
    d.src = (up ? eu : eg) + (size_t)e * D * DFE + (size_t)(256 * kb) * DFE + 128 * nb; d.n0 = 128 * nb; d.up = up; d.dst = Wegu8 + (size_t)e * 2 * DFE * D + 256 * kb; d.scale = up ? F6_W : -F6_W;
    return d;
}
__device__ __forceinline__ void p0w6_load(const P0W6& d, int wave, int lane, f32x2 (&a)[32]) {
#pragma unroll
    for (int r = 0; r < 32; ++r) a[r] = __builtin_nontemporal_load((const f32x2*)(d.src + (size_t)(32 * wave + r) * DFE + 2 * lane));
}
__device__ __forceinline__ void p0w6_to_lds(const f32x2 (&a)[32], LAS unsigned char* buf, int wave, int lane, float scale) {
    const int off = (wave >> 2) * 128 + 16 * (wave & 3);
#pragma unroll
    for (int h = 0; h < 2; ++h) { unsigned w[16];
#pragma unroll
        for (int i = 0; i < 16; ++i) w[i] = pk2(a[2 * i][h] * scale, a[2 * i + 1][h] * scale);
        const i32x6 P = pk32_fp6(w);
        LAS unsigned char* rowp = buf + (2 * lane + h) * 272 + off;
        *(LAS u32x4*)rowp = (u32x4){(unsigned)P[0], (unsigned)P[1], (unsigned)P[2], (unsigned)P[3]};
        *(LAS u32x4*)(rowp + 64) = (u32x4){(unsigned)P[4], (unsigned)P[5], 0u, 0u}; }
}
__device__ __forceinline__ void p0w6_store(const P0W6& d, const LAS unsigned char* buf, int tid) {
    const int row = tid >> 2, seg = tid & 3; const int ng = d.n0 + row; const int drow = (ng >> 7) * 256 + (ng & 127) + 128 * d.up;
#pragma unroll
    for (int j = 0; j < 4; ++j) __builtin_nontemporal_store(*(const LAS u32x4*)(buf + row * 272 + seg * 64 + 16 * j), (u32x4*)(d.dst + (size_t)drow * D + seg * 64 + 16 * j));
}
__device__ __forceinline__ void norm_row_bf16(const float* __restrict__ xrow, const float* __restrict__ gain, bf16_t* __restrict__ orow, int lane, float (&y)[16]) {
    f32x4 v[4];
#pragma unroll
    for (int j = 0; j < 2; ++j) { v[2 * j] = __builtin_nontemporal_load((const f32x4*)(xrow + 512 * j + 8 * lane)); v[2 * j + 1] = __builtin_nontemporal_load((const f32x4*)(xrow + 512 * j + 8 * lane + 4)); }
    float s = 0.f;
#pragma unroll
    for (int j = 0; j < 4; ++j) s += (v[j][0] * v[j][0] + v[j][1] * v[j][1]) + (v[j][2] * v[j][2] + v[j][3] * v[j][3]);
    const float r = 1.0f / sqrtf(wave_sum(s) * (1.0f / D) + RMS_EPS);
#pragma unroll
    for (int j = 0; j < 2; ++j) { const f32x4 g0 = *(const f32x4*)(gain + 512 * j + 8 * lane), g1 = *(const f32x4*)(gain + 512 * j + 8 * lane + 4);
#pragma unroll
        for (int q = 0; q < 4; ++q) { y[8 * j + q] = v[2 * j][q] * r * g0[q]; y[8 * j + 4 + q] = v[2 * j + 1][q] * r * g1[q]; }
        u32x4 w; w.x = pk2(y[8 * j], y[8 * j + 1]); w.y = pk2(y[8 * j + 2], y[8 * j + 3]); w.z = pk2(y[8 * j + 4], y[8 * j + 5]); w.w = pk2(y[8 * j + 6], y[8 * j + 7]);
        *(u32x4*)(orow + 512 * j + 8 * lane) = w; }
}

__device__ __forceinline__ int t5_bucket(int rel) {
    const int n = rel < 0 ? -rel : rel; const int ret = rel > 0 ? 16 : 0;
    int v;
    if (n < 8) v = n; else if (n < 12) v = 8; else if (n < 16) v = 9; else if (n < 23) v = 10; else if (n < 32) v = 11; else if (n < 46) v = 12; else if (n < 64) v = 13; else if (n < 91) v = 14; else v = 15;
    return ret + v;
}

constexpr int AT_KS_STR = 144, AT_VT_STR = 392;
constexpr int AT_L_K = 0, AT_L_VT = 192 * AT_KS_STR, AT_L_BT = AT_L_VT + 64 * AT_VT_STR, AT_L_OST = AT_L_BT + NQH * 256 * 4;
static_assert(AT_L_OST + NWAVES * 32 * 144 <= RING_BYTES, "attention LDS");
__device__ __forceinline__ void attn_qblock(LAS unsigned char* lds, const bf16x8 (&qf)[4], bf16_t* __restrict__ orow0, int head, int qb, int kb_min, float sink, int wave, int lane) {
    const int r32 = lane & 31, hh = lane >> 5;
    const LAS float* bt = (const LAS float*)(lds + AT_L_BT + head * 1024);
    f32x16 st[6];
#pragma unroll
    for (int kb = 0; kb < 6; ++kb) {
#pragma unroll
        for (int e = 0; e < 16; ++e) st[kb][e] = 0.f;
#pragma unroll
        for (int ks = 0; ks < 4; ++ks) { const bf16x8 kf = *(const LAS bf16x8*)(lds + AT_L_K + (kb * 32 + r32) * AT_KS_STR + 32 * ks + 16 * hh);
            st[kb] = __builtin_amdgcn_mfma_f32_32x32x16_bf16(kf, qf[ks], st[kb], 0, 0, 0); } }
    const float sinkl = sink * 1.44269504089f;
    float mx = sinkl;
#pragma unroll
    for (int kb = 0; kb < 6; ++kb) {
        if (kb < kb_min) {
#pragma unroll
            for (int e = 0; e < 16; ++e) st[kb][e] = -1e30f;
        } else {
#pragma unroll
            for (int e = 0; e < 16; e += 2) { const int j = kb * 32 + (e & 3) + 8 * (e >> 2) + 4 * hh; const int idx = j - (qb * 32 + r32) + 63;
                const f32x2 bb = {bt[idx], bt[idx + 1]}; const f32x2 qk = {st[kb][e], st[kb][e + 1]}; const f32x2 sc = qk * (0.125f * 1.44269504089f) + bb;
                st[kb][e] = sc.x; st[kb][e + 1] = sc.y; mx = __builtin_fmaxf(mx, __builtin_fmaxf(sc.x, sc.y)); } } }
    mx = fmaxf(mx, __shfl_xor(mx, 32));
    f32x2 sum2 = {0.f, 0.f};
#pragma unroll
    for (int kb = 0; kb < 6; ++kb)
#pragma unroll
        for (int e = 0; e < 16; e += 2) { const f32x2 d = (f32x2){st[kb][e], st[kb][e + 1]} - mx; f32x2 pe; pe.x = __builtin_amdgcn_exp2f(d.x); pe.y = __builtin_amdgcn_exp2f(d.y); st[kb][e] = pe.x; st[kb][e + 1] = pe.y; sum2 += pe; }
    float sum = sum2.x + sum2.y;
    sum += __shfl_xor(sum, 32);
    const float inv = 1.0f / (sum + __builtin_amdgcn_exp2f(sinkl - mx));
    f32x16 ot[2];
#pragma unroll
    for (int db = 0; db < 2; ++db)
#pragma unroll
        for (int e = 0; e < 16; ++e) ot[db][e] = 0.f;
#pragma unroll
    for (int kb = 0; kb < 6; ++kb)
#pragma unroll
        for (int s = 0; s < 2; ++s) {
            u32x4 pw; pw.x = pk2(st[kb][8 * s], st[kb][8 * s + 1]); pw.y = pk2(st[kb][8 * s + 2], st[kb][8 * s + 3]); pw.z = pk2(st[kb][8 * s + 4], st[kb][8 * s + 5]); pw.w = pk2(st[kb][8 * s + 6], st[kb][8 * s + 7]);
            const bf16x8 pf = __builtin_bit_cast(bf16x8, pw);
#pragma unroll
            for (int db = 0; db < 2; ++db) { const LAS unsigned char* vp = lds + AT_L_VT + (db * 32 + r32) * AT_VT_STR + 2 * (kb * 32 + 16 * s + 4 * hh);
                const u32x2 v0 = *(const LAS u32x2*)vp, v1 = *(const LAS u32x2*)(vp + 16);
                u32x4 vw; vw.x = v0.x; vw.y = v0.y; vw.z = v1.x; vw.w = v1.y;
                ot[db] = __builtin_amdgcn_mfma_f32_32x32x16_bf16(__builtin_bit_cast(bf16x8, vw), pf, ot[db], 0, 0, 0); } }
    LAS unsigned char* ost = lds + AT_L_OST + wave * (32 * 144);
#pragma unroll
    for (int db = 0; db < 2; ++db)
#pragma unroll
        for (int g4 = 0; g4 < 4; ++g4) { u32x2 w; w.x = pk2(ot[db][4 * g4] * inv, ot[db][4 * g4 + 1] * inv); w.y = pk2(ot[db][4 * g4 + 2] * inv, ot[db][4 * g4 + 3] * inv);
            *(LAS u32x2*)(ost + r32 * 144 + 2 * (db * 32 + 8 * g4 + 4 * hh)) = w; }
    LDS_WAIT();
#pragma unroll
    for (int i = 0; i < 4; ++i) { const int q = 8 * i + (lane >> 3), c = lane & 7; const u32x4 w = *(const LAS u32x4*)(ost + q * 144 + 16 * c);
        *(u32x4*)(orow0 + (size_t)q * D + 8 * c) = w; }
    LDS_WAIT();
}

__global__ void __launch_bounds__(NTHR, 2) fwd_kernel(Params p) {
    extern __shared__ __attribute__((aligned(16))) unsigned char lds_raw[];
    LAS unsigned char* lds = (LAS unsigned char*)lds_raw;
    volatile LAS unsigned* MISC = (volatile LAS unsigned*)(lds + LDS_MISC_OFF);
    const int tid = threadIdx.x, lane = tid & 63, wave = __builtin_amdgcn_readfirstlane(tid >> 6);
    const int G = gridDim.x, bx = blockIdx.x;
    const int vcu = (G % 8 == 0) ? (bx % 8) * (G / 8) + bx / 8 : bx;
    const int gw = vcu * NWAVES + wave, NGW = G * NWAVES;
    unsigned char* ws = p.ws;
    unsigned* ctl = (unsigned*)(ws + WS_CTL);
    if (tid < 64) MISC[tid] = 0u;
    __syncthreads();
    XcdBarrier bar; bar.bar = ctl + CW_BAR; bar.x = 0; bar.st = nullptr;
    if (MK_N_LAUNCHES == 1) bar = xcd_barrier_post(ctl + CW_BAR, MISC + 8);
    const int lo = p.ph_lo, hi = p.ph_hi;
#define IN(k) (lo <= (k) && (k) < hi)
    unsigned long long prb_c0 = 0, prb_r0 = 0, prb_c1 = 0, prb_r1 = 0;
#define PRB_BEGIN(k) do { if (PROBE_PH == (k)) { prb_c0 = __builtin_amdgcn_s_memtime(); prb_r0 = __builtin_amdgcn_s_memrealtime(); } } while (0)
#define PRB_END2(k) do { if (PROBE_PH == (k) && PROBE_MODE == 3) { prb_c1 = __builtin_amdgcn_s_memtime(); prb_r1 = __builtin_amdgcn_s_memrealtime(); } } while (0)
#define PRB_END(k) do { if (PROBE_PH == (k) && PROBE_MODE != 3) { prb_c1 = __builtin_amdgcn_s_memtime(); prb_r1 = __builtin_amdgcn_s_memrealtime(); } } while (0)
#define SEAM(k) do { if (MK_N_LAUNCHES == 1 && IN((k) + 1)) xcd_barrier(bar); } while (0)

    bf16_t* Win_t = (bf16_t*)(ws + WS_WIN); bf16_t* Wout_t = (bf16_t*)(ws + WS_WOUT); bf16_t* Wgu_t = (bf16_t*)(ws + WS_WGU); bf16_t* Wd_t = (bf16_t*)(ws + WS_WD);
    bf16_t* Wqkv_t = (bf16_t*)(ws + WS_WQKV); bf16_t* Wo_t = (bf16_t*)(ws + WS_WO); bf16_t* Wegu_t = (bf16_t*)(ws + WS_WEGU); bf16_t* Wed_t = (bf16_t*)(ws + WS_WED);
    bf16_t* XN = (bf16_t*)(ws + WS_XN); bf16_t* PROJ = (bf16_t*)(ws + WS_PROJ); bf16_t* MIXED = (bf16_t*)(ws + WS_MIXED); bf16_t* Hb = (bf16_t*)(ws + WS_H);
    bf16_t* QKV = (bf16_t*)(ws + WS_QKV); bf16_t* AO = (bf16_t*)(ws + WS_AO); bf16_t* HS = (bf16_t*)(ws + WS_HS); bf16_t* H2 = (bf16_t*)(ws + WS_H2);
    float* bias_tab = (float*)(ws + WS_BIAS); int* wgcnt = (int*)(ws + WS_WGCNT); int* tilemeta = (int*)(ws + WS_TILE);
    u32x2* slot_rec = (u32x2*)(ws + WS_SLOTT);
    float* rss = (float*)(ws + WS_RSS);
    float* X = p.out;

    PRB_BEGIN(0);
    if (IN(0)) for (int rep_ = 0; rep_ < NREP(0); ++rep_) {
        const int tid = fresh_tid(), lane = tid & 63;
        LAS unsigned char* scr = lds + wave * 8704;
        constexpr int T_WIN = 16 * 32, T_WOUT = 8 * 16, T_FG = 16 * 44, T_FD = 44 * 16, T_QKV = 16 * 20, T_WO = 16 * 16;
        constexpr int NT = T_WIN + T_WOUT + 2 * T_FG + T_FD + T_QKV + T_WO;
        unsigned char* Wegu8 = (unsigned char*)Wegu_t; unsigned char* Wed8 = (unsigned char*)Wed_t;
        PRB_BEGIN(100);
        {
            constexpr int NTW = MOE_GU_FP6 ? NEXP * 112 : NEXP * 336;
            f32x4 ta[16], tb[16], tc[16]; P0WTile da{}, db{}, dc{};
            int t = bx; int pb = 0;
#define P0W_LOAD(dd, rr, ti) do { if ((ti) < NTW) { dd = p0w_desc((ti), p.in[I_EG], p.in[I_EU], p.in[I_ED], Wegu8, Wed8); p0w_load(dd, wave, lane, rr); } } while (0)
#define P0W_DRAIN(dd, rr) do { p0w_to_lds(rr, lds + pb * 32768, wave, lane, dd.scale); __syncthreads(); p0w_store(dd, lds + pb * 32768, wave, lane); pb ^= 1; } while (0)
            P0W_LOAD(da, ta, t); P0W_LOAD(db, tb, t + G);
            while (t < NTW) {
                P0W_LOAD(dc, tc, t + 2 * G); P0W_DRAIN(da, ta); if (t + G >= NTW) break;
                P0W_LOAD(da, ta, t + 3 * G); P0W_DRAIN(db, tb); if (t + 2 * G >= NTW) break;
                P0W_LOAD(db, tb, t + 4 * G); P0W_DRAIN(dc, tc);
                t += 3 * G;
            }
#undef P0W_LOAD
#undef P0W_DRAIN
            __syncthreads();
        }
#if MOE_GU_FP6
        {
            constexpr int NT6 = NEXP * 224;
            f32x2 ta[32], tb[32], tc[32]; P0W6 da{}, db{}, dc{};
            int t = bx; int pb = 0;
#define P0W6_LOAD(dd, rr, ti) do { if ((ti) < NT6) { dd = p0w6_desc((ti), p.in[I_EG], p.in[I_EU], Wegu8); p0w6_load(dd, wave, lane, rr); } } while (0)
#define P0W6_DRAIN(dd, rr) do { p0w6_to_lds(rr, lds + pb * 34816, wave, lane, dd.scale); __syncthreads(); p0w6_store(dd, lds + pb * 34816, tid); pb ^= 1; } while (0)
            P0W6_LOAD(da, ta, t); P0W6_LOAD(db, tb, t + G);
            while (t < NT6) {
                P0W6_LOAD(dc, tc, t + 2 * G); P0W6_DRAIN(da, ta); if (t + G >= NT6) break;
                P0W6_LOAD(da, ta, t + 3 * G); P0W6_DRAIN(db, tb); if (t + 2 * G >= NT6) break;
                P0W6_LOAD(db, tb, t + 4 * G); P0W6_DRAIN(dc, tc);
                t += 3 * G;
            }
#undef P0W6_LOAD
#undef P0W6_DRAIN
            __syncthreads();
        }
#endif
        PRB_END(100); PRB_BEGIN(101);
        for (int it = (gw + NGW / 2) % NGW; it < NT; it += NGW) {
            int r = it;
            if (r < T_WIN) { const int kb = r / 32, nb = r % 32; p0_tile(p.in[I_WIN], MIXN, 64 * kb, 64 * nb, Win_t + (size_t)(64 * nb) * D + 64 * kb, D, scr, lane, p.in[I_EVNM]); continue; } r -= T_WIN;
            if (r < T_WOUT) { const int kb = 8 + r / 16, nb = r % 16; p0_tile(p.in[I_WOUT], D, 64 * kb, 64 * nb, Wout_t + (size_t)(64 * nb) * D + 64 * kb, D, scr, lane); continue; } r -= T_WOUT;
            if (r < 2 * T_FG) { const int up = r >= T_FG; const int q = up ? r - T_FG : r; const int kb = q / 44, nb = q % 44, n0 = 64 * nb;
                p0_tile(p.in[up ? I_FU : I_FG], DFF, 64 * kb, n0, Wgu_t + (size_t)((n0 / 128) * 256 + (n0 % 128) + (up ? 128 : 0)) * D + 64 * kb, D, scr, lane, p.in[I_EVNF], up ? 1.0f : -1.44269504089f); continue; } r -= 2 * T_FG;
            if (r < T_FD) { const int kb = r / 16, nb = r % 16; p0_tile(p.in[I_FD], D, 64 * kb, 64 * nb, Wd_t + (size_t)(64 * nb) * DFF + 64 * kb, DFF, scr, lane, nullptr, -0.69314718056f); continue; } r -= T_FD;
            if (r < T_QKV) { const int kb = r / 20, nb = r % 20; p0_tile(p.in[I_WQKV], QKVN, 64 * kb, 64 * nb, Wqkv_t + (size_t)(64 * nb) * D + 64 * kb, D, scr, lane, p.in[I_ODNM]); continue; } r -= T_QKV;
            { const int kb = r / 16, nb = r % 16; p0_tile(p.in[I_WO], D, 64 * kb, 64 * nb, Wo_t + (size_t)(64 * nb) * D + 64 * kb, D, scr, lane); }
        }
        PRB_END(101); PRB_BEGIN(102);
        for (int it = gw; it < 4 * 32 * 16; it += NGW) {
            const int g = it >> 9, cb = (it >> 4) & 31, nb = it & 15; const int n = 64 * nb + lane, c0 = 4 * cb;
            const float* wo = p.in[I_WOUT] + (size_t)(g * 128) * D + n; const float* ps = p.in[I_POOLS] + g * 128; const float* pw = p.in[I_POOLW] + (size_t)(g * 128 + c0) * 128;
            float acc[4] = {0.f, 0.f, 0.f, 0.f};
            for (int d0 = 0; d0 < 128; d0 += 64) {
                float w[64];
#pragma unroll
                for (int j = 0; j < 64; ++j) w[j] = wo[(size_t)(d0 + j) * D];
#pragma unroll
                for (int j = 0; j < 64; ++j) { const float ww = w[j] * ps[d0 + j];
#pragma unroll
                    for (int cc = 0; cc < 4; ++cc) acc[cc] += pw[cc * 128 + d0 + j] * ww; } }
            u32x2 o; o.x = pk2(acc[0], acc[1]); o.y = pk2(acc[2], acc[3]);
            *(u32x2*)(Wout_t + (size_t)n * D + g * 128 + c0) = o;
        }
        PRB_END(102); PRB_BEGIN(103);
        for (int m = gw; m < M; m += NGW) {
            const float* xrow = p.in[I_X] + (size_t)m * D; f32x4 v[4];
#pragma unroll
            for (int j = 0; j < 2; ++j) { v[2 * j] = __builtin_nontemporal_load((const f32x4*)(xrow + 512 * j + 8 * lane)); v[2 * j + 1] = __builtin_nontemporal_load((const f32x4*)(xrow + 512 * j + 8 * lane + 4)); }
            float s2 = 0.f;
#pragma unroll
            for (int j = 0; j < 4; ++j) s2 += (v[j][0] * v[j][0] + v[j][1] * v[j][1]) + (v[j][2] * v[j][2] + v[j][3] * v[j][3]);
            s2 = wave_sum(s2);
#pragma unroll
            for (int j = 0; j < 2; ++j) { u32x4 w; w.x = pk2(v[2 * j][0], v[2 * j][1]); w.y = pk2(v[2 * j][2], v[2 * j][3]); w.z = pk2(v[2 * j + 1][0], v[2 * j + 1][1]); w.w = pk2(v[2 * j + 1][2], v[2 * j + 1][3]);
                *(u32x4*)(XN + (size_t)m * D + 512 * j + 8 * lane) = w; }
            if (lane == 0) *(f32x4*)(rss + (size_t)m * 4) = (f32x4){s2, 0.f, 0.f, 0.f};
        }
        PRB_END(103);
        for (int i = bx * NTHR + tid; i < NQH * 256; i += G * NTHR) { const int h = i >> 8, idx = i & 255; bias_tab[i] = idx < 255 ? p.in[I_RELB][t5_bucket(idx - 191) * NQH + h] : 0.f; }
    }
    PRB_END(0);
    SEAM(0);
    PRB_END2(0);
    PRB_BEGIN(1);

    if (IN(1)) for (int rep_ = 0; rep_ < NREP(1); ++rep_) { pg8::Gemm g{XN, Win_t, 2 * D, 2 * D, 2 * D}; pg8::DenseOrder S; S.init(M, MIXN, G, bx, (LAS int*)(lds + LDS_UTAB_OFF)); pg8::EpiBf16 E{PROJ, MIXN, nullptr, rss};
        pg8::gemm_phase<pg8::EpiBf16, pg8::DenseOrder>(lds, g, S, E); }
    PRB_END(1);
    SEAM(1);
    PRB_END2(1);
    PRB_BEGIN(2);

    if (IN(2)) for (int rep_ = 0; rep_ < NREP(2); ++rep_) {
        const int tid = fresh_tid(), lane = tid & 63;
        for (int unit = gw; unit < (M / 32) * 2; unit += NGW) {
            const int rb = unit >> 1, half = unit & 1, r0 = rb * 32, bs = r0 & ~(SEQ - 1);
            if (half == 0) {
                const int w = 2 << (lane >> 4); const bf16_t* P = PROJ + 8 * lane;
                float s[8];
#pragma unroll
                for (int q = 0; q < 8; ++q) s[q] = 0.f;
                for (int j = 1; j <= 16; ++j) if (j <= w && r0 - j >= bs) { float f[8]; unpack8(*(const u32x4*)(P + (size_t)(r0 - j) * MIXN), f);
#pragma unroll
                    for (int q = 0; q < 8; ++q) s[q] += f[q]; }
#pragma unroll 8
                for (int r = r0; r < r0 + 32; ++r) {
                    float cur[8], old[8]; unpack8(*(const u32x4*)(P + (size_t)r * MIXN), cur);
                    const bool has_old = (r - w >= bs);
                    if (has_old) unpack8(*(const u32x4*)(P + (size_t)(r - w) * MIXN), old);
                    const int pos = r - bs + 1; const float inv = 1.0f / (float)(pos < w ? pos : w);
                    float o[8];
#pragma unroll
                    for (int q = 0; q < 8; ++q) { s[q] += cur[q]; if (has_old) s[q] -= old[q]; o[q] = s[q] * inv - cur[q]; }
                    *(u32x4*)(MIXED + (size_t)r * D + 8 * lane) = pack8(o);
                }
            } else {
                const bf16_t* P = PROJ + 8 * lane;
                float w0[8], w1[8], w2[8], z1[8], z2[8];
                { const float* cw = p.in[I_CONVW] + 8 * lane;
#pragma unroll
                  for (int q = 0; q < 8; ++q) { w0[q] = cw[q]; w1[q] = cw[512 + q]; w2[q] = cw[1024 + q]; z1[q] = 0.f; z2[q] = 0.f; } }
                if (r0 - 1 >= bs) { float a[8], b[8]; unpack8(*(const u32x4*)(P + (size_t)(r0 - 1) * MIXN + 1024), a); unpack8(*(const u32x4*)(P + (size_t)(r0 - 1) * MIXN + 1536), b);
#pragma unroll
                    for (int q = 0; q < 8; ++q) z1[q] = a[q] * b[q]; }
                if (r0 - 2 >= bs) { float a[8], b[8]; unpack8(*(const u32x4*)(P + (size_t)(r0 - 2) * MIXN + 1024), a); unpack8(*(const u32x4*)(P + (size_t)(r0 - 2) * MIXN + 1536), b);
#pragma unroll
                    for (int q = 0; q < 8; ++q) z2[q] = a[q] * b[q]; }
#pragma unroll 8
                for (int r = r0; r < r0 + 32; ++r) {
                    float gp[8], a[8], b[8], o[8];
                    unpack8(*(const u32x4*)(P + (size_t)r * MIXN + 512), gp); unpack8(*(const u32x4*)(P + (size_t)r * MIXN + 1024), a); unpack8(*(const u32x4*)(P + (size_t)r * MIXN + 1536), b);
#pragma unroll
                    for (int q = 0; q < 8; ++q) { const float zc = a[q] * b[q]; o[q] = gp[q] * (w0[q] * z2[q] + w1[q] * z1[q] + w2[q] * zc); z2[q] = z1[q]; z1[q] = zc; }
                    *(u32x4*)(MIXED + (size_t)r * D + 512 + 8 * lane) = pack8(o);
                }
            }
        }
    }
    PRB_END(2);
    SEAM(2);
    PRB_END2(2);
    PRB_BEGIN(3);

    if (IN(3)) for (int rep_ = 0; rep_ < NREP(3); ++rep_) { pg8::Gemm g{MIXED, Wout_t, 2 * D, 2 * D, 2 * D}; pg8::DenseOrder S; S.init(M, D, G, bx, (LAS int*)(lds + LDS_UTAB_OFF)); pg8::EpiResid<false> E{XN, XN, nullptr, rss + (size_t)M * 4, lds + LDS_XTAB_OFF};
        pg8::gemm_phase<pg8::EpiResid<false>, pg8::DenseOrder>(lds, g, S, E); }
    PRB_END(3);
    SEAM(3);
    PRB_END2(3);
    PRB_BEGIN(5);


    if (IN(5)) for (int rep_ = 0; rep_ < NREP(5); ++rep_) { pg8::Gemm g{XN, Wgu_t, 2 * D, 2 * D, 2 * D}; pg8::DenseOrder S; S.init(M, 2 * DFF, G, bx, (LAS int*)(lds + LDS_UTAB_OFF)); pg8::EpiSwiGLU E{Hb, DFF, rss + (size_t)M * 4};
        pg8::gemm_phase<pg8::EpiSwiGLU, pg8::DenseOrder>(lds, g, S, E);
#if PROBE_KDBG >= 0
        __syncthreads(); PRB_BEGIN(105);
        { pg8::EpiNull16 E2{(float*)(ws + WS_RSS)}; pg8::gemm_phase<pg8::EpiNull16, pg8::DenseOrder, false, true, true, PROBE_KDBG>(lds, g, S, E2); }
        PRB_END(105);
#endif
    }
    PRB_END(5);
    SEAM(5);
    PRB_END2(5);
    PRB_BEGIN(6);

    if (IN(6)) for (int rep_ = 0; rep_ < NREP(6); ++rep_) { pg8::Gemm g{Hb, Wd_t, 2 * DFF, 2 * DFF, 2 * DFF}; pg8::DenseOrder S; S.init(M, D, G, bx, (LAS int*)(lds + LDS_UTAB_OFF)); pg8::EpiResid<false> E{XN, XN, nullptr, rss + (size_t)M * 8, lds + LDS_XTAB_OFF};
        pg8::gemm_phase<pg8::EpiResid<false>, pg8::DenseOrder>(lds, g, S, E); }
    PRB_END(6);
    SEAM(6);
    PRB_END2(6);
    PRB_BEGIN(8);


    if (IN(8)) for (int rep_ = 0; rep_ < NREP(8); ++rep_) { pg8::Gemm g{XN, Wqkv_t, 2 * D, 2 * D, 2 * D}; pg8::DenseOrder S; S.init(M, QKVN, G, bx, (LAS int*)(lds + LDS_UTAB_OFF)); pg8::EpiBf16 E{QKV, QKVN, p.in[I_BQKV], rss + (size_t)M * 8};
        pg8::gemm_phase<pg8::EpiBf16, pg8::DenseOrder>(lds, g, S, E); }
    PRB_END(8);
    SEAM(8);
    PRB_END2(8);
    PRB_BEGIN(9);

    if (IN(9)) for (int rep_ = 0; rep_ < NREP(9); ++rep_) {
        const int tid = fresh_tid(), lane = tid & 63;
        for (int i = tid; i < NQH * 256; i += NTHR) *(LAS float*)(lds + AT_L_BT + 4 * i) = bias_tab[i] * 1.44269504089f;
        const int r32 = lane & 31, hh = lane >> 5;
        constexpr int NUNIT = BATCH * (SEQ / CHUNK) * NKVH;
        u32x4 kr[3], vr[3]; bf16x8 qfA[4], qfB[4];
#define AT_KV_LOAD(unit_) do { const int tid_ = fresh_tid(); const int kvh_ = (unit_) & 1, n_ = ((unit_) >> 1) & 255, t0_ = ((unit_) >> 9) * SEQ + n_ * CHUNK; _Pragma("unroll") for (int i = 0; i < 3; ++i) { const int pc = tid_ + i * NTHR, j = pc >> 3, c = pc & 7; \
            kr[i] = (u32x4){0u, 0u, 0u, 0u}; vr[i] = (u32x4){0u, 0u, 0u, 0u}; \
            if (n_ * CHUNK - 128 + j >= 0) { const bf16_t* src = QKV + (size_t)(t0_ - 128 + j) * QKVN + 1024 + kvh_ * HD + 8 * c; kr[i] = *(const u32x4*)src; vr[i] = *(const u32x4*)(src + 128); } } } while (0)
#define AT_Q_LOAD(qf_, unit_, qb_) do { const int l_ = fresh_tid() & 63; const int r32 = l_ & 31, hh = l_ >> 5; const int kvh_ = (unit_) & 1, n_ = ((unit_) >> 1) & 255, t0_ = ((unit_) >> 9) * SEQ + n_ * CHUNK; \
            const bf16_t* qp = QKV + (size_t)(t0_ + (qb_) * 32 + r32) * QKVN + (kvh_ * 8 + wave) * HD + 8 * hh; _Pragma("unroll") for (int ks = 0; ks < 4; ++ks) qf_[ks] = *(const bf16x8*)(qp + 16 * ks); } while (0)
        int unit = vcu;
        if (unit < NUNIT) { AT_KV_LOAD(unit); AT_Q_LOAD(qfA, unit, 0); }
        for (; unit < NUNIT; unit += G) {
            const int kvh = unit & 1, n = (unit >> 1) & 255, b = unit >> 9;
            const int t0 = b * SEQ + n * CHUNK;
            const bool has_next = unit + G < NUNIT;
            __syncthreads();
            const int tid_s = fresh_tid();
#pragma unroll
            for (int i = 0; i < 3; ++i) { const int pc = tid_s + i * NTHR, j = pc >> 3, c = pc & 7;
                *(LAS u32x4*)(lds + AT_L_K + j * AT_KS_STR + 16 * c) = kr[i];
                const unsigned vw[4] = {vr[i].x, vr[i].y, vr[i].z, vr[i].w};
                const bool odd = (j & 1) != 0;
                const unsigned m0 = odd ? vw[2] : vw[0], m1 = odd ? vw[3] : vw[1];
                const unsigned o0 = __shfl_xor(odd ? vw[0] : vw[2], 8), o1 = __shfl_xor(odd ? vw[1] : vw[3], 8);
                const unsigned e0 = odd ? o0 : m0, e1 = odd ? o1 : m1, d0 = odd ? m0 : o0, d1 = odd ? m1 : o1;
                LAS unsigned char* vb = lds + AT_L_VT + (8 * c + (odd ? 4 : 0)) * AT_VT_STR + 2 * (j & ~1);
                *(LAS unsigned*)(vb + 0 * AT_VT_STR) = (e0 & 0xffffu) | (d0 << 16);
                *(LAS unsigned*)(vb + 1 * AT_VT_STR) = (e0 >> 16) | (d0 & 0xffff0000u);
                *(LAS unsigned*)(vb + 2 * AT_VT_STR) = (e1 & 0xffffu) | (d1 << 16);
                *(LAS unsigned*)(vb + 3 * AT_VT_STR) = (e1 >> 16) | (d1 & 0xffff0000u); }
            AT_Q_LOAD(qfB, unit, 1);
            __syncthreads();
            const int head = kvh * 8 + wave;
            const float sink = p.in[I_SINK][head];
            const int kb_min = n == 0 ? 4 : (n == 1 ? 2 : 0);
            attn_qblock(lds, qfA, AO + (size_t)t0 * D + head * HD, head, 0, kb_min, sink, wave, fresh_tid() & 63);
            if (has_next) { AT_KV_LOAD(unit + G); AT_Q_LOAD(qfA, unit + G, 0); }
            attn_qblock(lds, qfB, AO + (size_t)(t0 + 32) * D + head * HD, head, 1, kb_min, sink, wave, fresh_tid() & 63);
        }
#undef AT_KV_LOAD
#undef AT_Q_LOAD
        __syncthreads();
    }
    PRB_END(9);
    SEAM(9);
    PRB_END2(9);
    PRB_BEGIN(10);

    if (IN(10)) for (int rep_ = 0; rep_ < NREP(10); ++rep_) { pg8::Gemm g{AO, Wo_t, 2 * D, 2 * D, 2 * D}; pg8::DenseOrder S; S.init(M, D, G, bx, (LAS int*)(lds + LDS_UTAB_OFF)); pg8::EpiResid<false> E{XN, XN, p.in[I_BO], nullptr, nullptr};
        pg8::gemm_phase<pg8::EpiResid<false>, pg8::DenseOrder>(lds, g, S, E); }
    PRB_END(10);
    SEAM(10);
    PRB_END2(10);
    PRB_BEGIN(11);

    const int RPW = (M + G - 1) / G;
    constexpr int L_RW = 0, L_RE = 32768, L_RWT = L_RE + 1024 * 4, L_RRK = L_RWT + 1024 * 4, L_CNT = L_RRK + 1024 * 4, L_SB = L_CNT + 64, L_SLOT = L_SB + 256;
    unsigned char* XN8 = (unsigned char*)p.out;
    if (IN(11)) for (int rep_ = 0; rep_ < NREP(11); ++rep_) {
        const int tid = fresh_tid(), lane = tid & 63;
        if (tid < 8) *(LAS int*)(lds + L_CNT + 4 * tid) = 0;
        const int rbase = bx * RPW;
        const int nrows = (M - rbase) < RPW ? (M - rbase) : RPW;
        f32x4 gn[4], wA[4][4], wB[4][4];
#pragma unroll
        for (int j = 0; j < 4; ++j) { gn[j] = *(const f32x4*)(p.in[I_ODNF] + 16 * lane + 4 * j);
#pragma unroll
            for (int q = 0; q < 4; ++q) { const float* wr = p.in[I_ROUTER] + (size_t)(16 * lane + 4 * j + q) * NEXP; wA[j][q] = *(const f32x4*)wr * gn[j][q]; wB[j][q] = *(const f32x4*)(wr + 4) * gn[j][q]; } }
        const bool h5 = (lane & 32) != 0, h4 = (lane & 16) != 0, h3 = (lane & 8) != 0;
        for (int rl0 = wave; rl0 < nrows; rl0 += 4 * NWAVES) {
            u32x4 pv[4][2];
#pragma unroll
            for (int u = 0; u < 4; ++u) { const int rl = rl0 + 8 * u; const int m = rbase + (rl < nrows ? rl : rl0);
#pragma unroll
                for (int hq = 0; hq < 2; ++hq) pv[u][hq] = __builtin_nontemporal_load((const u32x4*)(XN + (size_t)m * D + 16 * lane + 8 * hq)); }
#pragma unroll
            for (int u = 0; u < 4; ++u) { const int rl = rl0 + 8 * u; if (rl >= nrows) continue; const int m = rbase + rl;
                f32x4 x[4];
#pragma unroll
                for (int hq = 0; hq < 2; ++hq) { x[2 * hq] = (f32x4){bf_lo(pv[u][hq].x), bf_hi(pv[u][hq].x), bf_lo(pv[u][hq].y), bf_hi(pv[u][hq].y)}; x[2 * hq + 1] = (f32x4){bf_lo(pv[u][hq].z), bf_hi(pv[u][hq].z), bf_lo(pv[u][hq].w), bf_hi(pv[u][hq].w)}; }
                float s2 = 0.f; f32x4 la = {0.f, 0.f, 0.f, 0.f}, lb = {0.f, 0.f, 0.f, 0.f};
#pragma unroll
                for (int j = 0; j < 4; ++j) { s2 += (x[j][0] * x[j][0] + x[j][1] * x[j][1]) + (x[j][2] * x[j][2] + x[j][3] * x[j][3]);
#pragma unroll
                    for (int q = 0; q < 4; ++q) { la += wA[j][q] * x[j][q]; lb += wB[j][q] * x[j][q]; } }
                const float r = 1.0f / sqrtf(wave_sum(s2) * (1.0f / D) + RMS_EPS);
#if MOE_GU_FP6
                { unsigned own[8], w[16];
#pragma unroll
                  for (int j = 0; j < 4; ++j) { const f32x4 y = x[j] * (r * F6_ACT) * gn[j]; own[2 * j] = pk2(y[0], y[1]); own[2 * j + 1] = pk2(y[2], y[3]); }
                  const bool oddl = (lane & 1) != 0;
#pragma unroll
                  for (int i = 0; i < 8; ++i) { const unsigned pt = __shfl_xor(own[i], 1); w[i] = oddl ? pt : own[i]; w[8 + i] = oddl ? own[i] : pt; }
                  const i32x6 P = pk32_fp6(w);
                  const int pg = lane >> 1; unsigned char* gp = XN8 + (size_t)m * D + 128 * (pg >> 2) + 16 * (pg & 3) + (oddl ? 64 : 0);
                  *(u32x4*)gp = oddl ? (u32x4){(unsigned)P[4], (unsigned)P[5], 0u, 0u} : (u32x4){(unsigned)P[0], (unsigned)P[1], (unsigned)P[2], (unsigned)P[3]}; }
#else
                { u32x4 o;
                  { const f32x4 y = x[0] * r * gn[0]; o.x = pg8::pk4_fp8(y[0], y[1], y[2], y[3]); } { const f32x4 y = x[1] * r * gn[1]; o.y = pg8::pk4_fp8(y[0], y[1], y[2], y[3]); }
                  { const f32x4 y = x[2] * r * gn[2]; o.z = pg8::pk4_fp8(y[0], y[1], y[2], y[3]); } { const f32x4 y = x[3] * r * gn[3]; o.w = pg8::pk4_fp8(y[0], y[1], y[2], y[3]); }
                  *(u32x4*)(XN8 + (size_t)m * D + 16 * lane) = o; }
#endif
                float t4[4], s4[4];
#pragma unroll
                for (int i = 0; i < 4; ++i) { t4[i] = h5 ? lb[i] : la[i]; s4[i] = h5 ? la[i] : lb[i]; }
#pragma unroll
                for (int i = 0; i < 4; ++i) t4[i] += __shfl_xor(s4[i], 32);
                float t2[2], s2b[2];
#pragma unroll
                for (int i = 0; i < 2; ++i) { t2[i] = h4 ? t4[i + 2] : t4[i]; s2b[i] = h4 ? t4[i] : t4[i + 2]; }
#pragma unroll
                for (int i = 0; i < 2; ++i) t2[i] += __shfl_xor(s2b[i], 16);
                float t1 = h3 ? t2[1] : t2[0]; const float s1 = h3 ? t2[0] : t2[1];
                t1 += __shfl_xor(s1, 8); t1 += __shfl_xor(t1, 4); t1 += __shfl_xor(t1, 2); t1 += __shfl_xor(t1, 1);
                float lg[8];
#pragma unroll
                for (int e = 0; e < 8; ++e) lg[e] = __int_as_float(__builtin_amdgcn_readlane(__float_as_int(t1), 8 * e)) * r;
                int e0 = 0; float v0 = lg[0];
#pragma unroll
                for (int e = 1; e < 8; ++e) if (lg[e] > v0) { v0 = lg[e]; e0 = e; }
                int e1 = -1; float v1 = -3.0e38f;
#pragma unroll
                for (int e = 0; e < 8; ++e) if (e != e0 && lg[e] > v1) { v1 = lg[e]; e1 = e; }
                const float wt0 = 1.0f / (1.0f + __expf(v1 - v0));
                if (lane == 0) { *(LAS int*)(lds + L_RE + 8 * rl) = e0; *(LAS int*)(lds + L_RE + 8 * rl + 4) = e1; *(LAS float*)(lds + L_RWT + 8 * rl) = wt0; *(LAS float*)(lds + L_RWT + 8 * rl + 4) = 1.0f - wt0; }
            }
        }
        __syncthreads();
        { LAS int* wcnt = (LAS int*)(lds + L_SLOT);
          const int nent = 2 * nrows, nchunk = (nent + 63) >> 6;
          int rloc[2] = {0, 0}, emine[2] = {-1, -1};
#pragma unroll
          for (int cc = 0; cc < 2; ++cc) { const int chunk = wave + 8 * cc; if (chunk < nchunk) { const int en = chunk * 64 + lane; const int e = en < nent ? *(LAS int*)(lds + L_RE + 4 * en) : -1; emine[cc] = e;
#pragma unroll
              for (int ex = 0; ex < 8; ++ex) { const unsigned long long mk = __ballot(e == ex); if (e == ex) rloc[cc] = __popcll(mk & ((1ull << lane) - 1ull)); if (lane == 0) wcnt[chunk * 8 + ex] = __popcll(mk); } } }
          __syncthreads();
#pragma unroll
          for (int cc = 0; cc < 2; ++cc) { const int chunk = wave + 8 * cc; const int en = chunk * 64 + lane; if (chunk < nchunk && en < nent) { const int e = emine[cc]; int r = rloc[cc]; for (int c2 = 0; c2 < chunk; ++c2) r += wcnt[c2 * 8 + e]; *(LAS int*)(lds + L_RRK + 4 * en) = r; } }
          if (tid < 8) { int c = 0; for (int c2 = 0; c2 < nchunk; ++c2) c += wcnt[c2 * 8 + tid]; *(LAS int*)(lds + L_CNT + 4 * tid) = c; }
        }
        __syncthreads();
        if (tid < 8) wgcnt[bx * 8 + tid] = *(LAS int*)(lds + L_CNT + 4 * tid);
        __syncthreads();
    }
    PRB_END(11);
    SEAM(11);
    PRB_END2(11);
    PRB_BEGIN(12);

    if (IN(12)) for (int rep_ = 0; rep_ < NREP(12); ++rep_) {
        const int tid = fresh_tid(), lane = tid & 63;
        LAS int* sb = (LAS int*)(lds + L_SB);
        if (tid < 32) sb[tid] = 0;
        __syncthreads();
        for (int i = tid; i < G * 2; i += NTHR) { const int w = i >> 1, h4 = (i & 1) * 4; const u32x4 c = *(const u32x4*)(wgcnt + w * 8 + h4); const unsigned cv[4] = {c.x, c.y, c.z, c.w};
#pragma unroll
            for (int q = 0; q < 4; ++q) { __hip_atomic_fetch_add(sb + 16 + h4 + q, (int)cv[q], __ATOMIC_RELAXED, __HIP_MEMORY_SCOPE_WORKGROUP); if (w < bx) __hip_atomic_fetch_add(sb + 8 + h4 + q, (int)cv[q], __ATOMIC_RELAXED, __HIP_MEMORY_SCOPE_WORKGROUP); } }
        __syncthreads();
        if (tid == 0) { int base = 0; for (int e = 0; e < 8; ++e) { sb[e] = base; base += (sb[16 + e] + 255) & ~255; } sb[24] = base; }
        __syncthreads();
        const int rbase = bx * RPW;
        const int nrows = (M - rbase) < RPW ? (M - rbase) : RPW;
        unsigned char* HS8 = (unsigned char*)HS; int* tslot = (int*)(p.ws + WS_TSLOT);
        for (int en = tid; en < 2 * nrows; en += NTHR) { const int e = *(LAS int*)(lds + L_RE + 4 * en); const int slot = sb[e] + sb[8 + e] + *(LAS int*)(lds + L_RRK + 4 * en);
            *(LAS int*)(lds + L_SLOT + 4 * en) = slot; tslot[(en & 1) * M + rbase + (en >> 1)] = slot; u32x2 rec; rec.x = (unsigned)(2 * (rbase + (en >> 1)) + (en & 1)); rec.y = *(LAS unsigned*)(lds + L_RWT + 4 * en); slot_rec[slot] = rec; }
        __syncthreads();
        for (int en0 = wave; en0 < 2 * nrows; en0 += 4 * NWAVES) {
            u32x4 t[4];
#pragma unroll
            for (int u = 0; u < 4; ++u) { const int en = en0 + 8 * u; if (en < 2 * nrows) t[u] = *(const u32x4*)(XN8 + (size_t)(rbase + (en >> 1)) * D + 16 * lane); }
#pragma unroll
            for (int u = 0; u < 4; ++u) { const int en = en0 + 8 * u; if (en < 2 * nrows) *(u32x4*)(HS8 + (size_t)(*(LAS int*)(lds + L_SLOT + 4 * en)) * D + 16 * lane) = t[u]; } }
        if (bx == 0) {
            for (int e = 0; e < 8; ++e) { const int b0 = sb[e] + sb[16 + e], b1 = sb[e] + ((sb[16 + e] + 255) & ~255); for (int i = b0 + tid; i < b1; i += NTHR) { u32x2 rec; rec.x = 0xffffffffu; rec.y = 0u; slot_rec[i] = rec; } }
            const int nt_all = sb[24] >> 8;
            for (int j = tid; j < nt_all; j += NTHR) { int e = 0; for (int q = 1; q < 8; ++q) if ((j << 8) >= sb[q]) e = q; tilemeta[8 + j] = e; }
            if (tid == 0) { tilemeta[0] = nt_all; tilemeta[1] = nt_all; }
        }
        __syncthreads();
    }
    PRB_END(12);
    SEAM(12);
    PRB_END2(12);
    PRB_BEGIN(13);

    if (IN(13) || IN(14)) {
        const int tid = fresh_tid();
        for (int j = tid; j < 288; j += NTHR) *(LAS int*)(lds + LDS_TILE_OFF + 4 * j) = (j < MAXTILES + 8) ? tilemeta[j] : 0;
        __syncthreads();
    }
    const LAS int* tmeta = (const LAS int*)(lds + LDS_TILE_OFF);
    if (IN(13)) for (int rep_ = 0; rep_ < NREP(13); ++rep_) {
        const int nall = __builtin_amdgcn_readfirstlane(tmeta[0]);
        pg8::Gemm g{HS, Wegu_t, D, D, D}; pg8::MoeOrder S; S.T.init(nall, NFE_T, G, bx); S.tpe = NFE_T; S.tile_e = tmeta + 8; S.tab = (LAS int*)(lds + LDS_UTAB_OFF); S.prepare();
        pg8::EpiSwiGLU8 E{(unsigned char*)H2, DFE};
        pg8::gemm_phase<pg8::EpiSwiGLU8, pg8::MoeOrder, true, P13_ALIGN>(lds, g, S, E);
#if PROBE_K8 >= 0
        __syncthreads(); PRB_BEGIN(113);
        { pg8::EpiNull8<PROBE_K8_FMT> E2{(float*)(ws + WS_RSS)}; pg8::gemm_phase<pg8::EpiNull8<PROBE_K8_FMT>, pg8::MoeOrder, true, true, true, PROBE_K8>(lds, g, S, E2); }
        PRB_END(113);
#endif
    }
    PRB_END(13);
    SEAM(13);
    PRB_END2(13);
    PRB_BEGIN(14);
    const int TAILMODE = (G == 256);
    if (IN(14)) {
        const int nall = __builtin_amdgcn_readfirstlane(tmeta[0]);
        const int nfull = (TAILMODE && nall > 256) ? 256 : nall;
        { pg8::Gemm g{H2, Wed_t, DFE, DFE, DFE}; pg8::MoeOrder S; S.T.init(nfull, D / 256, G, bx); S.tpe = D / 256; S.tile_e = tmeta + 8; S.tab = (LAS int*)(lds + LDS_UTAB_OFF); S.prepare();
          pg8::EpiMoeDown E{(bf16_t*)(p.ws + WS_Y0), (const u32x2*)(p.ws + WS_SLOTT)};
          pg8::gemm_phase<pg8::EpiMoeDown, pg8::MoeOrder, true>(lds, g, S, E); }
        const int nall2 = __builtin_amdgcn_readfirstlane(tmeta[0]);
        const int nfull2 = (TAILMODE && nall2 > 256) ? 256 : nall2;
        if (nall2 > nfull2) {
            const int R = 4 * (nall2 - nfull2); const int NSL = (256 / R) < 14 ? (256 / R) : 14;
            const int c = bx, uidx = c / NSL, sl = c - uidx * NSL;
            const int p0 = 14 * sl / NSL, p1 = 14 * (sl + 1) / NSL;
            pg8::SingleOrder S; S.has = (uidx < R) && (p1 > p0); S.pm = nfull2 + (uidx >> 2); S.rm = S.pm; S.cn = uidx & 3;
            S.pn = __builtin_amdgcn_readfirstlane(tmeta[8 + (S.has ? S.pm : 0)]) * (D / 256) + S.cn;
            pg8::Gemm g{(const unsigned char*)H2 + 256 * p0, (const unsigned char*)Wed_t + 256 * p0, DFE, DFE, 256 * (p1 - p0)};
            pg8::EpiSlab E{(bf16_t*)(p.ws + WS_SLAB) + (size_t)c * 65536, (const u32x2*)(p.ws + WS_SLOTT)};
            pg8::gemm_phase<pg8::EpiSlab, pg8::SingleOrder, true>(lds, g, S, E);
        }
    }
    PRB_END(14);
    SEAM(14);
    PRB_END2(14);
    PRB_BEGIN(15);

    if (IN(15)) {
        const int lane = fresh_tid() & 63;
        const bf16_t* Y0 = (const bf16_t*)(ws + WS_Y0); const bf16_t* Y1 = (const bf16_t*)(ws + WS_Y1); const int* tslot = (const int*)(p.ws + WS_TSLOT); const bf16_t* slabs = (const bf16_t*)(p.ws + WS_SLAB);
        const int nall = tilemeta[0];
        const int nfull = (TAILMODE && nall > 256) ? 256 : nall;
        const int R = 4 * (nall - nfull); const int NSL = R > 0 ? ((256 / R) < 14 ? (256 / R) : 14) : 1;
        for (int m0 = gw; m0 < M; m0 += 2 * NGW) {
            u32x4 xr[2][2], yr[2][2][2]; int slot2[2][2];
#pragma unroll
            for (int rr = 0; rr < 2; ++rr) { const int m = (m0 + rr * NGW < M) ? m0 + rr * NGW : m0;
#pragma unroll
                for (int j = 0; j < 2; ++j) xr[rr][j] = __builtin_nontemporal_load((const u32x4*)(XN + (size_t)m * D + 512 * j + 8 * lane));
#pragma unroll
                for (int k = 0; k < 2; ++k) { slot2[rr][k] = tslot[k * M + m];
#pragma unroll
                    for (int j = 0; j < 2; ++j) yr[rr][k][j] = __builtin_nontemporal_load((const u32x4*)((k ? Y1 : Y0) + (size_t)m * D + 512 * j + 8 * lane)); } }
#pragma unroll
            for (int rr = 0; rr < 2; ++rr) { const int m = m0 + rr * NGW; if (m >= M) continue;
                float* xrow = X + (size_t)m * D; f32x4 v[4];
#pragma unroll
                for (int j = 0; j < 2; ++j) { float fx[8]; unpack8(xr[rr][j], fx); v[2 * j] = (f32x4){fx[0], fx[1], fx[2], fx[3]}; v[2 * j + 1] = (f32x4){fx[4], fx[5], fx[6], fx[7]}; }
#pragma unroll
                for (int k = 0; k < 2; ++k) {
                    const int slot = __builtin_amdgcn_readfirstlane(slot2[rr][k]); const int tile = slot >> 8;
                    if (tile < nfull) {
#pragma unroll
                        for (int j = 0; j < 2; ++j) { float f[8]; unpack8(yr[rr][k][j], f);
#pragma unroll
                            for (int q = 0; q < 4; ++q) { v[2 * j][q] += f[q]; v[2 * j + 1][q] += f[4 + q]; } }
                    } else {
#pragma unroll
                        for (int j = 0; j < 2; ++j) { const int col = 512 * j + 8 * lane; const int uidx = (tile - nfull) * 4 + (col >> 8);
                            const bf16_t* sp = slabs + ((size_t)uidx * NSL) * 65536 + (size_t)(slot & 255) * 256 + (col & 255);
#pragma unroll
                            for (int sb = 0; sb < 14; sb += 7) {
                                u32x4 sv[7];
#pragma unroll
                                for (int i = 0; i < 7; ++i) { const int sl = sb + i; sv[i] = (u32x4){0u, 0u, 0u, 0u}; if (sl < NSL && 14 * (sl + 1) / NSL > 14 * sl / NSL) sv[i] = *(const u32x4*)(sp + (size_t)sl * 65536); }
#pragma unroll
                                for (int i = 0; i < 7; ++i) { float f[8]; unpack8(sv[i], f);
#pragma unroll
                                    for (int q = 0; q < 4; ++q) { v[2 * j][q] += f[q]; v[2 * j + 1][q] += f[4 + q]; } } } }
                    }
                }
                float s2 = 0.f;
#pragma unroll
                for (int j = 0; j < 4; ++j) s2 += (v[j][0] * v[j][0] + v[j][1] * v[j][1]) + (v[j][2] * v[j][2] + v[j][3] * v[j][3]);
                const float r = 1.0f / sqrtf(wave_sum(s2) * (1.0f / D) + RMS_EPS);
#pragma unroll
                for (int j = 0; j < 2; ++j) { const f32x4 g0 = *(const f32x4*)(p.in[I_FINAL] + 512 * j + 8 * lane), g1 = *(const f32x4*)(p.in[I_FINAL] + 512 * j + 8 * lane + 4);
                    __builtin_nontemporal_store(v[2 * j] * r * g0, (f32x4*)(xrow + 512 * j + 8 * lane)); __builtin_nontemporal_store(v[2 * j + 1] * r * g1, (f32x4*)(xrow + 512 * j + 8 * lane + 4)); }
            }
        }
    }
    PRB_END(15);
    if (PROBE_PH >= 0 && bx == 0) {
        const unsigned long long dr = prb_r1 - prb_r0, dc = prb_c1 - prb_c0;
        const unsigned long long spin = (PROBE_MODE == 1) ? (dr ? dc * 10000ull / dr : 0ull) : 8ull * dr;
        const unsigned long long t0 = __builtin_amdgcn_s_memrealtime();
        while (__builtin_amdgcn_s_memrealtime() - t0 < spin) __builtin_amdgcn_s_sleep(8);
    }
#undef IN
#undef SEAM
}

extern "C" void kernel_launch(void* const* d_in, const int* in_sizes, int n_in, void* d_out, int out_size, void* d_ws, size_t ws_size, hipStream_t stream) {
    static int grid = 0;
    if (grid == 0) {
        if (n_in != 24 || in_sizes[0] != M * D || out_size != M * D || ws_size < WS_TOP) { fprintf(stderr, "kernel_launch: unexpected shapes (n_in %d, in0 %d, out %d, ws %zu < %zu)\n", n_in, n_in > 0 ? in_sizes[0] : -1, out_size, ws_size, (size_t)WS_TOP); grid = -1; return; }
        int dev = 0, cus = 0, per_cu = 0;
        if (hipGetDevice(&dev) != hipSuccess || hipDeviceGetAttribute(&cus, hipDeviceAttributeMultiprocessorCount, dev) != hipSuccess) { grid = -1; return; }
        if (hipFuncSetAttribute((const void*)fwd_kernel, hipFuncAttributeMaxDynamicSharedMemorySize, LDS_BYTES) != hipSuccess) { fprintf(stderr, "kernel_launch: hipFuncSetAttribute failed\n"); grid = -1; return; }
        if (hipOccupancyMaxActiveBlocksPerMultiprocessor(&per_cu, (const void*)fwd_kernel, NTHR, LDS_BYTES) != hipSuccess || per_cu < 1) fprintf(stderr, "kernel_launch: occupancy query reports %d\n", per_cu);
        (void)hipGetLastError();
        grid = cus < 256 ? cus : 256;
    }
    if (grid < 0) return;
    (void)hipMemsetAsync((char*)d_ws + WS_CTL, 0, CTL_ZERO_BYTES, stream);
    Params a{};
    for (int i = 0; i < 24; ++i) a.in[i] = (const float*)d_in[i];
    a.out = (float*)d_out; a.ws = (unsigned char*)d_ws;
    constexpr int NPH = 16;
    if (MK_N_LAUNCHES == 1) { a.ph_lo = 0; a.ph_hi = NPH; hipLaunchKernelGGL(fwd_kernel, dim3(grid), dim3(NTHR), LDS_BYTES, stream, a); }
    else for (int li = 0; li < NPH; ++li) { a.ph_lo = li; a.ph_hi = li + 1; hipLaunchKernelGGL(fwd_kernel, dim3(grid), dim3(NTHR), LDS_BYTES, stream, a); }
}
```
